# Optimizing an MI355X kernel written in HIP

```python
import jax
import jax.numpy as jnp
from jax import lax
import numpy as np

D_MODEL = 4096
BATCH = 1
SEQ = 16384
DEPTH = 4

D_PLE = 256
NORM_EPS = 1e-6
ROPE_THETA = 500000.0
ROPE_FRACTION = 4

GLA_HEADS = 12
GLA_DK = 64
GLA_DV = 128
GLA_WIDTH = GLA_HEADS * GLA_DV
GLA_RANK = 16
GLA_TAU = 16.0
GLA_CHUNK = 64

DSA_HEADS = 8
DSA_DH = 128
DSA_WIDTH = DSA_HEADS * DSA_DH
IDX_HEADS = 16
IDX_DIM = 64
TOPK_MAX = 256
Q_BLOCK = 128

MLSTM_HEADS = 6
MLSTM_DK = 128
MLSTM_DV = 256
MLSTM_WIDTH = MLSTM_HEADS * MLSTM_DV
MLSTM_CHUNK = 64
CONV_WIDTH = 4

MIX_WIDTH = GLA_WIDTH + DSA_WIDTH + MLSTM_WIDTH

COL_SPLITS = (
    GLA_HEADS * GLA_DK, GLA_HEADS * GLA_DK, GLA_WIDTH, GLA_RANK, GLA_WIDTH,
    DSA_WIDTH, DSA_WIDTH, DSA_WIDTH, DSA_WIDTH, IDX_HEADS * IDX_DIM, IDX_DIM, IDX_HEADS,
    MLSTM_HEADS * MLSTM_DK, MLSTM_HEADS * MLSTM_DK, MLSTM_WIDTH, MLSTM_HEADS, MLSTM_HEADS,
    MLSTM_WIDTH, MLSTM_WIDTH,
)
IN_WIDTH = sum(COL_SPLITS)

kernel_name = 'hymba_gla_dsa_mlstm_trunk'


def rmsnorm(x, g):
    x32 = x.astype(jnp.float32)
    y = x32 * lax.rsqrt(jnp.mean(x32 * x32, axis=-1, keepdims=True) + NORM_EPS)
    return (y * g.astype(jnp.float32)).astype(x.dtype)


def head_rmsnorm(y, gain):
    H, d = y.shape[-2:]
    y = y * lax.rsqrt(jnp.mean(y * y, axis=-1, keepdims=True) + NORM_EPS)
    y = y * gain.astype(jnp.float32).reshape(H, d)
    return y.reshape(y.shape[:-2] + (H * d,))


def split_columns(z):
    idx = np.cumsum(np.array(COL_SPLITS))[:-1].tolist()
    return jnp.split(z, idx, axis=-1)


def rope_tables(positions, rot_dim):
    inv = ROPE_THETA ** (-jnp.arange(0, rot_dim, 2, dtype=jnp.float32) / rot_dim)
    ang = positions.astype(jnp.float32)[..., None] * inv
    return jnp.cos(ang), jnp.sin(ang)


def apply_partial_rope(x, cos, sin):
    half = cos.shape[-1]
    rot = 2 * half
    x32 = x.astype(jnp.float32)
    x1, x2 = x32[..., :half], x32[..., half:rot]
    c, s = cos[:, :, None, :], sin[:, :, None, :]
    out = jnp.concatenate([x1 * c - x2 * s, x2 * c + x1 * s, x32[..., rot:]], axis=-1)
    return out.astype(x.dtype)


def causal_conv(x, w):
    K, C = w.shape
    return lax.conv_general_dilated(
        x, w[:, None, :].astype(x.dtype), window_strides=(1,), padding=[(K - 1, 0)],
        dimension_numbers=('NWC', 'WIO', 'NWC'), feature_group_count=C)


def to_chunks(t, n_heads, d, chunk):
    B, S = t.shape[:2]
    return t.reshape(B, S // chunk, chunk, n_heads, d).transpose(1, 0, 3, 2, 4)


def from_chunks(t):
    N, B, H, C, d = t.shape
    return t.transpose(1, 0, 3, 2, 4).reshape(B, N * C, H, d)


def gla_mixer(q, k, v, g_low, w_up, b_up, gain):
    B, S, _ = q.shape
    f32 = jnp.float32
    log_a = jax.nn.log_sigmoid((g_low @ w_up + b_up).astype(f32)) / GLA_TAU
    qc = to_chunks(q.astype(f32) * GLA_DK ** -0.5, GLA_HEADS, GLA_DK, GLA_CHUNK)
    kc = to_chunks(k.astype(f32), GLA_HEADS, GLA_DK, GLA_CHUNK)
    vc = to_chunks(v.astype(f32), GLA_HEADS, GLA_DV, GLA_CHUNK)
    gc = to_chunks(log_a, GLA_HEADS, GLA_DK, GLA_CHUNK)
    causal = jnp.tril(jnp.ones((GLA_CHUNK, GLA_CHUNK), dtype=bool))

    def step(state, inp):
        qi, ki, vi, gi = inp
        b = jnp.cumsum(gi, axis=2)
        b_end = b[:, :, -1, :]
        q_dec = qi * jnp.exp(b)
        scores = jnp.einsum('bhtd,bhsd->bhts', q_dec, ki * jnp.exp(-b))
        scores = jnp.where(causal, scores, 0.0)
        out = (jnp.einsum('bhtd,bhde->bhte', q_dec, state)
               + jnp.einsum('bhts,bhse->bhte', scores, vi))
        k_dec = ki * jnp.exp(b_end[:, :, None, :] - b)
        state = jnp.exp(b_end)[..., None] * state + jnp.einsum('bhsd,bhse->bhde', k_dec, vi)
        return state, out

    state0 = jnp.zeros((B, GLA_HEADS, GLA_DK, GLA_DV), f32)
    _, out = lax.scan(step, state0, (qc, kc, vc, gc))
    return head_rmsnorm(from_chunks(out), gain).astype(q.dtype)


def mlstm_mixer(q, k, v, i_pre, f_pre, o_pre, gain):
    B, S, _ = q.shape
    f32 = jnp.float32
    N, C = S // MLSTM_CHUNK, MLSTM_CHUNK
    qc = to_chunks(q.astype(f32) * MLSTM_DK ** -0.5, MLSTM_HEADS, MLSTM_DK, C)
    kc = to_chunks(k.astype(f32), MLSTM_HEADS, MLSTM_DK, C)
    vc = to_chunks(v.astype(f32), MLSTM_HEADS, MLSTM_DV, C)
    ic = i_pre.astype(f32).reshape(B, N, C, MLSTM_HEADS).transpose(1, 0, 3, 2)
    lfc = jax.nn.log_sigmoid(f_pre.astype(f32)).reshape(B, N, C, MLSTM_HEADS).transpose(1, 0, 3, 2)
    causal = jnp.tril(jnp.ones((C, C), dtype=bool))

    def step(carry, inp):
        c_st, n_st, m_st = carry
        qi, ki, vi, ii, lfi = inp
        b = jnp.cumsum(lfi, axis=-1)
        d_mat = jnp.where(causal, b[..., :, None] - b[..., None, :] + ii[..., None, :], -jnp.inf)
        inter = b + m_st[..., None]
        m = jnp.maximum(inter, jnp.max(d_mat, axis=-1))
        w_intra = jnp.exp(d_mat - m[..., None])
        w_inter = jnp.exp(inter - m)
        qk = jnp.einsum('bhtd,bhsd->bhts', qi, ki) * w_intra
        num = (w_inter[..., None] * jnp.einsum('bhtd,bhde->bhte', qi, c_st)
               + jnp.einsum('bhts,bhse->bhte', qk, vi))
        den = w_inter * jnp.einsum('bhtd,bhd->bht', qi, n_st) + jnp.sum(qk, axis=-1)
        h = num / jnp.maximum(jnp.abs(den), jnp.exp(-m))[..., None]
        b_end = b[..., -1]
        a_state = b_end + m_st
        a_in = b_end[..., None] - b + ii
        m_new = jnp.maximum(a_state, jnp.max(a_in, axis=-1))
        ws = jnp.exp(a_in - m_new[..., None])
        decay = jnp.exp(a_state - m_new)
        c_st = decay[..., None, None] * c_st + jnp.einsum('bhs,bhsd,bhse->bhde', ws, ki, vi)
        n_st = decay[..., None] * n_st + jnp.einsum('bhs,bhsd->bhd', ws, ki)
        return (c_st, n_st, m_new), h

    carry0 = (jnp.zeros((B, MLSTM_HEADS, MLSTM_DK, MLSTM_DV), f32),
              jnp.zeros((B, MLSTM_HEADS, MLSTM_DK), f32),
              jnp.zeros((B, MLSTM_HEADS), f32))
    _, h = lax.scan(step, carry0, (qc, kc, vc, ic, lfc))
    y = head_rmsnorm(from_chunks(h), gain) * jax.nn.sigmoid(o_pre.astype(f32))
    return y.astype(q.dtype)


def dsa_mixer(q, k, v, iq, ik, iw, cos_a, sin_a, cos_i, sin_i):
    B, S, _ = q.shape
    f32 = jnp.float32
    q = apply_partial_rope(q.reshape(B, S, DSA_HEADS, DSA_DH), cos_a, sin_a)
    k = apply_partial_rope(k.reshape(B, S, DSA_HEADS, DSA_DH), cos_a, sin_a)
    v = v.reshape(B, S, DSA_HEADS, DSA_DH)
    iq = apply_partial_rope(iq.reshape(B, S, IDX_HEADS, IDX_DIM), cos_i, sin_i).astype(f32)
    ik = apply_partial_rope(ik[:, :, None, :], cos_i, sin_i)[:, :, 0, :].astype(f32)
    iw = iw.astype(f32) * IDX_HEADS ** -0.5
    k_sel = min(TOPK_MAX, S // 4)
    nb = S // Q_BLOCK
    key_pos = jnp.arange(S)

    def blk(t):
        return t.reshape((B, nb, Q_BLOCK) + t.shape[2:]).swapaxes(0, 1)

    def attend(inp):
        qb, iqb, iwb, start = inp
        qpos = start + jnp.arange(Q_BLOCK)
        causal = key_pos[None, :] <= qpos[:, None]
        sc = jax.nn.relu(jnp.einsum('bqhd,bkd->bqhk', iqb, ik) * IDX_DIM ** -0.5)
        sc = jnp.einsum('bqhk,bqh->bqk', sc, iwb)
        sc = jnp.where(causal[None], sc, -jnp.inf)
        _, idx = lax.top_k(sc, k_sel)
        valid = idx <= qpos[None, :, None]
        ks = jax.vmap(lambda kk, ii: kk[ii])(k, idx)
        vs = jax.vmap(lambda vv, ii: vv[ii])(v, idx)
        logits = jnp.einsum('bqhd,bqkhd->bhqk', qb, ks).astype(f32) * DSA_DH ** -0.5
        logits = jnp.where(valid[:, None], logits, -jnp.inf)
        probs = jax.nn.softmax(logits, axis=-1)
        return jnp.einsum('bhqk,bqkhd->bqhd', probs.astype(vs.dtype), vs)

    starts = jnp.arange(nb) * Q_BLOCK
    out = lax.map(attend, (blk(q), blk(iq), blk(iw), starts))
    return out.swapaxes(0, 1).reshape(B, S, DSA_WIDTH)


def setup_inputs(seed: int = 0) -> dict:
    key = jax.random.key(seed)
    ks = jax.random.split(key, 17)
    f32 = jnp.float32

    def nrm(k, shape, scale):
        return scale * jax.random.normal(k, shape, f32)

    return {
        'x': nrm(ks[0], (BATCH, SEQ, D_MODEL), 1.0),
        'p': nrm(ks[1], (DEPTH, BATCH, SEQ, D_PLE), 1.0),
        'positions': jnp.broadcast_to(jnp.arange(SEQ, dtype=jnp.int32)[None, :], (BATCH, SEQ)),
        'g_in': 1.0 + nrm(ks[2], (DEPTH, D_MODEL), 0.02),
        'w_in': nrm(ks[3], (DEPTH, D_MODEL, IN_WIDTH), D_MODEL ** -0.5),
        'w_gla_up': nrm(ks[4], (DEPTH, GLA_RANK, GLA_HEADS * GLA_DK), GLA_RANK ** -0.5),
        'b_gla_up': nrm(ks[5], (DEPTH, GLA_HEADS * GLA_DK), 0.1),
        'g_gla_out': 1.0 + nrm(ks[6], (DEPTH, GLA_WIDTH), 0.02),
        'conv_q': nrm(ks[7], (DEPTH, CONV_WIDTH, MLSTM_HEADS * MLSTM_DK), CONV_WIDTH ** -0.5),
        'conv_k': nrm(ks[8], (DEPTH, CONV_WIDTH, MLSTM_HEADS * MLSTM_DK), CONV_WIDTH ** -0.5),
        'b_igate': nrm(ks[9], (DEPTH, MLSTM_HEADS), 0.1),
        'b_fgate': 3.0 + nrm(ks[10], (DEPTH, MLSTM_HEADS), 0.5),
        'g_mlstm_out': 1.0 + nrm(ks[11], (DEPTH, MLSTM_WIDTH), 0.02),
        'w_out': nrm(ks[12], (DEPTH, MIX_WIDTH, D_MODEL), MIX_WIDTH ** -0.5),
        'g_ple': 1.0 + nrm(ks[13], (DEPTH, D_MODEL), 0.02),
        'w_ple_gate': nrm(ks[14], (DEPTH, D_MODEL, D_MODEL), D_MODEL ** -0.5),
        'w_ple_proj': nrm(ks[15], (DEPTH, D_PLE, D_MODEL), D_PLE ** -0.5),
        'g_final': 1.0 + nrm(ks[16], (D_MODEL,), 0.02),
    }


def reference(x, p, positions, g_in, w_in, w_gla_up, b_gla_up, g_gla_out, conv_q, conv_k,
              b_igate, b_fgate, g_mlstm_out, w_out, g_ple, w_ple_gate, w_ple_proj, g_final):
    cos_a, sin_a = rope_tables(positions, DSA_DH // ROPE_FRACTION)
    cos_i, sin_i = rope_tables(positions, IDX_DIM // ROPE_FRACTION)
    h = x
    for i in range(DEPTH):
        u = rmsnorm(h, g_in[i])
        z = u @ w_in[i]
        (aq, ak, av, alow, agate,
         bq, bk, bv, bgate, biq, bik, biw,
         cq, ck, cv, ci, cf, co, cgate) = split_columns(z)
        ya = gla_mixer(aq, ak, av, alow, w_gla_up[i], b_gla_up[i], g_gla_out[i]) * jax.nn.silu(agate)
        yb = dsa_mixer(bq, bk, bv, biq, bik, biw, cos_a, sin_a, cos_i, sin_i) * jax.nn.silu(bgate)
        cq = jax.nn.silu(causal_conv(cq, conv_q[i]))
        ck = jax.nn.silu(causal_conv(ck, conv_k[i]))
        yc = mlstm_mixer(cq, ck, cv, ci + b_igate[i], cf + b_fgate[i], co, g_mlstm_out[i]) * jax.nn.silu(cgate)
        h = h + jnp.concatenate([ya, yb, yc], axis=-1) @ w_out[i]
        gate = jax.nn.sigmoid(rmsnorm(h, g_ple[i]) @ w_ple_gate[i])
        h = h + gate * (p[i] @ w_ple_proj[i])
    return rmsnorm(h, g_final)
```

```cpp
#include <hip/hip_runtime.h>
#include <cstdio>
#include <cstdint>
namespace pg8 {
#define PG8_LAS __attribute__((address_space(3)))
typedef unsigned short bf16_t;
typedef short bf16x8 __attribute__((ext_vector_type(8)));
typedef float f32x4 __attribute__((ext_vector_type(4)));
typedef unsigned u32x4 __attribute__((ext_vector_type(4)));
constexpr int BM = 256, BK = 64, HALF = 128, HTB = HALF * BK * 2  , STAGE_BYTES = 8 * HTB, NXCD = 8, WGM = 8;

__host__ __device__ __forceinline__ int lds_byte(int r, int c) { const int st = (r >> 4) * 2 + (c >> 5), rr = r & 15, cc = c & 31, ob = rr * 64 + cc * 2; return st * 1024 + (ob ^ (((ob >> 9) & 1) << 5)); }
__host__ __device__ __forceinline__ void stage_rc(int b, int& R, int& C) { const int st = b / 1024, sb = b % 1024, swz = sb ^ (((sb >> 9) & 1) << 5); R = (st >> 1) * 16 + swz / 64; C = (st & 1) * 32 + (swz % 64) / 2; }
__host__ __device__ __forceinline__ int perm32(int rho) { const int n = rho >> 4, i = rho & 15; return 8 * (i >> 2) + 4 * n + (i & 3); }

struct Unit { int pm, pn; };
struct Gemm { const bf16_t* A; const bf16_t* Bt; int M, N, K; };

struct StaticOrder {
    int nM, nN, nwg, G, c;
    __host__ __device__ void init(int M, int N, int G_, int c_) { nM = M / BM; nN = N / BM; nwg = nM * nN; G = G_; c = c_; }
    __host__ __device__ bool next(int i, Unit& u) const {
        const long L = (long)i * G + c; if (L >= nwg) return false;
        int wgid = (int)L; { const int q = nwg / NXCD, r = nwg % NXCD, xcd = wgid % NXCD, off = wgid / NXCD; wgid = (xcd < r ? xcd * (q + 1) : r * (q + 1) + (xcd - r) * q) + off; }
        const int nig = WGM * nN, gid = wgid / nig, fm = gid * WGM, gsz = (nM - fm) < WGM ? (nM - fm) : WGM;
        u.pm = fm + ((wgid % nig) % gsz); u.pn = (wgid % nig) / gsz; return true;
    }
    __device__ __forceinline__ void a_ready(const Unit&) const {}
    __device__ __forceinline__ void done(const Unit&) const {}
};

__device__ __forceinline__ unsigned cvt_pk_bf16(float lo, float hi) { unsigned r; asm volatile("v_cvt_pk_bf16_f32 %0, %1, %2" : "=v"(r) : "v"(lo), "v"(hi)); return r; }
typedef float f32x2 __attribute__((ext_vector_type(2)));
__device__ __forceinline__ f32x2 gelu_pk(f32x2 v) {
    const f32x2 av = __builtin_elementwise_abs(v), d = av * 0.2316418882f + 1.0f;
    f32x2 t; t.x = __builtin_amdgcn_rcpf(d.x); t.y = __builtin_amdgcn_rcpf(d.y);
    f32x2 q = t * 0.5307027145f + (-0.7265760135f); q = q * t + 0.7107068705f; q = q * t + (-0.142248368f); q = q * t + 0.127414796f; q = q * t;
    const f32x2 s = (v * v) * (-0.72134752044f);
    f32x2 e; e.x = __builtin_amdgcn_exp2f(s.x); e.y = __builtin_amdgcn_exp2f(s.y);
    const f32x2 m = v * (q * e), r = v - m;
    f32x2 o; o.x = v.x < 0.f ? m.x : r.x; o.y = v.y < 0.f ? m.y : r.y; return o;
}

template <int ACT  > struct EpiBf16 {
    static constexpr bool PERM = true, AFTER_DRAIN = false; static_assert(ACT == 0 || ACT == 1, "EpiBf16: ACT is 0 (none) or 1 (gelu_pk)");
    bf16_t* O; int ldc; const float* bias; int split_cols; size_t split_stride; float scale0;
    __device__ __forceinline__ void operator()(const f32x4 (&acc)[2][2][4][2], const Unit& u, int wr, int wc, int fr, int fq) const {
        const int row0 = u.pm * BM + wr * 64 + fr; int colt = u.pn * BM; bf16_t* base = O;
        float sc = 1.f; if (split_cols) { const int t = colt / split_cols; base += (size_t)t * split_stride; colt -= t * split_cols; if (t == 0) sc = scale0; }
        const int col0 = colt + wc * 32 + 8 * fq, bcol0 = u.pn * BM + wc * 32 + 8 * fq;
        f32x4 bv[2][2];
#pragma unroll
        for (int bj = 0; bj < 2; ++bj)
#pragma unroll
            for (int n = 0; n < 2; ++n) bv[bj][n] = bias ? *(const f32x4*)(bias + bcol0 + bj * HALF + 4 * n) : (f32x4){0.f, 0.f, 0.f, 0.f};
#pragma unroll
        for (int ai = 0; ai < 2; ++ai)
#pragma unroll
            for (int m = 0; m < 4; ++m) { bf16_t* rowp = base + (size_t)(row0 + ai * HALF + m * 16) * ldc + col0;
#pragma unroll
                for (int bj = 0; bj < 2; ++bj) { f32x4 v0 = acc[ai][bj][m][0] + bv[bj][0], v1 = acc[ai][bj][m][1] + bv[bj][1];
                    if (ACT == 1) { f32x2 a = gelu_pk((f32x2){v0[0], v0[1]}), b = gelu_pk((f32x2){v0[2], v0[3]}), c = gelu_pk((f32x2){v1[0], v1[1]}), d = gelu_pk((f32x2){v1[2], v1[3]});
                        v0 = (f32x4){a.x, a.y, b.x, b.y}; v1 = (f32x4){c.x, c.y, d.x, d.y}; }
                    v0 = v0 * sc; v1 = v1 * sc; u32x4 w; w.x = cvt_pk_bf16(v0[0], v0[1]); w.y = cvt_pk_bf16(v0[2], v0[3]); w.z = cvt_pk_bf16(v1[0], v1[1]); w.w = cvt_pk_bf16(v1[2], v1[3]);
                    *(u32x4*)(rowp + bj * HALF) = w; } }
    }
};

struct EpiResF32 {
    static constexpr bool PERM = false, AFTER_DRAIN = false;
    const float* base; float* out; int ldc;
    __device__ __forceinline__ void operator()(const f32x4 (&acc)[2][2][4][2], const Unit& u, int wr, int wc, int fr, int fq) const {
        const int row0 = u.pm * BM + wr * 64 + fr, col0 = u.pn * BM + wc * 32 + 4 * fq;
#pragma unroll
        for (int ai = 0; ai < 2; ++ai)
#pragma unroll
            for (int m = 0; m < 4; ++m) { const size_t off = (size_t)(row0 + ai * HALF + m * 16) * ldc + col0;
#pragma unroll
                for (int bj = 0; bj < 2; ++bj)
#pragma unroll
                    for (int n = 0; n < 2; ++n) { const f32x4 b = *(const f32x4*)(base + off + bj * HALF + n * 16); *(f32x4*)(out + off + bj * HALF + n * 16) = b + acc[ai][bj][m][n]; }
                asm volatile("" ::: "memory"); }
    }
};
struct EpiGate {
    static constexpr bool PERM = false, AFTER_DRAIN = false;
    float* h; const bf16_t* pp; int ldc;
    __device__ __forceinline__ void operator()(const f32x4 (&acc)[2][2][4][2], const Unit& u, int wr, int wc, int fr, int fq) const {
        typedef unsigned u32x2v __attribute__((ext_vector_type(2)));
        const int row0 = u.pm * BM + wr * 64 + fr, col0 = u.pn * BM + wc * 32 + 4 * fq;
#pragma unroll
        for (int ai = 0; ai < 2; ++ai)
#pragma unroll
            for (int m = 0; m < 4; ++m) { const size_t off = (size_t)(row0 + ai * HALF + m * 16) * ldc + col0;
#pragma unroll
                for (int bj = 0; bj < 2; ++bj)
#pragma unroll
                    for (int n = 0; n < 2; ++n) { const size_t o = off + bj * HALF + n * 16;
                        const f32x4 hv = *(const f32x4*)(h + o); const u32x2v pv = *(const u32x2v*)(pp + o); const f32x4 a = acc[ai][bj][m][n];
                        f32x4 p; p[0] = __uint_as_float(pv.x << 16); p[1] = __uint_as_float(pv.x & 0xffff0000u); p[2] = __uint_as_float(pv.y << 16); p[3] = __uint_as_float(pv.y & 0xffff0000u);
                        f32x4 r;
#pragma unroll
                        for (int j = 0; j < 4; ++j) { const float g = __builtin_amdgcn_rcpf(1.0f + __expf(-a[j])); r[j] = hv[j] + g * p[j]; }
                        *(f32x4*)(h + o) = r; }
                asm volatile("" ::: "memory"); }
    }
};

__device__ __forceinline__ float shx16(float v, int o, int lane) { return __int_as_float(__builtin_amdgcn_ds_bpermute((lane ^ o) << 2, __float_as_int(v))); }
struct EpiBf16Row {
    static constexpr bool PERM = true, AFTER_DRAIN = false;
    bf16_t* O; int ldc; const float* rs; bf16_t* hm; bf16_t* iq; bf16_t* ik; int c_hm0, c_hm1, c_iq0, c_ik0, seq;
    __device__ __forceinline__ void operator()(const f32x4 (&acc)[2][2][4][2], const Unit& u, int wr, int wc, int fr, int fq) const {
        const int row0 = u.pm * BM + wr * 64 + fr;
        bf16_t* bp[2]; size_t rstride[2]; bool live[2];
#pragma unroll
        for (int bj = 0; bj < 2; ++bj) { const int colb = u.pn * BM + bj * HALF; live[bj] = true;
            if (colb >= c_hm0 && colb < c_hm1) { const int rel = colb - c_hm0, which = rel >> 10, hh = (rel >> 7) & 7; bp[bj] = hm + ((size_t)(which * 8 + hh) * seq) * 128 + wc * 32 + 8 * fq; rstride[bj] = 128; }
            else if (colb >= c_iq0 && colb < c_ik0) { bp[bj] = iq + (colb - c_iq0) + wc * 32 + 8 * fq; rstride[bj] = 1024; }
            else if (colb == c_ik0) { bp[bj] = ik + wc * 32 + 8 * fq; rstride[bj] = 64; live[bj] = wc < 2; }
            else { bp[bj] = O + colb + wc * 32 + 8 * fq; rstride[bj] = (size_t)ldc; } }
#pragma unroll
        for (int ai = 0; ai < 2; ++ai)
#pragma unroll
            for (int m = 0; m < 4; ++m) { const int row = row0 + ai * HALF + m * 16; const float s = rs[row];
#pragma unroll
                for (int bj = 0; bj < 2; ++bj) { const f32x4 v0 = acc[ai][bj][m][0] * s, v1 = acc[ai][bj][m][1] * s;
                    u32x4 w; w.x = cvt_pk_bf16(v0[0], v0[1]); w.y = cvt_pk_bf16(v0[2], v0[3]); w.z = cvt_pk_bf16(v1[0], v1[1]); w.w = cvt_pk_bf16(v1[2], v1[3]);
                    if (live[bj]) *(u32x4*)(bp[bj] + (size_t)row * rstride[bj]) = w; } }
    }
};
struct EpiResF32N {
    static constexpr bool PERM = false, AFTER_DRAIN = false;
    const float* base; float* out; bf16_t* hb; float* part; int ldc;
    __device__ __forceinline__ void operator()(const f32x4 (&acc)[2][2][4][2], const Unit& u, int wr, int wc, int fr, int fq) const {
        typedef unsigned u32x2v __attribute__((ext_vector_type(2)));
        const int row0 = u.pm * BM + wr * 64 + fr, col0 = u.pn * BM + wc * 32 + 4 * fq, lane = fq * 16 + fr;
#pragma unroll
        for (int ai = 0; ai < 2; ++ai)
#pragma unroll
            for (int m = 0; m < 4; ++m) { const int row = row0 + ai * HALF + m * 16; const size_t off = (size_t)row * ldc + col0; float ss = 0.f;
#pragma unroll
                for (int bj = 0; bj < 2; ++bj)
#pragma unroll
                    for (int n = 0; n < 2; ++n) { const size_t o = off + bj * HALF + n * 16; const f32x4 r = *(const f32x4*)(base + o) + acc[ai][bj][m][n]; *(f32x4*)(out + o) = r;
                        u32x2v w; w.x = cvt_pk_bf16(r[0], r[1]); w.y = cvt_pk_bf16(r[2], r[3]); *(u32x2v*)(hb + o) = w; ss += (r[0] * r[0] + r[1] * r[1]) + (r[2] * r[2] + r[3] * r[3]); }
                ss += shx16(ss, 16, lane); ss += shx16(ss, 32, lane);
                if (fq == 0) part[(size_t)row * 64 + u.pn * 4 + wc] = ss;
                if (m & 1) asm volatile("" ::: "memory"); }
    }
};
struct EpiGateN {
    static constexpr bool PERM = false, AFTER_DRAIN = false;
    float* h; const bf16_t* pp; const float* rs; bf16_t* hb; float* part; int ldc;
    __device__ __forceinline__ void operator()(const f32x4 (&acc)[2][2][4][2], const Unit& u, int wr, int wc, int fr, int fq) const {
        typedef unsigned u32x2v __attribute__((ext_vector_type(2)));
        const int row0 = u.pm * BM + wr * 64 + fr, col0 = u.pn * BM + wc * 32 + 4 * fq, lane = fq * 16 + fr;
#pragma unroll
        for (int ai = 0; ai < 2; ++ai)
#pragma unroll
            for (int m = 0; m < 4; ++m) { const int row = row0 + ai * HALF + m * 16; const size_t off = (size_t)row * ldc + col0; const float s = rs[row]; float ss = 0.f;
#pragma unroll
                for (int bj = 0; bj < 2; ++bj)
#pragma unroll
                    for (int n = 0; n < 2; ++n) { const size_t o = off + bj * HALF + n * 16;
                        const f32x4 hv = *(const f32x4*)(h + o); const u32x2v pv = *(const u32x2v*)(pp + o); const f32x4 a = acc[ai][bj][m][n] * s;
                        f32x4 p; p[0] = __uint_as_float(pv.x << 16); p[1] = __uint_as_float(pv.x & 0xffff0000u); p[2] = __uint_as_float(pv.y << 16); p[3] = __uint_as_float(pv.y & 0xffff0000u);
                        f32x4 r;
#pragma unroll
                        for (int j = 0; j < 4; ++j) { const float g = __builtin_amdgcn_rcpf(1.0f + __expf(-a[j])); r[j] = hv[j] + g * p[j]; }
                        *(f32x4*)(h + o) = r; u32x2v w; w.x = cvt_pk_bf16(r[0], r[1]); w.y = cvt_pk_bf16(r[2], r[3]); *(u32x2v*)(hb + o) = w; ss += (r[0] * r[0] + r[1] * r[1]) + (r[2] * r[2] + r[3] * r[3]); }
                ss += shx16(ss, 16, lane); ss += shx16(ss, 32, lane);
                if (fq == 0) part[(size_t)row * 64 + u.pn * 4 + wc] = ss;
                if (m & 1) asm volatile("" ::: "memory"); }
    }
};

__device__ __forceinline__ void unpk8(const u32x4 w, float (&f)[8]) { f[0] = __uint_as_float(w.x << 16); f[1] = __uint_as_float(w.x & 0xffff0000u); f[2] = __uint_as_float(w.y << 16); f[3] = __uint_as_float(w.y & 0xffff0000u);
    f[4] = __uint_as_float(w.z << 16); f[5] = __uint_as_float(w.z & 0xffff0000u); f[6] = __uint_as_float(w.w << 16); f[7] = __uint_as_float(w.w & 0xffff0000u); }
struct EpiResB {
    static constexpr bool PERM = true, AFTER_DRAIN = false;
    const bf16_t* base; bf16_t* out; float* part; int ldc;
    __device__ __forceinline__ void operator()(const f32x4 (&acc)[2][2][4][2], const Unit& u, int wr, int wc, int fr, int fq) const {
        const int row0 = u.pm * BM + wr * 64 + fr, col0 = u.pn * BM + wc * 32 + 8 * fq, lane = fq * 16 + fr;
#pragma unroll
        for (int ai = 0; ai < 2; ++ai)
#pragma unroll
            for (int m = 0; m < 4; ++m) { const int row = row0 + ai * HALF + m * 16; const size_t off = (size_t)row * ldc + col0; float ss = 0.f;
#pragma unroll
                for (int bj = 0; bj < 2; ++bj) { const size_t o = off + bj * HALF; float b[8], r[8]; unpk8(*(const u32x4*)(base + o), b);
#pragma unroll
                    for (int j = 0; j < 4; ++j) { r[j] = b[j] + acc[ai][bj][m][0][j]; r[4 + j] = b[4 + j] + acc[ai][bj][m][1][j]; }
                    u32x4 w; w.x = cvt_pk_bf16(r[0], r[1]); w.y = cvt_pk_bf16(r[2], r[3]); w.z = cvt_pk_bf16(r[4], r[5]); w.w = cvt_pk_bf16(r[6], r[7]); *(u32x4*)(out + o) = w;
#pragma unroll
                    for (int j = 0; j < 8; ++j) ss += r[j] * r[j]; }
                ss += shx16(ss, 16, lane); ss += shx16(ss, 32, lane);
                if (fq == 0) part[(size_t)row * 64 + u.pn * 4 + wc] = ss;
                if (m & 1) asm volatile("" ::: "memory"); }
    }
};
struct EpiGateB {
    static constexpr bool PERM = true, AFTER_DRAIN = false;
    const bf16_t* hin; const bf16_t* pp; const float* rs; bf16_t* out; float* part; int ldc;
    __device__ __forceinline__ void operator()(const f32x4 (&acc)[2][2][4][2], const Unit& u, int wr, int wc, int fr, int fq) const {
        const int row0 = u.pm * BM + wr * 64 + fr, col0 = u.pn * BM + wc * 32 + 8 * fq, lane = fq * 16 + fr;
#pragma unroll
        for (int ai = 0; ai < 2; ++ai)
#pragma unroll
            for (int m = 0; m < 4; ++m) { const int row = row0 + ai * HALF + m * 16; const size_t off = (size_t)row * ldc + col0; const float s = rs[row]; float ss = 0.f;
#pragma unroll
                for (int bj = 0; bj < 2; ++bj) { const size_t o = off + bj * HALF; float hf[8], pf[8], r[8]; unpk8(*(const u32x4*)(hin + o), hf); unpk8(*(const u32x4*)(pp + o), pf);
#pragma unroll
                    for (int j = 0; j < 8; ++j) { const float a = (j < 4 ? acc[ai][bj][m][0][j & 3] : acc[ai][bj][m][1][j & 3]) * s; const float g = __builtin_amdgcn_rcpf(1.0f + __expf(-a)); r[j] = hf[j] + g * pf[j]; }
                    u32x4 w; w.x = cvt_pk_bf16(r[0], r[1]); w.y = cvt_pk_bf16(r[2], r[3]); w.z = cvt_pk_bf16(r[4], r[5]); w.w = cvt_pk_bf16(r[6], r[7]); *(u32x4*)(out + o) = w;
#pragma unroll
                    for (int j = 0; j < 8; ++j) ss += r[j] * r[j]; }
                ss += shx16(ss, 16, lane); ss += shx16(ss, 32, lane);
                if (fq == 0) part[(size_t)row * 64 + u.pn * 4 + wc] = ss;
                if (m & 1) asm volatile("" ::: "memory"); }
    }
};
template <class Epi, class Sched, bool ALIGN_EPI = false, bool SP2 = false>
__device__ __forceinline__ void gemm_phase(PG8_LAS unsigned char* lds, const Gemm g, const Sched& S, const Epi& E) {
    int tid_ = threadIdx.x; asm volatile("" : "+v"(tid_));
    const int tid = tid_, wid = __builtin_amdgcn_readfirstlane(tid >> 6), lane = tid & 63, wr = wid >> 2, wc = wid & 3, fr = lane & 15, fq = lane >> 4;
    const int K = g.K, nt = K / BK;
    unsigned voffA[2], voffB[2];
#pragma unroll
    for (int i = 0; i < 2; ++i) { int R, C; stage_rc(tid * 16 + i * 8192, R, C); const int Rb = Epi::PERM ? ((R & ~31) + perm32(R & 31)) : R;
        voffA[i] = (unsigned)(R * K + C) * 2u; voffB[i] = (unsigned)(Rb * K + C) * 2u; }
    const size_t kstep = (size_t)(BK * 2);
    const size_t hstep = (size_t)HALF * K * 2;
    const size_t tstep = 2 * hstep;
    const unsigned ldsw = (unsigned)wid * 1024u;
    const int aoff = lds_byte(wr * 64 + fr, fq * 8), boff = lds_byte(wc * 32 + fr, fq * 8);
#define PG8_SA(b, h) (((b) * 2 + (h)) * HTB)
#define PG8_SB(b, h) ((4 + (b) * 2 + (h)) * HTB)
#define PG8_STAGE(bufoff, gbase, voff) do { _Pragma("unroll") for (int _i = 0; _i < 2; ++_i) \
        __builtin_amdgcn_global_load_lds((const unsigned*)((const char*)(gbase) + (voff)[_i]), (PG8_LAS unsigned*)(lds + (bufoff) + ldsw + _i * 8192), 16, 0, 0); } while (0)
#define PG8_LDA(dst, b, h) do { _Pragma("unroll") for (int m = 0; m < 4; ++m) _Pragma("unroll") for (int k = 0; k < 2; ++k) dst[m][k] = *(const PG8_LAS bf16x8*)(lds + PG8_SA(b, h) + aoff + m * 2048 + k * 1024); } while (0)
#define PG8_LDB(dst, b, h) do { _Pragma("unroll") for (int n = 0; n < 2; ++n) _Pragma("unroll") for (int k = 0; k < 2; ++k) dst[n][k] = *(const PG8_LAS bf16x8*)(lds + PG8_SB(b, h) + boff + n * 2048 + k * 1024); } while (0)
#define PG8_MMA(ai, bj, At, Bt) do { __builtin_amdgcn_s_setprio(1); _Pragma("unroll") for (int m = 0; m < 4; ++m) _Pragma("unroll") for (int n = 0; n < 2; ++n) _Pragma("unroll") for (int k = 0; k < 2; ++k) \
        acc[ai][bj][m][n] = __builtin_amdgcn_mfma_f32_16x16x32_bf16(Bt[n][k], At[m][k], acc[ai][bj][m][n], 0, 0, 0); __builtin_amdgcn_s_setprio(0); } while (0)
#define PG8_WAIT_V(n) asm volatile("s_waitcnt vmcnt(" #n ")" ::: "memory")
#define PG8_WAIT_L(n) asm volatile("s_waitcnt lgkmcnt(" #n ")" ::: "memory")
#define PG8_BAR __builtin_amdgcn_s_barrier()
#define PG8_SCHED __builtin_amdgcn_sched_barrier(0)
    Unit cur, nxt; int ui = 0;
    if (!S.next(0, cur)) return;
    f32x4 acc[2][2][4][2];
#pragma unroll
    for (int a = 0; a < 2; ++a)
#pragma unroll
        for (int b = 0; b < 2; ++b)
#pragma unroll
            for (int m = 0; m < 4; ++m)
#pragma unroll
                for (int n = 0; n < 2; ++n) acc[a][b][m][n] = (f32x4){0.f, 0.f, 0.f, 0.f};
    bf16x8 At[4][2], B0[2][2], B1[2][2];
    const char* cA = (const char*)g.A + (size_t)cur.pm * tstep; const char* cB = (const char*)g.Bt + (size_t)cur.pn * tstep;
    S.a_ready(cur);
    if constexpr (SP2) {
        PG8_STAGE(PG8_SB(0, 0), cB, voffB); PG8_STAGE(PG8_SB(0, 1), cB + hstep, voffB); PG8_STAGE(PG8_SA(0, 0), cA, voffA); PG8_STAGE(PG8_SA(0, 1), cA + hstep, voffA);
        if (wr == 1) PG8_BAR;
        PG8_WAIT_V(2); PG8_BAR;
        PG8_STAGE(PG8_SB(1, 0), cB + kstep, voffB); PG8_STAGE(PG8_SA(1, 0), cA + kstep, voffA); PG8_STAGE(PG8_SB(1, 1), cB + hstep + kstep, voffB);
        PG8_WAIT_V(6); PG8_BAR;
    } else {
        PG8_STAGE(PG8_SB(0, 0), cB, voffB); PG8_STAGE(PG8_SA(0, 0), cA, voffA); PG8_STAGE(PG8_SB(0, 1), cB + hstep, voffB); PG8_STAGE(PG8_SA(0, 1), cA + hstep, voffA);
        if (wr == 1) PG8_BAR;
        PG8_WAIT_V(4); PG8_BAR;
        PG8_STAGE(PG8_SB(1, 0), cB + kstep, voffB); PG8_STAGE(PG8_SA(1, 0), cA + kstep, voffA); PG8_STAGE(PG8_SB(1, 1), cB + hstep + kstep, voffB);
        PG8_WAIT_V(6); PG8_BAR;
    }
    for (;;) {
        const bool has_next = S.next(ui + 1, nxt);
        const char* nA = has_next ? (const char*)g.A + (size_t)nxt.pm * tstep : cA; const char* nB = has_next ? (const char*)g.Bt + (size_t)nxt.pn * tstep : cB;
#pragma nounroll
        for (int t = 0; t < nt; t += 2) {
            const bool last = (t == nt - 2);
            const char* a1 = cA + (size_t)(t + 1) * kstep;
            const char* a2 = last ? nA : cA + (size_t)(t + 2) * kstep; const char* b2 = last ? nB : cB + (size_t)(t + 2) * kstep;
            const char* a3 = a2 + kstep; const char* b3 = b2 + kstep;
            if (last && has_next) S.a_ready(nxt);
            if constexpr (SP2) {
            PG8_LDB(B0, 0, 0); PG8_LDB(B1, 0, 1); PG8_SCHED; PG8_LDA(At, 0, 0); PG8_STAGE(PG8_SA(1, 1), a1 + hstep, voffA);
            PG8_WAIT_V(8); PG8_WAIT_L(0); PG8_BAR; PG8_MMA(0, 0, At, B0); PG8_MMA(0, 1, At, B1); PG8_BAR; PG8_SCHED;
            PG8_LDA(At, 0, 1); PG8_STAGE(PG8_SB(0, 0), b2, voffB); PG8_STAGE(PG8_SB(0, 1), b2 + hstep, voffB); PG8_STAGE(PG8_SA(0, 0), a2, voffA);
            PG8_WAIT_V(8); PG8_WAIT_L(0); PG8_BAR; PG8_MMA(1, 0, At, B0); PG8_MMA(1, 1, At, B1); PG8_BAR; PG8_SCHED;
            PG8_LDB(B0, 1, 0); PG8_LDB(B1, 1, 1); PG8_SCHED; PG8_LDA(At, 1, 0); PG8_STAGE(PG8_SA(0, 1), a2 + hstep, voffA);
            PG8_WAIT_V(8); PG8_WAIT_L(0); PG8_BAR; PG8_MMA(0, 0, At, B0); PG8_MMA(0, 1, At, B1); PG8_BAR; PG8_SCHED;
            PG8_LDA(At, 1, 1); PG8_STAGE(PG8_SB(1, 0), b3, voffB); PG8_STAGE(PG8_SB(1, 1), b3 + hstep, voffB); PG8_STAGE(PG8_SA(1, 0), a3, voffA);
            PG8_WAIT_V(8); PG8_WAIT_L(0); PG8_BAR; PG8_MMA(1, 0, At, B0); PG8_MMA(1, 1, At, B1); PG8_BAR; PG8_SCHED;
            } else {
            PG8_LDB(B0, 0, 0); PG8_SCHED; PG8_LDA(At, 0, 0); PG8_STAGE(PG8_SA(1, 1), a1 + hstep, voffA);
            PG8_WAIT_L(8); PG8_BAR; PG8_WAIT_L(0); PG8_MMA(0, 0, At, B0); PG8_BAR; PG8_SCHED;
            PG8_LDB(B1, 0, 1); PG8_STAGE(PG8_SB(0, 0), b2, voffB);
            PG8_BAR; PG8_WAIT_L(0); PG8_MMA(0, 1, At, B1); PG8_BAR;
            PG8_LDA(At, 0, 1); PG8_STAGE(PG8_SA(0, 0), a2, voffA);
            PG8_BAR; PG8_WAIT_L(0); PG8_MMA(1, 0, At, B0); PG8_BAR; PG8_SCHED;
            PG8_STAGE(PG8_SB(0, 1), b2 + hstep, voffB);
            PG8_WAIT_V(6); PG8_BAR; PG8_MMA(1, 1, At, B1); PG8_BAR;
            PG8_LDB(B0, 1, 0); PG8_SCHED; PG8_LDA(At, 1, 0); PG8_STAGE(PG8_SA(0, 1), a2 + hstep, voffA);
            PG8_WAIT_L(8); PG8_BAR; PG8_WAIT_L(0); PG8_MMA(0, 0, At, B0); PG8_BAR; PG8_SCHED;
            PG8_LDB(B1, 1, 1); PG8_STAGE(PG8_SB(1, 0), b3, voffB);
            PG8_BAR; PG8_WAIT_L(0); PG8_MMA(0, 1, At, B1); PG8_BAR;
            PG8_LDA(At, 1, 1); PG8_STAGE(PG8_SA(1, 0), a3, voffA);
            PG8_BAR; PG8_WAIT_L(0); PG8_MMA(1, 0, At, B0); PG8_BAR; PG8_SCHED;
            PG8_STAGE(PG8_SB(1, 1), b3 + hstep, voffB);
            PG8_WAIT_V(6); PG8_BAR; PG8_MMA(1, 1, At, B1); PG8_BAR;
            }
        }
        if constexpr (ALIGN_EPI) { if (wr == 0) PG8_BAR; }
        if constexpr (!Epi::AFTER_DRAIN) { E(acc, cur, wr, wc, fr, fq); S.done(cur); }
        if (!has_next) break;
#pragma unroll
        for (int a = 0; a < 2; ++a)
#pragma unroll
            for (int b = 0; b < 2; ++b)
#pragma unroll
                for (int m = 0; m < 4; ++m)
#pragma unroll
                    for (int n = 0; n < 2; ++n) acc[a][b][m][n] = (f32x4){0.f, 0.f, 0.f, 0.f};
        cur = nxt; cA = nA; cB = nB; ++ui;
        if constexpr (ALIGN_EPI) { if (wr == 1) PG8_BAR; }
    }
    PG8_WAIT_V(0);
    if constexpr (!ALIGN_EPI) { if (wr == 0) PG8_BAR; }
    PG8_BAR;
    if constexpr (Epi::AFTER_DRAIN) { E.fused(acc, cur, wr, wc, fr, fq, lds, wid, lane); S.done(cur); }
#undef PG8_SA
#undef PG8_SB
#undef PG8_STAGE
#undef PG8_LDA
#undef PG8_LDB
#undef PG8_MMA
#undef PG8_WAIT_V
#undef PG8_WAIT_L
#undef PG8_BAR
#undef PG8_SCHED
}
}

constexpr int SEQ = 16384, DM = 4096, DEPTH = 4, DPLE = 256;
constexpr int INW = 15980;
constexpr int ZW = 16384;
constexpr float NORM_EPS = 1e-6f;
constexpr int ZQ_A = 0, ZK_A = 768, ZV_A = 1536, ZLOW = 3072, ZGATE_A = 3200;
constexpr int ZQ_B = 4736, ZK_B = 5760, ZV_B = 6784, ZGATE_B = 7808, ZIQ = 8832, ZIK = 9856, ZIW = 9984;
constexpr int ZQ_C = 10112, ZK_C = 10880, ZV_C = 11648, ZIF = 13184, ZO_C = 13312, ZGATE_C = 14848;
constexpr int YA = 0, YB = 1536, YC = 2560;
constexpr int NCH = SEQ / 64;

constexpr size_t MiB = 1u << 20;
constexpr size_t WS_CTL = 0, CTL_ZERO_BYTES = 1 * MiB;
constexpr size_t WS_ROPE = 1 * MiB;
constexpr size_t WS_PBF = 4 * MiB;
constexpr size_t WS_WPLE = 36 * MiB;
constexpr size_t WS_WOUT = 44 * MiB;
constexpr size_t WS_WGATE = 172 * MiB;
constexpr size_t WS_WIN = 300 * MiB;
constexpr size_t WS_H = 812 * MiB;
constexpr size_t WS_U = 1068 * MiB;
constexpr size_t WS_Z = 1196 * MiB;
constexpr size_t WS_Y = 1708 * MiB;
constexpr size_t WS_PP = 1836 * MiB;
constexpr size_t WS_QA = 1964 * MiB, WS_KA = 1996 * MiB, WS_VA = 2028 * MiB;
constexpr size_t WS_IQ = 2060 * MiB;
constexpr size_t WS_IK = 2092 * MiB;
constexpr size_t WS_IW = 2094 * MiB;
constexpr size_t WS_MASK = 2096 * MiB;
constexpr size_t WS_BA = 2128 * MiB;
constexpr size_t WS_DS = 2176 * MiB;
constexpr size_t WS_SP = 2272 * MiB;
constexpr size_t WS_CQ = 2320 * MiB, WS_CK = 2344 * MiB;
constexpr size_t WS_MG = 2368 * MiB;
constexpr size_t WS_DC = 2372 * MiB;
constexpr size_t WS_CP = 2564 * MiB;
constexpr size_t WS_SCORE = 2660 * MiB;
constexpr size_t WS_HB2 = 3684 * MiB;
constexpr size_t WS_PART = 3812 * MiB;
constexpr size_t WS_RSTD = 3816 * MiB;
constexpr size_t WS_END = 3818 * MiB;
constexpr size_t MG_B = 0;
constexpr size_t MG_I = MG_B + (size_t)SEQ * 8;
constexpr size_t MG_ML = MG_I + (size_t)SEQ * 8;
constexpr size_t MG_MP = MG_ML + (size_t)NCH * 6 * 2;
constexpr size_t MG_DN = MG_MP + (size_t)NCH * 6;
constexpr size_t MG_NP = MG_DN + (size_t)NCH * 6 * 128;
static_assert((MG_NP + (size_t)NCH * 6 * 128) * 4 <= 4 * MiB, "mLSTM small arrays fit");

constexpr int CW_BAR = 4096;

constexpr int RING_BYTES = 131072;
constexpr int MISC_OFF = RING_BYTES + 320;
constexpr int LDS_BYTES = 147456;
constexpr int NWAVES = 8, NTHR = 512;

#define GAS __attribute__((address_space(1)))
#define LAS __attribute__((address_space(3)))
typedef unsigned short bf16;
typedef unsigned u32x4 __attribute__((ext_vector_type(4)));
typedef unsigned u32x2 __attribute__((ext_vector_type(2)));
typedef float f32x4 __attribute__((ext_vector_type(4)));
typedef float f32x2 __attribute__((ext_vector_type(2)));
typedef float f32x16 __attribute__((ext_vector_type(16)));
typedef short bf16x8 __attribute__((ext_vector_type(8)));
typedef short bf16x4 __attribute__((ext_vector_type(4)));
#define LDS_WAIT() asm volatile("s_waitcnt lgkmcnt(0)" ::: "memory")
#define VM_WAIT() asm volatile("s_waitcnt vmcnt(0)" ::: "memory")

__device__ __forceinline__ float bf2f(unsigned short b) { return __uint_as_float((unsigned)b << 16); }
__device__ __forceinline__ float bflo(unsigned w) { return __uint_as_float(w << 16); }
__device__ __forceinline__ float bfhi(unsigned w) { return __uint_as_float(w & 0xffff0000u); }
typedef __bf16 bf16x2_t __attribute__((ext_vector_type(2)));
__device__ __forceinline__ unsigned pk2(float lo, float hi) { const f32x2 v = {lo, hi}; const bf16x2_t b = __builtin_convertvector(v, bf16x2_t); return __builtin_bit_cast(unsigned, b); }
__device__ __forceinline__ unsigned short f2bf(float f) { return (unsigned short)(pk2(f, 0.f) & 0xffffu); }
__device__ __forceinline__ float shx(float v, int o, int lane) { return __int_as_float(__builtin_amdgcn_ds_bpermute((lane ^ o) << 2, __float_as_int(v))); }
__device__ __forceinline__ float shup(float v, int o, int lane) { return __int_as_float(__builtin_amdgcn_ds_bpermute(((lane - o) & 63) << 2, __float_as_int(v))); }
__device__ __forceinline__ unsigned shdn_u(unsigned v, int o, int lane) { return (unsigned)__builtin_amdgcn_ds_bpermute(((lane + o) & 63) << 2, (int)v); }
__device__ __forceinline__ float wave_sum(float v, int lane) {
#pragma unroll
    for (int o = 1; o < 64; o <<= 1) v += shx(v, o, lane);
    return v;
}
__device__ __forceinline__ float wave_max(float v, int lane) {
#pragma unroll
    for (int o = 1; o < 64; o <<= 1) v = fmaxf(v, shx(v, o, lane));
    return v;
}
__device__ __forceinline__ float log_sigmoidf(float x) { return fminf(x, 0.f) - log1pf(expf(-fabsf(x))); }
__device__ __forceinline__ float sigmoidf_(float x) { return __builtin_amdgcn_rcpf(1.0f + __expf(-x)); }
__device__ __forceinline__ float siluf_(float x) { return x * __builtin_amdgcn_rcpf(1.0f + __expf(-x)); }
__device__ __forceinline__ int crow(int r, int hi) { return (r & 3) + 8 * (r >> 2) + 4 * hi; }
__device__ __forceinline__ void unpack8(const u32x4 w, float (&f)[8]) { f[0] = bflo(w.x); f[1] = bfhi(w.x); f[2] = bflo(w.y); f[3] = bfhi(w.y); f[4] = bflo(w.z); f[5] = bfhi(w.z); f[6] = bflo(w.w); f[7] = bfhi(w.w); }
__device__ __forceinline__ u32x4 pack8f(const float (&f)[8]) { u32x4 o; o.x = pk2(f[0], f[1]); o.y = pk2(f[2], f[3]); o.z = pk2(f[4], f[5]); o.w = pk2(f[6], f[7]); return o; }
__device__ __forceinline__ int hw_lane() { int l; asm volatile("v_mbcnt_lo_u32_b32 %0, -1, 0\n\tv_mbcnt_hi_u32_b32 %0, -1, %0" : "=v"(l)); return l; }
#define XB_TMO      128
#define XB_XCNT(j)  (256  + 64 * (j))
#define XB_XSUB(j)  (1280 + 64 * (j))
#define XB_XGEN(j)  (2304 + 64 * (j))
#define XB_TOP      3328
#define XB_TOPGEN   3392
#define XCD_BAR_WORDS 3456
#define XB_SPIN_CAP (1u << 18)

__device__ __forceinline__ unsigned xb_ld(unsigned* p)              { return __hip_atomic_load(p, __ATOMIC_RELAXED, __HIP_MEMORY_SCOPE_AGENT); }
__device__ __forceinline__ unsigned xb_add(unsigned* p, unsigned v) { return __hip_atomic_fetch_add(p, v, __ATOMIC_RELAXED, __HIP_MEMORY_SCOPE_AGENT); }
__device__ __forceinline__ unsigned xb_xcc_id() { return (unsigned)__builtin_amdgcn_s_getreg((3 << 11) | 20) & 0xFu; }
#define XB_SPIN(cond, bar) do { unsigned _sp = 0; while (cond) { __builtin_amdgcn_s_sleep(1); \
    if ((++_sp & 255u) == 0u) { if (xb_ld(&(bar)[XB_TMO])) break; if (_sp > XB_SPIN_CAP) { atomicAdd(&(bar)[XB_TMO], 1u); break; } } } } while (0)

struct XcdBarrier {
    unsigned* bar; unsigned x;
    volatile LAS unsigned* st;
};

__device__ __forceinline__ XcdBarrier xcd_barrier_post(unsigned* bar, volatile LAS unsigned* st) {
    XcdBarrier b; b.bar = bar; b.x = xb_xcc_id(); b.st = st;
    if (threadIdx.x == 0) (void)xb_add(&bar[XB_XCNT(b.x)], 1u);
    return b;
}
__device__ __forceinline__ void xcd_barrier_complete(unsigned* bar, unsigned x, unsigned& nloc, unsigned& nx) {
    const unsigned G = gridDim.x * gridDim.y * gridDim.z;
    unsigned sum, cnt, mine, sp = 0u;
    for (;;) {
        sum = 0u; cnt = 0u; mine = 0u;
#pragma unroll
        for (unsigned j = 0; j < 16; ++j) { const unsigned c = xb_ld(&bar[XB_XCNT(j)]); sum += c; cnt += (c > 0u) ? 1u : 0u; mine = (j == x) ? c : mine; }
        if (sum == G) break;
        __builtin_amdgcn_s_sleep(1);
        if ((++sp & 255u) == 0u) { if (xb_ld(&bar[XB_TMO])) break; if (sp > XB_SPIN_CAP) { atomicAdd(&bar[XB_TMO], 1u); break; } }
    }
    nloc = mine > 0u ? mine : 1u; nx = cnt > 0u ? cnt : 1u;
}

__device__ __forceinline__ void xcd_barrier(const XcdBarrier& b) {
    asm volatile("s_waitcnt vmcnt(0)" ::: "memory");
    __syncthreads();
    if (threadIdx.x == 0) {
        unsigned* bar = b.bar;
        __builtin_amdgcn_s_waitcnt(0);
        unsigned nloc = b.st[0], nx = b.st[1];
        if (nloc == 0u) { xcd_barrier_complete(bar, b.x, nloc, nx); b.st[0] = nloc; b.st[1] = nx; }
        const unsigned old = xb_add(&bar[XB_XSUB(b.x)], 1u);
        const unsigned gen = old / nloc;
        if (old + 1u == (gen + 1u) * nloc) {
            __builtin_amdgcn_fence(__ATOMIC_RELEASE, "agent");
            asm volatile("s_waitcnt vmcnt(0)" ::: "memory");
            const unsigned og = xb_add(&bar[XB_TOP], 1u);
            const unsigned tg = og / nx;
            if (og + 1u == (tg + 1u) * nx) xb_add(&bar[XB_TOPGEN], 1u);
            else XB_SPIN(xb_ld(&bar[XB_TOPGEN]) == tg, bar);
            __builtin_amdgcn_fence(__ATOMIC_ACQUIRE, "agent");
            xb_add(&bar[XB_XGEN(b.x)], 1u);
            asm volatile("s_waitcnt vmcnt(0)" ::: "memory");
        } else {
            XB_SPIN(xb_ld(&bar[XB_XGEN(b.x)]) == gen, bar);
            __builtin_amdgcn_fence(__ATOMIC_ACQUIRE, "agent");
            asm volatile("s_waitcnt vmcnt(0)" ::: "memory");
        }
    }
    __syncthreads();
}

struct Frame {
    LAS unsigned char* lds;
    unsigned char* ws;
    int tid, lane, wave, G, vcu, gw, NGW;
};

__device__ __forceinline__ void zseg(int n0, int& src0, int& valid, float& cscale) {
    int d0, s0, sl;
    if (n0 < ZK_A) { d0 = ZQ_A; s0 = 0; sl = 768; }
    else if (n0 < ZV_A) { d0 = ZK_A; s0 = 768; sl = 768; }
    else if (n0 < ZLOW) { d0 = ZV_A; s0 = 1536; sl = 1536; }
    else if (n0 < ZGATE_A) { d0 = ZLOW; s0 = 3072; sl = 16; }
    else if (n0 < ZQ_B) { d0 = ZGATE_A; s0 = 3088; sl = 1536; }
    else if (n0 < ZK_B) { d0 = ZQ_B; s0 = 4624; sl = 1024; }
    else if (n0 < ZV_B) { d0 = ZK_B; s0 = 5648; sl = 1024; }
    else if (n0 < ZGATE_B) { d0 = ZV_B; s0 = 6672; sl = 1024; }
    else if (n0 < ZIQ) { d0 = ZGATE_B; s0 = 7696; sl = 1024; }
    else if (n0 < ZIK) { d0 = ZIQ; s0 = 8720; sl = 1024; }
    else if (n0 < ZIW) { d0 = ZIK; s0 = 9744; sl = 64; }
    else if (n0 < ZQ_C) { d0 = ZIW; s0 = 9808; sl = 16; }
    else if (n0 < ZK_C) { d0 = ZQ_C; s0 = 9824; sl = 768; }
    else if (n0 < ZV_C) { d0 = ZK_C; s0 = 10592; sl = 768; }
    else if (n0 < ZIF) { d0 = ZV_C; s0 = 11360; sl = 1536; }
    else if (n0 < ZO_C) { d0 = ZIF; s0 = 12896; sl = 12; }
    else if (n0 < ZGATE_C) { d0 = ZO_C; s0 = 12908; sl = 1536; }
    else { d0 = ZGATE_C; s0 = 14444; sl = 1536; }
    const int off = n0 - d0; int v = sl - off; v = v < 0 ? 0 : (v > 32 ? 32 : v);
    src0 = s0 + off; valid = v;
    cscale = (d0 == ZIQ) ? 0.0078125f : (d0 == ZIW) ? 4.0f : 1.0f;
}
__device__ __forceinline__ void transpose_item(const float* W, int K, int Nsrc, bf16* WT, int k0, int n0dst, int src0, int valid, LAS float* scr, int lane, const float* gk, const float cs = 1.0f) {
    const int j = lane & 31; const bool ok = j < valid;
    float vv[32];
    const float* wp = W + (size_t)(k0 + (lane >> 5)) * Nsrc + src0 + (ok ? j : 0);
#pragma unroll
    for (int i = 0; i < 32; ++i) vv[i] = wp[(size_t)(2 * i) * Nsrc];
#pragma unroll
    for (int i = 0; i < 32; ++i) { const int kk = 2 * i + (lane >> 5); const float gg = (gk ? gk[k0 + kk] : 1.0f) * cs; scr[kk * 33 + j] = ok ? vv[i] * gg : 0.f; }
    LDS_WAIT(); asm volatile("" ::: "memory");
    const int c = lane & 7;
#pragma unroll
    for (int jj = 0; jj < 4; ++jj) { const int n = (lane >> 3) + 8 * jj; const LAS float* s = scr + (8 * c) * 33 + n;
        u32x4 o; o.x = pk2(s[0 * 33], s[1 * 33]); o.y = pk2(s[2 * 33], s[3 * 33]); o.z = pk2(s[4 * 33], s[5 * 33]); o.w = pk2(s[6 * 33], s[7 * 33]);
        *(GAS u32x4*)(WT + (size_t)(n0dst + n) * K + k0 + 8 * c) = o; }
    LDS_WAIT(); asm volatile("" ::: "memory");
}
__device__ __forceinline__ void p0_prologue(const Frame& F, const float* w_in, const float* w_out, const float* w_ple_gate, const float* w_ple_proj, const float* pin, const int* pos, const float* g_in, const float* g_ple, const float* x) {
    LAS float* scr = (LAS float*)(F.lds + F.wave * 16384);
    constexpr int I_IN = (DM / 64) * (ZW / 32), I_SQ = (DM / 64) * (DM / 32), I_PL = (DPLE / 64) * (DM / 32), I_L = I_IN + 2 * I_SQ + I_PL;
    for (int it = F.gw; it < DEPTH * I_L; it += F.NGW) {
        const int L = it / I_L; int r = it - L * I_L;
        if (r < I_IN) { const int nb = r % (ZW / 32), kb = r / (ZW / 32); int s0, vd; float cs; zseg(nb * 32, s0, vd, cs);
            transpose_item(w_in + (size_t)L * DM * INW, DM, INW, (bf16*)(F.ws + WS_WIN) + (size_t)L * ZW * DM, kb * 64, nb * 32, s0, vd, scr, F.lane, g_in + (size_t)L * DM, cs); continue; }
        r -= I_IN;
        if (r < I_SQ) { const int nb = r % (DM / 32), kb = r / (DM / 32);
            transpose_item(w_out + (size_t)L * DM * DM, DM, DM, (bf16*)(F.ws + WS_WOUT) + (size_t)L * DM * DM, kb * 64, nb * 32, nb * 32, 32, scr, F.lane, nullptr); continue; }
        r -= I_SQ;
        if (r < I_SQ) { const int nb = r % (DM / 32), kb = r / (DM / 32);
            transpose_item(w_ple_gate + (size_t)L * DM * DM, DM, DM, (bf16*)(F.ws + WS_WGATE) + (size_t)L * DM * DM, kb * 64, nb * 32, nb * 32, 32, scr, F.lane, g_ple + (size_t)L * DM); continue; }
        r -= I_SQ;
        { const int nb = r % (DM / 32), kb = r / (DM / 32);
            transpose_item(w_ple_proj + (size_t)L * DPLE * DM, DPLE, DM, (bf16*)(F.ws + WS_WPLE) + (size_t)L * DM * DPLE, kb * 64, nb * 32, nb * 32, 32, scr, F.lane, nullptr); }
    }
    { bf16* hb = (bf16*)(F.ws + WS_U); float* rstd = (float*)(F.ws + WS_RSTD);
      for (int row = F.gw; row < SEQ; row += F.NGW) {
          const f32x4* xr = (const f32x4*)(x + (size_t)row * DM) + F.lane; f32x4 v[16]; float ss = 0.f;
#pragma unroll
          for (int j = 0; j < 16; ++j) { v[j] = xr[64 * j]; ss += (v[j][0] * v[j][0] + v[j][1] * v[j][1]) + (v[j][2] * v[j][2] + v[j][3] * v[j][3]); }
          ss = wave_sum(ss, F.lane); if (F.lane == 0) rstd[row] = 1.0f / sqrtf(ss * (1.0f / DM) + NORM_EPS);
          u32x2* o = (u32x2*)(hb + (size_t)row * DM) + F.lane;
#pragma unroll
          for (int j = 0; j < 16; ++j) { u32x2 w; w.x = pk2(v[j][0], v[j][1]); w.y = pk2(v[j][2], v[j][3]); o[64 * j] = w; } } }
    { const size_t n8 = (size_t)DEPTH * SEQ * DPLE / 8; bf16* pb = (bf16*)(F.ws + WS_PBF);
      for (size_t i = (size_t)blockIdx.x * NTHR + F.tid; i < n8; i += (size_t)F.G * NTHR) {
          const f32x4 a = *(const f32x4*)(pin + i * 8), b = *(const f32x4*)(pin + i * 8 + 4);
          u32x4 o; o.x = pk2(a[0], a[1]); o.y = pk2(a[2], a[3]); o.z = pk2(b[0], b[1]); o.w = pk2(b[2], b[3]);
          *(u32x4*)(pb + i * 8) = o; } }
    { float* cosA = (float*)(F.ws + WS_ROPE); float* sinA = cosA + (size_t)SEQ * 16; float* cosI = sinA + (size_t)SEQ * 16; float* sinI = cosI + (size_t)SEQ * 8;
      for (int i = blockIdx.x * NTHR + F.tid; i < SEQ * 24; i += F.G * NTHR) {
          const int t = i / 24, f = i % 24; const bool isA = f < 16; const int fi = isA ? f : f - 16; const double rot = isA ? 32.0 : 16.0;
          const float ex = -(float)(2 * fi) / (float)rot;
          const float inv = (float)exp((double)ex * 13.122363377404328);
          const float ang = (float)pos[t] * inv;
          const double a = (double)ang; const double n = rint(a * 0.15915494309189535);
          double rr = fma(-n, 6.283185307179586, a); rr = fma(-n, 2.4492935982947064e-16, rr);
          const float c = (float)cos(rr), s = (float)sin(rr);
          if (isA) { cosA[t * 16 + fi] = c; sinA[t * 16 + fi] = s; } else { cosI[t * 8 + fi] = c; sinI[t * 8 + fi] = s; } } }
}

__device__ __forceinline__ void reduce_rstd(const Frame& F) {
    const float* part = (const float*)(F.ws + WS_PART); float* rstd = (float*)(F.ws + WS_RSTD);
    for (int r4 = F.gw; r4 < SEQ / 4; r4 += F.NGW) { const int row = r4 * 4 + (F.lane >> 4); const f32x4 p = *(const f32x4*)(part + (size_t)row * 64 + (F.lane & 15) * 4);
        float s = (p[0] + p[1]) + (p[2] + p[3]); s += shx(s, 1, F.lane); s += shx(s, 2, F.lane); s += shx(s, 4, F.lane); s += shx(s, 8, F.lane);
        if ((F.lane & 15) == 0) rstd[row] = 1.0f / sqrtf(s * (1.0f / DM) + NORM_EPS); }
}
__device__ __forceinline__ void rmsnorm_to_bf16(const Frame& F, const float* src, const float* g, bf16* dst) {
    for (int row = F.gw; row < SEQ; row += F.NGW) {
        const f32x4* xr = (const f32x4*)(src + (size_t)row * DM) + F.lane; f32x4 v[16]; float ss = 0.f;
#pragma unroll
        for (int j = 0; j < 16; ++j) { v[j] = xr[64 * j]; ss += (v[j][0] * v[j][0] + v[j][1] * v[j][1]) + (v[j][2] * v[j][2] + v[j][3] * v[j][3]); }
        const float rs = 1.0f / sqrtf(wave_sum(ss, F.lane) * (1.0f / DM) + NORM_EPS);
        u32x2* o = (u32x2*)(dst + (size_t)row * DM) + F.lane;
#pragma unroll
        for (int j = 0; j < 16; ++j) { const f32x4 gv = ((const f32x4*)g)[F.lane + 64 * j]; u32x2 w; w.x = pk2(v[j][0] * rs * gv[0], v[j][1] * rs * gv[1]); w.y = pk2(v[j][2] * rs * gv[2], v[j][3] * rs * gv[3]); o[64 * j] = w; }
    }
}
__device__ __forceinline__ void rmsnorm_b2f(const Frame& F, const bf16* src, const float* g, float* dst) {
    for (int row = F.gw; row < SEQ; row += F.NGW) {
        const u32x4* xr = (const u32x4*)(src + (size_t)row * DM) + F.lane; float v[8][8]; float ss = 0.f;
#pragma unroll
        for (int j = 0; j < 8; ++j) { unpack8(xr[64 * j], v[j]);
#pragma unroll
            for (int q = 0; q < 8; ++q) ss += v[j][q] * v[j][q]; }
        const float rs = 1.0f / sqrtf(wave_sum(ss, F.lane) * (1.0f / DM) + NORM_EPS);
#pragma unroll
        for (int j = 0; j < 8; ++j) { const int c0 = (F.lane + 64 * j) * 8; const f32x4 g0 = *(const f32x4*)(g + c0), g1 = *(const f32x4*)(g + c0 + 4); f32x4 o0, o1;
#pragma unroll
            for (int q = 0; q < 4; ++q) { o0[q] = v[j][q] * rs * g0[q]; o1[q] = v[j][4 + q] * rs * g1[q]; }
            *(f32x4*)(dst + (size_t)row * DM + c0) = o0; *(f32x4*)(dst + (size_t)row * DM + c0 + 4) = o1; }
    }
}
__device__ __forceinline__ void rmsnorm_to_f32(const Frame& F, const float* src, const float* g, float* dst) {
    for (int row = F.gw; row < SEQ; row += F.NGW) {
        const f32x4* xr = (const f32x4*)(src + (size_t)row * DM) + F.lane; f32x4 v[16]; float ss = 0.f;
#pragma unroll
        for (int j = 0; j < 16; ++j) { v[j] = xr[64 * j]; ss += (v[j][0] * v[j][0] + v[j][1] * v[j][1]) + (v[j][2] * v[j][2] + v[j][3] * v[j][3]); }
        const float rs = 1.0f / sqrtf(wave_sum(ss, F.lane) * (1.0f / DM) + NORM_EPS);
        f32x4* o = (f32x4*)(dst + (size_t)row * DM) + F.lane;
#pragma unroll
        for (int j = 0; j < 16; ++j) { const f32x4 gv = ((const f32x4*)g)[F.lane + 64 * j]; f32x4 w; w[0] = v[j][0] * rs * gv[0]; w[1] = v[j][1] * rs * gv[1]; w[2] = v[j][2] * rs * gv[2]; w[3] = v[j][3] * rs * gv[3]; o[64 * j] = w; }
    }
}


__device__ __forceinline__ void p3_prep(const Frame& F, const float* wq, const float* wk, const float* b_ig, const float* b_fg, const float* wu, const float* bu) {
    const bf16* __restrict__ z = (const bf16*)(F.ws + WS_Z);
    const float* cosA = (const float*)(F.ws + WS_ROPE); const float* sinA = cosA + (size_t)SEQ * 16; const float* cosI = sinA + (size_t)SEQ * 16; const float* sinI = cosI + (size_t)SEQ * 8;
    const int gt = blockIdx.x * NTHR + F.tid, GT = F.G * NTHR;
#ifndef P3MASK
#define P3MASK 0
#endif
#define P3REP(k) for (int rep3_ = 0; rep3_ < (((P3MASK >> (k)) & 1) ? 2 : 1); ++rep3_)
    P3REP(1) { bf16* __restrict__ qk = (bf16*)(F.ws + WS_QA);
#pragma unroll 4
      for (int i = gt; i < 2 * 8 * SEQ; i += GT) { const int t = i & (SEQ - 1); bf16* p = qk + (size_t)i * 128;
          const u32x4 w0 = *(const u32x4*)p, w1 = *(const u32x4*)(p + 8), w2 = *(const u32x4*)(p + 16), w3 = *(const u32x4*)(p + 24);
          float x1[16], x2[16], o1[16], o2[16]; { float a[8]; unpack8(w0, a); for (int j = 0; j < 8; ++j) x1[j] = a[j]; unpack8(w1, a); for (int j = 0; j < 8; ++j) x1[8 + j] = a[j]; unpack8(w2, a); for (int j = 0; j < 8; ++j) x2[j] = a[j]; unpack8(w3, a); for (int j = 0; j < 8; ++j) x2[8 + j] = a[j]; }
          const float* cp = cosA + (size_t)t * 16; const float* sp = sinA + (size_t)t * 16;
#pragma unroll
          for (int j = 0; j < 16; ++j) { const float cc = cp[j], ss = sp[j]; o1[j] = x1[j] * cc - x2[j] * ss; o2[j] = x2[j] * cc + x1[j] * ss; }
          { float a[8]; for (int j = 0; j < 8; ++j) a[j] = o1[j]; *(u32x4*)p = pack8f(a); for (int j = 0; j < 8; ++j) a[j] = o1[8 + j]; *(u32x4*)(p + 8) = pack8f(a); for (int j = 0; j < 8; ++j) a[j] = o2[j]; *(u32x4*)(p + 16) = pack8f(a); for (int j = 0; j < 8; ++j) a[j] = o2[8 + j]; *(u32x4*)(p + 24) = pack8f(a); } } }
    P3REP(2) { bf16* __restrict__ iq = (bf16*)(F.ws + WS_IQ); bf16* __restrict__ ik = (bf16*)(F.ws + WS_IK);
#pragma unroll 4
      for (int i = gt; i < SEQ * 17; i += GT) { const bool isq = i < SEQ * 16; const int t = isq ? (i >> 4) : (i - SEQ * 16); bf16* p = isq ? iq + (size_t)i * 64 : ik + (size_t)t * 64;
          float a[8], b[8], oa[8], ob[8]; unpack8(*(const u32x4*)p, a); unpack8(*(const u32x4*)(p + 8), b);
          const float* cp = cosI + (size_t)t * 8; const float* sp = sinI + (size_t)t * 8;
#pragma unroll
          for (int j = 0; j < 8; ++j) { const float cc = cp[j], ss = sp[j]; oa[j] = a[j] * cc - b[j] * ss; ob[j] = b[j] * cc + a[j] * ss; }
          *(u32x4*)p = pack8f(oa); *(u32x4*)(p + 8) = pack8f(ob); } }
    P3REP(3) { bf16* __restrict__ cq = (bf16*)(F.ws + WS_CQ); bf16* __restrict__ ck = (bf16*)(F.ws + WS_CK);
      constexpr int PER = SEQ * 96;
#pragma unroll 4
      for (int i = gt; i < 2 * PER; i += GT) {
          const int which = i / PER, r = i - which * PER, c8 = r % 96, t = r / 96;
          const float* w = (which ? wk : wq) + c8 * 8; const int zc = (which ? ZK_C : ZQ_C) + c8 * 8; float acc[8];
#pragma unroll
          for (int j = 0; j < 8; ++j) acc[j] = 0.f;
#pragma unroll
          for (int tap = 0; tap < 4; ++tap) { const int ts = t - 3 + tap; if (ts >= 0) { float xv[8]; unpack8(*(const u32x4*)(z + (size_t)ts * ZW + zc), xv); const f32x4 w0 = *(const f32x4*)(w + tap * 768), w1 = *(const f32x4*)(w + tap * 768 + 4);
#pragma unroll
              for (int j = 0; j < 4; ++j) { acc[j] += xv[j] * w0[j]; acc[4 + j] += xv[4 + j] * w1[j]; } } }
          const float sc = which ? 1.0f : 0.08838834764831845f;
#pragma unroll
          for (int j = 0; j < 8; ++j) acc[j] = siluf_(acc[j]) * sc;
          *(u32x4*)((which ? ck : cq) + (size_t)t * 768 + c8 * 8) = pack8f(acc); } }
    P3REP(4) { float* mg = (float*)(F.ws + WS_MG);
      for (int u = F.gw; u < NCH * 6; u += F.NGW) { const int c = u / 6, h = u % 6, t = c * 64 + F.lane; const float bi = b_ig[h], bfg = b_fg[h];
          const float ci = bf2f(z[(size_t)t * ZW + ZIF + h]), cf = bf2f(z[(size_t)t * ZW + ZIF + 6 + h]);
          float v = log_sigmoidf(cf + bfg);
#pragma unroll
          for (int o = 1; o < 64; o <<= 1) { const float nb = shup(v, o, F.lane); if (F.lane >= o) v += nb; }
          mg[MG_B + (size_t)t * 8 + h] = v; mg[MG_I + (size_t)t * 8 + h] = ci + bi; } }
    P3REP(5) { float* bA = (float*)(F.ws + WS_BA); LAS float* al = (LAS float*)F.lds;
      for (int c = blockIdx.x; c < NCH; c += F.G) {
          __syncthreads();
          if (F.tid < 128) { const int s = F.tid >> 1, hf = F.tid & 1; float a[8]; unpack8(*(const u32x4*)(z + (size_t)(c * 64 + s) * ZW + ZLOW + hf * 8), a);
#pragma unroll
              for (int r = 0; r < 8; ++r) al[s * 16 + hf * 8 + r] = a[r]; }
          __syncthreads();
          for (int n = F.tid; n < 768; n += NTHR) { float wv[16];
#pragma unroll
              for (int r = 0; r < 16; ++r) wv[r] = wu[r * 768 + n];
              const float bb = bu[n]; float bs = 0.f; float* op = bA + (size_t)c * 64 * 768 + n;
#pragma unroll 4
              for (int s = 0; s < 64; ++s) { const f32x4 a0 = *(const LAS f32x4*)(al + s * 16), a1 = *(const LAS f32x4*)(al + s * 16 + 4), a2 = *(const LAS f32x4*)(al + s * 16 + 8), a3 = *(const LAS f32x4*)(al + s * 16 + 12);
                  float x = bb;
#pragma unroll
                  for (int r = 0; r < 4; ++r) { x += a0[r] * wv[r]; x += a1[r] * wv[4 + r]; x += a2[r] * wv[8 + r]; x += a3[r] * wv[12 + r]; }
                  bs += (fminf(x, 0.f) - __logf(1.0f + __expf(-fabsf(x)))) * (1.0f / 16.0f); op[(size_t)s * 768] = bs; } } }
    }
}

__device__ __forceinline__ f32x16 mfma32(bf16x8 a, bf16x8 b, f32x16 c) { return __builtin_amdgcn_mfma_f32_32x32x16_bf16(a, b, c, 0, 0, 0); }
__device__ __forceinline__ f32x4 mfma16(bf16x8 a, bf16x8 b, f32x4 c) { return __builtin_amdgcn_mfma_f32_16x16x32_bf16(a, b, c, 0, 0, 0); }
__device__ __forceinline__ f32x16 zero16() { f32x16 z;
#pragma unroll
    for (int i = 0; i < 16; ++i) z[i] = 0.f;
    return z; }

__device__ __forceinline__ void p4_index_scores(const Frame& F) {
    const bf16* iq = (const bf16*)(F.ws + WS_IQ); const bf16* ik = (const bf16*)(F.ws + WS_IK); const bf16* zw = (const bf16*)(F.ws + WS_Z) + ZIW; _Float16* sc = (_Float16*)(F.ws + WS_SCORE);
    LAS unsigned char* kl = F.lds;
    const int l15 = F.lane & 15, lq = F.lane >> 4;
    constexpr int NITEMS = 2112;
    for (int bi = blockIdx.x; bi < NITEMS; bi += F.G) {
        int j = 0, rem = bi; while (rem >= 128 - 4 * j) { rem -= 128 - 4 * j; ++j; }
        const int g = 8 * (4 * j + rem) + F.wave, t0 = 16 * g, s0 = 512 * j;
        int s_end = s0 + 512; if (s_end > t0 + 16) s_end = t0 + 16;
        __syncthreads();
        { int tl = F.tid; asm volatile("" : "+v"(tl));
#pragma unroll
          for (int i = 0; i < 8; ++i) { const int ch = tl + i * NTHR, row = ch >> 3, c8 = ch & 7;
              *(LAS u32x4*)(kl + row * 144 + c8 * 16) = *(const u32x4*)(ik + (size_t)(s0 + row) * 64 + c8 * 8); } }
        bf16x8 bq[16][2]; float w[16];
        const bf16* qp = iq + (size_t)(t0 + l15) * 1024 + 8 * lq;
#pragma unroll
        for (int h = 0; h < 16; ++h) { bq[h][0] = *(const bf16x8*)(qp + h * 64); bq[h][1] = *(const bf16x8*)(qp + h * 64 + 32); } { const bf16* wp = zw + (size_t)(t0 + l15) * ZW; float wa[8], wb[8]; unpack8(*(const u32x4*)wp, wa); unpack8(*(const u32x4*)(wp + 8), wb);
#pragma unroll
          for (int h = 0; h < 8; ++h) { w[h] = wa[h]; w[8 + h] = wb[h]; } }
        __syncthreads();
        _Float16* orow = sc + (size_t)(t0 + l15) * SEQ + 4 * lq;
        const LAS unsigned char* kp = kl + l15 * 144 + lq * 16;
        for (int s = s0; s < s_end; s += 16) {
            const bf16x8 a0 = *(const LAS bf16x8*)kp, a1 = *(const LAS bf16x8*)(kp + 64); kp += 16 * 144;
            f32x4 tot;
#pragma unroll
            for (int hh = 0; hh < 16; hh += 8) { f32x4 acc[8];
#pragma unroll
                for (int h = 0; h < 8; ++h) acc[h] = mfma16(a0, bq[hh + h][0], (f32x4){0.f, 0.f, 0.f, 0.f});
#pragma unroll
                for (int h = 0; h < 8; ++h) acc[h] = mfma16(a1, bq[hh + h][1], acc[h]);
                __builtin_amdgcn_sched_barrier(0);
#pragma unroll
                for (int h = 0; h < 8; ++h) {
#pragma unroll
                    for (int r = 0; r < 4; ++r) { const float c = fminf(fmaxf(acc[h][r], 0.f), 1.0f);
                        if (hh + h == 0) asm volatile("v_mul_f32 %0, %1, %2" : "=v"(tot[r]) : "v"(w[0]), "v"(c)); else asm volatile("v_fmac_f32 %0, %1, %2" : "+v"(tot[r]) : "v"(w[hh + h]), "v"(c)); } } }
            { typedef _Float16 h16x4 __attribute__((ext_vector_type(4))); h16x4 hv; hv[0] = (_Float16)tot[0]; hv[1] = (_Float16)tot[1]; hv[2] = (_Float16)tot[2]; hv[3] = (_Float16)tot[3]; *(h16x4*)(orow + s) = hv; }
        }
    }
}

__device__ __forceinline__ void p4_gla_local(const Frame& F) {
    const bf16* z = (const bf16*)(F.ws + WS_Z); const float* bA = (const float*)(F.ws + WS_BA); float* dS = (float*)(F.ws + WS_DS);
    LAS bf16* vT = (LAS bf16*)F.lds;
    LAS bf16* kT = vT + 128 * 72;
    const int r32 = F.lane & 31, hi = F.lane >> 5, s = F.tid >> 3, d8 = (F.tid & 7) * 8, e16 = (F.tid & 7) * 16;
    u32x4 kw, vw0, vw1; f32x4 b0, b1, e0, e1;
#define GLA_LOAD(u_) do { const int c_ = (u_) / 12, h_ = (u_) % 12, t0_ = c_ * 64; kw = *(const u32x4*)(z + (size_t)(t0_ + s) * ZW + ZK_A + h_ * 64 + d8); \
        const float* bp_ = bA + (size_t)(t0_ + s) * 768 + h_ * 64 + d8; const float* be_ = bA + (size_t)(t0_ + 63) * 768 + h_ * 64 + d8; \
        b0 = *(const f32x4*)bp_; b1 = *(const f32x4*)(bp_ + 4); e0 = *(const f32x4*)be_; e1 = *(const f32x4*)(be_ + 4); \
        const bf16* vp_ = z + (size_t)(t0_ + s) * ZW + ZV_A + h_ * 128 + e16; vw0 = *(const u32x4*)vp_; vw1 = *(const u32x4*)(vp_ + 8); } while (0)
    int u = blockIdx.x; if (u < NCH * 12) GLA_LOAD(u);
    for (; u < NCH * 12; u += F.G) {
        __syncthreads();
        { float kv[8]; unpack8(kw, kv);
#pragma unroll
          for (int j = 0; j < 4; ++j) { kT[(d8 + j) * 72 + s] = f2bf(kv[j] * __expf(e0[j] - b0[j])); kT[(d8 + 4 + j) * 72 + s] = f2bf(kv[4 + j] * __expf(e1[j] - b1[j])); }
          const unsigned ww[8] = {vw0.x, vw0.y, vw0.z, vw0.w, vw1.x, vw1.y, vw1.z, vw1.w};
#pragma unroll
          for (int j = 0; j < 8; ++j) { vT[(e16 + 2 * j) * 72 + s] = (bf16)(ww[j] & 0xffffu); vT[(e16 + 2 * j + 1) * 72 + s] = (bf16)(ww[j] >> 16); } }
        __syncthreads();
        if (u + F.G < NCH * 12) GLA_LOAD(u + F.G);
        const int et = F.wave >> 1, dt = F.wave & 1; f32x16 acc = zero16();
#pragma unroll
        for (int kk = 0; kk < 4; ++kk) { const bf16x8 a = *(const LAS bf16x8*)(kT + (32 * dt + r32) * 72 + 16 * kk + 8 * hi), b = *(const LAS bf16x8*)(vT + (32 * et + r32) * 72 + 16 * kk + 8 * hi); acc = mfma32(a, b, acc); }
        float* o = dS + ((size_t)u * 128 + 32 * et + r32) * 64 + 32 * dt + 4 * hi;
#pragma unroll
        for (int g = 0; g < 4; ++g) *(f32x4*)(o + 8 * g) = (f32x4){acc[4 * g], acc[4 * g + 1], acc[4 * g + 2], acc[4 * g + 3]};
    }
#undef GLA_LOAD
}

__device__ __forceinline__ void p4_mlstm_local(const Frame& F) {
    const bf16* z = (const bf16*)(F.ws + WS_Z); const bf16* ck = (const bf16*)(F.ws + WS_CK); float* mg = (float*)(F.ws + WS_MG); float* dC = (float*)(F.ws + WS_DC);
    LAS bf16* vT = (LAS bf16*)F.lds;
    LAS bf16* kT = vT + 256 * 72;
    LAS float* wsl = (LAS float*)(kT + 128 * 72);
    const int r32 = F.lane & 31, hi = F.lane >> 5, s = F.tid >> 3, d16 = (F.tid & 7) * 16, e32 = (F.tid & 7) * 32;
    u32x4 kw0, kw1, vw[4]; float gbs = 0.f, gig = 0.f;
#define ML_LOAD(u_) do { const int c_ = (u_) / 6, h_ = (u_) % 6, t0_ = c_ * 64; const bf16* kp_ = ck + (size_t)(t0_ + s) * 768 + h_ * 128 + d16; kw0 = *(const u32x4*)kp_; kw1 = *(const u32x4*)(kp_ + 8); \
        const bf16* vp_ = z + (size_t)(t0_ + s) * ZW + ZV_C + h_ * 256 + e32; _Pragma("unroll") for (int q_ = 0; q_ < 4; ++q_) vw[q_] = *(const u32x4*)(vp_ + 8 * q_); \
        if (F.wave == 0) { gbs = mg[MG_B + (size_t)(t0_ + F.lane) * 8 + h_]; gig = mg[MG_I + (size_t)(t0_ + F.lane) * 8 + h_]; } } while (0)
    int u = blockIdx.x; if (u < NCH * 6) ML_LOAD(u);
    for (; u < NCH * 6; u += F.G) {
        __syncthreads();
        if (F.wave == 0) { const float be = __int_as_float(__builtin_amdgcn_readlane(__float_as_int(gbs), 63));
            const float a = be - gbs + gig; const float ml = wave_max(a, F.lane); wsl[F.lane] = __expf(a - ml); if (F.lane == 0) { mg[MG_ML + (size_t)u * 2] = be; mg[MG_ML + (size_t)u * 2 + 1] = ml; } }
        __syncthreads();
        { const float wsv = wsl[s]; float k0[8], k1[8]; unpack8(kw0, k0); unpack8(kw1, k1);
#pragma unroll
          for (int j = 0; j < 8; ++j) { kT[(d16 + j) * 72 + s] = f2bf(k0[j] * wsv); kT[(d16 + 8 + j) * 72 + s] = f2bf(k1[j] * wsv); }
#pragma unroll
          for (int q = 0; q < 4; ++q) { const unsigned ww[4] = {vw[q].x, vw[q].y, vw[q].z, vw[q].w};
#pragma unroll
              for (int j = 0; j < 4; ++j) { vT[(e32 + 8 * q + 2 * j) * 72 + s] = (bf16)(ww[j] & 0xffffu); vT[(e32 + 8 * q + 2 * j + 1) * 72 + s] = (bf16)(ww[j] >> 16); } } }
        __syncthreads();
        if (u + F.G < NCH * 6) ML_LOAD(u + F.G);
        if (F.tid < 128) { float sum = 0.f; const LAS bf16* kr = kT + F.tid * 72;
#pragma unroll 8
            for (int ss = 0; ss < 64; ++ss) sum += bf2f(kr[ss]);
            mg[MG_DN + (size_t)u * 128 + F.tid] = sum; }
        const int et = F.wave; bf16x8 bv[4];
#pragma unroll
        for (int kk = 0; kk < 4; ++kk) bv[kk] = *(const LAS bf16x8*)(vT + (32 * et + r32) * 72 + 16 * kk + 8 * hi);
        float* o = dC + ((size_t)u * 256 + 32 * et + r32) * 128 + 4 * hi;
#pragma unroll
        for (int dt = 0; dt < 4; ++dt) { f32x16 acc = zero16();
#pragma unroll
            for (int kk = 0; kk < 4; ++kk) { const bf16x8 a = *(const LAS bf16x8*)(kT + (32 * dt + r32) * 72 + 16 * kk + 8 * hi); acc = mfma32(a, bv[kk], acc); }
#pragma unroll
            for (int g = 0; g < 4; ++g) *(f32x4*)(o + 32 * dt + 8 * g) = (f32x4){acc[4 * g], acc[4 * g + 1], acc[4 * g + 2], acc[4 * g + 3]}; }
    }
#undef ML_LOAD
}

#ifndef SCAN_B
#define SCAN_B 16
#endif
__device__ __forceinline__ void p5_scans(const Frame& F) {
    const float* bA = (const float*)(F.ws + WS_BA); const float* dS = (const float*)(F.ws + WS_DS); bf16* SP = (bf16*)(F.ws + WS_SP);
    float* mg = (float*)(F.ws + WS_MG); const float* dC = (const float*)(F.ws + WS_DC); bf16* CP = (bf16*)(F.ws + WS_CP);
    for (int grp = blockIdx.x + F.G * F.wave; grp < 1155; grp += F.G * 8) {
        const int l = F.lane;
        if (grp < 384) {
            const int i = grp * 64 + l, h = i >> 11, rem = i & 2047, e = rem >> 4, d4 = (rem & 15) * 4;
            f32x4 S = {0.f, 0.f, 0.f, 0.f};
            for (int c0 = 0; c0 < NCH; c0 += SCAN_B) { f32x4 dl[SCAN_B]; f32x4 dc[SCAN_B];
#pragma unroll
                for (int k = 0; k < SCAN_B; ++k) { const int c = c0 + k; dl[k] = *(const f32x4*)(dS + ((size_t)(c * 12 + h) * 128 + e) * 64 + d4); dc[k] = *(const f32x4*)(bA + (size_t)(c * 64 + 63) * 768 + h * 64 + d4); }
#pragma unroll
                for (int k = 0; k < SCAN_B; ++k) { const int c = c0 + k; u32x2 w; w.x = pk2(S[0], S[1]); w.y = pk2(S[2], S[3]); *(u32x2*)(SP + ((size_t)(c * 12 + h) * 128 + e) * 64 + d4) = w;
                    const float dv[4] = {dl[k][0], dl[k][1], dl[k][2], dl[k][3]};
#pragma unroll
                    for (int q = 0; q < 4; ++q) S[q] = __expf(dc[k][q]) * S[q] + dv[q]; } }
        } else {
            const int i = (grp - 384) * 64 + l; const bool isn = i >= 49152; const int ii = isn ? i - 49152 : i;
            const int h = isn ? (ii >> 5) : (ii >> 13), rem = ii & 8191, e = rem >> 5, d4 = (ii & 31) * 4;
            f32x4 S = {0.f, 0.f, 0.f, 0.f}; float m = 0.f;
            for (int c0 = 0; c0 < NCH; c0 += SCAN_B) { f32x4 dl[SCAN_B]; f32x2 ml[SCAN_B];
#pragma unroll
                for (int k = 0; k < SCAN_B; ++k) { const int c = c0 + k; ml[k] = *(const f32x2*)(mg + MG_ML + (size_t)(c * 6 + h) * 2);
                    if (isn) dl[k] = *(const f32x4*)(mg + MG_DN + (size_t)(c * 6 + h) * 128 + d4);
                    else dl[k] = *(const f32x4*)(dC + ((size_t)(c * 6 + h) * 256 + e) * 128 + d4); }
#pragma unroll
                for (int k = 0; k < SCAN_B; ++k) { const int c = c0 + k;
                    if (isn) { *(f32x4*)(mg + MG_NP + (size_t)(c * 6 + h) * 128 + d4) = S; if (d4 == 0) mg[MG_MP + (size_t)(c * 6 + h)] = m; }
                    else { u32x2 w; w.x = pk2(S[0], S[1]); w.y = pk2(S[2], S[3]); *(u32x2*)(CP + ((size_t)(c * 6 + h) * 256 + e) * 128 + d4) = w; }
                    const float a_state = ml[k][0] + m, m_new = fmaxf(a_state, ml[k][1]), f1 = __expf(a_state - m_new), f2 = __expf(ml[k][1] - m_new);
#pragma unroll
                    for (int q = 0; q < 4; ++q) S[q] = f1 * S[q] + f2 * dl[k][q];
                    m = m_new; } }
        }
    }
}

__device__ __forceinline__ unsigned long long perm_word(unsigned long long x) {
    unsigned long long t;
    t = ((x >> 4) ^ x) & 0x00F000F000F000F0ull; x ^= t ^ (t << 4);
    t = ((x >> 8) ^ x) & 0x0000FF000000FF00ull; x ^= t ^ (t << 8);
    t = ((x >> 16) ^ x) & 0x00000000FFFF0000ull; x ^= t ^ (t << 16);
    return x;
}
__device__ __forceinline__ void p5_select(const Frame& F) {
    const _Float16* sc = (const _Float16*)(F.ws + WS_SCORE); unsigned long long* mask = (unsigned long long*)(F.ws + WS_MASK);
    LAS unsigned char* wl = F.lds + F.wave * 12288;
    LAS unsigned* hist = (LAS unsigned*)wl;
    LAS unsigned* words = (LAS unsigned*)(wl + 8192);
    LAS float* cval = (LAS float*)(wl + 8192 + 2048);
    LAS int* ckey = (LAS int*)(wl + 8192 + 3072);
    const float PINF = __builtin_inff();
    for (int t = F.gw; t < SEQ; t += F.NGW) {
        int lane = F.lane; asm volatile("" : "+v"(lane));
        const unsigned long long lt_mask = (1ull << lane) - 1ull; const int lane8 = lane * 8;
        const int n = t + 1, nw = 4 * (t / 256 + 1), ng = (n + 63) >> 6;
        const _Float16* row = sc + (size_t)t * SEQ; unsigned long long* mrow = mask + (size_t)t * 256;
        if (n <= 256) {
            if (lane < nw) { const int k0 = lane * 64; const unsigned long long w = (t >= k0 + 63) ? ~0ull : (t < k0 ? 0ull : ((2ull << (t - k0)) - 1ull)); mrow[lane] = perm_word(w); }
            continue; }
        typedef _Float16 h16x8 __attribute__((ext_vector_type(8)));
        const int ng8 = (n + 511) >> 9; const h16x8* row8 = (const h16x8*)row + lane;
        h16x8 vv[32];
#pragma unroll
        for (int g = 0; g < 32; ++g) vv[g] = row8[(g < ng8 ? g : 0) * 64];
        float lmin = PINF, lmax = -PINF;
#pragma unroll
        for (int g = 0; g < 32; ++g) if (g < ng8) {
#pragma unroll
            for (int j = 0; j < 8; ++j) if (lane8 < n - (g * 512 + j)) { const float v = (float)vv[g][j]; lmin = fminf(lmin, v); lmax = fmaxf(lmax, v); } }
#pragma unroll
        for (int g = 0; g < 32; ++g) asm volatile("" : "+v"(vv[g]));
        lmin = -wave_max(-lmin, lane); lmax = wave_max(lmax, lane);
        const float span = lmax - lmin, lo = lmin, scale = span > 0.f ? 2047.0f / span : 0.f, los = -lo * scale;
#pragma unroll
        for (int k = 0; k < 8; ++k) *(LAS u32x4*)(hist + (k * 64 + lane) * 4) = (u32x4){0u, 0u, 0u, 0u};
#pragma unroll
        for (int k = 0; k < 2; ++k) *(LAS u32x4*)(words + (k * 64 + lane) * 4) = (u32x4){0u, 0u, 0u, 0u};
#pragma unroll
        for (int g = 0; g < 32; ++g) if (g < ng8) {
#pragma unroll
            for (int j = 0; j < 8; ++j) if (lane8 < n - (g * 512 + j)) { int b = (int)fmaf((float)vv[g][j], scale, los); b = b < 0 ? 0 : (b > 2047 ? 2047 : b);
                __hip_atomic_fetch_add(&hist[b], 1u, __ATOMIC_RELAXED, __HIP_MEMORY_SCOPE_WORKGROUP);
#ifdef PROBE_ATOM2
                asm volatile("" ::: "memory"); __hip_atomic_fetch_add(&hist[b], 1u, __ATOMIC_RELAXED, __HIP_MEMORY_SCOPE_WORKGROUP);
#endif
                } }
        unsigned mine = 0;
#pragma unroll
        for (int q = 0; q < 8; ++q) { const u32x4 x = *(const LAS u32x4*)(hist + lane * 32 + q * 4); mine += (x.x + x.y) + (x.z + x.w); }
#ifdef PROBE_ATOM2
        mine >>= 1;
#endif
        unsigned suf = mine;
#pragma unroll
        for (int o = 1; o < 64; o <<= 1) { const unsigned nb = shdn_u(suf, o, lane); if (lane + o < 64) suf += nb; }
        unsigned above = suf - mine; int Bl = -1; unsigned cal = 0;
        if (above < 256u && above + mine >= 256u) {
            for (int q = 31; q >= 0; --q) { unsigned hq = hist[lane * 32 + q];
#ifdef PROBE_ATOM2
                hq >>= 1;
#endif
                if (Bl < 0 && above + hq >= 256u) { Bl = lane * 32 + q; cal = above; } above += hq; } }
        const unsigned long long hitm = __ballot(Bl >= 0); const int src = hitm ? __builtin_ctzll(hitm) : 0;
        const int Bs = __builtin_amdgcn_readlane(Bl, src); const unsigned cnt_above = (unsigned)__builtin_amdgcn_readlane((int)cal, src);
#pragma unroll
        for (int g = 0; g < 32; ++g) asm volatile("" : "+v"(vv[g]));
        unsigned m = 0; LAS unsigned char* wbytes = (LAS unsigned char*)words;
#pragma unroll
        for (int g = 0; g < 32; ++g) if (g < ng8) { unsigned abits = 0, cbits = 0;
#pragma unroll
            for (int j = 0; j < 8; ++j) { int b = -1; if (lane8 < n - (g * 512 + j)) { b = (int)fmaf((float)vv[g][j], scale, los); b = b < 0 ? 0 : (b > 2047 ? 2047 : b); }
                abits |= (b > Bs ? 1u : 0u) << j; cbits |= (b == Bs ? 1u : 0u) << j; }
            wbytes[g * 64 + lane] = (unsigned char)abits;
            if (__ballot(cbits != 0u)) {
#pragma unroll
                for (int j = 0; j < 8; ++j) { const bool isc = (cbits >> j) & 1u; const unsigned long long bc = __ballot(isc);
                    if (bc) { const unsigned pos = m + (unsigned)__builtin_popcountll(bc & lt_mask); if (isc && pos < 256u) { cval[pos] = (float)vv[g][j]; ckey[pos] = lane8 + (g * 512 + j); } m += (unsigned)__builtin_popcountll(bc); } } } }
        const unsigned need = 256u - cnt_above;
        if (m <= 256u) {
            for (unsigned c = lane; c < m; c += 64) { const float mv = cval[c]; const int mk = ckey[c]; unsigned rank = 0;
                for (unsigned j = 0; j < m; ++j) { const float ov = cval[j]; const int ok = ckey[j]; rank += (ov > mv || (ov == mv && ok < mk)) ? 1u : 0u; }
                if (rank < need) __hip_atomic_fetch_or(&words[2 * (mk >> 6) + ((mk >> 5) & 1)], 1u << (mk & 31), __ATOMIC_RELAXED, __HIP_MEMORY_SCOPE_WORKGROUP); }
        } else {
            for (int g = 0; g < ng; ++g) { const int key = g * 64 + lane; int b = -1; if (key < n) { b = (int)fmaf((float)row[key], scale, los); b = b < 0 ? 0 : (b > 2047 ? 2047 : b); }
                const unsigned long long bc = __ballot(b == Bs); if (lane == 0) { words[2 * g] |= (unsigned)bc; words[2 * g + 1] |= (unsigned)(bc >> 32); } }
        }
#pragma unroll
        for (int k = 0; k < 4; ++k) { const int w = lane + 64 * k; if (w < nw) { const unsigned long long x = (unsigned long long)words[2 * w] | ((unsigned long long)words[2 * w + 1] << 32); mrow[w] = perm_word(x); } }
    }
}

__device__ __forceinline__ void p6_gla_out(const Frame& F, const float* gain) {
    const bf16* z = (const bf16*)(F.ws + WS_Z); const float* bA = (const float*)(F.ws + WS_BA); const bf16* SP = (const bf16*)(F.ws + WS_SP); bf16* y = (bf16*)(F.ws + WS_Y);
    LAS bf16* qd = (LAS bf16*)F.lds;
    LAS bf16* ki = qd + 64 * 72;
    LAS bf16* vT = ki + 64 * 72;
    LAS bf16* scl = vT + 128 * 72;
    LAS float* part = (LAS float*)(scl + 64 * 72);
    const int r32 = F.lane & 31, hi = F.lane >> 5, s = F.tid >> 3, d8 = (F.tid & 7) * 8, e16 = (F.tid & 7) * 16;
    u32x4 qw, kw, vw0, vw1; f32x4 b0, b1;
#define GO_LOAD(u_) do { const int c_ = (u_) / 12, h_ = (u_) % 12, t0_ = c_ * 64; const bf16* zr_ = z + (size_t)(t0_ + s) * ZW; qw = *(const u32x4*)(zr_ + ZQ_A + h_ * 64 + d8); kw = *(const u32x4*)(zr_ + ZK_A + h_ * 64 + d8); \
        const float* bp_ = bA + (size_t)(t0_ + s) * 768 + h_ * 64 + d8; b0 = *(const f32x4*)bp_; b1 = *(const f32x4*)(bp_ + 4); vw0 = *(const u32x4*)(zr_ + ZV_A + h_ * 128 + e16); vw1 = *(const u32x4*)(zr_ + ZV_A + h_ * 128 + e16 + 8); } while (0)
    int u = blockIdx.x; if (u < NCH * 12) GO_LOAD(u);
    for (; u < NCH * 12; u += F.G) {
        const int c = u / 12, h = u % 12, t0 = c * 64;
        __syncthreads();
        { float qv[8], kv[8], qo[8], ko[8]; unpack8(qw, qv); unpack8(kw, kv);
#pragma unroll
          for (int j = 0; j < 4; ++j) { const float ea = __expf(b0[j]), eb = __expf(b1[j]); qo[j] = qv[j] * 0.125f * ea; qo[4 + j] = qv[4 + j] * 0.125f * eb; ko[j] = kv[j] / ea; ko[4 + j] = kv[4 + j] / eb; }
          *(LAS u32x4*)(qd + s * 72 + d8) = pack8f(qo); *(LAS u32x4*)(ki + s * 72 + d8) = pack8f(ko);
          const unsigned ww[8] = {vw0.x, vw0.y, vw0.z, vw0.w, vw1.x, vw1.y, vw1.z, vw1.w};
#pragma unroll
          for (int j = 0; j < 8; ++j) { vT[(e16 + 2 * j) * 72 + s] = (bf16)(ww[j] & 0xffffu); vT[(e16 + 2 * j + 1) * 72 + s] = (bf16)(ww[j] >> 16); } }
        __syncthreads();
        if (u + F.G < NCH * 12) GO_LOAD(u + F.G);
        const int et = F.wave >> 1, tt = F.wave & 1, t = 32 * tt + r32;
        bf16x8 sa[4]; u32x2 gzv[4];
        { const bf16* sp = SP + ((size_t)u * 128 + 32 * et + r32) * 64 + 8 * hi;
#pragma unroll
          for (int kk = 0; kk < 4; ++kk) sa[kk] = *(const bf16x8*)(sp + 16 * kk);
#pragma unroll
          for (int g = 0; g < 4; ++g) gzv[g] = *(const u32x2*)(z + (size_t)(t0 + t) * ZW + ZGATE_A + h * 128 + 32 * et + 8 * g + 4 * hi); }
        if (F.wave < 4) { const int st = F.wave >> 1; f32x16 acc = zero16();
#pragma unroll
            for (int kk = 0; kk < 4; ++kk) { const bf16x8 a = *(const LAS bf16x8*)(ki + (32 * st + r32) * 72 + 16 * kk + 8 * hi), b = *(const LAS bf16x8*)(qd + (32 * tt + r32) * 72 + 16 * kk + 8 * hi); acc = mfma32(a, b, acc); }
#pragma unroll
            for (int g = 0; g < 4; ++g) { const int sb = 32 * st + 8 * g + 4 * hi; float m[4];
#pragma unroll
                for (int j = 0; j < 4; ++j) m[j] = (sb + j <= t) ? acc[4 * g + j] : 0.f;
                u32x2 w; w.x = pk2(m[0], m[1]); w.y = pk2(m[2], m[3]); *(LAS u32x2*)(scl + t * 72 + sb) = w; } }
        __syncthreads();
        f32x16 acc = zero16();
#pragma unroll
        for (int kk = 0; kk < 4; ++kk) { const bf16x8 b = *(const LAS bf16x8*)(qd + t * 72 + 16 * kk + 8 * hi); acc = mfma32(sa[kk], b, acc); }
#pragma unroll
        for (int kk = 0; kk < 4; ++kk) { const bf16x8 a = *(const LAS bf16x8*)(vT + (32 * et + r32) * 72 + 16 * kk + 8 * hi), b = *(const LAS bf16x8*)(scl + t * 72 + 16 * kk + 8 * hi); acc = mfma32(a, b, acc); }
        float ss = 0.f;
#pragma unroll
        for (int r = 0; r < 16; ++r) ss += acc[r] * acc[r];
        ss += shx(ss, 32, F.lane);
        if (hi == 0) part[t * 4 + et] = ss;
        __syncthreads();
        const f32x4 pp = *(const LAS f32x4*)(part + t * 4); const float rs = 1.0f / sqrtf(((pp[0] + pp[1]) + (pp[2] + pp[3])) * (1.0f / 128.0f) + NORM_EPS);
#pragma unroll
        for (int g = 0; g < 4; ++g) { const int e0 = 32 * et + 8 * g + 4 * hi; const f32x4 gv = *(const f32x4*)(gain + h * 128 + e0);
            const u32x2 gz = gzv[g]; const float ga[4] = {bflo(gz.x), bfhi(gz.x), bflo(gz.y), bfhi(gz.y)}; float o[4];
#pragma unroll
            for (int j = 0; j < 4; ++j) o[j] = acc[4 * g + j] * rs * gv[j] * siluf_(ga[j]);
            u32x2 w; w.x = pk2(o[0], o[1]); w.y = pk2(o[2], o[3]); *(u32x2*)(y + (size_t)(t0 + t) * DM + YA + h * 128 + e0) = w; }
    }
#undef GO_LOAD
}

__device__ __forceinline__ void p6_mlstm_out(const Frame& F, const float* gain) {
    const bf16* z = (const bf16*)(F.ws + WS_Z); const bf16* cq = (const bf16*)(F.ws + WS_CQ); const bf16* ck = (const bf16*)(F.ws + WS_CK); const float* mg = (const float*)(F.ws + WS_MG);
    const bf16* CP = (const bf16*)(F.ws + WS_CP); bf16* y = (bf16*)(F.ws + WS_Y);
    LAS bf16* qs = (LAS bf16*)F.lds;
    LAS bf16* ks = qs + 64 * 136;
    LAS bf16* vT = ks + 64 * 136;
    LAS bf16* pw = vT + 256 * 72;
    LAS float* fl = (LAS float*)(pw + 64 * 72);
    LAS float* bc = fl;
    LAS float* ig = fl + 64;
    LAS float* mt = fl + 128;
    LAS float* wi = fl + 192;
    LAS float* qn = fl + 256;
    LAS float* rp = fl + 320;
    LAS float* np = fl + 448;
    LAS float* sp = fl + 576;
    const int r32 = F.lane & 31, hi = F.lane >> 5, s = F.tid >> 3, d16 = (F.tid & 7) * 16, e32 = (F.tid & 7) * 32;
    u32x4 qw0, qw1, kw0, kw1, vw[4]; float gb = 0.f, gi = 0.f, gn0 = 0.f, gn1 = 0.f, gmp = 0.f;
#define MO_LOAD(u_) do { const int c_ = (u_) / 6, h_ = (u_) % 6, t0_ = c_ * 64; const bf16* qp_ = cq + (size_t)(t0_ + s) * 768 + h_ * 128 + d16; const bf16* kp_ = ck + (size_t)(t0_ + s) * 768 + h_ * 128 + d16; \
        qw0 = *(const u32x4*)qp_; qw1 = *(const u32x4*)(qp_ + 8); kw0 = *(const u32x4*)kp_; kw1 = *(const u32x4*)(kp_ + 8); \
        const bf16* vp_ = z + (size_t)(t0_ + s) * ZW + ZV_C + h_ * 256 + e32; _Pragma("unroll") for (int q_ = 0; q_ < 4; ++q_) vw[q_] = *(const u32x4*)(vp_ + 8 * q_); \
        gmp = mg[MG_MP + (size_t)(u_)]; \
        if (F.wave == 0) { gb = mg[MG_B + (size_t)(t0_ + F.lane) * 8 + h_]; gi = mg[MG_I + (size_t)(t0_ + F.lane) * 8 + h_]; } \
        if (F.wave == 1) { gn0 = mg[MG_NP + (size_t)(u_) * 128 + F.lane]; gn1 = mg[MG_NP + (size_t)(u_) * 128 + 64 + F.lane]; } } while (0)
    int u = blockIdx.x; if (u < NCH * 6) MO_LOAD(u);
    for (; u < NCH * 6; u += F.G) {
        const int c = u / 6, h = u % 6, t0 = c * 64;
        __syncthreads();
        { *(LAS u32x4*)(qs + s * 136 + d16) = qw0; *(LAS u32x4*)(qs + s * 136 + d16 + 8) = qw1; *(LAS u32x4*)(ks + s * 136 + d16) = kw0; *(LAS u32x4*)(ks + s * 136 + d16 + 8) = kw1;
#pragma unroll
          for (int q = 0; q < 4; ++q) { const unsigned ww[4] = {vw[q].x, vw[q].y, vw[q].z, vw[q].w};
#pragma unroll
              for (int j = 0; j < 4; ++j) { vT[(e32 + 8 * q + 2 * j) * 72 + s] = (bf16)(ww[j] & 0xffffu); vT[(e32 + 8 * q + 2 * j + 1) * 72 + s] = (bf16)(ww[j] >> 16); } } }
        const float m_prev = gmp;
        if (F.wave == 0) { const float b = gb, ii = gi; float pm = ii - b;
#pragma unroll
            for (int o = 1; o < 64; o <<= 1) { const float nb = shup(pm, o, F.lane); if (F.lane >= o) pm = fmaxf(pm, nb); }
            const float m = b + fmaxf(m_prev, pm); bc[F.lane] = b; ig[F.lane] = ii; mt[F.lane] = m; wi[F.lane] = __expf(b + m_prev - m); }
        if (F.wave == 1) { np[F.lane] = gn0; np[64 + F.lane] = gn1; }
        __syncthreads();
        if (u + F.G < NCH * 6) MO_LOAD(u + F.G);
        const int et = F.wave; bf16x8 ca[8];
        { const bf16* cp = CP + ((size_t)u * 256 + 32 * et + r32) * 128 + 8 * hi;
#pragma unroll
          for (int kk = 0; kk < 8; ++kk) ca[kk] = *(const bf16x8*)(cp + 16 * kk); }
        if (F.wave >= 4) { const int tq = (F.tid - 256) >> 2, qq = (F.tid - 256) & 3; float s = 0.f;
#pragma unroll 8
            for (int d = 0; d < 32; ++d) s += bf2f(qs[tq * 136 + qq * 32 + d]) * np[qq * 32 + d];
            s += shx(s, 1, F.lane); s += shx(s, 2, F.lane); if (qq == 0) qn[tq] = s; }
        else { const int st = F.wave >> 1, tt = F.wave & 1, t = 32 * tt + r32; f32x16 acc = zero16();
#pragma unroll
            for (int kk = 0; kk < 8; ++kk) { const bf16x8 a = *(const LAS bf16x8*)(ks + (32 * st + r32) * 136 + 16 * kk + 8 * hi), b = *(const LAS bf16x8*)(qs + t * 136 + 16 * kk + 8 * hi); acc = mfma32(a, b, acc); }
            const float bt = bc[t], mtt = mt[t]; float rsum = 0.f;
#pragma unroll
            for (int g = 0; g < 4; ++g) { const int sb = 32 * st + 8 * g + 4 * hi; float m[4];
#pragma unroll
                for (int j = 0; j < 4; ++j) { const int s = sb + j; const float w = (s <= t) ? __expf(bt - bc[s] + ig[s] - mtt) : 0.f; m[j] = acc[4 * g + j] * w; rsum += m[j]; }
                u32x2 w2; w2.x = pk2(m[0], m[1]); w2.y = pk2(m[2], m[3]); *(LAS u32x2*)(pw + t * 72 + sb) = w2; }
            rsum += shx(rsum, 32, F.lane); if (hi == 0) rp[t * 2 + st] = rsum; }
        __syncthreads();
        f32x16 hv[2];
        { bf16x8 va[4];
#pragma unroll
          for (int kk = 0; kk < 4; ++kk) va[kk] = *(const LAS bf16x8*)(vT + (32 * et + r32) * 72 + 16 * kk + 8 * hi);
#pragma unroll
          for (int tt = 0; tt < 2; ++tt) { const int t = 32 * tt + r32; f32x16 aI = zero16(), aA = zero16();
#pragma unroll
              for (int kk = 0; kk < 8; ++kk) { const bf16x8 b = *(const LAS bf16x8*)(qs + t * 136 + 16 * kk + 8 * hi); aI = mfma32(ca[kk], b, aI); }
#pragma unroll
              for (int kk = 0; kk < 4; ++kk) { const bf16x8 b = *(const LAS bf16x8*)(pw + t * 72 + 16 * kk + 8 * hi); aA = mfma32(va[kk], b, aA); }
              const float w = wi[t], den = w * qn[t] + rp[t * 2] + rp[t * 2 + 1], dn = 1.0f / fmaxf(fabsf(den), __expf(-mt[t])); float ss = 0.f;
#pragma unroll
              for (int r = 0; r < 16; ++r) { const float x = (w * aI[r] + aA[r]) * dn; hv[tt][r] = x; ss += x * x; }
              ss += shx(ss, 32, F.lane); if (hi == 0) sp[t * 8 + et] = ss; } }
        __syncthreads();
#pragma unroll
        for (int tt = 0; tt < 2; ++tt) { const int t = 32 * tt + r32; const f32x4 p0 = *(const LAS f32x4*)(sp + t * 8), p1 = *(const LAS f32x4*)(sp + t * 8 + 4);
            const float rs = 1.0f / sqrtf((((p0[0] + p0[1]) + (p0[2] + p0[3])) + ((p1[0] + p1[1]) + (p1[2] + p1[3]))) * (1.0f / 256.0f) + NORM_EPS);
            const bf16* zr = z + (size_t)(t0 + t) * ZW + h * 256;
#pragma unroll
            for (int g = 0; g < 4; ++g) { const int e0 = 32 * et + 8 * g + 4 * hi; const f32x4 gv = *(const f32x4*)(gain + h * 256 + e0);
                const u32x2 oz = *(const u32x2*)(zr + ZO_C + e0), gz = *(const u32x2*)(zr + ZGATE_C + e0);
                const float oa[4] = {bflo(oz.x), bfhi(oz.x), bflo(oz.y), bfhi(oz.y)}, ga[4] = {bflo(gz.x), bfhi(gz.x), bflo(gz.y), bfhi(gz.y)}; float o[4];
#pragma unroll
                for (int j = 0; j < 4; ++j) o[j] = hv[tt][4 * g + j] * rs * gv[j] * sigmoidf_(oa[j]) * siluf_(ga[j]);
                u32x2 w; w.x = pk2(o[0], o[1]); w.y = pk2(o[2], o[3]); *(u32x2*)(y + (size_t)(t0 + t) * DM + YC + h * 256 + e0) = w; } }
    }
#undef MO_LOAD
}

namespace dsa {
constexpr int D = 128, NW = 8, QBLK = 32, KVBLK = 64, QB = NW * QBLK;
constexpr int SHM_V = KVBLK * D * 2, SHM_K = KVBLK * D * 2;
constexpr int LDS_BYTES = 2 * SHM_V + 2 * SHM_K + NW * 64 * 4;
constexpr float SCALE = 0.08838834764831845f;
constexpr float THR = 8.f;
constexpr bool WSKIP = false;
constexpr size_t VOFF = (WS_VA - WS_KA) / 2;
typedef short s16x4 __attribute__((ext_vector_type(4)));
template <class A, class Bt> struct same_t { static constexpr bool v = false; };
template <class A> struct same_t<A, A> { static constexpr bool v = true; };
#define KSWZ(row, colB) ((row) * 256 + ((colB) ^ (((row) & 7) << 4)))
#define SBAR() __builtin_amdgcn_sched_barrier(0)
__device__ __forceinline__ int v_st(int k, int c) { const int kk = (k & ~0xC) | ((k & 4) << 1) | ((k & 8) >> 1); return ((kk >> 3) * 4 + (c >> 5)) * 512 + ((kk & 7) * 32 + (c & 31)) * 2; }
__device__ __forceinline__ int v_rd_base(int lane) { return ((lane & 3) << 3) | (((lane >> 2) & 3) << 6) | (((lane >> 4) & 1) << 5) | (((lane >> 5) & 1) << 8); }
constexpr int v_rd_off(int d0, int ks, int half) { return d0 * 512 + ks * 4096 + half * 2048; }
__device__ __forceinline__ unsigned cvtpk(float lo, float hi) {
    unsigned r; asm volatile("v_cvt_pk_bf16_f32 %0, %1, %2" : "=v"(r) : "v"(lo), "v"(hi)); return r;
}
__device__ __forceinline__ bf16x8 pack8(f32x4 a, f32x4 b) {
    u32x4 w = {cvtpk(a[0], a[1]), cvtpk(a[2], a[3]), cvtpk(b[0], b[1]), cvtpk(b[2], b[3])};
    return *reinterpret_cast<bf16x8*>(&w);
}
template <class T> __device__ __forceinline__ bf16x8 load8(const T* p) {
    if constexpr (same_t<T, float>::v) { return pack8(*(const f32x4*)p, *(const f32x4*)(p + 4)); }
    else { return *reinterpret_cast<const bf16x8*>(p); }
}
__device__ __forceinline__ void mask_bits(f32x16& p0, f32x16& p1, unsigned w) {
#pragma unroll
    for (int r = 0; r < 16; ++r) {
        const unsigned m0 = (unsigned)__builtin_amdgcn_sbfe((int)w, r, 1), m1 = (unsigned)__builtin_amdgcn_sbfe((int)w, 16 + r, 1);
        p0[r] = __uint_as_float((__float_as_uint(p0[r]) & m0) | (0xff800000u & ~m0));
        p1[r] = __uint_as_float((__float_as_uint(p1[r]) & m1) | (0xff800000u & ~m1));
    }
}
__device__ __forceinline__ void partialSM(f32x16& p0, f32x16& p1, float& m_reg, float& mn, float& alpha) {
    float pmax = p0[0]; for (int r = 1; r < 16; ++r) pmax = fmaxf(pmax, p0[r]); for (int r = 0; r < 16; ++r) pmax = fmaxf(pmax, p1[r]);
    { auto rr = __builtin_amdgcn_permlane32_swap(__float_as_uint(pmax), __float_as_uint(pmax), false, false);
      pmax = fmaxf(__uint_as_float(rr[0]), __uint_as_float(rr[1])); }
    constexpr float C2 = 1.4426950408889634f * SCALE;
    if (__builtin_expect(__all((pmax - m_reg) * SCALE <= THR), 1)) { mn = m_reg; alpha = 1.f; }
    else { mn = fmaxf(m_reg, pmax); alpha = __builtin_amdgcn_exp2f((m_reg - mn) * C2); m_reg = mn; }
    const float mnL = -mn * C2;
    for (int r = 0; r < 16; ++r) p0[r] = fmaf(p0[r], C2, mnL); for (int r = 0; r < 16; ++r) p1[r] = fmaf(p1[r], C2, mnL);
    for (int r = 0; r < 16; ++r) p0[r] = __builtin_amdgcn_exp2f(p0[r]);
}
__device__ __forceinline__ void finishSM(f32x16& p0, f32x16& p1, float alpha, float& l_reg, bf16x8& pa0, bf16x8& pa1, bf16x8& pa2, bf16x8& pa3) {
    for (int r = 0; r < 16; ++r) p1[r] = __builtin_amdgcn_exp2f(p1[r]);
    float ps = 0; for (int r = 0; r < 16; ++r) ps += p0[r]; for (int r = 0; r < 16; ++r) ps += p1[r];
    { auto rr = __builtin_amdgcn_permlane32_swap(__float_as_uint(ps), __float_as_uint(ps), false, false);
      ps = __uint_as_float(rr[0]) + __uint_as_float(rr[1]); }
    l_reg = l_reg * alpha + ps;
#define PK4(P, B_, OUT) do { unsigned a0 = cvtpk(P[B_+0], P[B_+1]), a1 = cvtpk(P[B_+2], P[B_+3]);                          \
        unsigned b0 = cvtpk(P[B_+4], P[B_+5]), b1 = cvtpk(P[B_+6], P[B_+7]);                                             \
        auto r0 = __builtin_amdgcn_permlane32_swap(a0, b0, false, false); auto r1 = __builtin_amdgcn_permlane32_swap(a1, b1, false, false); \
        u32x4 w = {r0[0], r1[0], r0[1], r1[1]}; OUT = *reinterpret_cast<bf16x8*>(&w); } while (0)
    PK4(p0, 0, pa0); PK4(p0, 8, pa1); PK4(p1, 0, pa2); PK4(p1, 8, pa3);
#undef PK4
}
template <int KB, bool SK>
__device__ __forceinline__ void qkt(f32x16& p0, f32x16& p1, const char* K_lds, int r32, int hi, const bf16x8* qr, bool act) {
    if (SK && !act) { const float NEG = -__builtin_inff();
#pragma unroll
        for (int r = 0; r < 16; ++r) { p0[r] = NEG; p1[r] = NEG; } return; }
    p0 = f32x16{}; p1 = f32x16{};
    const char* kb[4];
#pragma unroll
    for (int dd = 0; dd < 4; ++dd) kb[dd] = K_lds + KB * SHM_K + KSWZ(r32, (dd * 16 + hi * 8) * 2);
#pragma unroll
    for (int d0 = 0; d0 < 8; ++d0) { const char* a = kb[d0 & 3] + (d0 >> 2) * 128;
        bf16x8 b0 = *reinterpret_cast<const bf16x8*>(a);
        bf16x8 b1 = *reinterpret_cast<const bf16x8*>(a + 32 * 256);
        p0 = __builtin_amdgcn_mfma_f32_32x32x16_bf16(b0, qr[d0], p0, 0, 0, 0);
        p1 = __builtin_amdgcn_mfma_f32_32x32x16_bf16(b1, qr[d0], p1, 0, 0, 0); }
}
template <int VB, bool SK>
__device__ __forceinline__ void pv_tile(f32x16* o, int vb0, bf16x8 pa0, bf16x8 pa1, bf16x8 pa2, bf16x8 pa3, bool act) {
    if (SK && !act) return;
#define TRRD(dst, off) asm volatile("ds_read_b64_tr_b16 %0, %1 offset:%2" : "=&v"(dst) : "v"(vb0), "i"(off) : "memory")
#define PV_D0(d0) do { s16x4 l0, l1, l2, l3, h0, h1, h2, h3; constexpr int b_ = VB * SHM_V + v_rd_off(d0, 0, 0);     \
        TRRD(l0, b_); TRRD(h0, b_ + 2048); TRRD(l1, b_ + 4096); TRRD(h1, b_ + 6144); TRRD(l2, b_ + 8192); TRRD(h2, b_ + 10240); TRRD(l3, b_ + 12288); TRRD(h3, b_ + 14336); \
        asm volatile("s_waitcnt lgkmcnt(0)" ::: "memory"); SBAR();                 \
        o[d0] = __builtin_amdgcn_mfma_f32_32x32x16_bf16(pa0, (bf16x8){l0[0], l0[1], l0[2], l0[3], h0[0], h0[1], h0[2], h0[3]}, o[d0], 0, 0, 0);   \
        o[d0] = __builtin_amdgcn_mfma_f32_32x32x16_bf16(pa1, (bf16x8){l1[0], l1[1], l1[2], l1[3], h1[0], h1[1], h1[2], h1[3]}, o[d0], 0, 0, 0);   \
        o[d0] = __builtin_amdgcn_mfma_f32_32x32x16_bf16(pa2, (bf16x8){l2[0], l2[1], l2[2], l2[3], h2[0], h2[1], h2[2], h2[3]}, o[d0], 0, 0, 0);   \
        o[d0] = __builtin_amdgcn_mfma_f32_32x32x16_bf16(pa3, (bf16x8){l3[0], l3[1], l3[2], l3[3], h3[0], h3[1], h3[2], h3[3]}, o[d0], 0, 0, 0); } while (0)
    PV_D0(0); PV_D0(1); PV_D0(2); PV_D0(3);
#undef PV_D0
#undef TRRD
}
template <class TIn, class TOut> struct BlockRef { const TIn* Q; const TIn* K; const unsigned long long* M; int P0; };
template <class TIn> struct Seam {
    bf16x8 qr[8];
    bf16x8 st_v0, st_v1, st_k0, st_k1; f32x4 sf0, sf1, sf2, sf3;
    f32x4 tq[16];
};
__device__ __forceinline__ int swa_jlo(int P0, int W) { const int lowk = P0 - W + 1; return lowk > 0 ? lowk / KVBLK : 0; }
#define ROW(p, k0, rr) ((p) + (size_t)((k0) + (rr)) * D + sc)
#define VMW() asm volatile("s_waitcnt vmcnt(0)" ::: "memory")
#define VMWN(n) asm volatile("s_waitcnt vmcnt(%0)" :: "i"(n) : "memory")
#define SLOAD_H(Kp, Vp, k0) do { S.st_v0 = load8<TIn>(ROW(Vp, k0, sr)); S.st_v1 = load8<TIn>(ROW(Vp, k0, 32 + sr));              \
                         S.st_k0 = load8<TIn>(ROW(Kp, k0, sr)); S.st_k1 = load8<TIn>(ROW(Kp, k0, 32 + sr)); } while (0)
#define SWRITE_HK(bf) do { *(bf16x8*)(K_lds + (bf) * SHM_K + kws) = S.st_k0; *(bf16x8*)(K_lds + (bf) * SHM_K + kws + 32 * 256) = S.st_k1; } while (0)
#define SWRITE_HV(bf) do { *(bf16x8*)(V_lds + (bf) * SHM_V + vst0) = S.st_v0; *(bf16x8*)(V_lds + (bf) * SHM_V + vst1) = S.st_v1; } while (0)
#define SWRITE_H(bf) do { SWRITE_HV(bf); SWRITE_HK(bf); } while (0)
#define SLOAD_F(p, k0) do { S.sf0 = *(const f32x4*)ROW(p, k0, sr); S.sf1 = *(const f32x4*)(ROW(p, k0, sr) + 4);                \
                            S.sf2 = *(const f32x4*)ROW(p, k0, 32 + sr); S.sf3 = *(const f32x4*)(ROW(p, k0, 32 + sr) + 4); } while (0)
#define SWRITE_KF(bf) do { *(bf16x8*)(K_lds + (bf) * SHM_K + kws) = pack8(S.sf0, S.sf1); *(bf16x8*)(K_lds + (bf) * SHM_K + kws + 32 * 256) = pack8(S.sf2, S.sf3); } while (0)
#define SWRITE_VF(bf) do { *(bf16x8*)(V_lds + (bf) * SHM_V + vst0) = pack8(S.sf0, S.sf1); *(bf16x8*)(V_lds + (bf) * SHM_V + vst1) = pack8(S.sf2, S.sf3); } while (0)
template <class TIn, class TOut>
__device__ __forceinline__ void causal_swa_prime(const BlockRef<TIn, TOut>& cur, int W, char* lds, Seam<TIn>& S) {
    constexpr bool F32 = same_t<TIn, float>::v;
    int tid_l = threadIdx.x; asm volatile("" : "+v"(tid_l));
    const int tid = tid_l, wid = __builtin_amdgcn_readfirstlane(tid >> 6), lane = tid & 63, r32 = lane & 31, hi = lane >> 5;
    const int sr = tid >> 4, sc = (tid & 15) * 8, kws = KSWZ(sr, sc * 2); char* K_lds = lds + 2 * SHM_V;
    const int kb0 = swa_jlo(cur.P0, W) * KVBLK;
    for (int d0 = 0; d0 < 8; ++d0) S.qr[d0] = load8<TIn>(cur.Q + (size_t)(wid * QBLK + r32) * D + d0 * 16 + hi * 8);
    if constexpr (F32) { SLOAD_F((const float*)cur.K, kb0); VMW(); SWRITE_KF(0); SBAR(); SLOAD_F((const float*)(cur.K + VOFF), kb0); }
    else { SLOAD_H(cur.K, (cur.K + VOFF), kb0); VMW(); SWRITE_HK(0); }
    __syncthreads();
}
template <class TIn, class TOut>
__device__ __forceinline__ void causal_swa_block(const BlockRef<TIn, TOut>& cur, const BlockRef<TIn, TOut>& nxt, int skv, int W, char* lds, Seam<TIn>& S) {
    constexpr bool F32 = same_t<TIn, float>::v;
    int tid_l = threadIdx.x; asm volatile("" : "+v"(tid_l));
    const int tid = tid_l, wid = __builtin_amdgcn_readfirstlane(tid >> 6), lane = tid & 63, r32 = lane & 31, hi = lane >> 5;
    const int j_lo = swa_jlo(cur.P0, W);
    int j_hi = (cur.P0 + QB - 1) / KVBLK + 1; if (j_hi > skv / KVBLK) j_hi = skv / KVBLK;
    const int NT = j_hi - j_lo;
    const int kbn = swa_jlo(nxt.P0, W) * KVBLK;
    const int qlo = cur.P0 + wid * QBLK, qm = qlo + r32 - 4 * hi;
    char* V_lds = lds; char* K_lds = lds + 2 * SHM_V;
    float* ws = (float*)(lds + 2 * SHM_V + 2 * SHM_K) + wid * 64; float* li_l = ws, * al_l = ws + 32;
    float m_reg = -1e30f, l_reg = 0; f32x16 o[4] = {};
    const int sr = tid >> 4, sc = (tid & 15) * 8, vst0 = v_st(sr, sc), vst1 = v_st(32 + sr, sc), kws = KSWZ(sr, sc * 2);
    const int vb0 = (int)(uintptr_t)V_lds + v_rd_base(lane);
    const TIn* Kh = cur.K; const TIn* Vh = (cur.K + VOFF);
#define RESC(a) do { if (__any((a) < 1.f)) { if (hi == 0) al_l[r32] = (a); asm volatile("s_waitcnt lgkmcnt(0)" ::: "memory");              \
                     for (int d_ = 0; d_ < 4; ++d_) for (int r = 0; r < 16; ++r) o[d_][r] *= al_l[crow(r, hi)]; } } while (0)
#define KBASE(t) ((j_lo + (t)) * KVBLK)
#define ACT(t) (KBASE(t) <= qlo + QBLK - 1 && KBASE(t) + KVBLK - 1 >= qlo - W + 1)
#define MASKT(P0_, P1_, MW_) mask_bits(P0_, P1_, MW_)
    constexpr int NQL = F32 ? 16 : 8;
    constexpr bool SK = WSKIP && !F32;
#define SEAM_K0() do { VMWN(NQL); if constexpr (F32) { SWRITE_KF(0); SBAR(); SLOAD_F((const float*)(nxt.K + VOFF), kbn); } else { SWRITE_HK(0); } SBAR(); } while (0)
    f32x16 pA0, pA1, pB0, pB1; float mnA, mnB, alA, alB; bf16x8 pa0, pa1, pa2, pa3;
    const unsigned* M32 = (const unsigned*)cur.M;
#define MOFF() ({ int l_ = lane; asm volatile("" : "+v"(l_)); (unsigned)(wid * QBLK + (l_ & 31)) * 512u + (unsigned)(l_ >> 5); })
    unsigned mw = M32[MOFF()];
    if constexpr (F32) { VMW(); SWRITE_VF(0); SBAR(); } else { SWRITE_HV(0); SBAR(); }
    if (NT > 1) { if constexpr (F32) SLOAD_F((const float*)Kh, KBASE(1)); else SLOAD_H(Kh, Vh, KBASE(1)); }
    SBAR(); qkt<0, SK>(pA0, pA1, K_lds, r32, hi, S.qr, ACT(0));
    if constexpr (F32) { if (NT > 1) { VMW(); SWRITE_KF(1); SBAR(); SLOAD_F((const float*)Vh, KBASE(1)); } }
    MASKT(pA0, pA1, mw); partialSM(pA0, pA1, m_reg, mnA, alA);
    if (NT > 1) { VMW(); if constexpr (F32) { SWRITE_VF(1); SBAR(); if (NT > 2) SLOAD_F((const float*)Kh, KBASE(2)); } else SWRITE_H(1); }
    __syncthreads();
#define HALF_STEP(PX0, PX1, mnX, alX, PY0, PY1, alY, t, KB, VB, SB) do {                                                      \
        mw = M32[MOFF() + 2u * (unsigned)(t)];                                                                                     \
        SBAR(); qkt<KB, SK>(PX0, PX1, K_lds, r32, hi, S.qr, ACT(t));                                             \
        finishSM(PY0, PY1, alY, l_reg, pa0, pa1, pa2, pa3); SBAR();                                                           \
        if ((t) + 1 < NT) { if constexpr (F32) { VMW(); SWRITE_KF(SB); SBAR(); SLOAD_F((const float*)Vh, KBASE((t) + 1)); }  \
                            else { SLOAD_H(Kh, Vh, KBASE((t) + 1)); } SBAR(); }                                               \
        pv_tile<VB, SK>(o, vb0, pa0, pa1, pa2, pa3, ACT((t) - 1)); MASKT(PX0, PX1, mw); partialSM(PX0, PX1, m_reg, mnX, alX);                                        \
        __syncthreads();                                                                                                      \
        if ((t) + 1 < NT) { VMW(); if constexpr (F32) { SWRITE_VF(SB); SBAR(); if ((t) + 2 < NT) SLOAD_F((const float*)Kh, KBASE((t) + 2)); } \
                            else { SWRITE_H(SB); } }                                                                          \
        RESC(alX); __syncthreads(); } while (0)
    for (int t = 1; t + 1 < NT; t += 2) {
        HALF_STEP(pB0, pB1, mnB, alB, pA0, pA1, alA, t, 1, 0, 0);
        HALF_STEP(pA0, pA1, mnA, alA, pB0, pB1, alB, t + 1, 0, 1, 1);
    }
    const bool even = (NT & 1) == 0;
    if (even) { mw = M32[MOFF() + 2u * (unsigned)(NT - 1)]; SBAR(); qkt<1, SK>(pB0, pB1, K_lds, r32, hi, S.qr, ACT(NT - 1)); SBAR(); }
#define QROW(e) (nxt.Q + (size_t)(wid * QBLK + r32) * D + ((e) >> 1) * 16 + hi * 8 + ((e) & 1) * 4)
    if constexpr (F32) { SLOAD_F((const float*)nxt.K, kbn); SBAR();
#pragma unroll
        for (int e = 0; e < 8; ++e) S.tq[e] = *(const f32x4*)QROW(e); }
    else { SLOAD_H(nxt.K, (nxt.K + VOFF), kbn); SBAR();
#pragma unroll
        for (int d0 = 0; d0 < 8; ++d0) S.qr[d0] = load8<TIn>(nxt.Q + (size_t)(wid * QBLK + r32) * D + d0 * 16 + hi * 8); }
    SBAR();
    finishSM(pA0, pA1, alA, l_reg, pa0, pa1, pa2, pa3); SBAR();
    if constexpr (F32) {
#pragma unroll
        for (int e = 8; e < 16; ++e) S.tq[e] = *(const f32x4*)QROW(e); SBAR(); }
#undef QROW
    pv_tile<0, SK>(o, vb0, pa0, pa1, pa2, pa3, ACT(even ? NT - 2 : NT - 1));
    if (even) { MASKT(pB0, pB1, mw); partialSM(pB0, pB1, m_reg, mnB, alB); __syncthreads(); RESC(alB);
        finishSM(pB0, pB1, alB, l_reg, pa0, pa1, pa2, pa3); SBAR(); pv_tile<1, SK>(o, vb0, pa0, pa1, pa2, pa3, ACT(NT - 1)); }
    SBAR(); SEAM_K0();
    if (hi == 0) li_l[r32] = l_reg; asm volatile("s_waitcnt lgkmcnt(0)" ::: "memory");
    float rli[16];
#pragma unroll
    for (int r = 0; r < 16; ++r) rli[r] = __builtin_amdgcn_rcpf(li_l[crow(r, hi)]);
    TOut* Ow = ((TOut*)cur.Q) + (size_t)(wid * QBLK) * D;
#pragma unroll
    for (int r = 0; r < 16; ++r) { const int orow = crow(r, hi);
#pragma unroll
        for (int d0 = 0; d0 < 4; ++d0) { const float v = o[d0][r] * rli[r];
            if constexpr (same_t<TOut, float>::v) { Ow[(size_t)orow * D + d0 * 32 + r32] = v; }
            else { const float vn = __int_as_float(__builtin_amdgcn_ds_swizzle(__float_as_int(v), 0x041F));
                   if ((r32 & 1) == 0) *(unsigned*)(Ow + (size_t)orow * D + d0 * 32 + r32) = cvtpk(v, vn); } } }
    if constexpr (F32) {
#pragma unroll
        for (int d0 = 0; d0 < 8; ++d0) S.qr[d0] = pack8(S.tq[2 * d0], S.tq[2 * d0 + 1]); }
    __syncthreads();
#undef RESC
#undef KBASE
#undef ACT
#undef MASKT
#undef MOFF
#undef SEAM_K0
#undef HALF_STEP
}
#undef ROW
#undef VMW
#undef VMWN
#undef SLOAD_H
#undef SWRITE_HK
#undef SWRITE_HV
#undef SWRITE_H
#undef SLOAD_F
#undef SWRITE_KF
#undef SWRITE_VF

}

__device__ __forceinline__ void p6_dsa_attention(const Frame& F, char* lds_generic) {
    typedef dsa::BlockRef<unsigned short, unsigned short> Ref;
    const bf16* qA = (const bf16*)(F.ws + WS_QA); const bf16* kA = (const bf16*)(F.ws + WS_KA);
    const unsigned long long* mask = (const unsigned long long*)(F.ws + WS_MASK); const bf16* zz = (const bf16*)(F.ws + WS_Z); bf16* yy = (bf16*)(F.ws + WS_Y);
    constexpr int NQB = SEQ / dsa::QB, NITEM = 8 * (NQB / 2);
#define DSA_MKREF(R, item_, pass_) do { const int h_ = (item_) & 7, yy_ = (item_) >> 3, qb_ = (pass_) ? (NQB - 1 - yy_) : yy_, P0_ = qb_ * dsa::QB; \
        R.Q = qA + ((size_t)h_ * SEQ + P0_) * 128; R.K = kA + (size_t)h_ * SEQ * 128; R.M = mask + (size_t)P0_ * 256; R.P0 = P0_; } while (0)
    int item = blockIdx.x; if (item >= NITEM) return;
    int pass = 0; Ref cur; DSA_MKREF(cur, item, 0);
    dsa::Seam<unsigned short> S;
    __syncthreads();
    dsa::causal_swa_prime<unsigned short, unsigned short>(cur, 1 << 30, lds_generic, S);
    for (;;) {
        const bool more_pass = pass == 0, more_item = item + F.G < NITEM, last = !more_pass && !more_item;
        int itn = item, pn = pass + 1; if (!more_pass) { pn = 0; itn = more_item ? item + F.G : item; }
        Ref nxt = cur; if (!last) DSA_MKREF(nxt, itn, pn);
        dsa::causal_swa_block<unsigned short, unsigned short>(cur, nxt, SEQ, 1 << 30, lds_generic, S);
        if (!more_pass) {
            asm volatile("s_waitcnt vmcnt(0)" ::: "memory"); __syncthreads();
            __builtin_amdgcn_fence(__ATOMIC_ACQUIRE, "agent"); asm volatile("s_waitcnt vmcnt(0)" ::: "memory");
            const int h_ = item & 7, yy_ = item >> 3;
#pragma unroll 1
            for (int ps = 0; ps < 2; ++ps) { const int P0_ = (ps ? (NQB - 1 - yy_) : yy_) * dsa::QB;
#pragma unroll 1
                for (int i = F.tid; i < dsa::QB * 16; i += NTHR) { const int row = P0_ + (i >> 4), c8 = i & 15; float o[8], g[8];
                    unpack8(*(const u32x4*)(qA + ((size_t)h_ * SEQ + row) * 128 + c8 * 8), o); unpack8(*(const u32x4*)(zz + (size_t)row * ZW + ZGATE_B + h_ * 128 + c8 * 8), g);
#pragma unroll
                    for (int j = 0; j < 8; ++j) o[j] *= siluf_(g[j]);
                    *(u32x4*)(yy + (size_t)row * DM + YB + h_ * 128 + c8 * 8) = pack8f(o); } } }
        if (last) break;
        cur = nxt; item = itn; pass = pn;
    }
#undef DSA_MKREF
}

#ifdef DBG_CHECK
constexpr int DBG_T = 1024;
#if DBG_CHECK == 0
__device__ __forceinline__ void dbg_gla_seq(const Frame& F, float* ref) {
    const bf16* z = (const bf16*)(F.ws + WS_Z); const float* bA = (const float*)(F.ws + WS_BA);
    const int i4 = blockIdx.x * NTHR + F.tid; if (i4 >= 12 * 128 * 4) return;
    const int i = i4 >> 2, dq = (i4 & 3) * 16, h = i >> 7, e = i & 127; float S[16];
#pragma unroll
    for (int d = 0; d < 16; ++d) S[d] = 0.f;
    for (int t = 0; t < DBG_T; ++t) { const bf16* zr = z + (size_t)t * ZW; const float ve = bf2f(zr[ZV_A + h * 128 + e]); float o = 0.f;
#pragma unroll
        for (int d = 0; d < 16; ++d) { const float bt = bA[(size_t)t * 768 + h * 64 + dq + d], bp = (t & 63) ? bA[(size_t)(t - 1) * 768 + h * 64 + dq + d] : 0.f;
            S[d] = expf(bt - bp) * S[d] + bf2f(zr[ZK_A + h * 64 + dq + d]) * ve; o += bf2f(zr[ZQ_A + h * 64 + dq + d]) * 0.125f * S[d]; }
        o += shx(o, 1, F.lane); o += shx(o, 2, F.lane);
        if ((i4 & 3) == 0) ref[(size_t)t * 1536 + i] = o; }
}
#endif
#if DBG_CHECK == 1
__device__ __forceinline__ void dbg_mlstm_seq(const Frame& F, float* ref) {
    const bf16* z = (const bf16*)(F.ws + WS_Z); const bf16* cq = (const bf16*)(F.ws + WS_CQ); const bf16* ck = (const bf16*)(F.ws + WS_CK); const float* mg = (const float*)(F.ws + WS_MG);
    const int i = blockIdx.x * NTHR + F.tid; if (i >= 6 * 256) return;
    const int h = i >> 8, e = i & 255; float C[128]; float m = 0.f;
#pragma unroll
    for (int d = 0; d < 128; ++d) C[d] = 0.f;
    for (int t = 0; t < DBG_T; ++t) { const float bt = mg[MG_B + (size_t)t * 8 + h], bp = (t & 63) ? mg[MG_B + (size_t)(t - 1) * 8 + h] : 0.f, lf = bt - bp, ig = mg[MG_I + (size_t)t * 8 + h];
        const float mn = fmaxf(lf + m, ig), fa = expf(lf + m - mn), ia = expf(ig - mn); m = mn;
        const float ve = bf2f(z[(size_t)t * ZW + ZV_C + h * 256 + e]); float o = 0.f;
#pragma unroll
        for (int d = 0; d < 128; ++d) { C[d] = fa * C[d] + ia * bf2f(ck[(size_t)t * 768 + h * 128 + d]) * ve; o += bf2f(cq[(size_t)t * 768 + h * 128 + d]) * C[d]; }
        ref[(size_t)t * 1536 + i] = o;
#ifdef DBG_STATE
        if (t == 63) { const bf16* CP = (const bf16*)(F.ws + WS_CP); const float mp = mg[MG_MP + 6 + h]; float md = 0.f, mx = 0.f;
#pragma unroll
            for (int d = 0; d < 128; ++d) { const float a = bf2f(CP[((size_t)(6 + h) * 256 + e) * 128 + d]) * expf(mp - m), b = C[d]; md = fmaxf(md, fabsf(a - b)); mx = fmaxf(mx, fabsf(b)); }
            md = wave_max(md, F.lane); mx = wave_max(mx, F.lane);
            if (F.lane == 0) atomicMax((unsigned*)(F.ws + WS_CTL) + 2049, __float_as_uint(md / mx)); }
#endif
    }
}
#endif
__device__ __forceinline__ void dbg_compare(const Frame& F, const float* ref, const float* gainA, const float* gainC, int which, unsigned* res) {
    const bf16* z = (const bf16*)(F.ws + WS_Z); const bf16* y = (const bf16*)(F.ws + WS_Y);
    const int NH = which ? 6 : 12, HD = which ? 256 : 128;
    for (int u = F.gw; u < DBG_T * NH; u += F.NGW) { const int t = u / NH, h = u % NH; float ss = 0.f;
        for (int e = F.lane; e < HD; e += 64) { const float v = ref[(size_t)t * 1536 + h * HD + e]; ss += v * v; }
        ss = wave_sum(ss, F.lane); const float rs = 1.0f / sqrtf(ss / HD + NORM_EPS); float md = 0.f;
        for (int e = F.lane; e < HD; e += 64) { float v = ref[(size_t)t * 1536 + h * HD + e] * rs; float got;
            if (which) { v *= gainC[h * 256 + e] * sigmoidf_(bf2f(z[(size_t)t * ZW + ZO_C + h * 256 + e])) * siluf_(bf2f(z[(size_t)t * ZW + ZGATE_C + h * 256 + e])); got = bf2f(y[(size_t)t * DM + YC + h * 256 + e]); }
            else { v *= gainA[h * 128 + e] * siluf_(bf2f(z[(size_t)t * ZW + ZGATE_A + h * 128 + e])); got = bf2f(y[(size_t)t * DM + YA + h * 128 + e]); }
            md = fmaxf(md, fabsf(got - v)); }
        md = wave_max(md, F.lane); if (F.lane == 0) atomicMax(res, __float_as_uint(md)); }
}
#endif

struct Args { const void* in[18]; float* out; unsigned char* ws; };
#ifndef MIX_GLA
#define MIX_GLA 1
#endif
#ifndef MIX_MLSTM
#define MIX_MLSTM 1
#endif
#ifndef MIX_DSA
#define MIX_DSA 1
#endif

__global__ void __launch_bounds__(NTHR, 2) trunk_fwd(Args args) {
    extern __shared__ __attribute__((aligned(16))) unsigned char lds[];
    Frame F;
    F.lds = (LAS unsigned char*)lds; F.ws = args.ws;
    F.tid = threadIdx.x; F.lane = F.tid & 63; F.wave = __builtin_amdgcn_readfirstlane(F.tid >> 6);
    F.G = gridDim.x; { const int bx = blockIdx.x; F.vcu = (F.G % 8 == 0) ? (bx % 8) * (F.G / 8) + bx / 8 : bx; }
    F.gw = F.vcu * NWAVES + F.wave; F.NGW = F.G * NWAVES;
    volatile LAS unsigned* MISC = (volatile LAS unsigned*)(F.lds + MISC_OFF);
    for (int u = F.tid; u < (LDS_BYTES - RING_BYTES) / 4; u += NTHR) ((LAS unsigned*)(F.lds + RING_BYTES))[u] = 0u;
    __syncthreads();
    XcdBarrier bar = xcd_barrier_post((unsigned*)(F.ws + WS_CTL) + CW_BAR, MISC + 8);
#define GRID_BAR() do { size_t zb_ = 0; asm volatile("" : "+s"(zb_)); unsigned x_ = bar.x; asm volatile("" : "+s"(x_)); XcdBarrier b_; b_.bar = (unsigned*)(args.ws + zb_ + WS_CTL) + CW_BAR; b_.x = x_; b_.st = bar.st; xcd_barrier(b_); } while (0)
#define IN(k) ((const float*)args.in[k])
#define PHASE_BEGIN() do { size_t z_ = 0; asm volatile("" : "+s"(z_)); F.ws = args.ws + z_; unsigned lz_ = 0; asm volatile("" : "+s"(lz_)); F.lds = (LAS unsigned char*)lds + lz_; int t_ = threadIdx.x; asm volatile("" : "+v"(t_)); F.tid = t_; F.lane = t_ & 63; F.wave = __builtin_amdgcn_readfirstlane(t_ >> 6); \
        F.gw = F.vcu * NWAVES + F.wave; U = (bf16*)(F.ws + WS_U); Z = (bf16*)(F.ws + WS_Z); Y = (bf16*)(F.ws + WS_Y); PP = (bf16*)(F.ws + WS_PP); H = (float*)(F.ws + WS_H); } while (0)

    bf16 *U, *Z, *Y, *PP; float* H;

#ifndef DMASK
#define DMASK 0
#endif
#define REP(n) for (int rep_ = 0; rep_ < (((DMASK >> (n)) & 1) ? 2 : 1); ++rep_)
#ifndef ONLY
#define PH(n) 1
#else
#define PH(n) ((n) == ONLY)
#endif
    REP(0) { PHASE_BEGIN(); } REP(0) if (PH(0)) p0_prologue(F, IN(4), IN(13), IN(15), IN(16), IN(1), (const int*)args.in[2], IN(3), IN(14), IN(0));
    GRID_BAR();
    for (int L = 0; L < DEPTH; ++L) {

        REP(1) { PHASE_BEGIN(); } REP(1) if (PH(1)) { if (L > 0) { reduce_rstd(F); GRID_BAR(); } }
        REP(2) { PHASE_BEGIN(); } REP(2) if (PH(2)) { pg8::Gemm g{U, (const bf16*)(F.ws + WS_WIN) + (size_t)L * ZW * DM, SEQ, ZW, DM}; pg8::StaticOrder S; S.init(SEQ, ZW, F.G, (int)blockIdx.x);
          pg8::EpiBf16Row E{Z, ZW, (const float*)(F.ws + WS_RSTD), (bf16*)(F.ws + WS_QA), (bf16*)(F.ws + WS_IQ), (bf16*)(F.ws + WS_IK), ZQ_B, ZGATE_B, ZIQ, ZIK, SEQ};
          pg8::gemm_phase<pg8::EpiBf16Row, pg8::StaticOrder, true, true>(F.lds, g, S, E); }
        GRID_BAR();
        REP(3) { PHASE_BEGIN(); } REP(3) if (PH(3)) p3_prep(F, IN(8) + (size_t)L * 4 * 768, IN(9) + (size_t)L * 4 * 768, IN(10) + L * 6, IN(11) + L * 6, IN(5) + (size_t)L * 16 * 768, IN(6) + (size_t)L * 768);
        GRID_BAR();
#if MIX_DSA
        REP(4) { PHASE_BEGIN(); } REP(4) if (PH(4)) p4_index_scores(F);
#endif
#if MIX_GLA
        REP(5) { PHASE_BEGIN(); } REP(5) if (PH(5)) p4_gla_local(F);
#endif
#if MIX_MLSTM
        REP(6) { PHASE_BEGIN(); } REP(6) if (PH(6)) p4_mlstm_local(F);
#endif
        GRID_BAR();
#if MIX_GLA || MIX_MLSTM
        REP(7) { PHASE_BEGIN(); } REP(7) if (PH(7)) p5_scans(F);
#endif
#if MIX_DSA
        REP(8) { PHASE_BEGIN(); } REP(8) if (PH(8)) p5_select(F);
#endif
        GRID_BAR();
#if MIX_DSA
        REP(9) { PHASE_BEGIN(); } REP(9) if (PH(9)) p6_dsa_attention(F, (char*)lds);
#else
        { unsigned zz_ = 0; asm volatile("" : "+v"(zz_));
        for (int i = blockIdx.x * NTHR + F.tid; i < SEQ * 128; i += F.G * NTHR) { const int t = i >> 7, c8 = i & 127; *(u32x4*)(Y + (size_t)t * DM + YB + c8 * 8) = (u32x4){zz_, zz_, zz_, zz_}; } }
#endif
#if MIX_GLA
        REP(10) { PHASE_BEGIN(); } REP(10) if (PH(10)) p6_gla_out(F, IN(7) + (size_t)L * 1536);
#else
        { unsigned zz_ = 0; asm volatile("" : "+v"(zz_));
        for (int i = blockIdx.x * NTHR + F.tid; i < SEQ * 192; i += F.G * NTHR) { const int t = i / 192, c8 = i % 192; *(u32x4*)(Y + (size_t)t * DM + YA + c8 * 8) = (u32x4){zz_, zz_, zz_, zz_}; } }
#endif
#if MIX_MLSTM
        REP(11) { PHASE_BEGIN(); } REP(11) if (PH(11)) p6_mlstm_out(F, IN(12) + (size_t)L * 1536);
#else
        { unsigned zz_ = 0; asm volatile("" : "+v"(zz_));
        for (int i = blockIdx.x * NTHR + F.tid; i < SEQ * 192; i += F.G * NTHR) { const int t = i / 192, c8 = i % 192; *(u32x4*)(Y + (size_t)t * DM + YC + c8 * 8) = (u32x4){zz_, zz_, zz_, zz_}; } }
#endif
        GRID_BAR();
#ifdef DBG_CHECK
        if (L == 0) { PHASE_BEGIN(); float* ref = (float*)(F.ws + WS_SCORE); unsigned* res = (unsigned*)(F.ws + WS_CTL) + 2048;
#if DBG_CHECK == 0
            dbg_gla_seq(F, ref);
#else
            dbg_mlstm_seq(F, ref);
#endif
            GRID_BAR();
            PHASE_BEGIN(); dbg_compare(F, (const float*)(F.ws + WS_SCORE), IN(7), IN(12), DBG_CHECK, (unsigned*)(F.ws + WS_CTL) + 2048);
            GRID_BAR(); }
#endif
        REP(12) { PHASE_BEGIN(); } REP(12) if (PH(12)) { pg8::Gemm g{Y, (const bf16*)(F.ws + WS_WOUT) + (size_t)L * DM * DM, SEQ, DM, DM}; pg8::StaticOrder S; S.init(SEQ, DM, F.G, (int)blockIdx.x);
          pg8::EpiResB E{U, (bf16*)(F.ws + WS_HB2), (float*)(F.ws + WS_PART), DM};
          pg8::gemm_phase<pg8::EpiResB, pg8::StaticOrder, true, true>(F.lds, g, S, E); }
        GRID_BAR();
        REP(13) { PHASE_BEGIN(); } REP(13) if (PH(13)) reduce_rstd(F);
        REP(14) { PHASE_BEGIN(); } REP(14) if (PH(14)) { pg8::Gemm g{(const bf16*)(F.ws + WS_PBF) + (size_t)L * SEQ * DPLE, (const bf16*)(F.ws + WS_WPLE) + (size_t)L * DM * DPLE, SEQ, DM, DPLE}; pg8::StaticOrder S; S.init(SEQ, DM, F.G, (int)blockIdx.x);
          pg8::EpiBf16<0> E{PP, DM, nullptr, 0, 0, 1.f};
          pg8::gemm_phase<pg8::EpiBf16<0>, pg8::StaticOrder, true, true>(F.lds, g, S, E); }
        GRID_BAR();
        REP(15) { PHASE_BEGIN(); } REP(15) if (PH(15)) { pg8::Gemm g{(const bf16*)(F.ws + WS_HB2), (const bf16*)(F.ws + WS_WGATE) + (size_t)L * DM * DM, SEQ, DM, DM}; pg8::StaticOrder S; S.init(SEQ, DM, F.G, (int)blockIdx.x);
          pg8::EpiGateB E{(const bf16*)(F.ws + WS_HB2), PP, (const float*)(F.ws + WS_RSTD), U, (float*)(F.ws + WS_PART), DM};
          pg8::gemm_phase<pg8::EpiGateB, pg8::StaticOrder, true, true>(F.lds, g, S, E); }
        GRID_BAR();
    }
    REP(16) { PHASE_BEGIN(); } REP(16) if (PH(16)) rmsnorm_b2f(F, U, IN(17), args.out);
#ifdef DBG_CHECK
#ifdef DBG_STATE
#define DBG_WORD 2049
#else
#define DBG_WORD 2048
#endif
    GRID_BAR();
    if (blockIdx.x == 0 && threadIdx.x == 0) args.out[0] = 10000.0f * __uint_as_float(__hip_atomic_load((unsigned*)(args.ws + WS_CTL) + DBG_WORD, __ATOMIC_RELAXED, __HIP_MEMORY_SCOPE_AGENT));
#endif
}

extern "C" void kernel_launch(void* const* d_in, const int* in_sizes, int n_in, void* d_out, int out_size, void* d_ws, size_t ws_size, hipStream_t stream) {
    static int grid = 0;
    if (grid == 0) {
        if (n_in != 18 || out_size != SEQ * DM || ws_size < WS_END) { fprintf(stderr, "kernel_launch: unexpected shapes (n_in %d, out %d, ws %zu < %zu)\n", n_in, out_size, ws_size, (size_t)WS_END); grid = -1; return; }
        int dev = 0, cus = 0, per_cu = 0;
        if (hipGetDevice(&dev) != hipSuccess || hipDeviceGetAttribute(&cus, hipDeviceAttributeMultiprocessorCount, dev) != hipSuccess) { grid = -1; return; }
        if (hipFuncSetAttribute((const void*)trunk_fwd, hipFuncAttributeMaxDynamicSharedMemorySize, LDS_BYTES) != hipSuccess) { fprintf(stderr, "kernel_launch: hipFuncSetAttribute failed\n"); grid = -1; return; }
        if (hipOccupancyMaxActiveBlocksPerMultiprocessor(&per_cu, (const void*)trunk_fwd, NTHR, LDS_BYTES) != hipSuccess || per_cu < 1) fprintf(stderr, "kernel_launch: occupancy query says %d\n", per_cu);
        (void)hipGetLastError();
        grid = cus;
    }
    if (grid < 0) return;
    if (hipMemsetAsync((char*)d_ws + WS_CTL, 0, CTL_ZERO_BYTES, stream) != hipSuccess) return;
    Args a{};
    for (int i = 0; i < 18; ++i) a.in[i] = d_in[i];
    a.out = (float*)d_out; a.ws = (unsigned char*)d_ws;
    hipLaunchKernelGGL(trunk_fwd, dim3(grid), dim3(NTHR), LDS_BYTES, stream, a);
}
```

```cpp
#include <hip/hip_runtime.h>
#include <cstdio>
#include <cstdint>
namespace pg8 {
#define PG8_LAS __attribute__((address_space(3)))
typedef unsigned short bf16_t;
typedef short bf16x8 __attribute__((ext_vector_type(8)));
typedef float f32x4 __attribute__((ext_vector_type(4)));
typedef unsigned u32x4 __attribute__((ext_vector_type(4)));
constexpr int BM = 256, BK = 64, HALF = 128, HTB = HALF * BK * 2  , STAGE_BYTES = 8 * HTB, NXCD = 8, WGM = 8;

__host__ __device__ __forceinline__ int lds_byte(int r, int c) { const int st = (r >> 4) * 2 + (c >> 5), rr = r & 15, cc = c & 31, ob = rr * 64 + cc * 2; return st * 1024 + (ob ^ (((ob >> 9) & 1) << 5)); }
__host__ __device__ __forceinline__ void stage_rc(int b, int& R, int& C) { const int st = b / 1024, sb = b % 1024, swz = sb ^ (((sb >> 9) & 1) << 5); R = (st >> 1) * 16 + swz / 64; C = (st & 1) * 32 + (swz % 64) / 2; }
__host__ __device__ __forceinline__ int perm32(int rho) { const int n = rho >> 4, i = rho & 15; return 8 * (i >> 2) + 4 * n + (i & 3); }

struct Unit { int pm, pn; };
struct Gemm { const bf16_t* A; const bf16_t* Bt; int M, N, K; };

struct StaticOrder {
    int nM, nN, nwg, G, c;
    __host__ __device__ void init(int M, int N, int G_, int c_) { nM = M / BM; nN = N / BM; nwg = nM * nN; G = G_; c = c_; }
    __host__ __device__ bool next(int i, Unit& u) const {
        const long L = (long)i * G + c; if (L >= nwg) return false;
        int wgid = (int)L; { const int q = nwg / NXCD, r = nwg % NXCD, xcd = wgid % NXCD, off = wgid / NXCD; wgid = (xcd < r ? xcd * (q + 1) : r * (q + 1) + (xcd - r) * q) + off; }
        const int nig = WGM * nN, gid = wgid / nig, fm = gid * WGM, gsz = (nM - fm) < WGM ? (nM - fm) : WGM;
        u.pm = fm + ((wgid % nig) % gsz); u.pn = (wgid % nig) / gsz; return true;
    }
    __device__ __forceinline__ void a_ready(const Unit&) const {}
    __device__ __forceinline__ void done(const Unit&) const {}
};

__device__ __forceinline__ unsigned cvt_pk_bf16(float lo, float hi) { unsigned r; asm volatile("v_cvt_pk_bf16_f32 %0, %1, %2" : "=v"(r) : "v"(lo), "v"(hi)); return r; }
typedef float f32x2 __attribute__((ext_vector_type(2)));
__device__ __forceinline__ f32x2 gelu_pk(f32x2 v) {
    const f32x2 av = __builtin_elementwise_abs(v), d = av * 0.2316418882f + 1.0f;
    f32x2 t; t.x = __builtin_amdgcn_rcpf(d.x); t.y = __builtin_amdgcn_rcpf(d.y);
    f32x2 q = t * 0.5307027145f + (-0.7265760135f); q = q * t + 0.7107068705f; q = q * t + (-0.142248368f); q = q * t + 0.127414796f; q = q * t;
    const f32x2 s = (v * v) * (-0.72134752044f);
    f32x2 e; e.x = __builtin_amdgcn_exp2f(s.x); e.y = __builtin_amdgcn_exp2f(s.y);
    const f32x2 m = v * (q * e), r = v - m;
    f32x2 o; o.x = v.x < 0.f ? m.x : r.x; o.y = v.y < 0.f ? m.y : r.y; return o;
}

template <int ACT  > struct EpiBf16 {
    static constexpr bool PERM = true, AFTER_DRAIN = false; static_assert(ACT == 0 || ACT == 1, "EpiBf16: ACT is 0 (none) or 1 (gelu_pk)");
    bf16_t* O; int ldc; const float* bias; int split_cols; size_t split_stride; float scale0;
    __device__ __forceinline__ void operator()(const f32x4 (&acc)[2][2][4][2], const Unit& u, int wr, int wc, int fr, int fq) const {
        const int row0 = u.pm * BM + wr * 64 + fr; int colt = u.pn * BM; bf16_t* base = O;
        float sc = 1.f; if (split_cols) { const int t = colt / split_cols; base += (size_t)t * split_stride; colt -= t * split_cols; if (t == 0) sc = scale0; }
        const int col0 = colt + wc * 32 + 8 * fq, bcol0 = u.pn * BM + wc * 32 + 8 * fq;
        f32x4 bv[2][2];
#pragma unroll
        for (int bj = 0; bj < 2; ++bj)
#pragma unroll
            for (int n = 0; n < 2; ++n) bv[bj][n] = bias ? *(const f32x4*)(bias + bcol0 + bj * HALF + 4 * n) : (f32x4){0.f, 0.f, 0.f, 0.f};
#pragma unroll
        for (int ai = 0; ai < 2; ++ai)
#pragma unroll
            for (int m = 0; m < 4; ++m) { bf16_t* rowp = base + (size_t)(row0 + ai * HALF + m * 16) * ldc + col0;
#pragma unroll
                for (int bj = 0; bj < 2; ++bj) { f32x4 v0 = acc[ai][bj][m][0] + bv[bj][0], v1 = acc[ai][bj][m][1] + bv[bj][1];
                    if (ACT == 1) { f32x2 a = gelu_pk((f32x2){v0[0], v0[1]}), b = gelu_pk((f32x2){v0[2], v0[3]}), c = gelu_pk((f32x2){v1[0], v1[1]}), d = gelu_pk((f32x2){v1[2], v1[3]});
                        v0 = (f32x4){a.x, a.y, b.x, b.y}; v1 = (f32x4){c.x, c.y, d.x, d.y}; }
                    v0 = v0 * sc; v1 = v1 * sc; u32x4 w; w.x = cvt_pk_bf16(v0[0], v0[1]); w.y = cvt_pk_bf16(v0[2], v0[3]); w.z = cvt_pk_bf16(v1[0], v1[1]); w.w = cvt_pk_bf16(v1[2], v1[3]);
                    *(u32x4*)(rowp + bj * HALF) = w; } }
    }
};

struct EpiResF32 {
    static constexpr bool PERM = false, AFTER_DRAIN = false;
    const float* base; float* out; int ldc;
    __device__ __forceinline__ void operator()(const f32x4 (&acc)[2][2][4][2], const Unit& u, int wr, int wc, int fr, int fq) const {
        const int row0 = u.pm * BM + wr * 64 + fr, col0 = u.pn * BM + wc * 32 + 4 * fq;
#pragma unroll
        for (int ai = 0; ai < 2; ++ai)
#pragma unroll
            for (int m = 0; m < 4; ++m) { const size_t off = (size_t)(row0 + ai * HALF + m * 16) * ldc + col0;
#pragma unroll
                for (int bj = 0; bj < 2; ++bj)
#pragma unroll
                    for (int n = 0; n < 2; ++n) { const f32x4 b = *(const f32x4*)(base + off + bj * HALF + n * 16); *(f32x4*)(out + off + bj * HALF + n * 16) = b + acc[ai][bj][m][n]; }
                asm volatile("" ::: "memory"); }
    }
};
struct EpiGate {
    static constexpr bool PERM = false, AFTER_DRAIN = false;
    float* h; const bf16_t* pp; int ldc;
    __device__ __forceinline__ void operator()(const f32x4 (&acc)[2][2][4][2], const Unit& u, int wr, int wc, int fr, int fq) const {
        typedef unsigned u32x2v __attribute__((ext_vector_type(2)));
        const int row0 = u.pm * BM + wr * 64 + fr, col0 = u.pn * BM + wc * 32 + 4 * fq;
#pragma unroll
        for (int ai = 0; ai < 2; ++ai)
#pragma unroll
            for (int m = 0; m < 4; ++m) { const size_t off = (size_t)(row0 + ai * HALF + m * 16) * ldc + col0;
#pragma unroll
                for (int bj = 0; bj < 2; ++bj)
#pragma unroll
                    for (int n = 0; n < 2; ++n) { const size_t o = off + bj * HALF + n * 16;
                        const f32x4 hv = *(const f32x4*)(h + o); const u32x2v pv = *(const u32x2v*)(pp + o); const f32x4 a = acc[ai][bj][m][n];
                        f32x4 p; p[0] = __uint_as_float(pv.x << 16); p[1] = __uint_as_float(pv.x & 0xffff0000u); p[2] = __uint_as_float(pv.y << 16); p[3] = __uint_as_float(pv.y & 0xffff0000u);
                        f32x4 r;
#pragma unroll
                        for (int j = 0; j < 4; ++j) { const float g = __builtin_amdgcn_rcpf(1.0f + __expf(-a[j])); r[j] = hv[j] + g * p[j]; }
                        *(f32x4*)(h + o) = r; }
                asm volatile("" ::: "memory"); }
    }
};

__device__ __forceinline__ float shx16(float v, int o, int lane) { return __int_as_float(__builtin_amdgcn_ds_bpermute((lane ^ o) << 2, __float_as_int(v))); }
struct EpiBf16Row {
    static constexpr bool PERM = true, AFTER_DRAIN = false;
    bf16_t* O; int ldc; const float* rs; bf16_t* hm; bf16_t* iq; bf16_t* ik; int c_hm0, c_hm1, c_iq0, c_ik0, seq;
    __device__ __forceinline__ void operator()(const f32x4 (&acc)[2][2][4][2], const Unit& u, int wr, int wc, int fr, int fq) const {
        const int row0 = u.pm * BM + wr * 64 + fr;
        bf16_t* bp[2]; size_t rstride[2]; bool live[2];
#pragma unroll
        for (int bj = 0; bj < 2; ++bj) { const int colb = u.pn * BM + bj * HALF; live[bj] = true;
            if (colb >= c_hm0 && colb < c_hm1) { const int rel = colb - c_hm0, which = rel >> 10, hh = (rel >> 7) & 7; bp[bj] = hm + ((size_t)(which * 8 + hh) * seq) * 128 + wc * 32 + 8 * fq; rstride[bj] = 128; }
            else if (colb >= c_iq0 && colb < c_ik0) { bp[bj] = iq + (colb - c_iq0) + wc * 32 + 8 * fq; rstride[bj] = 1024; }
            else if (colb == c_ik0) { bp[bj] = ik + wc * 32 + 8 * fq; rstride[bj] = 64; live[bj] = wc < 2; }
            else { bp[bj] = O + colb + wc * 32 + 8 * fq; rstride[bj] = (size_t)ldc; } }
#pragma unroll
        for (int ai = 0; ai < 2; ++ai)
#pragma unroll
            for (int m = 0; m < 4; ++m) { const int row = row0 + ai * HALF + m * 16; const float s = rs[row];
#pragma unroll
                for (int bj = 0; bj < 2; ++bj) { const f32x4 v0 = acc[ai][bj][m][0] * s, v1 = acc[ai][bj][m][1] * s;
                    u32x4 w; w.x = cvt_pk_bf16(v0[0], v0[1]); w.y = cvt_pk_bf16(v0[2], v0[3]); w.z = cvt_pk_bf16(v1[0], v1[1]); w.w = cvt_pk_bf16(v1[2], v1[3]);
                    if (live[bj]) *(u32x4*)(bp[bj] + (size_t)row * rstride[bj]) = w; } }
    }
};
struct EpiResF32N {
    static constexpr bool PERM = false, AFTER_DRAIN = false;
    const float* base; float* out; bf16_t* hb; float* part; int ldc;
    __device__ __forceinline__ void operator()(const f32x4 (&acc)[2][2][4][2], const Unit& u, int wr, int wc, int fr, int fq) const {
        typedef unsigned u32x2v __attribute__((ext_vector_type(2)));
        const int row0 = u.pm * BM + wr * 64 + fr, col0 = u.pn * BM + wc * 32 + 4 * fq, lane = fq * 16 + fr;
#pragma unroll
        for (int ai = 0; ai < 2; ++ai)
#pragma unroll
            for (int m = 0; m < 4; ++m) { const int row = row0 + ai * HALF + m * 16; const size_t off = (size_t)row * ldc + col0; float ss = 0.f;
#pragma unroll
                for (int bj = 0; bj < 2; ++bj)
#pragma unroll
                    for (int n = 0; n < 2; ++n) { const size_t o = off + bj * HALF + n * 16; const f32x4 r = *(const f32x4*)(base + o) + acc[ai][bj][m][n]; *(f32x4*)(out + o) = r;
                        u32x2v w; w.x = cvt_pk_bf16(r[0], r[1]); w.y = cvt_pk_bf16(r[2], r[3]); *(u32x2v*)(hb + o) = w; ss += (r[0] * r[0] + r[1] * r[1]) + (r[2] * r[2] + r[3] * r[3]); }
                ss += shx16(ss, 16, lane); ss += shx16(ss, 32, lane);
                if (fq == 0) part[(size_t)row * 64 + u.pn * 4 + wc] = ss;
                if (m & 1) asm volatile("" ::: "memory"); }
    }
};
struct EpiGateN {
    static constexpr bool PERM = false, AFTER_DRAIN = false;
    float* h; const bf16_t* pp; const float* rs; bf16_t* hb; float* part; int ldc;
    __device__ __forceinline__ void operator()(const f32x4 (&acc)[2][2][4][2], const Unit& u, int wr, int wc, int fr, int fq) const {
        typedef unsigned u32x2v __attribute__((ext_vector_type(2)));
        const int row0 = u.pm * BM + wr * 64 + fr, col0 = u.pn * BM + wc * 32 + 4 * fq, lane = fq * 16 + fr;
#pragma unroll
        for (int ai = 0; ai < 2; ++ai)
#pragma unroll
            for (int m = 0; m < 4; ++m) { const int row = row0 + ai * HALF + m * 16; const size_t off = (size_t)row * ldc + col0; const float s = rs[row]; float ss = 0.f;
#pragma unroll
                for (int bj = 0; bj < 2; ++bj)
#pragma unroll
                    for (int n = 0; n < 2; ++n) { const size_t o = off + bj * HALF + n * 16;
                        const f32x4 hv = *(const f32x4*)(h + o); const u32x2v pv = *(const u32x2v*)(pp + o); const f32x4 a = acc[ai][bj][m][n] * s;
                        f32x4 p; p[0] = __uint_as_float(pv.x << 16); p[1] = __uint_as_float(pv.x & 0xffff0000u); p[2] = __uint_as_float(pv.y << 16); p[3] = __uint_as_float(pv.y & 0xffff0000u);
                        f32x4 r;
#pragma unroll
                        for (int j = 0; j < 4; ++j) { const float g = __builtin_amdgcn_rcpf(1.0f + __expf(-a[j])); r[j] = hv[j] + g * p[j]; }
                        *(f32x4*)(h + o) = r; u32x2v w; w.x = cvt_pk_bf16(r[0], r[1]); w.y = cvt_pk_bf16(r[2], r[3]); *(u32x2v*)(hb + o) = w; ss += (r[0] * r[0] + r[1] * r[1]) + (r[2] * r[2] + r[3] * r[3]); }
                ss += shx16(ss, 16, lane); ss += shx16(ss, 32, lane);
                if (fq == 0) part[(size_t)row * 64 + u.pn * 4 + wc] = ss;
                if (m & 1) asm volatile("" ::: "memory"); }
    }
};

__device__ __forceinline__ void unpk8(const u32x4 w, float (&f)[8]) { f[0] = __uint_as_float(w.x << 16); f[1] = __uint_as_float(w.x & 0xffff0000u); f[2] = __uint_as_float(w.y << 16); f[3] = __uint_as_float(w.y & 0xffff0000u);
    f[4] = __uint_as_float(w.z << 16); f[5] = __uint_as_float(w.z & 0xffff0000u); f[6] = __uint_as_float(w.w << 16); f[7] = __uint_as_float(w.w & 0xffff0000u); }
struct EpiResB {
    static constexpr bool PERM = true, AFTER_DRAIN = false;
    const bf16_t* base; bf16_t* out; float* part; int ldc;
    __device__ __forceinline__ void operator()(const f32x4 (&acc)[2][2][4][2], const Unit& u, int wr, int wc, int fr, int fq) const {
        const int row0 = u.pm * BM + wr * 64 + fr, col0 = u.pn * BM + wc * 32 + 8 * fq, lane = fq * 16 + fr;
#pragma unroll
        for (int ai = 0; ai < 2; ++ai)
#pragma unroll
            for (int m = 0; m < 4; ++m) { const int row = row0 + ai * HALF + m * 16; const size_t off = (size_t)row * ldc + col0; float ss = 0.f;
#pragma unroll
                for (int bj = 0; bj < 2; ++bj) { const size_t o = off + bj * HALF; float b[8], r[8]; unpk8(*(const u32x4*)(base + o), b);
#pragma unroll
                    for (int j = 0; j < 4; ++j) { r[j] = b[j] + acc[ai][bj][m][0][j]; r[4 + j] = b[4 + j] + acc[ai][bj][m][1][j]; }
                    u32x4 w; w.x = cvt_pk_bf16(r[0], r[1]); w.y = cvt_pk_bf16(r[2], r[3]); w.z = cvt_pk_bf16(r[4], r[5]); w.w = cvt_pk_bf16(r[6], r[7]); *(u32x4*)(out + o) = w;
#pragma unroll
                    for (int j = 0; j < 8; ++j) ss += r[j] * r[j]; }
                ss += shx16(ss, 16, lane); ss += shx16(ss, 32, lane);
                if (fq == 0) part[(size_t)row * 64 + u.pn * 4 + wc] = ss;
                if (m & 1) asm volatile("" ::: "memory"); }
    }
};
struct EpiGateB {
    static constexpr bool PERM = true, AFTER_DRAIN = false;
    const bf16_t* hin; const bf16_t* pp; const float* rs; bf16_t* out; float* part; int ldc;
    __device__ __forceinline__ void operator()(const f32x4 (&acc)[2][2][4][2], const Unit& u, int wr, int wc, int fr, int fq) const {
        const int row0 = u.pm * BM + wr * 64 + fr, col0 = u.pn * BM + wc * 32 + 8 * fq, lane = fq * 16 + fr;
#pragma unroll
        for (int ai = 0; ai < 2; ++ai)
#pragma unroll
            for (int m = 0; m < 4; ++m) { const int row = row0 + ai * HALF + m * 16; const size_t off = (size_t)row * ldc + col0; const float s = rs[row]; float ss = 0.f;
#pragma unroll
                for (int bj = 0; bj < 2; ++bj) { const size_t o = off + bj * HALF; float hf[8], pf[8], r[8]; unpk8(*(const u32x4*)(hin + o), hf); unpk8(*(const u32x4*)(pp + o), pf);
#pragma unroll
                    for (int j = 0; j < 8; ++j) { const float a = (j < 4 ? acc[ai][bj][m][0][j & 3] : acc[ai][bj][m][1][j & 3]) * s; const float g = __builtin_amdgcn_rcpf(1.0f + __expf(-a)); r[j] = hf[j] + g * pf[j]; }
                    u32x4 w; w.x = cvt_pk_bf16(r[0], r[1]); w.y = cvt_pk_bf16(r[2], r[3]); w.z = cvt_pk_bf16(r[4], r[5]); w.w = cvt_pk_bf16(r[6], r[7]); *(u32x4*)(out + o) = w;
#pragma unroll
                    for (int j = 0; j < 8; ++j) ss += r[j] * r[j]; }
                ss += shx16(ss, 16, lane); ss += shx16(ss, 32, lane);
                if (fq == 0) part[(size_t)row * 64 + u.pn * 4 + wc] = ss;
                if (m & 1) asm volatile("" ::: "memory"); }
    }
};
template <class Epi, class Sched, bool ALIGN_EPI = false, bool SP2 = false>
__device__ __forceinline__ void gemm_phase(PG8_LAS unsigned char* lds, const Gemm g, const Sched& S, const Epi& E) {
    int tid_ = threadIdx.x; asm volatile("" : "+v"(tid_));
    const int tid = tid_, wid = __builtin_amdgcn_readfirstlane(tid >> 6), lane = tid & 63, wr = wid >> 2, wc = wid & 3, fr = lane & 15, fq = lane >> 4;
    const int K = g.K, nt = K / BK;
    unsigned voffA[2], voffB[2];
#pragma unroll
    for (int i = 0; i < 2; ++i) { int R, C; stage_rc(tid * 16 + i * 8192, R, C); const int Rb = Epi::PERM ? ((R & ~31) + perm32(R & 31)) : R;
        voffA[i] = (unsigned)(R * K + C) * 2u; voffB[i] = (unsigned)(Rb * K + C) * 2u; }
    const size_t kstep = (size_t)(BK * 2);
    const size_t hstep = (size_t)HALF * K * 2;
    const size_t tstep = 2 * hstep;
    const unsigned ldsw = (unsigned)wid * 1024u;
    const int aoff = lds_byte(wr * 64 + fr, fq * 8), boff = lds_byte(wc * 32 + fr, fq * 8);
#define PG8_SA(b, h) (((b) * 2 + (h)) * HTB)
#define PG8_SB(b, h) ((4 + (b) * 2 + (h)) * HTB)
#define PG8_STAGE(bufoff, gbase, voff) do { _Pragma("unroll") for (int _i = 0; _i < 2; ++_i) \
        __builtin_amdgcn_global_load_lds((const unsigned*)((const char*)(gbase) + (voff)[_i]), (PG8_LAS unsigned*)(lds + (bufoff) + ldsw + _i * 8192), 16, 0, 0); } while (0)
#define PG8_LDA(dst, b, h) do { _Pragma("unroll") for (int m = 0; m < 4; ++m) _Pragma("unroll") for (int k = 0; k < 2; ++k) dst[m][k] = *(const PG8_LAS bf16x8*)(lds + PG8_SA(b, h) + aoff + m * 2048 + k * 1024); } while (0)
#define PG8_LDB(dst, b, h) do { _Pragma("unroll") for (int n = 0; n < 2; ++n) _Pragma("unroll") for (int k = 0; k < 2; ++k) dst[n][k] = *(const PG8_LAS bf16x8*)(lds + PG8_SB(b, h) + boff + n * 2048 + k * 1024); } while (0)
#define PG8_MMA(ai, bj, At, Bt) do { __builtin_amdgcn_s_setprio(1); _Pragma("unroll") for (int m = 0; m < 4; ++m) _Pragma("unroll") for (int n = 0; n < 2; ++n) _Pragma("unroll") for (int k = 0; k < 2; ++k) \
        acc[ai][bj][m][n] = __builtin_amdgcn_mfma_f32_16x16x32_bf16(Bt[n][k], At[m][k], acc[ai][bj][m][n], 0, 0, 0); __builtin_amdgcn_s_setprio(0); } while (0)
#define PG8_WAIT_V(n) asm volatile("s_waitcnt vmcnt(" #n ")" ::: "memory")
#define PG8_WAIT_L(n) asm volatile("s_waitcnt lgkmcnt(" #n ")" ::: "memory")
#define PG8_BAR __builtin_amdgcn_s_barrier()
#define PG8_SCHED __builtin_amdgcn_sched_barrier(0)
    Unit cur, nxt; int ui = 0;
    if (!S.next(0, cur)) return;
    f32x4 acc[2][2][4][2];
#pragma unroll
    for (int a = 0; a < 2; ++a)
#pragma unroll
        for (int b = 0; b < 2; ++b)
#pragma unroll
            for (int m = 0; m < 4; ++m)
#pragma unroll
                for (int n = 0; n < 2; ++n) acc[a][b][m][n] = (f32x4){0.f, 0.f, 0.f, 0.f};
    bf16x8 At[4][2], B0[2][2], B1[2][2];
    const char* cA = (const char*)g.A + (size_t)cur.pm * tstep; const char* cB = (const char*)g.Bt + (size_t)cur.pn * tstep;
    S.a_ready(cur);
    if constexpr (SP2) {
        PG8_STAGE(PG8_SB(0, 0), cB, voffB); PG8_STAGE(PG8_SB(0, 1), cB + hstep, voffB); PG8_STAGE(PG8_SA(0, 0), cA, voffA); PG8_STAGE(PG8_SA(0, 1), cA + hstep, voffA);
        if (wr == 1) PG8_BAR;
        PG8_WAIT_V(2); PG8_BAR;
        PG8_STAGE(PG8_SB(1, 0), cB + kstep, voffB); PG8_STAGE(PG8_SA(1, 0), cA + kstep, voffA); PG8_STAGE(PG8_SB(1, 1), cB + hstep + kstep, voffB);
        PG8_WAIT_V(6); PG8_BAR;
    } else {
        PG8_STAGE(PG8_SB(0, 0), cB, voffB); PG8_STAGE(PG8_SA(0, 0), cA, voffA); PG8_STAGE(PG8_SB(0, 1), cB + hstep, voffB); PG8_STAGE(PG8_SA(0, 1), cA + hstep, voffA);
        if (wr == 1) PG8_BAR;
        PG8_WAIT_V(4); PG8_BAR;
        PG8_STAGE(PG8_SB(1, 0), cB + kstep, voffB); PG8_STAGE(PG8_SA(1, 0), cA + kstep, voffA); PG8_STAGE(PG8_SB(1, 1), cB + hstep + kstep, voffB);
        PG8_WAIT_V(6); PG8_BAR;
    }
    for (;;) {
        const bool has_next = S.next(ui + 1, nxt);
        const char* nA = has_next ? (const char*)g.A + (size_t)nxt.pm * tstep : cA; const char* nB = has_next ? (const char*)g.Bt + (size_t)nxt.pn * tstep : cB;
#pragma nounroll
        for (int t = 0; t < nt; t += 2) {
            const bool last = (t == nt - 2);
            const char* a1 = cA + (size_t)(t + 1) * kstep;
            const char* a2 = last ? nA : cA + (size_t)(t + 2) * kstep; const char* b2 = last ? nB : cB + (size_t)(t + 2) * kstep;
            const char* a3 = a2 + kstep; const char* b3 = b2 + kstep;
            if (last && has_next) S.a_ready(nxt);
            if constexpr (SP2) {
            PG8_LDB(B0, 0, 0); PG8_LDB(B1, 0, 1); PG8_SCHED; PG8_LDA(At, 0, 0); PG8_STAGE(PG8_SA(1, 1), a1 + hstep, voffA);
            PG8_WAIT_V(8); PG8_WAIT_L(0); PG8_BAR; PG8_MMA(0, 0, At, B0); PG8_MMA(0, 1, At, B1); PG8_BAR; PG8_SCHED;
            PG8_LDA(At, 0, 1); PG8_STAGE(PG8_SB(0, 0), b2, voffB); PG8_STAGE(PG8_SB(0, 1), b2 + hstep, voffB); PG8_STAGE(PG8_SA(0, 0), a2, voffA);
            PG8_WAIT_V(8); PG8_WAIT_L(0); PG8_BAR; PG8_MMA(1, 0, At, B0); PG8_MMA(1, 1, At, B1); PG8_BAR; PG8_SCHED;
            PG8_LDB(B0, 1, 0); PG8_LDB(B1, 1, 1); PG8_SCHED; PG8_LDA(At, 1, 0); PG8_STAGE(PG8_SA(0, 1), a2 + hstep, voffA);
            PG8_WAIT_V(8); PG8_WAIT_L(0); PG8_BAR; PG8_MMA(0, 0, At, B0); PG8_MMA(0, 1, At, B1); PG8_BAR; PG8_SCHED;
            PG8_LDA(At, 1, 1); PG8_STAGE(PG8_SB(1, 0), b3, voffB); PG8_STAGE(PG8_SB(1, 1), b3 + hstep, voffB); PG8_STAGE(PG8_SA(1, 0), a3, voffA);
            PG8_WAIT_V(8); PG8_WAIT_L(0); PG8_BAR; PG8_MMA(1, 0, At, B0); PG8_MMA(1, 1, At, B1); PG8_BAR; PG8_SCHED;
            } else {
            PG8_LDB(B0, 0, 0); PG8_SCHED; PG8_LDA(At, 0, 0); PG8_STAGE(PG8_SA(1, 1), a1 + hstep, voffA);
            PG8_WAIT_L(8); PG8_BAR; PG8_WAIT_L(0); PG8_MMA(0, 0, At, B0); PG8_BAR; PG8_SCHED;
            PG8_LDB(B1, 0, 1); PG8_STAGE(PG8_SB(0, 0), b2, voffB);
            PG8_BAR; PG8_WAIT_L(0); PG8_MMA(0, 1, At, B1); PG8_BAR;
            PG8_LDA(At, 0, 1); PG8_STAGE(PG8_SA(0, 0), a2, voffA);
            PG8_BAR; PG8_WAIT_L(0); PG8_MMA(1, 0, At, B0); PG8_BAR; PG8_SCHED;
            PG8_STAGE(PG8_SB(0, 1), b2 + hstep, voffB);
            PG8_WAIT_V(6); PG8_BAR; PG8_MMA(1, 1, At, B1); PG8_BAR;
            PG8_LDB(B0, 1, 0); PG8_SCHED; PG8_LDA(At, 1, 0); PG8_STAGE(PG8_SA(0, 1), a2 + hstep, voffA);
            PG8_WAIT_L(8); PG8_BAR; PG8_WAIT_L(0); PG8_MMA(0, 0, At, B0); PG8_BAR; PG8_SCHED;
            PG8_LDB(B1, 1, 1); PG8_STAGE(PG8_SB(1, 0), b3, voffB);
            PG8_BAR; PG8_WAIT_L(0); PG8_MMA(0, 1, At, B1); PG8_BAR;
            PG8_LDA(At, 1, 1); PG8_STAGE(PG8_SA(1, 0), a3, voffA);
            PG8_BAR; PG8_WAIT_L(0); PG8_MMA(1, 0, At, B0); PG8_BAR; PG8_SCHED;
            PG8_STAGE(PG8_SB(1, 1), b3 + hstep, voffB);
            PG8_WAIT_V(6); PG8_BAR; PG8_MMA(1, 1, At, B1); PG8_BAR;
            }
        }
        if constexpr (ALIGN_EPI) { if (wr == 0) PG8_BAR; }
        if constexpr (!Epi::AFTER_DRAIN) { E(acc, cur, wr, wc, fr, fq); S.done(cur); }
        if (!has_next) break;
#pragma unroll
        for (int a = 0; a < 2; ++a)
#pragma unroll
            for (int b = 0; b < 2; ++b)
#pragma unroll
                for (int m = 0; m < 4; ++m)
#pragma unroll
                    for (int n = 0; n < 2; ++n) acc[a][b][m][n] = (f32x4){0.f, 0.f, 0.f, 0.f};
        cur = nxt; cA = nA; cB = nB; ++ui;
        if constexpr (ALIGN_EPI) { if (wr == 1) PG8_BAR; }
    }
    PG8_WAIT_V(0);
    if constexpr (!ALIGN_EPI) { if (wr == 0) PG8_BAR; }
    PG8_BAR;
    if constexpr (Epi::AFTER_DRAIN) { E.fused(acc, cur, wr, wc, fr, fq, lds, wid, lane); S.done(cur); }
#undef PG8_SA
#undef PG8_SB
#undef PG8_STAGE
#undef PG8_LDA
#undef PG8_LDB
#undef PG8_MMA
#undef PG8_WAIT_V
#undef PG8_WAIT_L
#undef PG8_BAR
#undef PG8_SCHED
}
}

constexpr int SEQ = 16384, DM = 4096, DEPTH = 4, DPLE = 256;
constexpr int INW = 15980;
constexpr int ZW = 16384;
constexpr float NORM_EPS = 1e-6f;
constexpr int ZQ_A = 0, ZK_A = 768, ZV_A = 1536, ZLOW = 3072, ZGATE_A = 3200;
constexpr int ZQ_B = 4736, ZK_B = 5760, ZV_B = 6784, ZGATE_B = 7808, ZIQ = 8832, ZIK = 9856, ZIW = 9984;
constexpr int ZQ_C = 10112, ZK_C = 10880, ZV_C = 11648, ZIF = 13184, ZO_C = 13312, ZGATE_C = 14848;
constexpr int YA = 0, YB = 1536, YC = 2560;
constexpr int NCH = SEQ / 64;

constexpr size_t MiB = 1u << 20;
constexpr size_t WS_CTL = 0, CTL_ZERO_BYTES = 1 * MiB;
constexpr size_t WS_ROPE = 1 * MiB;
constexpr size_t WS_PBF = 4 * MiB;
constexpr size_t WS_WPLE = 36 * MiB;
constexpr size_t WS_WOUT = 44 * MiB;
constexpr size_t WS_WGATE = 172 * MiB;
constexpr size_t WS_WIN = 300 * MiB;
constexpr size_t WS_H = 812 * MiB;
constexpr size_t WS_U = 1068 * MiB;
constexpr size_t WS_Z = 1196 * MiB;
constexpr size_t WS_Y = 1708 * MiB;
constexpr size_t WS_PP = 1836 * MiB;
constexpr size_t WS_QA = 1964 * MiB, WS_KA = 1996 * MiB, WS_VA = 2028 * MiB;
constexpr size_t WS_IQ = 2060 * MiB;
constexpr size_t WS_IK = 2092 * MiB;
constexpr size_t WS_IW = 2094 * MiB;
constexpr size_t WS_MASK = 2096 * MiB;
constexpr size_t WS_BA = 2128 * MiB;
constexpr size_t WS_DS = 2176 * MiB;
constexpr size_t WS_SP = 2272 * MiB;
constexpr size_t WS_CQ = 2320 * MiB, WS_CK = 2344 * MiB;
constexpr size_t WS_MG = 2368 * MiB;
constexpr size_t WS_DC = 2372 * MiB;
constexpr size_t WS_CP = 2564 * MiB;
constexpr size_t WS_SCORE = 2660 * MiB;
constexpr size_t WS_HB2 = 3684 * MiB;
constexpr size_t WS_PART = 3812 * MiB;
constexpr size_t WS_RSTD = 3816 * MiB;
constexpr size_t WS_END = 3818 * MiB;
constexpr size_t MG_B = 0;
constexpr size_t MG_I = MG_B + (size_t)SEQ * 8;
constexpr size_t MG_ML = MG_I + (size_t)SEQ * 8;
constexpr size_t MG_MP = MG_ML + (size_t)NCH * 6 * 2;
constexpr size_t MG_DN = MG_MP + (size_t)NCH * 6;
constexpr size_t MG_NP = MG_DN + (size_t)NCH * 6 * 128;
static_assert((MG_NP + (size_t)NCH * 6 * 128) * 4 <= 4 * MiB, "mLSTM small arrays fit");

constexpr int CW_BAR = 4096;

constexpr int RING_BYTES = 131072;
constexpr int MISC_OFF = RING_BYTES + 320;
constexpr int LDS_BYTES = 147456;
constexpr int NWAVES = 8, NTHR = 512;

#define GAS __attribute__((address_space(1)))
#define LAS __attribute__((address_space(3)))
typedef unsigned short bf16;
typedef unsigned u32x4 __attribute__((ext_vector_type(4)));
typedef unsigned u32x2 __attribute__((ext_vector_type(2)));
typedef float f32x4 __attribute__((ext_vector_type(4)));
typedef float f32x2 __attribute__((ext_vector_type(2)));
typedef float f32x16 __attribute__((ext_vector_type(16)));
typedef short bf16x8 __attribute__((ext_vector_type(8)));
typedef short bf16x4 __attribute__((ext_vector_type(4)));
#define LDS_WAIT() asm volatile("s_waitcnt lgkmcnt(0)" ::: "memory")
#define VM_WAIT() asm volatile("s_waitcnt vmcnt(0)" ::: "memory")

__device__ __forceinline__ float bf2f(unsigned short b) { return __uint_as_float((unsigned)b << 16); }
__device__ __forceinline__ float bflo(unsigned w) { return __uint_as_float(w << 16); }
__device__ __forceinline__ float bfhi(unsigned w) { return __uint_as_float(w & 0xffff0000u); }
typedef __bf16 bf16x2_t __attribute__((ext_vector_type(2)));
__device__ __forceinline__ unsigned pk2(float lo, float hi) { const f32x2 v = {lo, hi}; const bf16x2_t b = __builtin_convertvector(v, bf16x2_t); return __builtin_bit_cast(unsigned, b); }
__device__ __forceinline__ unsigned short f2bf(float f) { return (unsigned short)(pk2(f, 0.f) & 0xffffu); }
__device__ __forceinline__ float shx(float v, int o, int lane) { return __int_as_float(__builtin_amdgcn_ds_bpermute((lane ^ o) << 2, __float_as_int(v))); }
__device__ __forceinline__ float shup(float v, int o, int lane) { return __int_as_float(__builtin_amdgcn_ds_bpermute(((lane - o) & 63) << 2, __float_as_int(v))); }
__device__ __forceinline__ unsigned shdn_u(unsigned v, int o, int lane) { return (unsigned)__builtin_amdgcn_ds_bpermute(((lane + o) & 63) << 2, (int)v); }
__device__ __forceinline__ float wave_sum(float v, int lane) {
#pragma unroll
    for (int o = 1; o < 64; o <<= 1) v += shx(v, o, lane);
    return v;
}
__device__ __forceinline__ float wave_max(float v, int lane) {
#pragma unroll
    for (int o = 1; o < 64; o <<= 1) v = fmaxf(v, shx(v, o, lane));
    return v;
}
__device__ __forceinline__ float log_sigmoidf(float x) { return fminf(x, 0.f) - log1pf(expf(-fabsf(x))); }
__device__ __forceinline__ float sigmoidf_(float x) { return __builtin_amdgcn_rcpf(1.0f + __expf(-x)); }
__device__ __forceinline__ float siluf_(float x) { return x * __builtin_amdgcn_rcpf(1.0f + __expf(-x)); }
__device__ __forceinline__ int crow(int r, int hi) { return (r & 3) + 8 * (r >> 2) + 4 * hi; }
__device__ __forceinline__ void unpack8(const u32x4 w, float (&f)[8]) { f[0] = bflo(w.x); f[1] = bfhi(w.x); f[2] = bflo(w.y); f[3] = bfhi(w.y); f[4] = bflo(w.z); f[5] = bfhi(w.z); f[6] = bflo(w.w); f[7] = bfhi(w.w); }
__device__ __forceinline__ u32x4 pack8f(const float (&f)[8]) { u32x4 o; o.x = pk2(f[0], f[1]); o.y = pk2(f[2], f[3]); o.z = pk2(f[4], f[5]); o.w = pk2(f[6], f[7]); return o; }
__device__ __forceinline__ int hw_lane() { int l; asm volatile("v_mbcnt_lo_u32_b32 %0, -1, 0\n\tv_mbcnt_hi_u32_b32 %0, -1, %0" : "=v"(l)); return l; }
#define XB_TMO      128
#define XB_XCNT(j)  (256  + 64 * (j))
#define XB_XSUB(j)  (1280 + 64 * (j))
#define XB_XGEN(j)  (2304 + 64 * (j))
#define XB_TOP      3328
#define XB_TOPGEN   3392
#define XCD_BAR_WORDS 3456
#define XB_SPIN_CAP (1u << 18)

__device__ __forceinline__ unsigned xb_ld(unsigned* p)              { return __hip_atomic_load(p, __ATOMIC_RELAXED, __HIP_MEMORY_SCOPE_AGENT); }
__device__ __forceinline__ unsigned xb_add(unsigned* p, unsigned v) { return __hip_atomic_fetch_add(p, v, __ATOMIC_RELAXED, __HIP_MEMORY_SCOPE_AGENT); }
__device__ __forceinline__ unsigned xb_xcc_id() { return (unsigned)__builtin_amdgcn_s_getreg((3 << 11) | 20) & 0xFu; }
#define XB_SPIN(cond, bar) do { unsigned _sp = 0; while (cond) { __builtin_amdgcn_s_sleep(1); \
    if ((++_sp & 255u) == 0u) { if (xb_ld(&(bar)[XB_TMO])) break; if (_sp > XB_SPIN_CAP) { atomicAdd(&(bar)[XB_TMO], 1u); break; } } } } while (0)

struct XcdBarrier {
    unsigned* bar; unsigned x;
    volatile LAS unsigned* st;
};

__device__ __forceinline__ XcdBarrier xcd_barrier_post(unsigned* bar, volatile LAS unsigned* st) {
    XcdBarrier b; b.bar = bar; b.x = xb_xcc_id(); b.st = st;
    if (threadIdx.x == 0) (void)xb_add(&bar[XB_XCNT(b.x)], 1u);
    return b;
}
__device__ __forceinline__ void xcd_barrier_complete(unsigned* bar, unsigned x, unsigned& nloc, unsigned& nx) {
    const unsigned G = gridDim.x * gridDim.y * gridDim.z;
    unsigned sum, cnt, mine, sp = 0u;
    for (;;) {
        sum = 0u; cnt = 0u; mine = 0u;
#pragma unroll
        for (unsigned j = 0; j < 16; ++j) { const unsigned c = xb_ld(&bar[XB_XCNT(j)]); sum += c; cnt += (c > 0u) ? 1u : 0u; mine = (j == x) ? c : mine; }
        if (sum == G) break;
        __builtin_amdgcn_s_sleep(1);
        if ((++sp & 255u) == 0u) { if (xb_ld(&bar[XB_TMO])) break; if (sp > XB_SPIN_CAP) { atomicAdd(&bar[XB_TMO], 1u); break; } }
    }
    nloc = mine > 0u ? mine : 1u; nx = cnt > 0u ? cnt : 1u;
}

__device__ __forceinline__ void xcd_barrier(const XcdBarrier& b) {
    asm volatile("s_waitcnt vmcnt(0)" ::: "memory");
    __syncthreads();
    if (threadIdx.x == 0) {
        unsigned* bar = b.bar;
        __builtin_amdgcn_s_waitcnt(0);
        unsigned nloc = b.st[0], nx = b.st[1];
        if (nloc == 0u) { xcd_barrier_complete(bar, b.x, nloc, nx); b.st[0] = nloc; b.st[1] = nx; }
        const unsigned old = xb_add(&bar[XB_XSUB(b.x)], 1u);
        const unsigned gen = old / nloc;
        if (old + 1u == (gen + 1u) * nloc) {
            __builtin_amdgcn_fence(__ATOMIC_RELEASE, "agent");
            asm volatile("s_waitcnt vmcnt(0)" ::: "memory");
            const unsigned og = xb_add(&bar[XB_TOP], 1u);
            const unsigned tg = og / nx;
            if (og + 1u == (tg + 1u) * nx) xb_add(&bar[XB_TOPGEN], 1u);
            else XB_SPIN(xb_ld(&bar[XB_TOPGEN]) == tg, bar);
            __builtin_amdgcn_fence(__ATOMIC_ACQUIRE, "agent");
            xb_add(&bar[XB_XGEN(b.x)], 1u);
            asm volatile("s_waitcnt vmcnt(0)" ::: "memory");
        } else {
            XB_SPIN(xb_ld(&bar[XB_XGEN(b.x)]) == gen, bar);
            __builtin_amdgcn_fence(__ATOMIC_ACQUIRE, "agent");
            asm volatile("s_waitcnt vmcnt(0)" ::: "memory");
        }
    }
    __syncthreads();
}

struct Frame {
    LAS unsigned char* lds;
    unsigned char* ws;
    int tid, lane, wave, G, vcu, gw, NGW;
};

__device__ __forceinline__ void zseg(int n0, int& src0, int& valid, float& cscale) {
    int d0, s0, sl;
    if (n0 < ZK_A) { d0 = ZQ_A; s0 = 0; sl = 768; }
    else if (n0 < ZV_A) { d0 = ZK_A; s0 = 768; sl = 768; }
    else if (n0 < ZLOW) { d0 = ZV_A; s0 = 1536; sl = 1536; }
    else if (n0 < ZGATE_A) { d0 = ZLOW; s0 = 3072; sl = 16; }
    else if (n0 < ZQ_B) { d0 = ZGATE_A; s0 = 3088; sl = 1536; }
    else if (n0 < ZK_B) { d0 = ZQ_B; s0 = 4624; sl = 1024; }
    else if (n0 < ZV_B) { d0 = ZK_B; s0 = 5648; sl = 1024; }
    else if (n0 < ZGATE_B) { d0 = ZV_B; s0 = 6672; sl = 1024; }
    else if (n0 < ZIQ) { d0 = ZGATE_B; s0 = 7696; sl = 1024; }
    else if (n0 < ZIK) { d0 = ZIQ; s0 = 8720; sl = 1024; }
    else if (n0 < ZIW) { d0 = ZIK; s0 = 9744; sl = 64; }
    else if (n0 < ZQ_C) { d0 = ZIW; s0 = 9808; sl = 16; }
    else if (n0 < ZK_C) { d0 = ZQ_C; s0 = 9824; sl = 768; }
    else if (n0 < ZV_C) { d0 = ZK_C; s0 = 10592; sl = 768; }
    else if (n0 < ZIF) { d0 = ZV_C; s0 = 11360; sl = 1536; }
    else if (n0 < ZO_C) { d0 = ZIF; s0 = 12896; sl = 12; }
    else if (n0 < ZGATE_C) { d0 = ZO_C; s0 = 12908; sl = 1536; }
    else { d0 = ZGATE_C; s0 = 14444; sl = 1536; }
    const int off = n0 - d0; int v = sl - off; v = v < 0 ? 0 : (v > 32 ? 32 : v);
    src0 = s0 + off; valid = v;
    cscale = (d0 == ZIQ) ? 0.0078125f : (d0 == ZIW) ? 4.0f : 1.0f;
}
__device__ __forceinline__ void transpose_item(const float* W, int K, int Nsrc, bf16* WT, int k0, int n0dst, int src0, int valid, LAS float* scr, int lane, const float* gk, const float cs = 1.0f) {
    const int j = lane & 31; const bool ok = j < valid;
    float vv[32];
    const float* wp = W + (size_t)(k0 + (lane >> 5)) * Nsrc + src0 + (ok ? j : 0);
#pragma unroll
    for (int i = 0; i < 32; ++i) vv[i] = wp[(size_t)(2 * i) * Nsrc];
#pragma unroll
    for (int i = 0; i < 32; ++i) { const int kk = 2 * i + (lane >> 5); const float gg = (gk ? gk[k0 + kk] : 1.0f) * cs; scr[kk * 33 + j] = ok ? vv[i] * gg : 0.f; }
    LDS_WAIT(); asm volatile("" ::: "memory");
    const int c = lane & 7;
#pragma unroll
    for (int jj = 0; jj < 4; ++jj) { const int n = (lane >> 3) + 8 * jj; const LAS float* s = scr + (8 * c) * 33 + n;
        u32x4 o; o.x = pk2(s[0 * 33], s[1 * 33]); o.y = pk2(s[2 * 33], s[3 * 33]); o.z = pk2(s[4 * 33], s[5 * 33]); o.w = pk2(s[6 * 33], s[7 * 33]);
        *(GAS u32x4*)(WT + (size_t)(n0dst + n) * K + k0 + 8 * c) = o; }
    LDS_WAIT(); asm volatile("" ::: "memory");
}
__device__ __forceinline__ void p0_prologue(const Frame& F, const float* w_in, const float* w_out, const float* w_ple_gate, const float* w_ple_proj, const float* pin, const int* pos, const float* g_in, const float* g_ple, const float* x) {
    LAS float* scr = (LAS float*)(F.lds + F.wave * 16384);
    constexpr int I_IN = (DM / 64) * (ZW / 32), I_SQ = (DM / 64) * (DM / 32), I_PL = (DPLE / 64) * (DM / 32), I_L = I_IN + 2 * I_SQ + I_PL;
    for (int it = F.gw; it < DEPTH * I_L; it += F.NGW) {
        const int L = it / I_L; int r = it - L * I_L;
        if (r < I_IN) { const int nb = r % (ZW / 32), kb = r / (ZW / 32); int s0, vd; float cs; zseg(nb * 32, s0, vd, cs);
            transpose_item(w_in + (size_t)L * DM * INW, DM, INW, (bf16*)(F.ws + WS_WIN) + (size_t)L * ZW * DM, kb * 64, nb * 32, s0, vd, scr, F.lane, g_in + (size_t)L * DM, cs); continue; }
        r -= I_IN;
        if (r < I_SQ) { const int nb = r % (DM / 32), kb = r / (DM / 32);
            transpose_item(w_out + (size_t)L * DM * DM, DM, DM, (bf16*)(F.ws + WS_WOUT) + (size_t)L * DM * DM, kb * 64, nb * 32, nb * 32, 32, scr, F.lane, nullptr); continue; }
        r -= I_SQ;
        if (r < I_SQ) { const int nb = r % (DM / 32), kb = r / (DM / 32);
            transpose_item(w_ple_gate + (size_t)L * DM * DM, DM, DM, (bf16*)(F.ws + WS_WGATE) + (size_t)L * DM * DM, kb * 64, nb * 32, nb * 32, 32, scr, F.lane, g_ple + (size_t)L * DM); continue; }
        r -= I_SQ;
        { const int nb = r % (DM / 32), kb = r / (DM / 32);
            transpose_item(w_ple_proj + (size_t)L * DPLE * DM, DPLE, DM, (bf16*)(F.ws + WS_WPLE) + (size_t)L * DM * DPLE, kb * 64, nb * 32, nb * 32, 32, scr, F.lane, nullptr); }
    }
    { bf16* hb = (bf16*)(F.ws + WS_U); float* rstd = (float*)(F.ws + WS_RSTD);
      for (int row = F.gw; row < SEQ; row += F.NGW) {
          const f32x4* xr = (const f32x4*)(x + (size_t)row * DM) + F.lane; f32x4 v[16]; float ss = 0.f;
#pragma unroll
          for (int j = 0; j < 16; ++j) { v[j] = xr[64 * j]; ss += (v[j][0] * v[j][0] + v[j][1] * v[j][1]) + (v[j][2] * v[j][2] + v[j][3] * v[j][3]); }
          ss = wave_sum(ss, F.lane); if (F.lane == 0) rstd[row] = 1.0f / sqrtf(ss * (1.0f / DM) + NORM_EPS);
          u32x2* o = (u32x2*)(hb + (size_t)row * DM) + F.lane;
#pragma unroll
          for (int j = 0; j < 16; ++j) { u32x2 w; w.x = pk2(v[j][0], v[j][1]); w.y = pk2(v[j][2], v[j][3]); o[64 * j] = w; } } }
    { const size_t n8 = (size_t)DEPTH * SEQ * DPLE / 8; bf16* pb = (bf16*)(F.ws + WS_PBF);
      for (size_t i = (size_t)blockIdx.x * NTHR + F.tid; i < n8; i += (size_t)F.G * NTHR) {
          const f32x4 a = *(const f32x4*)(pin + i * 8), b = *(const f32x4*)(pin + i * 8 + 4);
          u32x4 o; o.x = pk2(a[0], a[1]); o.y = pk2(a[2], a[3]); o.z = pk2(b[0], b[1]); o.w = pk2(b[2], b[3]);
          *(u32x4*)(pb + i * 8) = o; } }
    { float* cosA = (float*)(F.ws + WS_ROPE); float* sinA = cosA + (size_t)SEQ * 16; float* cosI = sinA + (size_t)SEQ * 16; float* sinI = cosI + (size_t)SEQ * 8;
      for (int i = blockIdx.x * NTHR + F.tid; i < SEQ * 24; i += F.G * NTHR) {
          const int t = i / 24, f = i % 24; const bool isA = f < 16; const int fi = isA ? f : f - 16; const double rot = isA ? 32.0 : 16.0;
          const float ex = -(float)(2 * fi) / (float)rot;
          const float inv = (float)exp((double)ex * 13.122363377404328);
          const float ang = (float)pos[t] * inv;
          const double a = (double)ang; const double n = rint(a * 0.15915494309189535);
          double rr = fma(-n, 6.283185307179586, a); rr = fma(-n, 2.4492935982947064e-16, rr);
          const float c = (float)cos(rr), s = (float)sin(rr);
          if (isA) { cosA[t * 16 + fi] = c; sinA[t * 16 + fi] = s; } else { cosI[t * 8 + fi] = c; sinI[t * 8 + fi] = s; } } }
}

__device__ __forceinline__ void reduce_rstd(const Frame& F) {
    const float* part = (const float*)(F.ws + WS_PART); float* rstd = (float*)(F.ws + WS_RSTD);
    for (int r4 = F.gw; r4 < SEQ / 4; r4 += F.NGW) { const int row = r4 * 4 + (F.lane >> 4); const f32x4 p = *(const f32x4*)(part + (size_t)row * 64 + (F.lane & 15) * 4);
        float s = (p[0] + p[1]) + (p[2] + p[3]); s += shx(s, 1, F.lane); s += shx(s, 2, F.lane); s += shx(s, 4, F.lane); s += shx(s, 8, F.lane);
        if ((F.lane & 15) == 0) rstd[row] = 1.0f / sqrtf(s * (1.0f / DM) + NORM_EPS); }
}
__device__ __forceinline__ void rmsnorm_to_bf16(const Frame& F, const float* src, const float* g, bf16* dst) {
    for (int row = F.gw; row < SEQ; row += F.NGW) {
        const f32x4* xr = (const f32x4*)(src + (size_t)row * DM) + F.lane; f32x4 v[16]; float ss = 0.f;
#pragma unroll
        for (int j = 0; j < 16; ++j) { v[j] = xr[64 * j]; ss += (v[j][0] * v[j][0] + v[j][1] * v[j][1]) + (v[j][2] * v[j][2] + v[j][3] * v[j][3]); }
        const float rs = 1.0f / sqrtf(wave_sum(ss, F.lane) * (1.0f / DM) + NORM_EPS);
        u32x2* o = (u32x2*)(dst + (size_t)row * DM) + F.lane;
#pragma unroll
        for (int j = 0; j < 16; ++j) { const f32x4 gv = ((const f32x4*)g)[F.lane + 64 * j]; u32x2 w; w.x = pk2(v[j][0] * rs * gv[0], v[j][1] * rs * gv[1]); w.y = pk2(v[j][2] * rs * gv[2], v[j][3] * rs * gv[3]); o[64 * j] = w; }
    }
}
__device__ __forceinline__ void rmsnorm_b2f(const Frame& F, const bf16* src, const float* g, float* dst) {
    for (int row = F.gw; row < SEQ; row += F.NGW) {
        const u32x4* xr = (const u32x4*)(src + (size_t)row * DM) + F.lane; float v[8][8]; float ss = 0.f;
#pragma unroll
        for (int j = 0; j < 8; ++j) { unpack8(xr[64 * j], v[j]);
#pragma unroll
            for (int q = 0; q < 8; ++q) ss += v[j][q] * v[j][q]; }
        const float rs = 1.0f / sqrtf(wave_sum(ss, F.lane) * (1.0f / DM) + NORM_EPS);
#pragma unroll
        for (int j = 0; j < 8; ++j) { const int c0 = (F.lane + 64 * j) * 8; const f32x4 g0 = *(const f32x4*)(g + c0), g1 = *(const f32x4*)(g + c0 + 4); f32x4 o0, o1;
#pragma unroll
            for (int q = 0; q < 4; ++q) { o0[q] = v[j][q] * rs * g0[q]; o1[q] = v[j][4 + q] * rs * g1[q]; }
            *(f32x4*)(dst + (size_t)row * DM + c0) = o0; *(f32x4*)(dst + (size_t)row * DM + c0 + 4) = o1; }
    }
}
__device__ __forceinline__ void rmsnorm_to_f32(const Frame& F, const float* src, const float* g, float* dst) {
    for (int row = F.gw; row < SEQ; row += F.NGW) {
        const f32x4* xr = (const f32x4*)(src + (size_t)row * DM) + F.lane; f32x4 v[16]; float ss = 0.f;
#pragma unroll
        for (int j = 0; j < 16; ++j) { v[j] = xr[64 * j]; ss += (v[j][0] * v[j][0] + v[j][1] * v[j][1]) + (v[j][2] * v[j][2] + v[j][3] * v[j][3]); }
        const float rs = 1.0f / sqrtf(wave_sum(ss, F.lane) * (1.0f / DM) + NORM_EPS);
        f32x4* o = (f32x4*)(dst + (size_t)row * DM) + F.lane;
#pragma unroll
        for (int j = 0; j < 16; ++j) { const f32x4 gv = ((const f32x4*)g)[F.lane + 64 * j]; f32x4 w; w[0] = v[j][0] * rs * gv[0]; w[1] = v[j][1] * rs * gv[1]; w[2] = v[j][2] * rs * gv[2]; w[3] = v[j][3] * rs * gv[3]; o[64 * j] = w; }
    }
}


__device__ __forceinline__ void p3_prep(const Frame& F, const float* wq, const float* wk, const float* b_ig, const float* b_fg, const float* wu, const float* bu) {
    const bf16* __restrict__ z = (const bf16*)(F.ws + WS_Z);
    const float* cosA = (const float*)(F.ws + WS_ROPE); const float* sinA = cosA + (size_t)SEQ * 16; const float* cosI = sinA + (size_t)SEQ * 16; const float* sinI = cosI + (size_t)SEQ * 8;
    const int gt = blockIdx.x * NTHR + F.tid, GT = F.G * NTHR;
#ifndef P3MASK
#define P3MASK 0
#endif
#define P3REP(k) for (int rep3_ = 0; rep3_ < (((P3MASK >> (k)) & 1) ? 2 : 1); ++rep3_)
    P3REP(1) { bf16* __restrict__ qk = (bf16*)(F.ws + WS_QA);
#pragma unroll 4
      for (int i = gt; i < 2 * 8 * SEQ; i += GT) { const int t = i & (SEQ - 1); bf16* p = qk + (size_t)i * 128;
          const u32x4 w0 = *(const u32x4*)p, w1 = *(const u32x4*)(p + 8), w2 = *(const u32x4*)(p + 16), w3 = *(const u32x4*)(p + 24);
          float x1[16], x2[16], o1[16], o2[16]; { float a[8]; unpack8(w0, a); for (int j = 0; j < 8; ++j) x1[j] = a[j]; unpack8(w1, a); for (int j = 0; j < 8; ++j) x1[8 + j] = a[j]; unpack8(w2, a); for (int j = 0; j < 8; ++j) x2[j] = a[j]; unpack8(w3, a); for (int j = 0; j < 8; ++j) x2[8 + j] = a[j]; }
          const float* cp = cosA + (size_t)t * 16; const float* sp = sinA + (size_t)t * 16;
#pragma unroll
          for (int j = 0; j < 16; ++j) { const float cc = cp[j], ss = sp[j]; o1[j] = x1[j] * cc - x2[j] * ss; o2[j] = x2[j] * cc + x1[j] * ss; }
          { float a[8]; for (int j = 0; j < 8; ++j) a[j] = o1[j]; *(u32x4*)p = pack8f(a); for (int j = 0; j < 8; ++j) a[j] = o1[8 + j]; *(u32x4*)(p + 8) = pack8f(a); for (int j = 0; j < 8; ++j) a[j] = o2[j]; *(u32x4*)(p + 16) = pack8f(a); for (int j = 0; j < 8; ++j) a[j] = o2[8 + j]; *(u32x4*)(p + 24) = pack8f(a); } } }
    P3REP(2) { bf16* __restrict__ iq = (bf16*)(F.ws + WS_IQ); bf16* __restrict__ ik = (bf16*)(F.ws + WS_IK);
#pragma unroll 4
      for (int i = gt; i < SEQ * 17; i += GT) { const bool isq = i < SEQ * 16; const int t = isq ? (i >> 4) : (i - SEQ * 16); bf16* p = isq ? iq + (size_t)i * 64 : ik + (size_t)t * 64;
          float a[8], b[8], oa[8], ob[8]; unpack8(*(const u32x4*)p, a); unpack8(*(const u32x4*)(p + 8), b);
          const float* cp = cosI + (size_t)t * 8; const float* sp = sinI + (size_t)t * 8;
#pragma unroll
          for (int j = 0; j < 8; ++j) { const float cc = cp[j], ss = sp[j]; oa[j] = a[j] * cc - b[j] * ss; ob[j] = b[j] * cc + a[j] * ss; }
          *(u32x4*)p = pack8f(oa); *(u32x4*)(p + 8) = pack8f(ob); } }
    P3REP(3) { bf16* __restrict__ cq = (bf16*)(F.ws + WS_CQ); bf16* __restrict__ ck = (bf16*)(F.ws + WS_CK);
      constexpr int PER = SEQ * 96;
#pragma unroll 4
      for (int i = gt; i < 2 * PER; i += GT) {
          const int which = i / PER, r = i - which * PER, c8 = r % 96, t = r / 96;
          const float* w = (which ? wk : wq) + c8 * 8; const int zc = (which ? ZK_C : ZQ_C) + c8 * 8; float acc[8];
#pragma unroll
          for (int j = 0; j < 8; ++j) acc[j] = 0.f;
#pragma unroll
          for (int tap = 0; tap < 4; ++tap) { const int ts = t - 3 + tap; if (ts >= 0) { float xv[8]; unpack8(*(const u32x4*)(z + (size_t)ts * ZW + zc), xv); const f32x4 w0 = *(const f32x4*)(w + tap * 768), w1 = *(const f32x4*)(w + tap * 768 + 4);
#pragma unroll
              for (int j = 0; j < 4; ++j) { acc[j] += xv[j] * w0[j]; acc[4 + j] += xv[4 + j] * w1[j]; } } }
          const float sc = which ? 1.0f : 0.08838834764831845f;
#pragma unroll
          for (int j = 0; j < 8; ++j) acc[j] = siluf_(acc[j]) * sc;
          *(u32x4*)((which ? ck : cq) + (size_t)t * 768 + c8 * 8) = pack8f(acc); } }
    P3REP(4) { float* mg = (float*)(F.ws + WS_MG);
      for (int u = F.gw; u < NCH * 6; u += F.NGW) { const int c = u / 6, h = u % 6, t = c * 64 + F.lane; const float bi = b_ig[h], bfg = b_fg[h];
          const float ci = bf2f(z[(size_t)t * ZW + ZIF + h]), cf = bf2f(z[(size_t)t * ZW + ZIF + 6 + h]);
          float v = log_sigmoidf(cf + bfg);
#pragma unroll
          for (int o = 1; o < 64; o <<= 1) { const float nb = shup(v, o, F.lane); if (F.lane >= o) v += nb; }
          mg[MG_B + (size_t)t * 8 + h] = v; mg[MG_I + (size_t)t * 8 + h] = ci + bi; } }
    P3REP(5) { float* bA = (float*)(F.ws + WS_BA); LAS float* al = (LAS float*)F.lds;
      for (int c = blockIdx.x; c < NCH; c += F.G) {
          __syncthreads();
          if (F.tid < 128) { const int s = F.tid >> 1, hf = F.tid & 1; float a[8]; unpack8(*(const u32x4*)(z + (size_t)(c * 64 + s) * ZW + ZLOW + hf * 8), a);
#pragma unroll
              for (int r = 0; r < 8; ++r) al[s * 16 + hf * 8 + r] = a[r]; }
          __syncthreads();
          for (int n = F.tid; n < 768; n += NTHR) { float wv[16];
#pragma unroll
              for (int r = 0; r < 16; ++r) wv[r] = wu[r * 768 + n];
              const float bb = bu[n]; float bs = 0.f; float* op = bA + (size_t)c * 64 * 768 + n;
#pragma unroll 4
              for (int s = 0; s < 64; ++s) { const f32x4 a0 = *(const LAS f32x4*)(al + s * 16), a1 = *(const LAS f32x4*)(al + s * 16 + 4), a2 = *(const LAS f32x4*)(al + s * 16 + 8), a3 = *(const LAS f32x4*)(al + s * 16 + 12);
                  float x = bb;
#pragma unroll
                  for (int r = 0; r < 4; ++r) { x += a0[r] * wv[r]; x += a1[r] * wv[4 + r]; x += a2[r] * wv[8 + r]; x += a3[r] * wv[12 + r]; }
                  bs += (fminf(x, 0.f) - __logf(1.0f + __expf(-fabsf(x)))) * (1.0f / 16.0f); op[(size_t)s * 768] = bs; } } }
    }
}

__device__ __forceinline__ f32x16 mfma32(bf16x8 a, bf16x8 b, f32x16 c) { return __builtin_amdgcn_mfma_f32_32x32x16_bf16(a, b, c, 0, 0, 0); }
__device__ __forceinline__ f32x4 mfma16(bf16x8 a, bf16x8 b, f32x4 c) { return __builtin_amdgcn_mfma_f32_16x16x32_bf16(a, b, c, 0, 0, 0); }
__device__ __forceinline__ f32x16 zero16() { f32x16 z;
#pragma unroll
    for (int i = 0; i < 16; ++i) z[i] = 0.f;
    return z; }

__device__ __forceinline__ void p4_index_scores(const Frame& F) {
    const bf16* iq = (const bf16*)(F.ws + WS_IQ); const bf16* ik = (const bf16*)(F.ws + WS_IK); const bf16* zw = (const bf16*)(F.ws + WS_Z) + ZIW; _Float16* sc = (_Float16*)(F.ws + WS_SCORE);
    LAS unsigned char* kl = F.lds;
    const int l15 = F.lane & 15, lq = F.lane >> 4;
    constexpr int NITEMS = 2112;
    for (int bi = blockIdx.x; bi < NITEMS; bi += F.G) {
        int j = 0, rem = bi; while (rem >= 128 - 4 * j) { rem -= 128 - 4 * j; ++j; }
        const int g = 8 * (4 * j + rem) + F.wave, t0 = 16 * g, s0 = 512 * j;
        int s_end = s0 + 512; if (s_end > t0 + 16) s_end = t0 + 16;
        __syncthreads();
        { int tl = F.tid; asm volatile("" : "+v"(tl));
#pragma unroll
          for (int i = 0; i < 8; ++i) { const int ch = tl + i * NTHR, row = ch >> 3, c8 = ch & 7;
              *(LAS u32x4*)(kl + row * 144 + c8 * 16) = *(const u32x4*)(ik + (size_t)(s0 + row) * 64 + c8 * 8); } }
        bf16x8 bq[16][2]; float w[16];
        const bf16* qp = iq + (size_t)(t0 + l15) * 1024 + 8 * lq;
#pragma unroll
        for (int h = 0; h < 16; ++h) { bq[h][0] = *(const bf16x8*)(qp + h * 64); bq[h][1] = *(const bf16x8*)(qp + h * 64 + 32); } { const bf16* wp = zw + (size_t)(t0 + l15) * ZW; float wa[8], wb[8]; unpack8(*(const u32x4*)wp, wa); unpack8(*(const u32x4*)(wp + 8), wb);
#pragma unroll
          for (int h = 0; h < 8; ++h) { w[h] = wa[h]; w[8 + h] = wb[h]; } }
        __syncthreads();
        _Float16* orow = sc + (size_t)(t0 + l15) * SEQ + 4 * lq;
        const LAS unsigned char* kp = kl + l15 * 144 + lq * 16;
        for (int s = s0; s < s_end; s += 16) {
            const bf16x8 a0 = *(const LAS bf16x8*)kp, a1 = *(const LAS bf16x8*)(kp + 64); kp += 16 * 144;
            f32x4 tot;
#pragma unroll
            for (int hh = 0; hh < 16; hh += 8) { f32x4 acc[8];
#pragma unroll
                for (int h = 0; h < 8; ++h) acc[h] = mfma16(a0, bq[hh + h][0], (f32x4){0.f, 0.f, 0.f, 0.f});
#pragma unroll
                for (int h = 0; h < 8; ++h) acc[h] = mfma16(a1, bq[hh + h][1], acc[h]);
                __builtin_amdgcn_sched_barrier(0);
#pragma unroll
                for (int h = 0; h < 8; ++h) {
#pragma unroll
                    for (int r = 0; r < 4; ++r) { const float c = fminf(fmaxf(acc[h][r], 0.f), 1.0f);
                        if (hh + h == 0) asm volatile("v_mul_f32 %0, %1, %2" : "=v"(tot[r]) : "v"(w[0]), "v"(c)); else asm volatile("v_fmac_f32 %0, %1, %2" : "+v"(tot[r]) : "v"(w[hh + h]), "v"(c)); } } }
            { typedef _Float16 h16x4 __attribute__((ext_vector_type(4))); h16x4 hv; hv[0] = (_Float16)tot[0]; hv[1] = (_Float16)tot[1]; hv[2] = (_Float16)tot[2]; hv[3] = (_Float16)tot[3]; *(h16x4*)(orow + s) = hv; }
        }
    }
}

__device__ __forceinline__ void p4_gla_local(const Frame& F) {
    const bf16* z = (const bf16*)(F.ws + WS_Z); const float* bA = (const float*)(F.ws + WS_BA); float* dS = (float*)(F.ws + WS_DS);
    LAS bf16* vT = (LAS bf16*)F.lds;
    LAS bf16* kT = vT + 128 * 72;
    const int r32 = F.lane & 31, hi = F.lane >> 5, s = F.tid >> 3, d8 = (F.tid & 7) * 8, e16 = (F.tid & 7) * 16;
    u32x4 kw, vw0, vw1; f32x4 b0, b1, e0, e1;
#define GLA_LOAD(u_) do { const int c_ = (u_) / 12, h_ = (u_) % 12, t0_ = c_ * 64; kw = *(const u32x4*)(z + (size_t)(t0_ + s) * ZW + ZK_A + h_ * 64 + d8); \
        const float* bp_ = bA + (size_t)(t0_ + s) * 768 + h_ * 64 + d8; const float* be_ = bA + (size_t)(t0_ + 63) * 768 + h_ * 64 + d8; \
        b0 = *(const f32x4*)bp_; b1 = *(const f32x4*)(bp_ + 4); e0 = *(const f32x4*)be_; e1 = *(const f32x4*)(be_ + 4); \
        const bf16* vp_ = z + (size_t)(t0_ + s) * ZW + ZV_A + h_ * 128 + e16; vw0 = *(const u32x4*)vp_; vw1 = *(const u32x4*)(vp_ + 8); } while (0)
    int u = blockIdx.x; if (u < NCH * 12) GLA_LOAD(u);
    for (; u < NCH * 12; u += F.G) {
        __syncthreads();
        { float kv[8]; unpack8(kw, kv);
#pragma unroll
          for (int j = 0; j < 4; ++j) { kT[(d8 + j) * 72 + s] = f2bf(kv[j] * __expf(e0[j] - b0[j])); kT[(d8 + 4 + j) * 72 + s] = f2bf(kv[4 + j] * __expf(e1[j] - b1[j])); }
          const unsigned ww[8] = {vw0.x, vw0.y, vw0.z, vw0.w, vw1.x, vw1.y, vw1.z, vw1.w};
#pragma unroll
          for (int j = 0; j < 8; ++j) { vT[(e16 + 2 * j) * 72 + s] = (bf16)(ww[j] & 0xffffu); vT[(e16 + 2 * j + 1) * 72 + s] = (bf16)(ww[j] >> 16); } }
        __syncthreads();
        if (u + F.G < NCH * 12) GLA_LOAD(u + F.G);
        const int et = F.wave >> 1, dt = F.wave & 1; f32x16 acc = zero16();
#pragma unroll
        for (int kk = 0; kk < 4; ++kk) { const bf16x8 a = *(const LAS bf16x8*)(kT + (32 * dt + r32) * 72 + 16 * kk + 8 * hi), b = *(const LAS bf16x8*)(vT + (32 * et + r32) * 72 + 16 * kk + 8 * hi); acc = mfma32(a, b, acc); }
        float* o = dS + ((size_t)u * 128 + 32 * et + r32) * 64 + 32 * dt + 4 * hi;
#pragma unroll
        for (int g = 0; g < 4; ++g) *(f32x4*)(o + 8 * g) = (f32x4){acc[4 * g], acc[4 * g + 1], acc[4 * g + 2], acc[4 * g + 3]};
    }
#undef GLA_LOAD
}

__device__ __forceinline__ void p4_mlstm_local(const Frame& F) {
    const bf16* z = (const bf16*)(F.ws + WS_Z); const bf16* ck = (const bf16*)(F.ws + WS_CK); float* mg = (float*)(F.ws + WS_MG); float* dC = (float*)(F.ws + WS_DC);
    LAS bf16* vT = (LAS bf16*)F.lds;
    LAS bf16* kT = vT + 256 * 72;
    LAS float* wsl = (LAS float*)(kT + 128 * 72);
    const int r32 = F.lane & 31, hi = F.lane >> 5, s = F.tid >> 3, d16 = (F.tid & 7) * 16, e32 = (F.tid & 7) * 32;
    u32x4 kw0, kw1, vw[4]; float gbs = 0.f, gig = 0.f;
#define ML_LOAD(u_) do { const int c_ = (u_) / 6, h_ = (u_) % 6, t0_ = c_ * 64; const bf16* kp_ = ck + (size_t)(t0_ + s) * 768 + h_ * 128 + d16; kw0 = *(const u32x4*)kp_; kw1 = *(const u32x4*)(kp_ + 8); \
        const bf16* vp_ = z + (size_t)(t0_ + s) * ZW + ZV_C + h_ * 256 + e32; _Pragma("unroll") for (int q_ = 0; q_ < 4; ++q_) vw[q_] = *(const u32x4*)(vp_ + 8 * q_); \
        if (F.wave == 0) { gbs = mg[MG_B + (size_t)(t0_ + F.lane) * 8 + h_]; gig = mg[MG_I + (size_t)(t0_ + F.lane) * 8 + h_]; } } while (0)
    int u = blockIdx.x; if (u < NCH * 6) ML_LOAD(u);
    for (; u < NCH * 6; u += F.G) {
        __syncthreads();
        if (F.wave == 0) { const float be = __int_as_float(__builtin_amdgcn_readlane(__float_as_int(gbs), 63));
            const float a = be - gbs + gig; const float ml = wave_max(a, F.lane); wsl[F.lane] = __expf(a - ml); if (F.lane == 0) { mg[MG_ML + (size_t)u * 2] = be; mg[MG_ML + (size_t)u * 2 + 1] = ml; } }
        __syncthreads();
        { const float wsv = wsl[s]; float k0[8], k1[8]; unpack8(kw0, k0); unpack8(kw1, k1);
#pragma unroll
          for (int j = 0; j < 8; ++j) { kT[(d16 + j) * 72 + s] = f2bf(k0[j] * wsv); kT[(d16 + 8 + j) * 72 + s] = f2bf(k1[j] * wsv); }
#pragma unroll
          for (int q = 0; q < 4; ++q) { const unsigned ww[4] = {vw[q].x, vw[q].y, vw[q].z, vw[q].w};
#pragma unroll
              for (int j = 0; j < 4; ++j) { vT[(e32 + 8 * q + 2 * j) * 72 + s] = (bf16)(ww[j] & 0xffffu); vT[(e32 + 8 * q + 2 * j + 1) * 72 + s] = (bf16)(ww[j] >> 16); } } }
        __syncthreads();
        if (u + F.G < NCH * 6) ML_LOAD(u + F.G);
        if (F.tid < 128) { float sum = 0.f; const LAS bf16* kr = kT + F.tid * 72;
#pragma unroll 8
            for (int ss = 0; ss < 64; ++ss) sum += bf2f(kr[ss]);
            mg[MG_DN + (size_t)u * 128 + F.tid] = sum; }
        const int et = F.wave; bf16x8 bv[4];
#pragma unroll
        for (int kk = 0; kk < 4; ++kk) bv[kk] = *(const LAS bf16x8*)(vT + (32 * et + r32) * 72 + 16 * kk + 8 * hi);
        float* o = dC + ((size_t)u * 256 + 32 * et + r32) * 128 + 4 * hi;
#pragma unroll
        for (int dt = 0; dt < 4; ++dt) { f32x16 acc = zero16();
#pragma unroll
            for (int kk = 0; kk < 4; ++kk) { const bf16x8 a = *(const LAS bf16x8*)(kT + (32 * dt + r32) * 72 + 16 * kk + 8 * hi); acc = mfma32(a, bv[kk], acc); }
#pragma unroll
            for (int g = 0; g < 4; ++g) *(f32x4*)(o + 32 * dt + 8 * g) = (f32x4){acc[4 * g], acc[4 * g + 1], acc[4 * g + 2], acc[4 * g + 3]}; }
    }
#undef ML_LOAD
}

#ifndef SCAN_B
#define SCAN_B 16
#endif
__device__ __forceinline__ void p5_scans(const Frame& F) {
    const float* bA = (const float*)(F.ws + WS_BA); const float* dS = (const float*)(F.ws + WS_DS); bf16* SP = (bf16*)(F.ws + WS_SP);
    float* mg = (float*)(F.ws + WS_MG); const float* dC = (const float*)(F.ws + WS_DC); bf16* CP = (bf16*)(F.ws + WS_CP);
    for (int grp = blockIdx.x + F.G * F.wave; grp < 1155; grp += F.G * 8) {
        const int l = F.lane;
        if (grp < 384) {
            const int i = grp * 64 + l, h = i >> 11, rem = i & 2047, e = rem >> 4, d4 = (rem & 15) * 4;
            f32x4 S = {0.f, 0.f, 0.f, 0.f};
            for (int c0 = 0; c0 < NCH; c0 += SCAN_B) { f32x4 dl[SCAN_B]; f32x4 dc[SCAN_B];
#pragma unroll
                for (int k = 0; k < SCAN_B; ++k) { const int c = c0 + k; dl[k] = *(const f32x4*)(dS + ((size_t)(c * 12 + h) * 128 + e) * 64 + d4); dc[k] = *(const f32x4*)(bA + (size_t)(c * 64 + 63) * 768 + h * 64 + d4); }
#pragma unroll
                for (int k = 0; k < SCAN_B; ++k) { const int c = c0 + k; u32x2 w; w.x = pk2(S[0], S[1]); w.y = pk2(S[2], S[3]); *(u32x2*)(SP + ((size_t)(c * 12 + h) * 128 + e) * 64 + d4) = w;
                    const float dv[4] = {dl[k][0], dl[k][1], dl[k][2], dl[k][3]};
#pragma unroll
                    for (int q = 0; q < 4; ++q) S[q] = __expf(dc[k][q]) * S[q] + dv[q]; } }
        } else {
            const int i = (grp - 384) * 64 + l; const bool isn = i >= 49152; const int ii = isn ? i - 49152 : i;
            const int h = isn ? (ii >> 5) : (ii >> 13), rem = ii & 8191, e = rem >> 5, d4 = (ii & 31) * 4;
            f32x4 S = {0.f, 0.f, 0.f, 0.f}; float m = 0.f;
            for (int c0 = 0; c0 < NCH; c0 += SCAN_B) { f32x4 dl[SCAN_B]; f32x2 ml[SCAN_B];
#pragma unroll
                for (int k = 0; k < SCAN_B; ++k) { const int c = c0 + k; ml[k] = *(const f32x2*)(mg + MG_ML + (size_t)(c * 6 + h) * 2);
                    if (isn) dl[k] = *(const f32x4*)(mg + MG_DN + (size_t)(c * 6 + h) * 128 + d4);
                    else dl[k] = *(const f32x4*)(dC + ((size_t)(c * 6 + h) * 256 + e) * 128 + d4); }
#pragma unroll
                for (int k = 0; k < SCAN_B; ++k) { const int c = c0 + k;
                    if (isn) { *(f32x4*)(mg + MG_NP + (size_t)(c * 6 + h) * 128 + d4) = S; if (d4 == 0) mg[MG_MP + (size_t)(c * 6 + h)] = m; }
                    else { u32x2 w; w.x = pk2(S[0], S[1]); w.y = pk2(S[2], S[3]); *(u32x2*)(CP + ((size_t)(c * 6 + h) * 256 + e) * 128 + d4) = w; }
                    const float a_state = ml[k][0] + m, m_new = fmaxf(a_state, ml[k][1]), f1 = __expf(a_state - m_new), f2 = __expf(ml[k][1] - m_new);
#pragma unroll
                    for (int q = 0; q < 4; ++q) S[q] = f1 * S[q] + f2 * dl[k][q];
                    m = m_new; } }
        }
    }
}

__device__ __forceinline__ unsigned long long perm_word(unsigned long long x) {
    unsigned long long t;
    t = ((x >> 4) ^ x) & 0x00F000F000F000F0ull; x ^= t ^ (t << 4);
    t = ((x >> 8) ^ x) & 0x0000FF000000FF00ull; x ^= t ^ (t << 8);
    t = ((x >> 16) ^ x) & 0x00000000FFFF0000ull; x ^= t ^ (t << 16);
    return x;
}
__device__ __forceinline__ void p5_select(const Frame& F) {
    const _Float16* sc = (const _Float16*)(F.ws + WS_SCORE); unsigned long long* mask = (unsigned long long*)(F.ws + WS_MASK);
    LAS unsigned char* wl = F.lds + F.wave * 12304;
    LAS unsigned* hist = (LAS unsigned*)wl;
    LAS unsigned* words = (LAS unsigned*)(wl + 8192);
    LAS float* cval = (LAS float*)(wl + 8192 + 2048);
    LAS int* ckey = (LAS int*)(wl + 8192 + 3072);
    const float PINF = __builtin_inff();
    for (int t = F.gw; t < SEQ; t += F.NGW) {
        int lane = F.lane; asm volatile("" : "+v"(lane));
        const unsigned long long lt_mask = (1ull << lane) - 1ull; const int lane8 = lane * 8;
        const int n = t + 1, nw = 4 * (t / 256 + 1), ng = (n + 63) >> 6;
        const _Float16* row = sc + (size_t)t * SEQ; unsigned long long* mrow = mask + (size_t)t * 256;
        if (n <= 256) {
            if (lane < nw) { const int k0 = lane * 64; const unsigned long long w = (t >= k0 + 63) ? ~0ull : (t < k0 ? 0ull : ((2ull << (t - k0)) - 1ull)); mrow[lane] = perm_word(w); }
            continue; }
        typedef _Float16 h16x8 __attribute__((ext_vector_type(8))); typedef _Float16 h16x2 __attribute__((ext_vector_type(2)));
        const int ng8 = (n + 511) >> 9, glast = ng8 - 1; const h16x8* row8 = (const h16x8*)row + lane;
        u32x4 vv[32];
#pragma unroll
        for (int g = 0; g < 32; ++g) vv[g] = *(const u32x4*)(row8 + (g < ng8 ? g : 0) * 64);
        int nvl = n - 512 * glast - lane8; nvl = nvl < 0 ? 0 : (nvl > 8 ? 8 : nvl); const unsigned vlast = (1u << nvl) - 1u;
#define SEL_FILL(G, FILLPAIR) do { unsigned* d_ = (unsigned*)&vv[G]; _Pragma("unroll") for (int q_ = 0; q_ < 4; ++q_) { \
            const unsigned keep_ = (((vlast >> (2 * q_)) & 1u) ? 0x0000ffffu : 0u) | (((vlast >> (2 * q_ + 1)) & 1u) ? 0xffff0000u : 0u); d_[q_] = (d_[q_] & keep_) | ((FILLPAIR) & ~keep_); } } while (0)
#pragma unroll
        for (int g = 0; g < 32; ++g) if (g == glast) { const unsigned f0 = (unsigned)__builtin_amdgcn_readfirstlane((int)vv[g].x) & 0xffffu; SEL_FILL(g, f0 | (f0 << 16)); }
        h16x2 pmin = {(_Float16)65504.f, (_Float16)65504.f}, pmax = {(_Float16)-65504.f, (_Float16)-65504.f};
#pragma unroll
        for (int g = 0; g < 32; ++g) if (g < ng8) {
#pragma unroll
            for (int q = 0; q < 4; ++q) { const h16x2 x = __builtin_bit_cast(h16x2, ((const unsigned*)&vv[g])[q]); pmin = __builtin_elementwise_min(pmin, x); pmax = __builtin_elementwise_max(pmax, x); } }
        float lmin = fminf((float)pmin[0], (float)pmin[1]), lmax = fmaxf((float)pmax[0], (float)pmax[1]);
        lmin = -wave_max(-lmin, lane); lmax = wave_max(lmax, lane);
        const float span = lmax - lmin, lo = lmin, scale = span > 0.f ? 2047.0f / span : 0.f, los = -lo * scale;
        { const unsigned fm = (unsigned)__builtin_bit_cast(unsigned short, (_Float16)lmin);
#pragma unroll
          for (int g = 0; g < 32; ++g) if (g == glast) SEL_FILL(g, fm | (fm << 16)); }
#undef SEL_FILL
#pragma unroll
        for (int k = 0; k < 8; ++k) *(LAS u32x4*)(hist + (k * 64 + lane) * 4) = (u32x4){0u, 0u, 0u, 0u};
#pragma unroll
        for (int k = 0; k < 2; ++k) *(LAS u32x4*)(words + (k * 64 + lane) * 4) = (u32x4){0u, 0u, 0u, 0u};
#define SEL_BIN(G, J) ({ const h16x2 x_ = __builtin_bit_cast(h16x2, ((const unsigned*)&vv[G])[(J) >> 1]); int b_ = (int)fmaf((float)x_[(J) & 1], scale, los); b_ = b_ < 0 ? 0 : (b_ > 2047 ? 2047 : b_); b_; })
#pragma unroll
        for (int g = 0; g < 32; ++g) asm volatile("" : "+v"(vv[g]));
#pragma unroll
        for (int g = 0; g < 32; ++g) if (g < ng8) {
#pragma unroll
            for (int j = 0; j < 8; ++j) { const int b = SEL_BIN(g, j); __hip_atomic_fetch_add(&hist[b], 1u, __ATOMIC_RELAXED, __HIP_MEMORY_SCOPE_WORKGROUP); } }
        unsigned mine = 0;
#pragma unroll
        for (int q = 0; q < 8; ++q) { const u32x4 x = *(const LAS u32x4*)(hist + lane * 32 + q * 4); mine += (x.x + x.y) + (x.z + x.w); }
        unsigned suf = mine;
#pragma unroll
        for (int o = 1; o < 64; o <<= 1) { const unsigned nb = shdn_u(suf, o, lane); if (lane + o < 64) suf += nb; }
        unsigned above = suf - mine; int Bl = -1; unsigned cal = 0;
        if (above < 256u && above + mine >= 256u) {
            for (int q = 31; q >= 0; --q) { const unsigned hq = hist[lane * 32 + q]; if (Bl < 0 && above + hq >= 256u) { Bl = lane * 32 + q; cal = above; } above += hq; } }
        const unsigned long long hitm = __ballot(Bl >= 0); const int src = hitm ? __builtin_ctzll(hitm) : 0;
        const int Bs = __builtin_amdgcn_readlane(Bl, src); const unsigned cnt_above = (unsigned)__builtin_amdgcn_readlane((int)cal, src);
#pragma unroll
        for (int g = 0; g < 32; ++g) asm volatile("" : "+v"(vv[g]));
        LAS unsigned char* wbytes = (LAS unsigned char*)words; LAS unsigned* mcnt = (LAS unsigned*)(ckey + 256);
        if (lane == 0) *mcnt = 0u;
#pragma unroll
        for (int g = 0; g < 32; ++g) if (g < ng8) { int b[8]; unsigned abits = 0u; bool anyc = false;
#pragma unroll
            for (int j = 7; j >= 0; --j) { b[j] = SEL_BIN(g, j); abits = __builtin_amdgcn_alignbit(abits, (unsigned)(Bs - b[j]), 31); anyc |= (b[j] == Bs); }
            const unsigned vm = (g == glast) ? vlast : 0xffu;
            wbytes[g * 64 + lane] = (unsigned char)(abits & vm);
            if (anyc) {
#pragma unroll
                for (int j = 0; j < 8; ++j) if (b[j] == Bs && ((vm >> j) & 1u)) { const unsigned pos = __hip_atomic_fetch_add(mcnt, 1u, __ATOMIC_RELAXED, __HIP_MEMORY_SCOPE_WORKGROUP);
                    if (pos < 256u) { const h16x2 x = __builtin_bit_cast(h16x2, ((const unsigned*)&vv[g])[j >> 1]); cval[pos] = (float)x[j & 1]; ckey[pos] = lane8 + (g * 512 + j); } } } }
#undef SEL_BIN
        const unsigned m = *mcnt;
        const unsigned need = 256u - cnt_above;
        if (m <= 256u) {
            for (unsigned c = lane; c < m; c += 64) { const float mv = cval[c]; const int mk = ckey[c]; unsigned rank = 0;
                for (unsigned j = 0; j < m; ++j) { const float ov = cval[j]; const int ok = ckey[j]; rank += (ov > mv || (ov == mv && ok < mk)) ? 1u : 0u; }
                if (rank < need) __hip_atomic_fetch_or(&words[2 * (mk >> 6) + ((mk >> 5) & 1)], 1u << (mk & 31), __ATOMIC_RELAXED, __HIP_MEMORY_SCOPE_WORKGROUP); }
        } else {
            for (int g = 0; g < ng; ++g) { const int key = g * 64 + lane; int b = -1; if (key < n) { b = (int)fmaf((float)row[key], scale, los); b = b < 0 ? 0 : (b > 2047 ? 2047 : b); }
                const unsigned long long bc = __ballot(b == Bs); if (lane == 0) { words[2 * g] |= (unsigned)bc; words[2 * g + 1] |= (unsigned)(bc >> 32); } }
        }
#pragma unroll
        for (int k = 0; k < 4; ++k) { const int w = lane + 64 * k; if (w < nw) { const unsigned long long x = (unsigned long long)words[2 * w] | ((unsigned long long)words[2 * w + 1] << 32); mrow[w] = perm_word(x); } }
    }
}

__device__ __forceinline__ void p6_gla_out(const Frame& F, const float* gain) {
    const bf16* z = (const bf16*)(F.ws + WS_Z); const float* bA = (const float*)(F.ws + WS_BA); const bf16* SP = (const bf16*)(F.ws + WS_SP); bf16* y = (bf16*)(F.ws + WS_Y);
    LAS bf16* qd = (LAS bf16*)F.lds;
    LAS bf16* ki = qd + 64 * 72;
    LAS bf16* vT = ki + 64 * 72;
    LAS bf16* scl = vT + 128 * 72;
    LAS float* part = (LAS float*)(scl + 64 * 72);
    const int r32 = F.lane & 31, hi = F.lane >> 5, s = F.tid >> 3, d8 = (F.tid & 7) * 8, e16 = (F.tid & 7) * 16;
    u32x4 qw, kw, vw0, vw1; f32x4 b0, b1;
#define GO_LOAD(u_) do { const int c_ = (u_) / 12, h_ = (u_) % 12, t0_ = c_ * 64; const bf16* zr_ = z + (size_t)(t0_ + s) * ZW; qw = *(const u32x4*)(zr_ + ZQ_A + h_ * 64 + d8); kw = *(const u32x4*)(zr_ + ZK_A + h_ * 64 + d8); \
        const float* bp_ = bA + (size_t)(t0_ + s) * 768 + h_ * 64 + d8; b0 = *(const f32x4*)bp_; b1 = *(const f32x4*)(bp_ + 4); vw0 = *(const u32x4*)(zr_ + ZV_A + h_ * 128 + e16); vw1 = *(const u32x4*)(zr_ + ZV_A + h_ * 128 + e16 + 8); } while (0)
    int u = blockIdx.x; if (u < NCH * 12) GO_LOAD(u);
    for (; u < NCH * 12; u += F.G) {
        const int c = u / 12, h = u % 12, t0 = c * 64;
        __syncthreads();
        { float qv[8], kv[8], qo[8], ko[8]; unpack8(qw, qv); unpack8(kw, kv);
#pragma unroll
          for (int j = 0; j < 4; ++j) { const float ea = __expf(b0[j]), eb = __expf(b1[j]); qo[j] = qv[j] * 0.125f * ea; qo[4 + j] = qv[4 + j] * 0.125f * eb; ko[j] = kv[j] / ea; ko[4 + j] = kv[4 + j] / eb; }
          *(LAS u32x4*)(qd + s * 72 + d8) = pack8f(qo); *(LAS u32x4*)(ki + s * 72 + d8) = pack8f(ko);
          const unsigned ww[8] = {vw0.x, vw0.y, vw0.z, vw0.w, vw1.x, vw1.y, vw1.z, vw1.w};
#pragma unroll
          for (int j = 0; j < 8; ++j) { vT[(e16 + 2 * j) * 72 + s] = (bf16)(ww[j] & 0xffffu); vT[(e16 + 2 * j + 1) * 72 + s] = (bf16)(ww[j] >> 16); } }
        __syncthreads();
        if (u + F.G < NCH * 12) GO_LOAD(u + F.G);
        const int et = F.wave >> 1, tt = F.wave & 1, t = 32 * tt + r32;
        bf16x8 sa[4]; u32x2 gzv[4];
        { const bf16* sp = SP + ((size_t)u * 128 + 32 * et + r32) * 64 + 8 * hi;
#pragma unroll
          for (int kk = 0; kk < 4; ++kk) sa[kk] = *(const bf16x8*)(sp + 16 * kk);
#pragma unroll
          for (int g = 0; g < 4; ++g) gzv[g] = *(const u32x2*)(z + (size_t)(t0 + t) * ZW + ZGATE_A + h * 128 + 32 * et + 8 * g + 4 * hi); }
        if (F.wave < 4) { const int st = F.wave >> 1; f32x16 acc = zero16();
#pragma unroll
            for (int kk = 0; kk < 4; ++kk) { const bf16x8 a = *(const LAS bf16x8*)(ki + (32 * st + r32) * 72 + 16 * kk + 8 * hi), b = *(const LAS bf16x8*)(qd + (32 * tt + r32) * 72 + 16 * kk + 8 * hi); acc = mfma32(a, b, acc); }
#pragma unroll
            for (int g = 0; g < 4; ++g) { const int sb = 32 * st + 8 * g + 4 * hi; float m[4];
#pragma unroll
                for (int j = 0; j < 4; ++j) m[j] = (sb + j <= t) ? acc[4 * g + j] : 0.f;
                u32x2 w; w.x = pk2(m[0], m[1]); w.y = pk2(m[2], m[3]); *(LAS u32x2*)(scl + t * 72 + sb) = w; } }
        __syncthreads();
        f32x16 acc = zero16();
#pragma unroll
        for (int kk = 0; kk < 4; ++kk) { const bf16x8 b = *(const LAS bf16x8*)(qd + t * 72 + 16 * kk + 8 * hi); acc = mfma32(sa[kk], b, acc); }
#pragma unroll
        for (int kk = 0; kk < 4; ++kk) { const bf16x8 a = *(const LAS bf16x8*)(vT + (32 * et + r32) * 72 + 16 * kk + 8 * hi), b = *(const LAS bf16x8*)(scl + t * 72 + 16 * kk + 8 * hi); acc = mfma32(a, b, acc); }
        float ss = 0.f;
#pragma unroll
        for (int r = 0; r < 16; ++r) ss += acc[r] * acc[r];
        ss += shx(ss, 32, F.lane);
        if (hi == 0) part[t * 4 + et] = ss;
        __syncthreads();
        const f32x4 pp = *(const LAS f32x4*)(part + t * 4); const float rs = 1.0f / sqrtf(((pp[0] + pp[1]) + (pp[2] + pp[3])) * (1.0f / 128.0f) + NORM_EPS);
#pragma unroll
        for (int g = 0; g < 4; ++g) { const int e0 = 32 * et + 8 * g + 4 * hi; const f32x4 gv = *(const f32x4*)(gain + h * 128 + e0);
            const u32x2 gz = gzv[g]; const float ga[4] = {bflo(gz.x), bfhi(gz.x), bflo(gz.y), bfhi(gz.y)}; float o[4];
#pragma unroll
            for (int j = 0; j < 4; ++j) o[j] = acc[4 * g + j] * rs * gv[j] * siluf_(ga[j]);
            u32x2 w; w.x = pk2(o[0], o[1]); w.y = pk2(o[2], o[3]); *(u32x2*)(y + (size_t)(t0 + t) * DM + YA + h * 128 + e0) = w; }
    }
#undef GO_LOAD
}

__device__ __forceinline__ void p6_mlstm_out(const Frame& F, const float* gain) {
    const bf16* z = (const bf16*)(F.ws + WS_Z); const bf16* cq = (const bf16*)(F.ws + WS_CQ); const bf16* ck = (const bf16*)(F.ws + WS_CK); const float* mg = (const float*)(F.ws + WS_MG);
    const bf16* CP = (const bf16*)(F.ws + WS_CP); bf16* y = (bf16*)(F.ws + WS_Y);
    LAS bf16* qs = (LAS bf16*)F.lds;
    LAS bf16* ks = qs + 64 * 136;
    LAS bf16* vT = ks + 64 * 136;
    LAS bf16* pw = vT + 256 * 72;
    LAS float* fl = (LAS float*)(pw + 64 * 72);
    LAS float* bc = fl;
    LAS float* ig = fl + 64;
    LAS float* mt = fl + 128;
    LAS float* wi = fl + 192;
    LAS float* qn = fl + 256;
    LAS float* rp = fl + 320;
    LAS float* np = fl + 448;
    LAS float* sp = fl + 576;
    const int r32 = F.lane & 31, hi = F.lane >> 5, s = F.tid >> 3, d16 = (F.tid & 7) * 16, e32 = (F.tid & 7) * 32;
    u32x4 qw0, qw1, kw0, kw1, vw[4]; float gb = 0.f, gi = 0.f, gn0 = 0.f, gn1 = 0.f, gmp = 0.f;
#define MO_LOAD(u_) do { const int c_ = (u_) / 6, h_ = (u_) % 6, t0_ = c_ * 64; const bf16* qp_ = cq + (size_t)(t0_ + s) * 768 + h_ * 128 + d16; const bf16* kp_ = ck + (size_t)(t0_ + s) * 768 + h_ * 128 + d16; \
        qw0 = *(const u32x4*)qp_; qw1 = *(const u32x4*)(qp_ + 8); kw0 = *(const u32x4*)kp_; kw1 = *(const u32x4*)(kp_ + 8); \
        const bf16* vp_ = z + (size_t)(t0_ + s) * ZW + ZV_C + h_ * 256 + e32; _Pragma("unroll") for (int q_ = 0; q_ < 4; ++q_) vw[q_] = *(const u32x4*)(vp_ + 8 * q_); \
        gmp = mg[MG_MP + (size_t)(u_)]; \
        if (F.wave == 0) { gb = mg[MG_B + (size_t)(t0_ + F.lane) * 8 + h_]; gi = mg[MG_I + (size_t)(t0_ + F.lane) * 8 + h_]; } \
        if (F.wave == 1) { gn0 = mg[MG_NP + (size_t)(u_) * 128 + F.lane]; gn1 = mg[MG_NP + (size_t)(u_) * 128 + 64 + F.lane]; } } while (0)
    int u = blockIdx.x; if (u < NCH * 6) MO_LOAD(u);
    for (; u < NCH * 6; u += F.G) {
        const int c = u / 6, h = u % 6, t0 = c * 64;
        __syncthreads();
        { *(LAS u32x4*)(qs + s * 136 + d16) = qw0; *(LAS u32x4*)(qs + s * 136 + d16 + 8) = qw1; *(LAS u32x4*)(ks + s * 136 + d16) = kw0; *(LAS u32x4*)(ks + s * 136 + d16 + 8) = kw1;
#pragma unroll
          for (int q = 0; q < 4; ++q) { const unsigned ww[4] = {vw[q].x, vw[q].y, vw[q].z, vw[q].w};
#pragma unroll
              for (int j = 0; j < 4; ++j) { vT[(e32 + 8 * q + 2 * j) * 72 + s] = (bf16)(ww[j] & 0xffffu); vT[(e32 + 8 * q + 2 * j + 1) * 72 + s] = (bf16)(ww[j] >> 16); } } }
        const float m_prev = gmp;
        if (F.wave == 0) { const float b = gb, ii = gi; float pm = ii - b;
#pragma unroll
            for (int o = 1; o < 64; o <<= 1) { const float nb = shup(pm, o, F.lane); if (F.lane >= o) pm = fmaxf(pm, nb); }
            const float m = b + fmaxf(m_prev, pm); bc[F.lane] = b; ig[F.lane] = ii; mt[F.lane] = m; wi[F.lane] = __expf(b + m_prev - m); }
        if (F.wave == 1) { np[F.lane] = gn0; np[64 + F.lane] = gn1; }
        __syncthreads();
        if (u + F.G < NCH * 6) MO_LOAD(u + F.G);
        const int et = F.wave; bf16x8 ca[8];
        { const bf16* cp = CP + ((size_t)u * 256 + 32 * et + r32) * 128 + 8 * hi;
#pragma unroll
          for (int kk = 0; kk < 8; ++kk) ca[kk] = *(const bf16x8*)(cp + 16 * kk); }
        if (F.wave >= 4) { const int tq = (F.tid - 256) >> 2, qq = (F.tid - 256) & 3; float s = 0.f;
#pragma unroll 8
            for (int d = 0; d < 32; ++d) s += bf2f(qs[tq * 136 + qq * 32 + d]) * np[qq * 32 + d];
            s += shx(s, 1, F.lane); s += shx(s, 2, F.lane); if (qq == 0) qn[tq] = s; }
        else { const int st = F.wave >> 1, tt = F.wave & 1, t = 32 * tt + r32; f32x16 acc = zero16();
#pragma unroll
            for (int kk = 0; kk < 8; ++kk) { const bf16x8 a = *(const LAS bf16x8*)(ks + (32 * st + r32) * 136 + 16 * kk + 8 * hi), b = *(const LAS bf16x8*)(qs + t * 136 + 16 * kk + 8 * hi); acc = mfma32(a, b, acc); }
            const float bt = bc[t], mtt = mt[t]; float rsum = 0.f;
#pragma unroll
            for (int g = 0; g < 4; ++g) { const int sb = 32 * st + 8 * g + 4 * hi; float m[4];
#pragma unroll
                for (int j = 0; j < 4; ++j) { const int s = sb + j; const float w = (s <= t) ? __expf(bt - bc[s] + ig[s] - mtt) : 0.f; m[j] = acc[4 * g + j] * w; rsum += m[j]; }
                u32x2 w2; w2.x = pk2(m[0], m[1]); w2.y = pk2(m[2], m[3]); *(LAS u32x2*)(pw + t * 72 + sb) = w2; }
            rsum += shx(rsum, 32, F.lane); if (hi == 0) rp[t * 2 + st] = rsum; }
        __syncthreads();
        f32x16 hv[2];
        { bf16x8 va[4];
#pragma unroll
          for (int kk = 0; kk < 4; ++kk) va[kk] = *(const LAS bf16x8*)(vT + (32 * et + r32) * 72 + 16 * kk + 8 * hi);
#pragma unroll
          for (int tt = 0; tt < 2; ++tt) { const int t = 32 * tt + r32; f32x16 aI = zero16(), aA = zero16();
#pragma unroll
              for (int kk = 0; kk < 8; ++kk) { const bf16x8 b = *(const LAS bf16x8*)(qs + t * 136 + 16 * kk + 8 * hi); aI = mfma32(ca[kk], b, aI); }
#pragma unroll
              for (int kk = 0; kk < 4; ++kk) { const bf16x8 b = *(const LAS bf16x8*)(pw + t * 72 + 16 * kk + 8 * hi); aA = mfma32(va[kk], b, aA); }
              const float w = wi[t], den = w * qn[t] + rp[t * 2] + rp[t * 2 + 1], dn = 1.0f / fmaxf(fabsf(den), __expf(-mt[t])); float ss = 0.f;
#pragma unroll
              for (int r = 0; r < 16; ++r) { const float x = (w * aI[r] + aA[r]) * dn; hv[tt][r] = x; ss += x * x; }
              ss += shx(ss, 32, F.lane); if (hi == 0) sp[t * 8 + et] = ss; } }
        __syncthreads();
#pragma unroll
        for (int tt = 0; tt < 2; ++tt) { const int t = 32 * tt + r32; const f32x4 p0 = *(const LAS f32x4*)(sp + t * 8), p1 = *(const LAS f32x4*)(sp + t * 8 + 4);
            const float rs = 1.0f / sqrtf((((p0[0] + p0[1]) + (p0[2] + p0[3])) + ((p1[0] + p1[1]) + (p1[2] + p1[3]))) * (1.0f / 256.0f) + NORM_EPS);
            const bf16* zr = z + (size_t)(t0 + t) * ZW + h * 256;
#pragma unroll
            for (int g = 0; g < 4; ++g) { const int e0 = 32 * et + 8 * g + 4 * hi; const f32x4 gv = *(const f32x4*)(gain + h * 256 + e0);
                const u32x2 oz = *(const u32x2*)(zr + ZO_C + e0), gz = *(const u32x2*)(zr + ZGATE_C + e0);
                const float oa[4] = {bflo(oz.x), bfhi(oz.x), bflo(oz.y), bfhi(oz.y)}, ga[4] = {bflo(gz.x), bfhi(gz.x), bflo(gz.y), bfhi(gz.y)}; float o[4];
#pragma unroll
                for (int j = 0; j < 4; ++j) o[j] = hv[tt][4 * g + j] * rs * gv[j] * sigmoidf_(oa[j]) * siluf_(ga[j]);
                u32x2 w; w.x = pk2(o[0], o[1]); w.y = pk2(o[2], o[3]); *(u32x2*)(y + (size_t)(t0 + t) * DM + YC + h * 256 + e0) = w; } }
    }
#undef MO_LOAD
}

namespace dsa {
constexpr int D = 128, NW = 8, QBLK = 32, KVBLK = 64, QB = NW * QBLK;
constexpr int SHM_V = KVBLK * D * 2, SHM_K = KVBLK * D * 2;
constexpr int LDS_BYTES = 2 * SHM_V + 2 * SHM_K + NW * 64 * 4;
constexpr float SCALE = 0.08838834764831845f;
constexpr float THR = 8.f;
constexpr bool WSKIP = false;
constexpr size_t VOFF = (WS_VA - WS_KA) / 2;
typedef short s16x4 __attribute__((ext_vector_type(4)));
template <class A, class Bt> struct same_t { static constexpr bool v = false; };
template <class A> struct same_t<A, A> { static constexpr bool v = true; };
#define KSWZ(row, colB) ((row) * 256 + ((colB) ^ (((row) & 7) << 4)))
#define SBAR() __builtin_amdgcn_sched_barrier(0)
__device__ __forceinline__ int v_st(int k, int c) { const int kk = (k & ~0xC) | ((k & 4) << 1) | ((k & 8) >> 1); return ((kk >> 3) * 4 + (c >> 5)) * 512 + ((kk & 7) * 32 + (c & 31)) * 2; }
__device__ __forceinline__ int v_rd_base(int lane) { return ((lane & 3) << 3) | (((lane >> 2) & 3) << 6) | (((lane >> 4) & 1) << 5) | (((lane >> 5) & 1) << 8); }
constexpr int v_rd_off(int d0, int ks, int half) { return d0 * 512 + ks * 4096 + half * 2048; }
__device__ __forceinline__ unsigned cvtpk(float lo, float hi) {
    unsigned r; asm volatile("v_cvt_pk_bf16_f32 %0, %1, %2" : "=v"(r) : "v"(lo), "v"(hi)); return r;
}
__device__ __forceinline__ bf16x8 pack8(f32x4 a, f32x4 b) {
    u32x4 w = {cvtpk(a[0], a[1]), cvtpk(a[2], a[3]), cvtpk(b[0], b[1]), cvtpk(b[2], b[3])};
    return *reinterpret_cast<bf16x8*>(&w);
}
template <class T> __device__ __forceinline__ bf16x8 load8(const T* p) {
    if constexpr (same_t<T, float>::v) { return pack8(*(const f32x4*)p, *(const f32x4*)(p + 4)); }
    else { return *reinterpret_cast<const bf16x8*>(p); }
}
__device__ __forceinline__ void mask_bits(f32x16& p0, f32x16& p1, unsigned w) {
#pragma unroll
    for (int r = 0; r < 16; ++r) {
        const unsigned m0 = (unsigned)__builtin_amdgcn_sbfe((int)w, r, 1), m1 = (unsigned)__builtin_amdgcn_sbfe((int)w, 16 + r, 1);
        p0[r] = __uint_as_float((__float_as_uint(p0[r]) & m0) | (0xff800000u & ~m0));
        p1[r] = __uint_as_float((__float_as_uint(p1[r]) & m1) | (0xff800000u & ~m1));
    }
}
__device__ __forceinline__ void partialSM(f32x16& p0, f32x16& p1, float& m_reg, float& mn, float& alpha) {
    float pmax = p0[0]; for (int r = 1; r < 16; ++r) pmax = fmaxf(pmax, p0[r]); for (int r = 0; r < 16; ++r) pmax = fmaxf(pmax, p1[r]);
    { auto rr = __builtin_amdgcn_permlane32_swap(__float_as_uint(pmax), __float_as_uint(pmax), false, false);
      pmax = fmaxf(__uint_as_float(rr[0]), __uint_as_float(rr[1])); }
    constexpr float C2 = 1.4426950408889634f * SCALE;
    if (__builtin_expect(__all((pmax - m_reg) * SCALE <= THR), 1)) { mn = m_reg; alpha = 1.f; }
    else { mn = fmaxf(m_reg, pmax); alpha = __builtin_amdgcn_exp2f((m_reg - mn) * C2); m_reg = mn; }
    const float mnL = -mn * C2;
    for (int r = 0; r < 16; ++r) p0[r] = fmaf(p0[r], C2, mnL); for (int r = 0; r < 16; ++r) p1[r] = fmaf(p1[r], C2, mnL);
    for (int r = 0; r < 16; ++r) p0[r] = __builtin_amdgcn_exp2f(p0[r]);
}
__device__ __forceinline__ void finishSM(f32x16& p0, f32x16& p1, float alpha, float& l_reg, bf16x8& pa0, bf16x8& pa1, bf16x8& pa2, bf16x8& pa3) {
    for (int r = 0; r < 16; ++r) p1[r] = __builtin_amdgcn_exp2f(p1[r]);
    float ps = 0; for (int r = 0; r < 16; ++r) ps += p0[r]; for (int r = 0; r < 16; ++r) ps += p1[r];
    { auto rr = __builtin_amdgcn_permlane32_swap(__float_as_uint(ps), __float_as_uint(ps), false, false);
      ps = __uint_as_float(rr[0]) + __uint_as_float(rr[1]); }
    l_reg = l_reg * alpha + ps;
#define PK4(P, B_, OUT) do { unsigned a0 = cvtpk(P[B_+0], P[B_+1]), a1 = cvtpk(P[B_+2], P[B_+3]);                          \
        unsigned b0 = cvtpk(P[B_+4], P[B_+5]), b1 = cvtpk(P[B_+6], P[B_+7]);                                             \
        auto r0 = __builtin_amdgcn_permlane32_swap(a0, b0, false, false); auto r1 = __builtin_amdgcn_permlane32_swap(a1, b1, false, false); \
        u32x4 w = {r0[0], r1[0], r0[1], r1[1]}; OUT = *reinterpret_cast<bf16x8*>(&w); } while (0)
    PK4(p0, 0, pa0); PK4(p0, 8, pa1); PK4(p1, 0, pa2); PK4(p1, 8, pa3);
#undef PK4
}
template <int KB, bool SK>
__device__ __forceinline__ void qkt(f32x16& p0, f32x16& p1, const char* K_lds, int r32, int hi, const bf16x8* qr, bool act) {
    if (SK && !act) { const float NEG = -__builtin_inff();
#pragma unroll
        for (int r = 0; r < 16; ++r) { p0[r] = NEG; p1[r] = NEG; } return; }
    p0 = f32x16{}; p1 = f32x16{};
    const char* kb[4];
#pragma unroll
    for (int dd = 0; dd < 4; ++dd) kb[dd] = K_lds + KB * SHM_K + KSWZ(r32, (dd * 16 + hi * 8) * 2);
#pragma unroll
    for (int d0 = 0; d0 < 8; ++d0) { const char* a = kb[d0 & 3] + (d0 >> 2) * 128;
        bf16x8 b0 = *reinterpret_cast<const bf16x8*>(a);
        bf16x8 b1 = *reinterpret_cast<const bf16x8*>(a + 32 * 256);
        p0 = __builtin_amdgcn_mfma_f32_32x32x16_bf16(b0, qr[d0], p0, 0, 0, 0);
        p1 = __builtin_amdgcn_mfma_f32_32x32x16_bf16(b1, qr[d0], p1, 0, 0, 0); }
}
template <int VB, bool SK>
__device__ __forceinline__ void pv_tile(f32x16* o, int vb0, bf16x8 pa0, bf16x8 pa1, bf16x8 pa2, bf16x8 pa3, bool act) {
    if (SK && !act) return;
#define TRRD(dst, off) asm volatile("ds_read_b64_tr_b16 %0, %1 offset:%2" : "=&v"(dst) : "v"(vb0), "i"(off) : "memory")
#define PV_D0(d0) do { s16x4 l0, l1, l2, l3, h0, h1, h2, h3; constexpr int b_ = VB * SHM_V + v_rd_off(d0, 0, 0);     \
        TRRD(l0, b_); TRRD(h0, b_ + 2048); TRRD(l1, b_ + 4096); TRRD(h1, b_ + 6144); TRRD(l2, b_ + 8192); TRRD(h2, b_ + 10240); TRRD(l3, b_ + 12288); TRRD(h3, b_ + 14336); \
        asm volatile("s_waitcnt lgkmcnt(0)" ::: "memory"); SBAR();                 \
        o[d0] = __builtin_amdgcn_mfma_f32_32x32x16_bf16(pa0, (bf16x8){l0[0], l0[1], l0[2], l0[3], h0[0], h0[1], h0[2], h0[3]}, o[d0], 0, 0, 0);   \
        o[d0] = __builtin_amdgcn_mfma_f32_32x32x16_bf16(pa1, (bf16x8){l1[0], l1[1], l1[2], l1[3], h1[0], h1[1], h1[2], h1[3]}, o[d0], 0, 0, 0);   \
        o[d0] = __builtin_amdgcn_mfma_f32_32x32x16_bf16(pa2, (bf16x8){l2[0], l2[1], l2[2], l2[3], h2[0], h2[1], h2[2], h2[3]}, o[d0], 0, 0, 0);   \
        o[d0] = __builtin_amdgcn_mfma_f32_32x32x16_bf16(pa3, (bf16x8){l3[0], l3[1], l3[2], l3[3], h3[0], h3[1], h3[2], h3[3]}, o[d0], 0, 0, 0); } while (0)
    PV_D0(0); PV_D0(1); PV_D0(2); PV_D0(3);
#undef PV_D0
#undef TRRD
}
template <class TIn, class TOut> struct BlockRef { const TIn* Q; const TIn* K; const unsigned long long* M; int P0; };
template <class TIn> struct Seam {
    bf16x8 qr[8];
    bf16x8 st_v0, st_v1, st_k0, st_k1; f32x4 sf0, sf1, sf2, sf3;
    f32x4 tq[16];
};
__device__ __forceinline__ int swa_jlo(int P0, int W) { const int lowk = P0 - W + 1; return lowk > 0 ? lowk / KVBLK : 0; }
#define ROW(p, k0, rr) ((p) + (size_t)((k0) + (rr)) * D + sc)
#define VMW() asm volatile("s_waitcnt vmcnt(0)" ::: "memory")
#define VMWN(n) asm volatile("s_waitcnt vmcnt(%0)" :: "i"(n) : "memory")
#define SLOAD_H(Kp, Vp, k0) do { S.st_v0 = load8<TIn>(ROW(Vp, k0, sr)); S.st_v1 = load8<TIn>(ROW(Vp, k0, 32 + sr));              \
                         S.st_k0 = load8<TIn>(ROW(Kp, k0, sr)); S.st_k1 = load8<TIn>(ROW(Kp, k0, 32 + sr)); } while (0)
#define SWRITE_HK(bf) do { *(bf16x8*)(K_lds + (bf) * SHM_K + kws) = S.st_k0; *(bf16x8*)(K_lds + (bf) * SHM_K + kws + 32 * 256) = S.st_k1; } while (0)
#define SWRITE_HV(bf) do { *(bf16x8*)(V_lds + (bf) * SHM_V + vst0) = S.st_v0; *(bf16x8*)(V_lds + (bf) * SHM_V + vst1) = S.st_v1; } while (0)
#define SWRITE_H(bf) do { SWRITE_HV(bf); SWRITE_HK(bf); } while (0)
#define SLOAD_F(p, k0) do { S.sf0 = *(const f32x4*)ROW(p, k0, sr); S.sf1 = *(const f32x4*)(ROW(p, k0, sr) + 4);                \
                            S.sf2 = *(const f32x4*)ROW(p, k0, 32 + sr); S.sf3 = *(const f32x4*)(ROW(p, k0, 32 + sr) + 4); } while (0)
#define SWRITE_KF(bf) do { *(bf16x8*)(K_lds + (bf) * SHM_K + kws) = pack8(S.sf0, S.sf1); *(bf16x8*)(K_lds + (bf) * SHM_K + kws + 32 * 256) = pack8(S.sf2, S.sf3); } while (0)
#define SWRITE_VF(bf) do { *(bf16x8*)(V_lds + (bf) * SHM_V + vst0) = pack8(S.sf0, S.sf1); *(bf16x8*)(V_lds + (bf) * SHM_V + vst1) = pack8(S.sf2, S.sf3); } while (0)
template <class TIn, class TOut>
__device__ __forceinline__ void causal_swa_prime(const BlockRef<TIn, TOut>& cur, int W, char* lds, Seam<TIn>& S) {
    constexpr bool F32 = same_t<TIn, float>::v;
    int tid_l = threadIdx.x; asm volatile("" : "+v"(tid_l));
    const int tid = tid_l, wid = __builtin_amdgcn_readfirstlane(tid >> 6), lane = tid & 63, r32 = lane & 31, hi = lane >> 5;
    const int sr = tid >> 4, sc = (tid & 15) * 8, kws = KSWZ(sr, sc * 2); char* K_lds = lds + 2 * SHM_V;
    const int kb0 = swa_jlo(cur.P0, W) * KVBLK;
    for (int d0 = 0; d0 < 8; ++d0) S.qr[d0] = load8<TIn>(cur.Q + (size_t)(wid * QBLK + r32) * D + d0 * 16 + hi * 8);
    if constexpr (F32) { SLOAD_F((const float*)cur.K, kb0); VMW(); SWRITE_KF(0); SBAR(); SLOAD_F((const float*)(cur.K + VOFF), kb0); }
    else { SLOAD_H(cur.K, (cur.K + VOFF), kb0); VMW(); SWRITE_HK(0); }
    __syncthreads();
}
template <class TIn, class TOut>
__device__ __forceinline__ void causal_swa_block(const BlockRef<TIn, TOut>& cur, const BlockRef<TIn, TOut>& nxt, int skv, int W, char* lds, Seam<TIn>& S) {
    constexpr bool F32 = same_t<TIn, float>::v;
    int tid_l = threadIdx.x; asm volatile("" : "+v"(tid_l));
    const int tid = tid_l, wid = __builtin_amdgcn_readfirstlane(tid >> 6), lane = tid & 63, r32 = lane & 31, hi = lane >> 5;
    const int j_lo = swa_jlo(cur.P0, W);
    int j_hi = (cur.P0 + QB - 1) / KVBLK + 1; if (j_hi > skv / KVBLK) j_hi = skv / KVBLK;
    const int NT = j_hi - j_lo;
    const int kbn = swa_jlo(nxt.P0, W) * KVBLK;
    const int qlo = cur.P0 + wid * QBLK, qm = qlo + r32 - 4 * hi;
    char* V_lds = lds; char* K_lds = lds + 2 * SHM_V;
    float* ws = (float*)(lds + 2 * SHM_V + 2 * SHM_K) + wid * 64; float* li_l = ws, * al_l = ws + 32;
    float m_reg = -1e30f, l_reg = 0; f32x16 o[4] = {};
    const int sr = tid >> 4, sc = (tid & 15) * 8, vst0 = v_st(sr, sc), vst1 = v_st(32 + sr, sc), kws = KSWZ(sr, sc * 2);
    const int vb0 = (int)(uintptr_t)V_lds + v_rd_base(lane);
    const TIn* Kh = cur.K; const TIn* Vh = (cur.K + VOFF);
#define RESC(a) do { if (__any((a) < 1.f)) { if (hi == 0) al_l[r32] = (a); asm volatile("s_waitcnt lgkmcnt(0)" ::: "memory");              \
                     for (int d_ = 0; d_ < 4; ++d_) for (int r = 0; r < 16; ++r) o[d_][r] *= al_l[crow(r, hi)]; } } while (0)
#define KBASE(t) ((j_lo + (t)) * KVBLK)
#define ACT(t) (KBASE(t) <= qlo + QBLK - 1 && KBASE(t) + KVBLK - 1 >= qlo - W + 1)
#define MASKT(P0_, P1_, MW_) mask_bits(P0_, P1_, MW_)
    constexpr int NQL = F32 ? 16 : 8;
    constexpr bool SK = WSKIP && !F32;
#define SEAM_K0() do { VMWN(NQL); if constexpr (F32) { SWRITE_KF(0); SBAR(); SLOAD_F((const float*)(nxt.K + VOFF), kbn); } else { SWRITE_HK(0); } SBAR(); } while (0)
    f32x16 pA0, pA1, pB0, pB1; float mnA, mnB, alA, alB; bf16x8 pa0, pa1, pa2, pa3;
    const unsigned* M32 = (const unsigned*)cur.M;
#define MOFF() ({ int l_ = lane; asm volatile("" : "+v"(l_)); (unsigned)(wid * QBLK + (l_ & 31)) * 512u + (unsigned)(l_ >> 5); })
    unsigned mw = M32[MOFF()];
    if constexpr (F32) { VMW(); SWRITE_VF(0); SBAR(); } else { SWRITE_HV(0); SBAR(); }
    if (NT > 1) { if constexpr (F32) SLOAD_F((const float*)Kh, KBASE(1)); else SLOAD_H(Kh, Vh, KBASE(1)); }
    SBAR(); qkt<0, SK>(pA0, pA1, K_lds, r32, hi, S.qr, ACT(0));
    if constexpr (F32) { if (NT > 1) { VMW(); SWRITE_KF(1); SBAR(); SLOAD_F((const float*)Vh, KBASE(1)); } }
    MASKT(pA0, pA1, mw); partialSM(pA0, pA1, m_reg, mnA, alA);
    if (NT > 1) { VMW(); if constexpr (F32) { SWRITE_VF(1); SBAR(); if (NT > 2) SLOAD_F((const float*)Kh, KBASE(2)); } else SWRITE_H(1); }
    __syncthreads();
#define HALF_STEP(PX0, PX1, mnX, alX, PY0, PY1, alY, t, KB, VB, SB) do {                                                      \
        mw = M32[MOFF() + 2u * (unsigned)(t)];                                                                                     \
        SBAR(); qkt<KB, SK>(PX0, PX1, K_lds, r32, hi, S.qr, ACT(t));                                             \
        finishSM(PY0, PY1, alY, l_reg, pa0, pa1, pa2, pa3); SBAR();                                                           \
        if ((t) + 1 < NT) { if constexpr (F32) { VMW(); SWRITE_KF(SB); SBAR(); SLOAD_F((const float*)Vh, KBASE((t) + 1)); }  \
                            else { SLOAD_H(Kh, Vh, KBASE((t) + 1)); } SBAR(); }                                               \
        pv_tile<VB, SK>(o, vb0, pa0, pa1, pa2, pa3, ACT((t) - 1)); MASKT(PX0, PX1, mw); partialSM(PX0, PX1, m_reg, mnX, alX);                                        \
        __syncthreads();                                                                                                      \
        if ((t) + 1 < NT) { VMW(); if constexpr (F32) { SWRITE_VF(SB); SBAR(); if ((t) + 2 < NT) SLOAD_F((const float*)Kh, KBASE((t) + 2)); } \
                            else { SWRITE_H(SB); } }                                                                          \
        RESC(alX); __syncthreads(); } while (0)
    for (int t = 1; t + 1 < NT; t += 2) {
        HALF_STEP(pB0, pB1, mnB, alB, pA0, pA1, alA, t, 1, 0, 0);
        HALF_STEP(pA0, pA1, mnA, alA, pB0, pB1, alB, t + 1, 0, 1, 1);
    }
    const bool even = (NT & 1) == 0;
    if (even) { mw = M32[MOFF() + 2u * (unsigned)(NT - 1)]; SBAR(); qkt<1, SK>(pB0, pB1, K_lds, r32, hi, S.qr, ACT(NT - 1)); SBAR(); }
#define QROW(e) (nxt.Q + (size_t)(wid * QBLK + r32) * D + ((e) >> 1) * 16 + hi * 8 + ((e) & 1) * 4)
    if constexpr (F32) { SLOAD_F((const float*)nxt.K, kbn); SBAR();
#pragma unroll
        for (int e = 0; e < 8; ++e) S.tq[e] = *(const f32x4*)QROW(e); }
    else { SLOAD_H(nxt.K, (nxt.K + VOFF), kbn); SBAR();
#pragma unroll
        for (int d0 = 0; d0 < 8; ++d0) S.qr[d0] = load8<TIn>(nxt.Q + (size_t)(wid * QBLK + r32) * D + d0 * 16 + hi * 8); }
    SBAR();
    finishSM(pA0, pA1, alA, l_reg, pa0, pa1, pa2, pa3); SBAR();
    if constexpr (F32) {
#pragma unroll
        for (int e = 8; e < 16; ++e) S.tq[e] = *(const f32x4*)QROW(e); SBAR(); }
#undef QROW
    pv_tile<0, SK>(o, vb0, pa0, pa1, pa2, pa3, ACT(even ? NT - 2 : NT - 1));
    if (even) { MASKT(pB0, pB1, mw); partialSM(pB0, pB1, m_reg, mnB, alB); __syncthreads(); RESC(alB);
        finishSM(pB0, pB1, alB, l_reg, pa0, pa1, pa2, pa3); SBAR(); pv_tile<1, SK>(o, vb0, pa0, pa1, pa2, pa3, ACT(NT - 1)); }
    SBAR(); SEAM_K0();
    if (hi == 0) li_l[r32] = l_reg; asm volatile("s_waitcnt lgkmcnt(0)" ::: "memory");
    float rli[16];
#pragma unroll
    for (int r = 0; r < 16; ++r) rli[r] = __builtin_amdgcn_rcpf(li_l[crow(r, hi)]);
    TOut* Ow = ((TOut*)cur.Q) + (size_t)(wid * QBLK) * D;
#pragma unroll
    for (int r = 0; r < 16; ++r) { const int orow = crow(r, hi);
#pragma unroll
        for (int d0 = 0; d0 < 4; ++d0) { const float v = o[d0][r] * rli[r];
            if constexpr (same_t<TOut, float>::v) { Ow[(size_t)orow * D + d0 * 32 + r32] = v; }
            else { const float vn = __int_as_float(__builtin_amdgcn_ds_swizzle(__float_as_int(v), 0x041F));
                   if ((r32 & 1) == 0) *(unsigned*)(Ow + (size_t)orow * D + d0 * 32 + r32) = cvtpk(v, vn); } } }
    if constexpr (F32) {
#pragma unroll
        for (int d0 = 0; d0 < 8; ++d0) S.qr[d0] = pack8(S.tq[2 * d0], S.tq[2 * d0 + 1]); }
    __syncthreads();
#undef RESC
#undef KBASE
#undef ACT
#undef MASKT
#undef MOFF
#undef SEAM_K0
#undef HALF_STEP
}
#undef ROW
#undef VMW
#undef VMWN
#undef SLOAD_H
#undef SWRITE_HK
#undef SWRITE_HV
#undef SWRITE_H
#undef SLOAD_F
#undef SWRITE_KF
#undef SWRITE_VF

}

__device__ __forceinline__ void p6_dsa_attention(const Frame& F, char* lds_generic) {
    typedef dsa::BlockRef<unsigned short, unsigned short> Ref;
    const bf16* qA = (const bf16*)(F.ws + WS_QA); const bf16* kA = (const bf16*)(F.ws + WS_KA);
    const unsigned long long* mask = (const unsigned long long*)(F.ws + WS_MASK); const bf16* zz = (const bf16*)(F.ws + WS_Z); bf16* yy = (bf16*)(F.ws + WS_Y);
    constexpr int NQB = SEQ / dsa::QB, NITEM = 8 * (NQB / 2);
#define DSA_MKREF(R, item_, pass_) do { const int h_ = (item_) & 7, yy_ = (item_) >> 3, qb_ = (pass_) ? (NQB - 1 - yy_) : yy_, P0_ = qb_ * dsa::QB; \
        R.Q = qA + ((size_t)h_ * SEQ + P0_) * 128; R.K = kA + (size_t)h_ * SEQ * 128; R.M = mask + (size_t)P0_ * 256; R.P0 = P0_; } while (0)
    int item = blockIdx.x; if (item >= NITEM) return;
    int pass = 0; Ref cur; DSA_MKREF(cur, item, 0);
    dsa::Seam<unsigned short> S;
    __syncthreads();
    dsa::causal_swa_prime<unsigned short, unsigned short>(cur, 1 << 30, lds_generic, S);
    for (;;) {
        const bool more_pass = pass == 0, more_item = item + F.G < NITEM, last = !more_pass && !more_item;
        int itn = item, pn = pass + 1; if (!more_pass) { pn = 0; itn = more_item ? item + F.G : item; }
        Ref nxt = cur; if (!last) DSA_MKREF(nxt, itn, pn);
        dsa::causal_swa_block<unsigned short, unsigned short>(cur, nxt, SEQ, 1 << 30, lds_generic, S);
        if (!more_pass) {
            asm volatile("s_waitcnt vmcnt(0)" ::: "memory"); __syncthreads();
            __builtin_amdgcn_fence(__ATOMIC_ACQUIRE, "agent"); asm volatile("s_waitcnt vmcnt(0)" ::: "memory");
            const int h_ = item & 7, yy_ = item >> 3;
#pragma unroll 1
            for (int ps = 0; ps < 2; ++ps) { const int P0_ = (ps ? (NQB - 1 - yy_) : yy_) * dsa::QB;
#pragma unroll 1
                for (int i = F.tid; i < dsa::QB * 16; i += NTHR) { const int row = P0_ + (i >> 4), c8 = i & 15; float o[8], g[8];
                    unpack8(*(const u32x4*)(qA + ((size_t)h_ * SEQ + row) * 128 + c8 * 8), o); unpack8(*(const u32x4*)(zz + (size_t)row * ZW + ZGATE_B + h_ * 128 + c8 * 8), g);
#pragma unroll
                    for (int j = 0; j < 8; ++j) o[j] *= siluf_(g[j]);
                    *(u32x4*)(yy + (size_t)row * DM + YB + h_ * 128 + c8 * 8) = pack8f(o); } } }
        if (last) break;
        cur = nxt; item = itn; pass = pn;
    }
#undef DSA_MKREF
}

#ifdef DBG_CHECK
constexpr int DBG_T = 1024;
#if DBG_CHECK == 0
__device__ __forceinline__ void dbg_gla_seq(const Frame& F, float* ref) {
    const bf16* z = (const bf16*)(F.ws + WS_Z); const float* bA = (const float*)(F.ws + WS_BA);
    const int i4 = blockIdx.x * NTHR + F.tid; if (i4 >= 12 * 128 * 4) return;
    const int i = i4 >> 2, dq = (i4 & 3) * 16, h = i >> 7, e = i & 127; float S[16];
#pragma unroll
    for (int d = 0; d < 16; ++d) S[d] = 0.f;
    for (int t = 0; t < DBG_T; ++t) { const bf16* zr = z + (size_t)t * ZW; const float ve = bf2f(zr[ZV_A + h * 128 + e]); float o = 0.f;
#pragma unroll
        for (int d = 0; d < 16; ++d) { const float bt = bA[(size_t)t * 768 + h * 64 + dq + d], bp = (t & 63) ? bA[(size_t)(t - 1) * 768 + h * 64 + dq + d] : 0.f;
            S[d] = expf(bt - bp) * S[d] + bf2f(zr[ZK_A + h * 64 + dq + d]) * ve; o += bf2f(zr[ZQ_A + h * 64 + dq + d]) * 0.125f * S[d]; }
        o += shx(o, 1, F.lane); o += shx(o, 2, F.lane);
        if ((i4 & 3) == 0) ref[(size_t)t * 1536 + i] = o; }
}
#endif
#if DBG_CHECK == 1
__device__ __forceinline__ void dbg_mlstm_seq(const Frame& F, float* ref) {
    const bf16* z = (const bf16*)(F.ws + WS_Z); const bf16* cq = (const bf16*)(F.ws + WS_CQ); const bf16* ck = (const bf16*)(F.ws + WS_CK); const float* mg = (const float*)(F.ws + WS_MG);
    const int i = blockIdx.x * NTHR + F.tid; if (i >= 6 * 256) return;
    const int h = i >> 8, e = i & 255; float C[128]; float m = 0.f;
#pragma unroll
    for (int d = 0; d < 128; ++d) C[d] = 0.f;
    for (int t = 0; t < DBG_T; ++t) { const float bt = mg[MG_B + (size_t)t * 8 + h], bp = (t & 63) ? mg[MG_B + (size_t)(t - 1) * 8 + h] : 0.f, lf = bt - bp, ig = mg[MG_I + (size_t)t * 8 + h];
        const float mn = fmaxf(lf + m, ig), fa = expf(lf + m - mn), ia = expf(ig - mn); m = mn;
        const float ve = bf2f(z[(size_t)t * ZW + ZV_C + h * 256 + e]); float o = 0.f;
#pragma unroll
        for (int d = 0; d < 128; ++d) { C[d] = fa * C[d] + ia * bf2f(ck[(size_t)t * 768 + h * 128 + d]) * ve; o += bf2f(cq[(size_t)t * 768 + h * 128 + d]) * C[d]; }
        ref[(size_t)t * 1536 + i] = o;
#ifdef DBG_STATE
        if (t == 63) { const bf16* CP = (const bf16*)(F.ws + WS_CP); const float mp = mg[MG_MP + 6 + h]; float md = 0.f, mx = 0.f;
#pragma unroll
            for (int d = 0; d < 128; ++d) { const float a = bf2f(CP[((size_t)(6 + h) * 256 + e) * 128 + d]) * expf(mp - m), b = C[d]; md = fmaxf(md, fabsf(a - b)); mx = fmaxf(mx, fabsf(b)); }
            md = wave_max(md, F.lane); mx = wave_max(mx, F.lane);
            if (F.lane == 0) atomicMax((unsigned*)(F.ws + WS_CTL) + 2049, __float_as_uint(md / mx)); }
#endif
    }
}
#endif
__device__ __forceinline__ void dbg_compare(const Frame& F, const float* ref, const float* gainA, const float* gainC, int which, unsigned* res) {
    const bf16* z = (const bf16*)(F.ws + WS_Z); const bf16* y = (const bf16*)(F.ws + WS_Y);
    const int NH = which ? 6 : 12, HD = which ? 256 : 128;
    for (int u = F.gw; u < DBG_T * NH; u += F.NGW) { const int t = u / NH, h = u % NH; float ss = 0.f;
        for (int e = F.lane; e < HD; e += 64) { const float v = ref[(size_t)t * 1536 + h * HD + e]; ss += v * v; }
        ss = wave_sum(ss, F.lane); const float rs = 1.0f / sqrtf(ss / HD + NORM_EPS); float md = 0.f;
        for (int e = F.lane; e < HD; e += 64) { float v = ref[(size_t)t * 1536 + h * HD + e] * rs; float got;
            if (which) { v *= gainC[h * 256 + e] * sigmoidf_(bf2f(z[(size_t)t * ZW + ZO_C + h * 256 + e])) * siluf_(bf2f(z[(size_t)t * ZW + ZGATE_C + h * 256 + e])); got = bf2f(y[(size_t)t * DM + YC + h * 256 + e]); }
            else { v *= gainA[h * 128 + e] * siluf_(bf2f(z[(size_t)t * ZW + ZGATE_A + h * 128 + e])); got = bf2f(y[(size_t)t * DM + YA + h * 128 + e]); }
            md = fmaxf(md, fabsf(got - v)); }
        md = wave_max(md, F.lane); if (F.lane == 0) atomicMax(res, __float_as_uint(md)); }
}
#endif

struct Args { const void* in[18]; float* out; unsigned char* ws; };
#ifndef MIX_GLA
#define MIX_GLA 1
#endif
#ifndef MIX_MLSTM
#define MIX_MLSTM 1
#endif
#ifndef MIX_DSA
#define MIX_DSA 1
#endif

__global__ void __launch_bounds__(NTHR, 2) trunk_fwd(Args args) {
    extern __shared__ __attribute__((aligned(16))) unsigned char lds[];
    Frame F;
    F.lds = (LAS unsigned char*)lds; F.ws = args.ws;
    F.tid = threadIdx.x; F.lane = F.tid & 63; F.wave = __builtin_amdgcn_readfirstlane(F.tid >> 6);
    F.G = gridDim.x; { const int bx = blockIdx.x; F.vcu = (F.G % 8 == 0) ? (bx % 8) * (F.G / 8) + bx / 8 : bx; }
    F.gw = F.vcu * NWAVES + F.wave; F.NGW = F.G * NWAVES;
    volatile LAS unsigned* MISC = (volatile LAS unsigned*)(F.lds + MISC_OFF);
    for (int u = F.tid; u < (LDS_BYTES - RING_BYTES) / 4; u += NTHR) ((LAS unsigned*)(F.lds + RING_BYTES))[u] = 0u;
    __syncthreads();
    XcdBarrier bar = xcd_barrier_post((unsigned*)(F.ws + WS_CTL) + CW_BAR, MISC + 8);
#define GRID_BAR() do { size_t zb_ = 0; asm volatile("" : "+s"(zb_)); unsigned x_ = bar.x; asm volatile("" : "+s"(x_)); XcdBarrier b_; b_.bar = (unsigned*)(args.ws + zb_ + WS_CTL) + CW_BAR; b_.x = x_; b_.st = bar.st; xcd_barrier(b_); } while (0)
#define IN(k) ((const float*)args.in[k])
#define PHASE_BEGIN() do { size_t z_ = 0; asm volatile("" : "+s"(z_)); F.ws = args.ws + z_; unsigned lz_ = 0; asm volatile("" : "+s"(lz_)); F.lds = (LAS unsigned char*)lds + lz_; int t_ = threadIdx.x; asm volatile("" : "+v"(t_)); F.tid = t_; F.lane = t_ & 63; F.wave = __builtin_amdgcn_readfirstlane(t_ >> 6); \
        F.gw = F.vcu * NWAVES + F.wave; U = (bf16*)(F.ws + WS_U); Z = (bf16*)(F.ws + WS_Z); Y = (bf16*)(F.ws + WS_Y); PP = (bf16*)(F.ws + WS_PP); H = (float*)(F.ws + WS_H); } while (0)

    bf16 *U, *Z, *Y, *PP; float* H;

#ifndef DMASK
#define DMASK 0
#endif
#define REP(n) for (int rep_ = 0; rep_ < (((DMASK >> (n)) & 1) ? 2 : 1); ++rep_)
#ifndef ONLY
#define PH(n) 1
#else
#define PH(n) ((n) == ONLY)
#endif
    REP(0) { PHASE_BEGIN(); } REP(0) if (PH(0)) p0_prologue(F, IN(4), IN(13), IN(15), IN(16), IN(1), (const int*)args.in[2], IN(3), IN(14), IN(0));
    GRID_BAR();
    for (int L = 0; L < DEPTH; ++L) {

        REP(1) { PHASE_BEGIN(); } REP(1) if (PH(1)) { if (L > 0) { reduce_rstd(F); GRID_BAR(); } }
        REP(2) { PHASE_BEGIN(); } REP(2) if (PH(2)) { pg8::Gemm g{U, (const bf16*)(F.ws + WS_WIN) + (size_t)L * ZW * DM, SEQ, ZW, DM}; pg8::StaticOrder S; S.init(SEQ, ZW, F.G, (int)blockIdx.x);
          pg8::EpiBf16Row E{Z, ZW, (const float*)(F.ws + WS_RSTD), (bf16*)(F.ws + WS_QA), (bf16*)(F.ws + WS_IQ), (bf16*)(F.ws + WS_IK), ZQ_B, ZGATE_B, ZIQ, ZIK, SEQ};
          pg8::gemm_phase<pg8::EpiBf16Row, pg8::StaticOrder, true, true>(F.lds, g, S, E); }
        GRID_BAR();
        REP(3) { PHASE_BEGIN(); } REP(3) if (PH(3)) p3_prep(F, IN(8) + (size_t)L * 4 * 768, IN(9) + (size_t)L * 4 * 768, IN(10) + L * 6, IN(11) + L * 6, IN(5) + (size_t)L * 16 * 768, IN(6) + (size_t)L * 768);
        GRID_BAR();
#if MIX_DSA
        REP(4) { PHASE_BEGIN(); } REP(4) if (PH(4)) p4_index_scores(F);
#endif
#if MIX_GLA
        REP(5) { PHASE_BEGIN(); } REP(5) if (PH(5)) p4_gla_local(F);
#endif
#if MIX_MLSTM
        REP(6) { PHASE_BEGIN(); } REP(6) if (PH(6)) p4_mlstm_local(F);
#endif
        GRID_BAR();
#if MIX_GLA || MIX_MLSTM
        REP(7) { PHASE_BEGIN(); } REP(7) if (PH(7)) p5_scans(F);
#endif
#if MIX_DSA
        REP(8) { PHASE_BEGIN(); } REP(8) if (PH(8)) p5_select(F);
#endif
        GRID_BAR();
#if MIX_DSA
        REP(9) { PHASE_BEGIN(); } REP(9) if (PH(9)) p6_dsa_attention(F, (char*)lds);
#else
        { unsigned zz_ = 0; asm volatile("" : "+v"(zz_));
        for (int i = blockIdx.x * NTHR + F.tid; i < SEQ * 128; i += F.G * NTHR) { const int t = i >> 7, c8 = i & 127; *(u32x4*)(Y + (size_t)t * DM + YB + c8 * 8) = (u32x4){zz_, zz_, zz_, zz_}; } }
#endif
#if MIX_GLA
        REP(10) { PHASE_BEGIN(); } REP(10) if (PH(10)) p6_gla_out(F, IN(7) + (size_t)L * 1536);
#else
        { unsigned zz_ = 0; asm volatile("" : "+v"(zz_));
        for (int i = blockIdx.x * NTHR + F.tid; i < SEQ * 192; i += F.G * NTHR) { const int t = i / 192, c8 = i % 192; *(u32x4*)(Y + (size_t)t * DM + YA + c8 * 8) = (u32x4){zz_, zz_, zz_, zz_}; } }
#endif
#if MIX_MLSTM
        REP(11) { PHASE_BEGIN(); } REP(11) if (PH(11)) p6_mlstm_out(F, IN(12) + (size_t)L * 1536);
#else
        { unsigned zz_ = 0; asm volatile("" : "+v"(zz_));
        for (int i = blockIdx.x * NTHR + F.tid; i < SEQ * 192; i += F.G * NTHR) { const int t = i / 192, c8 = i % 192; *(u32x4*)(Y + (size_t)t * DM + YC + c8 * 8) = (u32x4){zz_, zz_, zz_, zz_}; } }
#endif
        GRID_BAR();
#ifdef DBG_CHECK
        if (L == 0) { PHASE_BEGIN(); float* ref = (float*)(F.ws + WS_SCORE); unsigned* res = (unsigned*)(F.ws + WS_CTL) + 2048;
#if DBG_CHECK == 0
            dbg_gla_seq(F, ref);
#else
            dbg_mlstm_seq(F, ref);
#endif
            GRID_BAR();
            PHASE_BEGIN(); dbg_compare(F, (const float*)(F.ws + WS_SCORE), IN(7), IN(12), DBG_CHECK, (unsigned*)(F.ws + WS_CTL) + 2048);
            GRID_BAR(); }
#endif
        REP(12) { PHASE_BEGIN(); } REP(12) if (PH(12)) { pg8::Gemm g{Y, (const bf16*)(F.ws + WS_WOUT) + (size_t)L * DM * DM, SEQ, DM, DM}; pg8::StaticOrder S; S.init(SEQ, DM, F.G, (int)blockIdx.x);
          pg8::EpiResB E{U, (bf16*)(F.ws + WS_HB2), (float*)(F.ws + WS_PART), DM};
          pg8::gemm_phase<pg8::EpiResB, pg8::StaticOrder, true, true>(F.lds, g, S, E); }
        GRID_BAR();
        REP(13) { PHASE_BEGIN(); } REP(13) if (PH(13)) reduce_rstd(F);
        REP(14) { PHASE_BEGIN(); } REP(14) if (PH(14)) { pg8::Gemm g{(const bf16*)(F.ws + WS_PBF) + (size_t)L * SEQ * DPLE, (const bf16*)(F.ws + WS_WPLE) + (size_t)L * DM * DPLE, SEQ, DM, DPLE}; pg8::StaticOrder S; S.init(SEQ, DM, F.G, (int)blockIdx.x);
          pg8::EpiBf16<0> E{PP, DM, nullptr, 0, 0, 1.f};
          pg8::gemm_phase<pg8::EpiBf16<0>, pg8::StaticOrder, true, true>(F.lds, g, S, E); }
        GRID_BAR();
        REP(15) { PHASE_BEGIN(); } REP(15) if (PH(15)) { pg8::Gemm g{(const bf16*)(F.ws + WS_HB2), (const bf16*)(F.ws + WS_WGATE) + (size_t)L * DM * DM, SEQ, DM, DM}; pg8::StaticOrder S; S.init(SEQ, DM, F.G, (int)blockIdx.x);
          pg8::EpiGateB E{(const bf16*)(F.ws + WS_HB2), PP, (const float*)(F.ws + WS_RSTD), U, (float*)(F.ws + WS_PART), DM};
          pg8::gemm_phase<pg8::EpiGateB, pg8::StaticOrder, true, true>(F.lds, g, S, E); }
        GRID_BAR();
    }
    REP(16) { PHASE_BEGIN(); } REP(16) if (PH(16)) rmsnorm_b2f(F, U, IN(17), args.out);
#ifdef DBG_CHECK
#ifdef DBG_STATE
#define DBG_WORD 2049
#else
#define DBG_WORD 2048
#endif
    GRID_BAR();
    if (blockIdx.x == 0 && threadIdx.x == 0) args.out[0] = 10000.0f * __uint_as_float(__hip_atomic_load((unsigned*)(args.ws + WS_CTL) + DBG_WORD, __ATOMIC_RELAXED, __HIP_MEMORY_SCOPE_AGENT));
#endif
}

extern "C" void kernel_launch(void* const* d_in, const int* in_sizes, int n_in, void* d_out, int out_size, void* d_ws, size_t ws_size, hipStream_t stream) {
    static int grid = 0;
    if (grid == 0) {
        if (n_in != 18 || out_size != SEQ * DM || ws_size < WS_END) { fprintf(stderr, "kernel_launch: unexpected shapes (n_in %d, out %d, ws %zu < %zu)\n", n_in, out_size, ws_size, (size_t)WS_END); grid = -1; return; }
        int dev = 0, cus = 0, per_cu = 0;
        if (hipGetDevice(&dev) != hipSuccess || hipDeviceGetAttribute(&cus, hipDeviceAttributeMultiprocessorCount, dev) != hipSuccess) { grid = -1; return; }
        if (hipFuncSetAttribute((const void*)trunk_fwd, hipFuncAttributeMaxDynamicSharedMemorySize, LDS_BYTES) != hipSuccess) { fprintf(stderr, "kernel_launch: hipFuncSetAttribute failed\n"); grid = -1; return; }
        if (hipOccupancyMaxActiveBlocksPerMultiprocessor(&per_cu, (const void*)trunk_fwd, NTHR, LDS_BYTES) != hipSuccess || per_cu < 1) fprintf(stderr, "kernel_launch: occupancy query says %d\n", per_cu);
        (void)hipGetLastError();
        grid = cus;
    }
    if (grid < 0) return;
    if (hipMemsetAsync((char*)d_ws + WS_CTL, 0, CTL_ZERO_BYTES, stream) != hipSuccess) return;
    Args a{};
    for (int i = 0; i < 18; ++i) a.in[i] = d_in[i];
    a.out = (float*)d_out; a.ws = (unsigned char*)d_ws;
    hipLaunchKernelGGL(trunk_fwd, dim3(grid), dim3(NTHR), LDS_BYTES, stream, a);
}
```

```cpp
#include <hip/hip_runtime.h>
#include <cstdio>
#include <cstdint>
namespace pg8 {
#define PG8_LAS __attribute__((address_space(3)))
typedef unsigned short bf16_t;
typedef short bf16x8 __attribute__((ext_vector_type(8)));
typedef float f32x4 __attribute__((ext_vector_type(4)));
typedef unsigned u32x4 __attribute__((ext_vector_type(4)));
constexpr int BM = 256, BK = 64, HALF = 128, HTB = HALF * BK * 2  , STAGE_BYTES = 8 * HTB, NXCD = 8, WGM = 8;

__host__ __device__ __forceinline__ int lds_byte(int r, int c) { const int st = (r >> 4) * 2 + (c >> 5), rr = r & 15, cc = c & 31, ob = rr * 64 + cc * 2; return st * 1024 + (ob ^ (((ob >> 9) & 1) << 5)); }
__host__ __device__ __forceinline__ void stage_rc(int b, int& R, int& C) { const int st = b / 1024, sb = b % 1024, swz = sb ^ (((sb >> 9) & 1) << 5); R = (st >> 1) * 16 + swz / 64; C = (st & 1) * 32 + (swz % 64) / 2; }
__host__ __device__ __forceinline__ int perm32(int rho) { const int n = rho >> 4, i = rho & 15; return 8 * (i >> 2) + 4 * n + (i & 3); }

struct Unit { int pm, pn; };
struct Gemm { const bf16_t* A; const bf16_t* Bt; int M, N, K; };

struct StaticOrder {
    int nM, nN, nwg, G, c;
    __host__ __device__ void init(int M, int N, int G_, int c_) { nM = M / BM; nN = N / BM; nwg = nM * nN; G = G_; c = c_; }
    __host__ __device__ bool next(int i, Unit& u) const {
        const long L = (long)i * G + c; if (L >= nwg) return false;
        int wgid = (int)L; { const int q = nwg / NXCD, r = nwg % NXCD, xcd = wgid % NXCD, off = wgid / NXCD; wgid = (xcd < r ? xcd * (q + 1) : r * (q + 1) + (xcd - r) * q) + off; }
        const int nig = WGM * nN, gid = wgid / nig, fm = gid * WGM, gsz = (nM - fm) < WGM ? (nM - fm) : WGM;
        u.pm = fm + ((wgid % nig) % gsz); u.pn = (wgid % nig) / gsz; return true;
    }
    __device__ __forceinline__ void a_ready(const Unit&) const {}
    __device__ __forceinline__ void done(const Unit&) const {}
};

__device__ __forceinline__ unsigned cvt_pk_bf16(float lo, float hi) { unsigned r; asm volatile("v_cvt_pk_bf16_f32 %0, %1, %2" : "=v"(r) : "v"(lo), "v"(hi)); return r; }
typedef float f32x2 __attribute__((ext_vector_type(2)));
__device__ __forceinline__ f32x2 gelu_pk(f32x2 v) {
    const f32x2 av = __builtin_elementwise_abs(v), d = av * 0.2316418882f + 1.0f;
    f32x2 t; t.x = __builtin_amdgcn_rcpf(d.x); t.y = __builtin_amdgcn_rcpf(d.y);
    f32x2 q = t * 0.5307027145f + (-0.7265760135f); q = q * t + 0.7107068705f; q = q * t + (-0.142248368f); q = q * t + 0.127414796f; q = q * t;
    const f32x2 s = (v * v) * (-0.72134752044f);
    f32x2 e; e.x = __builtin_amdgcn_exp2f(s.x); e.y = __builtin_amdgcn_exp2f(s.y);
    const f32x2 m = v * (q * e), r = v - m;
    f32x2 o; o.x = v.x < 0.f ? m.x : r.x; o.y = v.y < 0.f ? m.y : r.y; return o;
}

template <int ACT  > struct EpiBf16 {
    static constexpr bool PERM = true, AFTER_DRAIN = false; static_assert(ACT == 0 || ACT == 1, "EpiBf16: ACT is 0 (none) or 1 (gelu_pk)");
    bf16_t* O; int ldc; const float* bias; int split_cols; size_t split_stride; float scale0;
    __device__ __forceinline__ void operator()(const f32x4 (&acc)[2][2][4][2], const Unit& u, int wr, int wc, int fr, int fq) const {
        const int row0 = u.pm * BM + wr * 64 + fr; int colt = u.pn * BM; bf16_t* base = O;
        float sc = 1.f; if (split_cols) { const int t = colt / split_cols; base += (size_t)t * split_stride; colt -= t * split_cols; if (t == 0) sc = scale0; }
        const int col0 = colt + wc * 32 + 8 * fq, bcol0 = u.pn * BM + wc * 32 + 8 * fq;
        f32x4 bv[2][2];
#pragma unroll
        for (int bj = 0; bj < 2; ++bj)
#pragma unroll
            for (int n = 0; n < 2; ++n) bv[bj][n] = bias ? *(const f32x4*)(bias + bcol0 + bj * HALF + 4 * n) : (f32x4){0.f, 0.f, 0.f, 0.f};
#pragma unroll
        for (int ai = 0; ai < 2; ++ai)
#pragma unroll
            for (int m = 0; m < 4; ++m) { bf16_t* rowp = base + (size_t)(row0 + ai * HALF + m * 16) * ldc + col0;
#pragma unroll
                for (int bj = 0; bj < 2; ++bj) { f32x4 v0 = acc[ai][bj][m][0] + bv[bj][0], v1 = acc[ai][bj][m][1] + bv[bj][1];
                    if (ACT == 1) { f32x2 a = gelu_pk((f32x2){v0[0], v0[1]}), b = gelu_pk((f32x2){v0[2], v0[3]}), c = gelu_pk((f32x2){v1[0], v1[1]}), d = gelu_pk((f32x2){v1[2], v1[3]});
                        v0 = (f32x4){a.x, a.y, b.x, b.y}; v1 = (f32x4){c.x, c.y, d.x, d.y}; }
                    v0 = v0 * sc; v1 = v1 * sc; u32x4 w; w.x = cvt_pk_bf16(v0[0], v0[1]); w.y = cvt_pk_bf16(v0[2], v0[3]); w.z = cvt_pk_bf16(v1[0], v1[1]); w.w = cvt_pk_bf16(v1[2], v1[3]);
                    *(u32x4*)(rowp + bj * HALF) = w; } }
    }
};

struct EpiResF32 {
    static constexpr bool PERM = false, AFTER_DRAIN = false;
    const float* base; float* out; int ldc;
    __device__ __forceinline__ void operator()(const f32x4 (&acc)[2][2][4][2], const Unit& u, int wr, int wc, int fr, int fq) const {
        const int row0 = u.pm * BM + wr * 64 + fr, col0 = u.pn * BM + wc * 32 + 4 * fq;
#pragma unroll
        for (int ai = 0; ai < 2; ++ai)
#pragma unroll
            for (int m = 0; m < 4; ++m) { const size_t off = (size_t)(row0 + ai * HALF + m * 16) * ldc + col0;
#pragma unroll
                for (int bj = 0; bj < 2; ++bj)
#pragma unroll
                    for (int n = 0; n < 2; ++n) { const f32x4 b = *(const f32x4*)(base + off + bj * HALF + n * 16); *(f32x4*)(out + off + bj * HALF + n * 16) = b + acc[ai][bj][m][n]; }
                asm volatile("" ::: "memory"); }
    }
};
struct EpiGate {
    static constexpr bool PERM = false, AFTER_DRAIN = false;
    float* h; const bf16_t* pp; int ldc;
    __device__ __forceinline__ void operator()(const f32x4 (&acc)[2][2][4][2], const Unit& u, int wr, int wc, int fr, int fq) const {
        typedef unsigned u32x2v __attribute__((ext_vector_type(2)));
        const int row0 = u.pm * BM + wr * 64 + fr, col0 = u.pn * BM + wc * 32 + 4 * fq;
#pragma unroll
        for (int ai = 0; ai < 2; ++ai)
#pragma unroll
            for (int m = 0; m < 4; ++m) { const size_t off = (size_t)(row0 + ai * HALF + m * 16) * ldc + col0;
#pragma unroll
                for (int bj = 0; bj < 2; ++bj)
#pragma unroll
                    for (int n = 0; n < 2; ++n) { const size_t o = off + bj * HALF + n * 16;
                        const f32x4 hv = *(const f32x4*)(h + o); const u32x2v pv = *(const u32x2v*)(pp + o); const f32x4 a = acc[ai][bj][m][n];
                        f32x4 p; p[0] = __uint_as_float(pv.x << 16); p[1] = __uint_as_float(pv.x & 0xffff0000u); p[2] = __uint_as_float(pv.y << 16); p[3] = __uint_as_float(pv.y & 0xffff0000u);
                        f32x4 r;
#pragma unroll
                        for (int j = 0; j < 4; ++j) { const float g = __builtin_amdgcn_rcpf(1.0f + __expf(-a[j])); r[j] = hv[j] + g * p[j]; }
                        *(f32x4*)(h + o) = r; }
                asm volatile("" ::: "memory"); }
    }
};

__device__ __forceinline__ float shx16(float v, int o, int lane) { return __int_as_float(__builtin_amdgcn_ds_bpermute((lane ^ o) << 2, __float_as_int(v))); }
struct EpiBf16Row {
    static constexpr bool PERM = true, AFTER_DRAIN = false;
    bf16_t* O; int ldc; const float* rs; bf16_t* hm; bf16_t* iq; bf16_t* ik; int c_hm0, c_hm1, c_iq0, c_ik0, seq;
    __device__ __forceinline__ void operator()(const f32x4 (&acc)[2][2][4][2], const Unit& u, int wr, int wc, int fr, int fq) const {
        const int row0 = u.pm * BM + wr * 64 + fr;
        bf16_t* bp[2]; size_t rstride[2]; bool live[2];
#pragma unroll
        for (int bj = 0; bj < 2; ++bj) { const int colb = u.pn * BM + bj * HALF; live[bj] = true;
            if (colb >= c_hm0 && colb < c_hm1) { const int rel = colb - c_hm0, which = rel >> 10, hh = (rel >> 7) & 7; bp[bj] = hm + ((size_t)(which * 8 + hh) * seq) * 128 + wc * 32 + 8 * fq; rstride[bj] = 128; }
            else if (colb >= c_iq0 && colb < c_ik0) { bp[bj] = iq + (colb - c_iq0) + wc * 32 + 8 * fq; rstride[bj] = 1024; }
            else if (colb == c_ik0) { bp[bj] = ik + wc * 32 + 8 * fq; rstride[bj] = 64; live[bj] = wc < 2; }
            else { bp[bj] = O + colb + wc * 32 + 8 * fq; rstride[bj] = (size_t)ldc; } }
#pragma unroll
        for (int ai = 0; ai < 2; ++ai)
#pragma unroll
            for (int m = 0; m < 4; ++m) { const int row = row0 + ai * HALF + m * 16; const float s = rs[row];
#pragma unroll
                for (int bj = 0; bj < 2; ++bj) { const f32x4 v0 = acc[ai][bj][m][0] * s, v1 = acc[ai][bj][m][1] * s;
                    u32x4 w; w.x = cvt_pk_bf16(v0[0], v0[1]); w.y = cvt_pk_bf16(v0[2], v0[3]); w.z = cvt_pk_bf16(v1[0], v1[1]); w.w = cvt_pk_bf16(v1[2], v1[3]);
                    if (live[bj]) *(u32x4*)(bp[bj] + (size_t)row * rstride[bj]) = w; } }
    }
};
struct EpiResF32N {
    static constexpr bool PERM = false, AFTER_DRAIN = false;
    const float* base; float* out; bf16_t* hb; float* part; int ldc;
    __device__ __forceinline__ void operator()(const f32x4 (&acc)[2][2][4][2], const Unit& u, int wr, int wc, int fr, int fq) const {
        typedef unsigned u32x2v __attribute__((ext_vector_type(2)));
        const int row0 = u.pm * BM + wr * 64 + fr, col0 = u.pn * BM + wc * 32 + 4 * fq, lane = fq * 16 + fr;
#pragma unroll
        for (int ai = 0; ai < 2; ++ai)
#pragma unroll
            for (int m = 0; m < 4; ++m) { const int row = row0 + ai * HALF + m * 16; const size_t off = (size_t)row * ldc + col0; float ss = 0.f;
#pragma unroll
                for (int bj = 0; bj < 2; ++bj)
#pragma unroll
                    for (int n = 0; n < 2; ++n) { const size_t o = off + bj * HALF + n * 16; const f32x4 r = *(const f32x4*)(base + o) + acc[ai][bj][m][n]; *(f32x4*)(out + o) = r;
                        u32x2v w; w.x = cvt_pk_bf16(r[0], r[1]); w.y = cvt_pk_bf16(r[2], r[3]); *(u32x2v*)(hb + o) = w; ss += (r[0] * r[0] + r[1] * r[1]) + (r[2] * r[2] + r[3] * r[3]); }
                ss += shx16(ss, 16, lane); ss += shx16(ss, 32, lane);
                if (fq == 0) part[(size_t)row * 64 + u.pn * 4 + wc] = ss;
                if (m & 1) asm volatile("" ::: "memory"); }
    }
};
struct EpiGateN {
    static constexpr bool PERM = false, AFTER_DRAIN = false;
    float* h; const bf16_t* pp; const float* rs; bf16_t* hb; float* part; int ldc;
    __device__ __forceinline__ void operator()(const f32x4 (&acc)[2][2][4][2], const Unit& u, int wr, int wc, int fr, int fq) const {
        typedef unsigned u32x2v __attribute__((ext_vector_type(2)));
        const int row0 = u.pm * BM + wr * 64 + fr, col0 = u.pn * BM + wc * 32 + 4 * fq, lane = fq * 16 + fr;
#pragma unroll
        for (int ai = 0; ai < 2; ++ai)
#pragma unroll
            for (int m = 0; m < 4; ++m) { const int row = row0 + ai * HALF + m * 16; const size_t off = (size_t)row * ldc + col0; const float s = rs[row]; float ss = 0.f;
#pragma unroll
                for (int bj = 0; bj < 2; ++bj)
#pragma unroll
                    for (int n = 0; n < 2; ++n) { const size_t o = off + bj * HALF + n * 16;
                        const f32x4 hv = *(const f32x4*)(h + o); const u32x2v pv = *(const u32x2v*)(pp + o); const f32x4 a = acc[ai][bj][m][n] * s;
                        f32x4 p; p[0] = __uint_as_float(pv.x << 16); p[1] = __uint_as_float(pv.x & 0xffff0000u); p[2] = __uint_as_float(pv.y << 16); p[3] = __uint_as_float(pv.y & 0xffff0000u);
                        f32x4 r;
#pragma unroll
                        for (int j = 0; j < 4; ++j) { const float g = __builtin_amdgcn_rcpf(1.0f + __expf(-a[j])); r[j] = hv[j] + g * p[j]; }
                        *(f32x4*)(h + o) = r; u32x2v w; w.x = cvt_pk_bf16(r[0], r[1]); w.y = cvt_pk_bf16(r[2], r[3]); *(u32x2v*)(hb + o) = w; ss += (r[0] * r[0] + r[1] * r[1]) + (r[2] * r[2] + r[3] * r[3]); }
                ss += shx16(ss, 16, lane); ss += shx16(ss, 32, lane);
                if (fq == 0) part[(size_t)row * 64 + u.pn * 4 + wc] = ss;
                if (m & 1) asm volatile("" ::: "memory"); }
    }
};

__device__ __forceinline__ void unpk8(const u32x4 w, float (&f)[8]) { f[0] = __uint_as_float(w.x << 16); f[1] = __uint_as_float(w.x & 0xffff0000u); f[2] = __uint_as_float(w.y << 16); f[3] = __uint_as_float(w.y & 0xffff0000u);
    f[4] = __uint_as_float(w.z << 16); f[5] = __uint_as_float(w.z & 0xffff0000u); f[6] = __uint_as_float(w.w << 16); f[7] = __uint_as_float(w.w & 0xffff0000u); }
struct EpiResB {
    static constexpr bool PERM = true, AFTER_DRAIN = false;
    const bf16_t* base; bf16_t* out; float* part; int ldc;
    __device__ __forceinline__ void operator()(const f32x4 (&acc)[2][2][4][2], const Unit& u, int wr, int wc, int fr, int fq) const {
        const int row0 = u.pm * BM + wr * 64 + fr, col0 = u.pn * BM + wc * 32 + 8 * fq, lane = fq * 16 + fr;
#pragma unroll
        for (int ai = 0; ai < 2; ++ai)
#pragma unroll
            for (int m = 0; m < 4; ++m) { const int row = row0 + ai * HALF + m * 16; const size_t off = (size_t)row * ldc + col0; float ss = 0.f;
#pragma unroll
                for (int bj = 0; bj < 2; ++bj) { const size_t o = off + bj * HALF; float b[8], r[8]; unpk8(*(const u32x4*)(base + o), b);
#pragma unroll
                    for (int j = 0; j < 4; ++j) { r[j] = b[j] + acc[ai][bj][m][0][j]; r[4 + j] = b[4 + j] + acc[ai][bj][m][1][j]; }
                    u32x4 w; w.x = cvt_pk_bf16(r[0], r[1]); w.y = cvt_pk_bf16(r[2], r[3]); w.z = cvt_pk_bf16(r[4], r[5]); w.w = cvt_pk_bf16(r[6], r[7]); *(u32x4*)(out + o) = w;
#pragma unroll
                    for (int j = 0; j < 8; ++j) ss += r[j] * r[j]; }
                ss += shx16(ss, 16, lane); ss += shx16(ss, 32, lane);
                if (fq == 0) part[(size_t)row * 64 + u.pn * 4 + wc] = ss;
                if (m & 1) asm volatile("" ::: "memory"); }
    }
};
struct EpiGateB {
    static constexpr bool PERM = true, AFTER_DRAIN = false;
    const bf16_t* hin; const bf16_t* pp; const float* rs; bf16_t* out; float* part; int ldc;
    __device__ __forceinline__ void operator()(const f32x4 (&acc)[2][2][4][2], const Unit& u, int wr, int wc, int fr, int fq) const {
        const int row0 = u.pm * BM + wr * 64 + fr, col0 = u.pn * BM + wc * 32 + 8 * fq, lane = fq * 16 + fr;
#pragma unroll
        for (int ai = 0; ai < 2; ++ai)
#pragma unroll
            for (int m = 0; m < 4; ++m) { const int row = row0 + ai * HALF + m * 16; const size_t off = (size_t)row * ldc + col0; const float s = rs[row]; float ss = 0.f;
#pragma unroll
                for (int bj = 0; bj < 2; ++bj) { const size_t o = off + bj * HALF; float hf[8], pf[8], r[8]; unpk8(*(const u32x4*)(hin + o), hf); unpk8(*(const u32x4*)(pp + o), pf);
#pragma unroll
                    for (int j = 0; j < 8; ++j) { const float a = (j < 4 ? acc[ai][bj][m][0][j & 3] : acc[ai][bj][m][1][j & 3]) * s; const float g = __builtin_amdgcn_rcpf(1.0f + __expf(-a)); r[j] = hf[j] + g * pf[j]; }
                    u32x4 w; w.x = cvt_pk_bf16(r[0], r[1]); w.y = cvt_pk_bf16(r[2], r[3]); w.z = cvt_pk_bf16(r[4], r[5]); w.w = cvt_pk_bf16(r[6], r[7]); *(u32x4*)(out + o) = w;
#pragma unroll
                    for (int j = 0; j < 8; ++j) ss += r[j] * r[j]; }
                ss += shx16(ss, 16, lane); ss += shx16(ss, 32, lane);
                if (fq == 0) part[(size_t)row * 64 + u.pn * 4 + wc] = ss;
                if (m & 1) asm volatile("" ::: "memory"); }
    }
};
template <class Epi, class Sched, bool ALIGN_EPI = false, bool SP2 = false>
__device__ __forceinline__ void gemm_phase(PG8_LAS unsigned char* lds, const Gemm g, const Sched& S, const Epi& E) {
    int tid_ = threadIdx.x; asm volatile("" : "+v"(tid_));
    const int tid = tid_, wid = __builtin_amdgcn_readfirstlane(tid >> 6), lane = tid & 63, wr = wid >> 2, wc = wid & 3, fr = lane & 15, fq = lane >> 4;
    const int K = g.K, nt = K / BK;
    unsigned voffA[2], voffB[2];
#pragma unroll
    for (int i = 0; i < 2; ++i) { int R, C; stage_rc(tid * 16 + i * 8192, R, C); const int Rb = Epi::PERM ? ((R & ~31) + perm32(R & 31)) : R;
        voffA[i] = (unsigned)(R * K + C) * 2u; voffB[i] = (unsigned)(Rb * K + C) * 2u; }
    const size_t kstep = (size_t)(BK * 2);
    const size_t hstep = (size_t)HALF * K * 2;
    const size_t tstep = 2 * hstep;
    const unsigned ldsw = (unsigned)wid * 1024u;
    const int aoff = lds_byte(wr * 64 + fr, fq * 8), boff = lds_byte(wc * 32 + fr, fq * 8);
#define PG8_SA(b, h) (((b) * 2 + (h)) * HTB)
#define PG8_SB(b, h) ((4 + (b) * 2 + (h)) * HTB)
#define PG8_STAGE(bufoff, gbase, voff) do { _Pragma("unroll") for (int _i = 0; _i < 2; ++_i) \
        __builtin_amdgcn_global_load_lds((const unsigned*)((const char*)(gbase) + (voff)[_i]), (PG8_LAS unsigned*)(lds + (bufoff) + ldsw + _i * 8192), 16, 0, 0); } while (0)
#define PG8_LDA(dst, b, h) do { _Pragma("unroll") for (int m = 0; m < 4; ++m) _Pragma("unroll") for (int k = 0; k < 2; ++k) dst[m][k] = *(const PG8_LAS bf16x8*)(lds + PG8_SA(b, h) + aoff + m * 2048 + k * 1024); } while (0)
#define PG8_LDB(dst, b, h) do { _Pragma("unroll") for (int n = 0; n < 2; ++n) _Pragma("unroll") for (int k = 0; k < 2; ++k) dst[n][k] = *(const PG8_LAS bf16x8*)(lds + PG8_SB(b, h) + boff + n * 2048 + k * 1024); } while (0)
#define PG8_MMA(ai, bj, At, Bt) do { __builtin_amdgcn_s_setprio(1); _Pragma("unroll") for (int m = 0; m < 4; ++m) _Pragma("unroll") for (int n = 0; n < 2; ++n) _Pragma("unroll") for (int k = 0; k < 2; ++k) \
        acc[ai][bj][m][n] = __builtin_amdgcn_mfma_f32_16x16x32_bf16(Bt[n][k], At[m][k], acc[ai][bj][m][n], 0, 0, 0); __builtin_amdgcn_s_setprio(0); } while (0)
#define PG8_WAIT_V(n) asm volatile("s_waitcnt vmcnt(" #n ")" ::: "memory")
#define PG8_WAIT_L(n) asm volatile("s_waitcnt lgkmcnt(" #n ")" ::: "memory")
#define PG8_BAR __builtin_amdgcn_s_barrier()
#define PG8_SCHED __builtin_amdgcn_sched_barrier(0)
    Unit cur, nxt; int ui = 0;
    if (!S.next(0, cur)) return;
    f32x4 acc[2][2][4][2];
#pragma unroll
    for (int a = 0; a < 2; ++a)
#pragma unroll
        for (int b = 0; b < 2; ++b)
#pragma unroll
            for (int m = 0; m < 4; ++m)
#pragma unroll
                for (int n = 0; n < 2; ++n) acc[a][b][m][n] = (f32x4){0.f, 0.f, 0.f, 0.f};
    bf16x8 At[4][2], B0[2][2], B1[2][2];
    const char* cA = (const char*)g.A + (size_t)cur.pm * tstep; const char* cB = (const char*)g.Bt + (size_t)cur.pn * tstep;
    S.a_ready(cur);
    if constexpr (SP2) {
        PG8_STAGE(PG8_SB(0, 0), cB, voffB); PG8_STAGE(PG8_SB(0, 1), cB + hstep, voffB); PG8_STAGE(PG8_SA(0, 0), cA, voffA); PG8_STAGE(PG8_SA(0, 1), cA + hstep, voffA);
        if (wr == 1) PG8_BAR;
        PG8_WAIT_V(2); PG8_BAR;
        PG8_STAGE(PG8_SB(1, 0), cB + kstep, voffB); PG8_STAGE(PG8_SA(1, 0), cA + kstep, voffA); PG8_STAGE(PG8_SB(1, 1), cB + hstep + kstep, voffB);
        PG8_WAIT_V(6); PG8_BAR;
    } else {
        PG8_STAGE(PG8_SB(0, 0), cB, voffB); PG8_STAGE(PG8_SA(0, 0), cA, voffA); PG8_STAGE(PG8_SB(0, 1), cB + hstep, voffB); PG8_STAGE(PG8_SA(0, 1), cA + hstep, voffA);
        if (wr == 1) PG8_BAR;
        PG8_WAIT_V(4); PG8_BAR;
        PG8_STAGE(PG8_SB(1, 0), cB + kstep, voffB); PG8_STAGE(PG8_SA(1, 0), cA + kstep, voffA); PG8_STAGE(PG8_SB(1, 1), cB + hstep + kstep, voffB);
        PG8_WAIT_V(6); PG8_BAR;
    }
    for (;;) {
        const bool has_next = S.next(ui + 1, nxt);
        const char* nA = has_next ? (const char*)g.A + (size_t)nxt.pm * tstep : cA; const char* nB = has_next ? (const char*)g.Bt + (size_t)nxt.pn * tstep : cB;
#pragma nounroll
        for (int t = 0; t < nt; t += 2) {
            const bool last = (t == nt - 2);
            const char* a1 = cA + (size_t)(t + 1) * kstep;
            const char* a2 = last ? nA : cA + (size_t)(t + 2) * kstep; const char* b2 = last ? nB : cB + (size_t)(t + 2) * kstep;
            const char* a3 = a2 + kstep; const char* b3 = b2 + kstep;
            if (last && has_next) S.a_ready(nxt);
            if constexpr (SP2) {
            PG8_LDB(B0, 0, 0); PG8_LDB(B1, 0, 1); PG8_SCHED; PG8_LDA(At, 0, 0); PG8_STAGE(PG8_SA(1, 1), a1 + hstep, voffA);
            PG8_WAIT_V(8); PG8_WAIT_L(0); PG8_BAR; PG8_MMA(0, 0, At, B0); PG8_MMA(0, 1, At, B1); PG8_BAR; PG8_SCHED;
            PG8_LDA(At, 0, 1); PG8_STAGE(PG8_SB(0, 0), b2, voffB); PG8_STAGE(PG8_SB(0, 1), b2 + hstep, voffB); PG8_STAGE(PG8_SA(0, 0), a2, voffA);
            PG8_WAIT_V(8); PG8_WAIT_L(0); PG8_BAR; PG8_MMA(1, 0, At, B0); PG8_MMA(1, 1, At, B1); PG8_BAR; PG8_SCHED;
            PG8_LDB(B0, 1, 0); PG8_LDB(B1, 1, 1); PG8_SCHED; PG8_LDA(At, 1, 0); PG8_STAGE(PG8_SA(0, 1), a2 + hstep, voffA);
            PG8_WAIT_V(8); PG8_WAIT_L(0); PG8_BAR; PG8_MMA(0, 0, At, B0); PG8_MMA(0, 1, At, B1); PG8_BAR; PG8_SCHED;
            PG8_LDA(At, 1, 1); PG8_STAGE(PG8_SB(1, 0), b3, voffB); PG8_STAGE(PG8_SB(1, 1), b3 + hstep, voffB); PG8_STAGE(PG8_SA(1, 0), a3, voffA);
            PG8_WAIT_V(8); PG8_WAIT_L(0); PG8_BAR; PG8_MMA(1, 0, At, B0); PG8_MMA(1, 1, At, B1); PG8_BAR; PG8_SCHED;
            } else {
            PG8_LDB(B0, 0, 0); PG8_SCHED; PG8_LDA(At, 0, 0); PG8_STAGE(PG8_SA(1, 1), a1 + hstep, voffA);
            PG8_WAIT_L(8); PG8_BAR; PG8_WAIT_L(0); PG8_MMA(0, 0, At, B0); PG8_BAR; PG8_SCHED;
            PG8_LDB(B1, 0, 1); PG8_STAGE(PG8_SB(0, 0), b2, voffB);
            PG8_BAR; PG8_WAIT_L(0); PG8_MMA(0, 1, At, B1); PG8_BAR;
            PG8_LDA(At, 0, 1); PG8_STAGE(PG8_SA(0, 0), a2, voffA);
            PG8_BAR; PG8_WAIT_L(0); PG8_MMA(1, 0, At, B0); PG8_BAR; PG8_SCHED;
            PG8_STAGE(PG8_SB(0, 1), b2 + hstep, voffB);
            PG8_WAIT_V(6); PG8_BAR; PG8_MMA(1, 1, At, B1); PG8_BAR;
            PG8_LDB(B0, 1, 0); PG8_SCHED; PG8_LDA(At, 1, 0); PG8_STAGE(PG8_SA(0, 1), a2 + hstep, voffA);
            PG8_WAIT_L(8); PG8_BAR; PG8_WAIT_L(0); PG8_MMA(0, 0, At, B0); PG8_BAR; PG8_SCHED;
            PG8_LDB(B1, 1, 1); PG8_STAGE(PG8_SB(1, 0), b3, voffB);
            PG8_BAR; PG8_WAIT_L(0); PG8_MMA(0, 1, At, B1); PG8_BAR;
            PG8_LDA(At, 1, 1); PG8_STAGE(PG8_SA(1, 0), a3, voffA);
            PG8_BAR; PG8_WAIT_L(0); PG8_MMA(1, 0, At, B0); PG8_BAR; PG8_SCHED;
            PG8_STAGE(PG8_SB(1, 1), b3 + hstep, voffB);
            PG8_WAIT_V(6); PG8_BAR; PG8_MMA(1, 1, At, B1); PG8_BAR;
            }
        }
        if constexpr (ALIGN_EPI) { if (wr == 0) PG8_BAR; }
        if constexpr (!Epi::AFTER_DRAIN) { E(acc, cur, wr, wc, fr, fq); S.done(cur); }
        if (!has_next) break;
#pragma unroll
        for (int a = 0; a < 2; ++a)
#pragma unroll
            for (int b = 0; b < 2; ++b)
#pragma unroll
                for (int m = 0; m < 4; ++m)
#pragma unroll
                    for (int n = 0; n < 2; ++n) acc[a][b][m][n] = (f32x4){0.f, 0.f, 0.f, 0.f};
        cur = nxt; cA = nA; cB = nB; ++ui;
        if constexpr (ALIGN_EPI) { if (wr == 1) PG8_BAR; }
    }
    PG8_WAIT_V(0);
    if constexpr (!ALIGN_EPI) { if (wr == 0) PG8_BAR; }
    PG8_BAR;
    if constexpr (Epi::AFTER_DRAIN) { E.fused(acc, cur, wr, wc, fr, fq, lds, wid, lane); S.done(cur); }
#undef PG8_SA
#undef PG8_SB
#undef PG8_STAGE
#undef PG8_LDA
#undef PG8_LDB
#undef PG8_MMA
#undef PG8_WAIT_V
#undef PG8_WAIT_L
#undef PG8_BAR
#undef PG8_SCHED
}
}

constexpr int SEQ = 16384, DM = 4096, DEPTH = 4, DPLE = 256;
constexpr int INW = 15980;
constexpr int ZW = 16384;
constexpr float NORM_EPS = 1e-6f;
constexpr int ZQ_A = 0, ZK_A = 768, ZV_A = 1536, ZLOW = 3072, ZGATE_A = 3200;
constexpr int ZQ_B = 4736, ZK_B = 5760, ZV_B = 6784, ZGATE_B = 7808, ZIQ = 8832, ZIK = 9856, ZIW = 9984;
constexpr int ZQ_C = 10112, ZK_C = 10880, ZV_C = 11648, ZIF = 13184, ZO_C = 13312, ZGATE_C = 14848;
constexpr int YA = 0, YB = 1536, YC = 2560;
constexpr int NCH = SEQ / 64;

constexpr size_t MiB = 1u << 20;
constexpr size_t WS_CTL = 0, CTL_ZERO_BYTES = 1 * MiB;
constexpr size_t WS_ROPE = 1 * MiB;
constexpr size_t WS_PBF = 4 * MiB;
constexpr size_t WS_WPLE = 36 * MiB;
constexpr size_t WS_WOUT = 44 * MiB;
constexpr size_t WS_WGATE = 172 * MiB;
constexpr size_t WS_WIN = 300 * MiB;
constexpr size_t WS_H = 812 * MiB;
constexpr size_t WS_QT = 812 * MiB;
constexpr size_t WS_U = 1068 * MiB;
constexpr size_t WS_Z = 1196 * MiB;
constexpr size_t WS_Y = 1708 * MiB;
constexpr size_t WS_PP = 1836 * MiB;
constexpr size_t WS_QA = 1964 * MiB, WS_KA = 1996 * MiB, WS_VA = 2028 * MiB;
constexpr size_t WS_IQ = 2060 * MiB;
constexpr size_t WS_IK = 2092 * MiB;
constexpr size_t WS_IW = 2094 * MiB;
constexpr size_t WS_MASK = 2096 * MiB;
constexpr size_t WS_BA = 2128 * MiB;
constexpr size_t WS_DS = 2176 * MiB;
constexpr size_t WS_SP = 2272 * MiB;
constexpr size_t WS_CQ = 2320 * MiB, WS_CK = 2344 * MiB;
constexpr size_t WS_MG = 2368 * MiB;
constexpr size_t WS_DC = 2372 * MiB;
constexpr size_t WS_CP = 2564 * MiB;
constexpr size_t WS_SCORE = 2660 * MiB;
constexpr size_t WS_HB2 = 3684 * MiB;
constexpr size_t WS_PART = 3812 * MiB;
constexpr size_t WS_RSTD = 3816 * MiB;
constexpr size_t WS_END = 3818 * MiB;
constexpr size_t MG_B = 0;
constexpr size_t MG_I = MG_B + (size_t)SEQ * 8;
constexpr size_t MG_ML = MG_I + (size_t)SEQ * 8;
constexpr size_t MG_MP = MG_ML + (size_t)NCH * 6 * 2;
constexpr size_t MG_DN = MG_MP + (size_t)NCH * 6;
constexpr size_t MG_NP = MG_DN + (size_t)NCH * 6 * 128;
static_assert((MG_NP + (size_t)NCH * 6 * 128) * 4 <= 4 * MiB, "mLSTM small arrays fit");

constexpr int CW_BAR = 4096;

constexpr int RING_BYTES = 131072;
constexpr int MISC_OFF = RING_BYTES + 320;
constexpr int LDS_BYTES = 147456;
constexpr int NWAVES = 8, NTHR = 512;

#define GAS __attribute__((address_space(1)))
#define LAS __attribute__((address_space(3)))
typedef unsigned short bf16;
typedef unsigned u32x4 __attribute__((ext_vector_type(4)));
typedef unsigned u32x2 __attribute__((ext_vector_type(2)));
typedef float f32x4 __attribute__((ext_vector_type(4)));
typedef float f32x2 __attribute__((ext_vector_type(2)));
typedef float f32x16 __attribute__((ext_vector_type(16)));
typedef short bf16x8 __attribute__((ext_vector_type(8)));
typedef short bf16x4 __attribute__((ext_vector_type(4)));
#define LDS_WAIT() asm volatile("s_waitcnt lgkmcnt(0)" ::: "memory")
#define VM_WAIT() asm volatile("s_waitcnt vmcnt(0)" ::: "memory")

__device__ __forceinline__ float bf2f(unsigned short b) { return __uint_as_float((unsigned)b << 16); }
__device__ __forceinline__ float bflo(unsigned w) { return __uint_as_float(w << 16); }
__device__ __forceinline__ float bfhi(unsigned w) { return __uint_as_float(w & 0xffff0000u); }
typedef __bf16 bf16x2_t __attribute__((ext_vector_type(2)));
__device__ __forceinline__ unsigned pk2(float lo, float hi) { const f32x2 v = {lo, hi}; const bf16x2_t b = __builtin_convertvector(v, bf16x2_t); return __builtin_bit_cast(unsigned, b); }
__device__ __forceinline__ unsigned short f2bf(float f) { return (unsigned short)(pk2(f, 0.f) & 0xffffu); }
__device__ __forceinline__ float shx(float v, int o, int lane) { return __int_as_float(__builtin_amdgcn_ds_bpermute((lane ^ o) << 2, __float_as_int(v))); }
__device__ __forceinline__ float shup(float v, int o, int lane) { return __int_as_float(__builtin_amdgcn_ds_bpermute(((lane - o) & 63) << 2, __float_as_int(v))); }
__device__ __forceinline__ unsigned shdn_u(unsigned v, int o, int lane) { return (unsigned)__builtin_amdgcn_ds_bpermute(((lane + o) & 63) << 2, (int)v); }
__device__ __forceinline__ float wave_sum(float v, int lane) {
#pragma unroll
    for (int o = 1; o < 64; o <<= 1) v += shx(v, o, lane);
    return v;
}
__device__ __forceinline__ float wave_max(float v, int lane) {
#pragma unroll
    for (int o = 1; o < 64; o <<= 1) v = fmaxf(v, shx(v, o, lane));
    return v;
}
__device__ __forceinline__ float log_sigmoidf(float x) { return fminf(x, 0.f) - log1pf(expf(-fabsf(x))); }
__device__ __forceinline__ float sigmoidf_(float x) { return __builtin_amdgcn_rcpf(1.0f + __expf(-x)); }
__device__ __forceinline__ float siluf_(float x) { return x * __builtin_amdgcn_rcpf(1.0f + __expf(-x)); }
__device__ __forceinline__ int crow(int r, int hi) { return (r & 3) + 8 * (r >> 2) + 4 * hi; }
__device__ __forceinline__ void unpack8(const u32x4 w, float (&f)[8]) { f[0] = bflo(w.x); f[1] = bfhi(w.x); f[2] = bflo(w.y); f[3] = bfhi(w.y); f[4] = bflo(w.z); f[5] = bfhi(w.z); f[6] = bflo(w.w); f[7] = bfhi(w.w); }
__device__ __forceinline__ u32x4 pack8f(const float (&f)[8]) { u32x4 o; o.x = pk2(f[0], f[1]); o.y = pk2(f[2], f[3]); o.z = pk2(f[4], f[5]); o.w = pk2(f[6], f[7]); return o; }
__device__ __forceinline__ int hw_lane() { int l; asm volatile("v_mbcnt_lo_u32_b32 %0, -1, 0\n\tv_mbcnt_hi_u32_b32 %0, -1, %0" : "=v"(l)); return l; }
#define XB_TMO      128
#define XB_XCNT(j)  (256  + 64 * (j))
#define XB_XSUB(j)  (1280 + 64 * (j))
#define XB_XGEN(j)  (2304 + 64 * (j))
#define XB_TOP      3328
#define XB_TOPGEN   3392
#define XCD_BAR_WORDS 3456
#define XB_SPIN_CAP (1u << 18)

__device__ __forceinline__ unsigned xb_ld(unsigned* p)              { return __hip_atomic_load(p, __ATOMIC_RELAXED, __HIP_MEMORY_SCOPE_AGENT); }
__device__ __forceinline__ unsigned xb_add(unsigned* p, unsigned v) { return __hip_atomic_fetch_add(p, v, __ATOMIC_RELAXED, __HIP_MEMORY_SCOPE_AGENT); }
__device__ __forceinline__ unsigned xb_xcc_id() { return (unsigned)__builtin_amdgcn_s_getreg((3 << 11) | 20) & 0xFu; }
#define XB_SPIN(cond, bar) do { unsigned _sp = 0; while (cond) { __builtin_amdgcn_s_sleep(1); \
    if ((++_sp & 255u) == 0u) { if (xb_ld(&(bar)[XB_TMO])) break; if (_sp > XB_SPIN_CAP) { atomicAdd(&(bar)[XB_TMO], 1u); break; } } } } while (0)

struct XcdBarrier {
    unsigned* bar; unsigned x;
    volatile LAS unsigned* st;
};

__device__ __forceinline__ XcdBarrier xcd_barrier_post(unsigned* bar, volatile LAS unsigned* st) {
    XcdBarrier b; b.bar = bar; b.x = xb_xcc_id(); b.st = st;
    if (threadIdx.x == 0) (void)xb_add(&bar[XB_XCNT(b.x)], 1u);
    return b;
}
__device__ __forceinline__ void xcd_barrier_complete(unsigned* bar, unsigned x, unsigned& nloc, unsigned& nx) {
    const unsigned G = gridDim.x * gridDim.y * gridDim.z;
    unsigned sum, cnt, mine, sp = 0u;
    for (;;) {
        sum = 0u; cnt = 0u; mine = 0u;
#pragma unroll
        for (unsigned j = 0; j < 16; ++j) { const unsigned c = xb_ld(&bar[XB_XCNT(j)]); sum += c; cnt += (c > 0u) ? 1u : 0u; mine = (j == x) ? c : mine; }
        if (sum == G) break;
        __builtin_amdgcn_s_sleep(1);
        if ((++sp & 255u) == 0u) { if (xb_ld(&bar[XB_TMO])) break; if (sp > XB_SPIN_CAP) { atomicAdd(&bar[XB_TMO], 1u); break; } }
    }
    nloc = mine > 0u ? mine : 1u; nx = cnt > 0u ? cnt : 1u;
}

__device__ __forceinline__ void xcd_barrier(const XcdBarrier& b) {
    asm volatile("s_waitcnt vmcnt(0)" ::: "memory");
    __syncthreads();
    if (threadIdx.x == 0) {
        unsigned* bar = b.bar;
        __builtin_amdgcn_s_waitcnt(0);
        unsigned nloc = b.st[0], nx = b.st[1];
        if (nloc == 0u) { xcd_barrier_complete(bar, b.x, nloc, nx); b.st[0] = nloc; b.st[1] = nx; }
        const unsigned old = xb_add(&bar[XB_XSUB(b.x)], 1u);
        const unsigned gen = old / nloc;
        if (old + 1u == (gen + 1u) * nloc) {
            __builtin_amdgcn_fence(__ATOMIC_RELEASE, "agent");
            asm volatile("s_waitcnt vmcnt(0)" ::: "memory");
            const unsigned og = xb_add(&bar[XB_TOP], 1u);
            const unsigned tg = og / nx;
            if (og + 1u == (tg + 1u) * nx) xb_add(&bar[XB_TOPGEN], 1u);
            else XB_SPIN(xb_ld(&bar[XB_TOPGEN]) == tg, bar);
            __builtin_amdgcn_fence(__ATOMIC_ACQUIRE, "agent");
            xb_add(&bar[XB_XGEN(b.x)], 1u);
            asm volatile("s_waitcnt vmcnt(0)" ::: "memory");
        } else {
            XB_SPIN(xb_ld(&bar[XB_XGEN(b.x)]) == gen, bar);
            __builtin_amdgcn_fence(__ATOMIC_ACQUIRE, "agent");
            asm volatile("s_waitcnt vmcnt(0)" ::: "memory");
        }
    }
    __syncthreads();
}

struct Frame {
    LAS unsigned char* lds;
    unsigned char* ws;
    int tid, lane, wave, G, vcu, gw, NGW;
};

__device__ __forceinline__ void zseg(int n0, int& src0, int& valid, float& cscale) {
    int d0, s0, sl;
    if (n0 < ZK_A) { d0 = ZQ_A; s0 = 0; sl = 768; }
    else if (n0 < ZV_A) { d0 = ZK_A; s0 = 768; sl = 768; }
    else if (n0 < ZLOW) { d0 = ZV_A; s0 = 1536; sl = 1536; }
    else if (n0 < ZGATE_A) { d0 = ZLOW; s0 = 3072; sl = 16; }
    else if (n0 < ZQ_B) { d0 = ZGATE_A; s0 = 3088; sl = 1536; }
    else if (n0 < ZK_B) { d0 = ZQ_B; s0 = 4624; sl = 1024; }
    else if (n0 < ZV_B) { d0 = ZK_B; s0 = 5648; sl = 1024; }
    else if (n0 < ZGATE_B) { d0 = ZV_B; s0 = 6672; sl = 1024; }
    else if (n0 < ZIQ) { d0 = ZGATE_B; s0 = 7696; sl = 1024; }
    else if (n0 < ZIK) { d0 = ZIQ; s0 = 8720; sl = 1024; }
    else if (n0 < ZIW) { d0 = ZIK; s0 = 9744; sl = 64; }
    else if (n0 < ZQ_C) { d0 = ZIW; s0 = 9808; sl = 16; }
    else if (n0 < ZK_C) { d0 = ZQ_C; s0 = 9824; sl = 768; }
    else if (n0 < ZV_C) { d0 = ZK_C; s0 = 10592; sl = 768; }
    else if (n0 < ZIF) { d0 = ZV_C; s0 = 11360; sl = 1536; }
    else if (n0 < ZO_C) { d0 = ZIF; s0 = 12896; sl = 12; }
    else if (n0 < ZGATE_C) { d0 = ZO_C; s0 = 12908; sl = 1536; }
    else { d0 = ZGATE_C; s0 = 14444; sl = 1536; }
    const int off = n0 - d0; int v = sl - off; v = v < 0 ? 0 : (v > 32 ? 32 : v);
    src0 = s0 + off; valid = v;
    cscale = (d0 == ZIQ) ? 0.0078125f : (d0 == ZIW) ? 2.0f : 1.0f;
}
__device__ __forceinline__ void transpose_item(const float* W, int K, int Nsrc, bf16* WT, int k0, int n0dst, int src0, int valid, LAS float* scr, int lane, const float* gk, const float cs = 1.0f) {
    const int j = lane & 31; const bool ok = j < valid;
    float vv[32];
    const float* wp = W + (size_t)(k0 + (lane >> 5)) * Nsrc + src0 + (ok ? j : 0);
#pragma unroll
    for (int i = 0; i < 32; ++i) vv[i] = wp[(size_t)(2 * i) * Nsrc];
#pragma unroll
    for (int i = 0; i < 32; ++i) { const int kk = 2 * i + (lane >> 5); const float gg = (gk ? gk[k0 + kk] : 1.0f) * cs; scr[kk * 33 + j] = ok ? vv[i] * gg : 0.f; }
    LDS_WAIT(); asm volatile("" ::: "memory");
    const int c = lane & 7;
#pragma unroll
    for (int jj = 0; jj < 4; ++jj) { const int n = (lane >> 3) + 8 * jj; const LAS float* s = scr + (8 * c) * 33 + n;
        u32x4 o; o.x = pk2(s[0 * 33], s[1 * 33]); o.y = pk2(s[2 * 33], s[3 * 33]); o.z = pk2(s[4 * 33], s[5 * 33]); o.w = pk2(s[6 * 33], s[7 * 33]);
        *(GAS u32x4*)(WT + (size_t)(n0dst + n) * K + k0 + 8 * c) = o; }
    LDS_WAIT(); asm volatile("" ::: "memory");
}
__device__ __forceinline__ void p0_prologue(const Frame& F, const float* w_in, const float* w_out, const float* w_ple_gate, const float* w_ple_proj, const float* pin, const int* pos, const float* g_in, const float* g_ple, const float* x) {
    LAS float* scr = (LAS float*)(F.lds + F.wave * 16384);
    constexpr int I_IN = (DM / 64) * (ZW / 32), I_SQ = (DM / 64) * (DM / 32), I_PL = (DPLE / 64) * (DM / 32), I_L = I_IN + 2 * I_SQ + I_PL;
    for (int it = F.gw; it < DEPTH * I_L; it += F.NGW) {
        const int L = it / I_L; int r = it - L * I_L;
        if (r < I_IN) { const int nb = r % (ZW / 32), kb = r / (ZW / 32); int s0, vd; float cs; zseg(nb * 32, s0, vd, cs);
            transpose_item(w_in + (size_t)L * DM * INW, DM, INW, (bf16*)(F.ws + WS_WIN) + (size_t)L * ZW * DM, kb * 64, nb * 32, s0, vd, scr, F.lane, g_in + (size_t)L * DM, cs); continue; }
        r -= I_IN;
        if (r < I_SQ) { const int nb = r % (DM / 32), kb = r / (DM / 32);
            transpose_item(w_out + (size_t)L * DM * DM, DM, DM, (bf16*)(F.ws + WS_WOUT) + (size_t)L * DM * DM, kb * 64, nb * 32, nb * 32, 32, scr, F.lane, nullptr); continue; }
        r -= I_SQ;
        if (r < I_SQ) { const int nb = r % (DM / 32), kb = r / (DM / 32);
            transpose_item(w_ple_gate + (size_t)L * DM * DM, DM, DM, (bf16*)(F.ws + WS_WGATE) + (size_t)L * DM * DM, kb * 64, nb * 32, nb * 32, 32, scr, F.lane, g_ple + (size_t)L * DM); continue; }
        r -= I_SQ;
        { const int nb = r % (DM / 32), kb = r / (DM / 32);
            transpose_item(w_ple_proj + (size_t)L * DPLE * DM, DPLE, DM, (bf16*)(F.ws + WS_WPLE) + (size_t)L * DM * DPLE, kb * 64, nb * 32, nb * 32, 32, scr, F.lane, nullptr); }
    }
    { bf16* hb = (bf16*)(F.ws + WS_U); float* rstd = (float*)(F.ws + WS_RSTD);
      for (int row = F.gw; row < SEQ; row += F.NGW) {
          const f32x4* xr = (const f32x4*)(x + (size_t)row * DM) + F.lane; f32x4 v[16]; float ss = 0.f;
#pragma unroll
          for (int j = 0; j < 16; ++j) { v[j] = xr[64 * j]; ss += (v[j][0] * v[j][0] + v[j][1] * v[j][1]) + (v[j][2] * v[j][2] + v[j][3] * v[j][3]); }
          ss = wave_sum(ss, F.lane); if (F.lane == 0) rstd[row] = 1.0f / sqrtf(ss * (1.0f / DM) + NORM_EPS);
          u32x2* o = (u32x2*)(hb + (size_t)row * DM) + F.lane;
#pragma unroll
          for (int j = 0; j < 16; ++j) { u32x2 w; w.x = pk2(v[j][0], v[j][1]); w.y = pk2(v[j][2], v[j][3]); o[64 * j] = w; } } }
    { const size_t n8 = (size_t)DEPTH * SEQ * DPLE / 8; bf16* pb = (bf16*)(F.ws + WS_PBF);
      for (size_t i = (size_t)blockIdx.x * NTHR + F.tid; i < n8; i += (size_t)F.G * NTHR) {
          const f32x4 a = *(const f32x4*)(pin + i * 8), b = *(const f32x4*)(pin + i * 8 + 4);
          u32x4 o; o.x = pk2(a[0], a[1]); o.y = pk2(a[2], a[3]); o.z = pk2(b[0], b[1]); o.w = pk2(b[2], b[3]);
          *(u32x4*)(pb + i * 8) = o; } }
    { float* cosA = (float*)(F.ws + WS_ROPE); float* sinA = cosA + (size_t)SEQ * 16; float* cosI = sinA + (size_t)SEQ * 16; float* sinI = cosI + (size_t)SEQ * 8;
      for (int i = blockIdx.x * NTHR + F.tid; i < SEQ * 24; i += F.G * NTHR) {
          const int t = i / 24, f = i % 24; const bool isA = f < 16; const int fi = isA ? f : f - 16; const double rot = isA ? 32.0 : 16.0;
          const float ex = -(float)(2 * fi) / (float)rot;
          const float inv = (float)exp((double)ex * 13.122363377404328);
          const float ang = (float)pos[t] * inv;
          const double a = (double)ang; const double n = rint(a * 0.15915494309189535);
          double rr = fma(-n, 6.283185307179586, a); rr = fma(-n, 2.4492935982947064e-16, rr);
          const float c = (float)cos(rr), s = (float)sin(rr);
          if (isA) { cosA[t * 16 + fi] = c; sinA[t * 16 + fi] = s; } else { cosI[t * 8 + fi] = c; sinI[t * 8 + fi] = s; } } }
}

__device__ __forceinline__ void reduce_rstd(const Frame& F) {
    const float* part = (const float*)(F.ws + WS_PART); float* rstd = (float*)(F.ws + WS_RSTD);
    for (int r4 = F.gw; r4 < SEQ / 4; r4 += F.NGW) { const int row = r4 * 4 + (F.lane >> 4); const f32x4 p = *(const f32x4*)(part + (size_t)row * 64 + (F.lane & 15) * 4);
        float s = (p[0] + p[1]) + (p[2] + p[3]); s += shx(s, 1, F.lane); s += shx(s, 2, F.lane); s += shx(s, 4, F.lane); s += shx(s, 8, F.lane);
        if ((F.lane & 15) == 0) rstd[row] = 1.0f / sqrtf(s * (1.0f / DM) + NORM_EPS); }
}
__device__ __forceinline__ void rmsnorm_to_bf16(const Frame& F, const float* src, const float* g, bf16* dst) {
    for (int row = F.gw; row < SEQ; row += F.NGW) {
        const f32x4* xr = (const f32x4*)(src + (size_t)row * DM) + F.lane; f32x4 v[16]; float ss = 0.f;
#pragma unroll
        for (int j = 0; j < 16; ++j) { v[j] = xr[64 * j]; ss += (v[j][0] * v[j][0] + v[j][1] * v[j][1]) + (v[j][2] * v[j][2] + v[j][3] * v[j][3]); }
        const float rs = 1.0f / sqrtf(wave_sum(ss, F.lane) * (1.0f / DM) + NORM_EPS);
        u32x2* o = (u32x2*)(dst + (size_t)row * DM) + F.lane;
#pragma unroll
        for (int j = 0; j < 16; ++j) { const f32x4 gv = ((const f32x4*)g)[F.lane + 64 * j]; u32x2 w; w.x = pk2(v[j][0] * rs * gv[0], v[j][1] * rs * gv[1]); w.y = pk2(v[j][2] * rs * gv[2], v[j][3] * rs * gv[3]); o[64 * j] = w; }
    }
}
__device__ __forceinline__ void rmsnorm_b2f(const Frame& F, const bf16* src, const float* g, float* dst) {
    for (int row = F.gw; row < SEQ; row += F.NGW) {
        const u32x4* xr = (const u32x4*)(src + (size_t)row * DM) + F.lane; float v[8][8]; float ss = 0.f;
#pragma unroll
        for (int j = 0; j < 8; ++j) { unpack8(xr[64 * j], v[j]);
#pragma unroll
            for (int q = 0; q < 8; ++q) ss += v[j][q] * v[j][q]; }
        const float rs = 1.0f / sqrtf(wave_sum(ss, F.lane) * (1.0f / DM) + NORM_EPS);
#pragma unroll
        for (int j = 0; j < 8; ++j) { const int c0 = (F.lane + 64 * j) * 8; const f32x4 g0 = *(const f32x4*)(g + c0), g1 = *(const f32x4*)(g + c0 + 4); f32x4 o0, o1;
#pragma unroll
            for (int q = 0; q < 4; ++q) { o0[q] = v[j][q] * rs * g0[q]; o1[q] = v[j][4 + q] * rs * g1[q]; }
            *(f32x4*)(dst + (size_t)row * DM + c0) = o0; *(f32x4*)(dst + (size_t)row * DM + c0 + 4) = o1; }
    }
}
__device__ __forceinline__ void rmsnorm_to_f32(const Frame& F, const float* src, const float* g, float* dst) {
    for (int row = F.gw; row < SEQ; row += F.NGW) {
        const f32x4* xr = (const f32x4*)(src + (size_t)row * DM) + F.lane; f32x4 v[16]; float ss = 0.f;
#pragma unroll
        for (int j = 0; j < 16; ++j) { v[j] = xr[64 * j]; ss += (v[j][0] * v[j][0] + v[j][1] * v[j][1]) + (v[j][2] * v[j][2] + v[j][3] * v[j][3]); }
        const float rs = 1.0f / sqrtf(wave_sum(ss, F.lane) * (1.0f / DM) + NORM_EPS);
        f32x4* o = (f32x4*)(dst + (size_t)row * DM) + F.lane;
#pragma unroll
        for (int j = 0; j < 16; ++j) { const f32x4 gv = ((const f32x4*)g)[F.lane + 64 * j]; f32x4 w; w[0] = v[j][0] * rs * gv[0]; w[1] = v[j][1] * rs * gv[1]; w[2] = v[j][2] * rs * gv[2]; w[3] = v[j][3] * rs * gv[3]; o[64 * j] = w; }
    }
}


__device__ __forceinline__ void p3_prep(const Frame& F, const float* wq, const float* wk, const float* b_ig, const float* b_fg, const float* wu, const float* bu) {
    const bf16* __restrict__ z = (const bf16*)(F.ws + WS_Z);
    const float* cosA = (const float*)(F.ws + WS_ROPE); const float* sinA = cosA + (size_t)SEQ * 16; const float* cosI = sinA + (size_t)SEQ * 16; const float* sinI = cosI + (size_t)SEQ * 8;
    const int gt = blockIdx.x * NTHR + F.tid, GT = F.G * NTHR;
#ifndef P3MASK
#define P3MASK 0
#endif
#define P3REP(k) for (int rep3_ = 0; rep3_ < (((P3MASK >> (k)) & 1) ? 2 : 1); ++rep3_)
    P3REP(1) { bf16* __restrict__ qk = (bf16*)(F.ws + WS_QA);
#pragma unroll 4
      for (int i = gt; i < 2 * 8 * SEQ; i += GT) { const int t = i & (SEQ - 1); bf16* p = qk + (size_t)i * 128;
          const u32x4 w0 = *(const u32x4*)p, w1 = *(const u32x4*)(p + 8), w2 = *(const u32x4*)(p + 16), w3 = *(const u32x4*)(p + 24);
          float x1[16], x2[16], o1[16], o2[16]; { float a[8]; unpack8(w0, a); for (int j = 0; j < 8; ++j) x1[j] = a[j]; unpack8(w1, a); for (int j = 0; j < 8; ++j) x1[8 + j] = a[j]; unpack8(w2, a); for (int j = 0; j < 8; ++j) x2[j] = a[j]; unpack8(w3, a); for (int j = 0; j < 8; ++j) x2[8 + j] = a[j]; }
          const float* cp = cosA + (size_t)t * 16; const float* sp = sinA + (size_t)t * 16;
#pragma unroll
          for (int j = 0; j < 16; ++j) { const float cc = cp[j], ss = sp[j]; o1[j] = x1[j] * cc - x2[j] * ss; o2[j] = x2[j] * cc + x1[j] * ss; }
          { float a[8]; for (int j = 0; j < 8; ++j) a[j] = o1[j]; *(u32x4*)p = pack8f(a); for (int j = 0; j < 8; ++j) a[j] = o1[8 + j]; *(u32x4*)(p + 8) = pack8f(a); for (int j = 0; j < 8; ++j) a[j] = o2[j]; *(u32x4*)(p + 16) = pack8f(a); for (int j = 0; j < 8; ++j) a[j] = o2[8 + j]; *(u32x4*)(p + 24) = pack8f(a); } } }
    P3REP(2) { bf16* __restrict__ iq = (bf16*)(F.ws + WS_IQ); bf16* __restrict__ ik = (bf16*)(F.ws + WS_IK); bf16* __restrict__ qt = (bf16*)(F.ws + WS_QT);
      for (int i = gt; i < SEQ * 8; i += GT) { const int t = i >> 3, c8 = i & 7;
          const float* cp = cosI + (size_t)t * 8; const float* sp = sinI + (size_t)t * 8;
          if (c8 == 1) { bf16* p = ik + (size_t)t * 64;
              float a[8], b[8], oa[8], ob[8]; unpack8(*(const u32x4*)p, a); unpack8(*(const u32x4*)(p + 8), b);
#pragma unroll
              for (int j = 0; j < 8; ++j) { const float cc = cp[j], ss = sp[j]; oa[j] = a[j] * cc - b[j] * ss; ob[j] = b[j] * cc + a[j] * ss; }
              *(u32x4*)p = pack8f(oa); *(u32x4*)(p + 8) = pack8f(ob);
          } else {
              float wv[16]; { const bf16* wp = z + (size_t)t * ZW + ZIW; float wa[8], wb[8]; unpack8(*(const u32x4*)wp, wa); unpack8(*(const u32x4*)(wp + 8), wb);
#pragma unroll
                for (int h = 0; h < 8; ++h) { wv[h] = wa[h]; wv[8 + h] = wb[h]; } }
              bf16* qo = qt + (size_t)t * 128;
              if (c8 == 0) { float sa[8], sb[8], cc[8], ss[8];
#pragma unroll
                  for (int j = 0; j < 8; ++j) { sa[j] = 0.f; sb[j] = 0.f; cc[j] = cp[j]; ss[j] = sp[j]; }
#pragma unroll
                  for (int h = 0; h < 16; ++h) { bf16* p = iq + ((size_t)t * 16 + h) * 64;
                      float a[8], b[8], oa[8], ob[8]; unpack8(*(const u32x4*)p, a); unpack8(*(const u32x4*)(p + 8), b);
#pragma unroll
                      for (int j = 0; j < 8; ++j) { oa[j] = a[j] * cc[j] - b[j] * ss[j]; ob[j] = b[j] * cc[j] + a[j] * ss[j]; }
                      const u32x4 pa = pack8f(oa), pb = pack8f(ob); *(u32x4*)p = pa; *(u32x4*)(p + 8) = pb; unpack8(pa, oa); unpack8(pb, ob);
#pragma unroll
                      for (int j = 0; j < 8; ++j) { sa[j] += wv[h] * oa[j]; sb[j] += wv[h] * ob[j]; } }
                  { const u32x4 hi = pack8f(sa); float r[8]; unpack8(hi, r);
#pragma unroll
                    for (int j = 0; j < 8; ++j) r[j] = sa[j] - r[j];
                    *(u32x4*)qo = hi; *(u32x4*)(qo + 64) = pack8f(r); }
                  { const u32x4 hi = pack8f(sb); float r[8]; unpack8(hi, r);
#pragma unroll
                    for (int j = 0; j < 8; ++j) r[j] = sb[j] - r[j];
                    *(u32x4*)(qo + 8) = hi; *(u32x4*)(qo + 72) = pack8f(r); }
              } else { float s8[8];
#pragma unroll
                  for (int j = 0; j < 8; ++j) s8[j] = 0.f;
#pragma unroll
                  for (int h = 0; h < 16; ++h) { float a[8]; unpack8(*(const u32x4*)(iq + ((size_t)t * 16 + h) * 64 + c8 * 8), a);
#pragma unroll
                      for (int j = 0; j < 8; ++j) s8[j] += wv[h] * a[j]; }
                  const u32x4 hi = pack8f(s8); float r[8]; unpack8(hi, r);
#pragma unroll
                  for (int j = 0; j < 8; ++j) r[j] = s8[j] - r[j];
                  *(u32x4*)(qo + c8 * 8) = hi; *(u32x4*)(qo + 64 + c8 * 8) = pack8f(r); } } } }
    P3REP(3) { bf16* __restrict__ cq = (bf16*)(F.ws + WS_CQ); bf16* __restrict__ ck = (bf16*)(F.ws + WS_CK);
      constexpr int PER = SEQ * 96;
#pragma unroll 4
      for (int i = gt; i < 2 * PER; i += GT) {
          const int which = i / PER, r = i - which * PER, c8 = r % 96, t = r / 96;
          const float* w = (which ? wk : wq) + c8 * 8; const int zc = (which ? ZK_C : ZQ_C) + c8 * 8; float acc[8];
#pragma unroll
          for (int j = 0; j < 8; ++j) acc[j] = 0.f;
#pragma unroll
          for (int tap = 0; tap < 4; ++tap) { const int ts = t - 3 + tap; if (ts >= 0) { float xv[8]; unpack8(*(const u32x4*)(z + (size_t)ts * ZW + zc), xv); const f32x4 w0 = *(const f32x4*)(w + tap * 768), w1 = *(const f32x4*)(w + tap * 768 + 4);
#pragma unroll
              for (int j = 0; j < 4; ++j) { acc[j] += xv[j] * w0[j]; acc[4 + j] += xv[4 + j] * w1[j]; } } }
          const float sc = which ? 1.0f : 0.08838834764831845f;
#pragma unroll
          for (int j = 0; j < 8; ++j) acc[j] = siluf_(acc[j]) * sc;
          *(u32x4*)((which ? ck : cq) + (size_t)t * 768 + c8 * 8) = pack8f(acc); } }
    P3REP(4) { float* mg = (float*)(F.ws + WS_MG);
      for (int u = F.gw; u < NCH * 6; u += F.NGW) { const int c = u / 6, h = u % 6, t = c * 64 + F.lane; const float bi = b_ig[h], bfg = b_fg[h];
          const float ci = bf2f(z[(size_t)t * ZW + ZIF + h]), cf = bf2f(z[(size_t)t * ZW + ZIF + 6 + h]);
          float v = log_sigmoidf(cf + bfg);
#pragma unroll
          for (int o = 1; o < 64; o <<= 1) { const float nb = shup(v, o, F.lane); if (F.lane >= o) v += nb; }
          mg[MG_B + (size_t)t * 8 + h] = v; mg[MG_I + (size_t)t * 8 + h] = ci + bi; } }
    P3REP(5) { float* bA = (float*)(F.ws + WS_BA); LAS float* al = (LAS float*)F.lds;
      for (int c = blockIdx.x; c < NCH; c += F.G) {
          __syncthreads();
          if (F.tid < 128) { const int s = F.tid >> 1, hf = F.tid & 1; float a[8]; unpack8(*(const u32x4*)(z + (size_t)(c * 64 + s) * ZW + ZLOW + hf * 8), a);
#pragma unroll
              for (int r = 0; r < 8; ++r) al[s * 16 + hf * 8 + r] = a[r]; }
          __syncthreads();
          for (int n = F.tid; n < 768; n += NTHR) { float wv[16];
#pragma unroll
              for (int r = 0; r < 16; ++r) wv[r] = wu[r * 768 + n];
              const float bb = bu[n]; float bs = 0.f; float* op = bA + (size_t)c * 64 * 768 + n;
#pragma unroll 4
              for (int s = 0; s < 64; ++s) { const f32x4 a0 = *(const LAS f32x4*)(al + s * 16), a1 = *(const LAS f32x4*)(al + s * 16 + 4), a2 = *(const LAS f32x4*)(al + s * 16 + 8), a3 = *(const LAS f32x4*)(al + s * 16 + 12);
                  float x = bb;
#pragma unroll
                  for (int r = 0; r < 4; ++r) { x += a0[r] * wv[r]; x += a1[r] * wv[4 + r]; x += a2[r] * wv[8 + r]; x += a3[r] * wv[12 + r]; }
                  bs += (fminf(x, 0.f) - __logf(1.0f + __expf(-fabsf(x)))) * (1.0f / 16.0f); op[(size_t)s * 768] = bs; } } }
    }
}

__device__ __forceinline__ f32x16 mfma32(bf16x8 a, bf16x8 b, f32x16 c) { return __builtin_amdgcn_mfma_f32_32x32x16_bf16(a, b, c, 0, 0, 0); }
__device__ __forceinline__ f32x4 mfma16(bf16x8 a, bf16x8 b, f32x4 c) { return __builtin_amdgcn_mfma_f32_16x16x32_bf16(a, b, c, 0, 0, 0); }
__device__ __forceinline__ f32x16 zero16() { f32x16 z;
#pragma unroll
    for (int i = 0; i < 16; ++i) z[i] = 0.f;
    return z; }

__device__ __forceinline__ void p4_index_scores(const Frame& F) {
    const bf16* iq = (const bf16*)(F.ws + WS_IQ); const bf16* ik = (const bf16*)(F.ws + WS_IK); const bf16* zw = (const bf16*)(F.ws + WS_Z) + ZIW; _Float16* sc = (_Float16*)(F.ws + WS_SCORE);
    const int l15 = F.lane & 15, lq = F.lane >> 4;
    constexpr int NITEMS = 2112;
#define IDX_J(bi_, j_, rem_) do { j_ = 0; rem_ = (bi_); while (rem_ >= 128 - 4 * j_) { rem_ -= 128 - 4 * j_; ++j_; } } while (0)
#define IDX_STAGE(bi_, buf_) do { int j_, rem_; IDX_J(bi_, j_, rem_); const int ln_ = hw_lane(); \
        _Pragma("unroll") for (int i_ = 0; i_ < 8; ++i_) { const int ci_ = i_ * 8 + F.wave, r_ = ci_ * 8 + (ln_ >> 3), c_ = (ln_ & 7) ^ ((r_ >> 1) & 7); \
            __builtin_amdgcn_global_load_lds((const unsigned*)(ik + (size_t)(512 * j_ + r_) * 64 + c_ * 8), (LAS unsigned*)(F.lds + (buf_) * 65536 + ci_ * 1024), 16, 0, 0); } } while (0)
    int bi = blockIdx.x, par = 0;
    if (bi < NITEMS) IDX_STAGE(bi, 0);
    for (; bi < NITEMS; bi += F.G, par ^= 1) {
        int j, rem; IDX_J(bi, j, rem);
        const int g = 8 * (4 * j + rem) + F.wave, t0 = 16 * g, s0 = 512 * j;
        int s_end = s0 + 512; if (s_end > t0 + 16) s_end = t0 + 16;
        bf16x8 bq[16][2]; float w[16];
        const bf16* qp = iq + (size_t)(t0 + l15) * 1024 + 8 * lq;
#pragma unroll
        for (int h = 0; h < 16; ++h) { bq[h][0] = *(const bf16x8*)(qp + h * 64); bq[h][1] = *(const bf16x8*)(qp + h * 64 + 32); } { const bf16* wp = zw + (size_t)(t0 + l15) * ZW; float wa[8], wb[8]; unpack8(*(const u32x4*)wp, wa); unpack8(*(const u32x4*)(wp + 8), wb);
#pragma unroll
          for (int h = 0; h < 8; ++h) { w[h] = wa[h]; w[8 + h] = wb[h]; } }
        bf16x8 bt[4]; { const bf16* tp = (const bf16*)(F.ws + WS_QT) + (size_t)(t0 + l15) * 128 + 8 * lq; bt[0] = *(const bf16x8*)tp; bt[1] = *(const bf16x8*)(tp + 32); bt[2] = *(const bf16x8*)(tp + 64); bt[3] = *(const bf16x8*)(tp + 96); }
        VM_WAIT();
        __syncthreads();
        if (bi + F.G < NITEMS) IDX_STAGE(bi + F.G, par ^ 1);
        _Float16* orow = sc + (size_t)(t0 + l15) * SEQ + 4 * lq;
        const LAS unsigned char* kp0 = F.lds + par * 65536 + l15 * 128 + ((lq ^ (l15 >> 1)) << 4);
        const LAS unsigned char* kp1 = F.lds + par * 65536 + l15 * 128 + (((lq + 4) ^ (l15 >> 1)) << 4);
        for (int s = s0; s < s_end; s += 16) {
            const bf16x8 a0 = *(const LAS bf16x8*)kp0, a1 = *(const LAS bf16x8*)kp1; kp0 += 2048; kp1 += 2048;
            f32x4 tot = mfma16(a0, bt[0], (f32x4){0.f, 0.f, 0.f, 0.f});
#pragma unroll
            for (int hh = 0; hh < 16; hh += 8) { f32x4 acc[8];
                __builtin_amdgcn_s_setprio(1);
#pragma unroll
                for (int h = 0; h < 8; ++h) acc[h] = mfma16(a0, bq[hh + h][0], (f32x4){0.f, 0.f, 0.f, 0.f});
                if (hh == 0) { tot = mfma16(a1, bt[1], tot); tot = mfma16(a0, bt[2], tot); }
#pragma unroll
                for (int h = 0; h < 8; ++h) acc[h] = mfma16(a1, bq[hh + h][1], acc[h]);
                if (hh == 0) tot = mfma16(a1, bt[3], tot);
                __builtin_amdgcn_s_setprio(0);
                __builtin_amdgcn_sched_barrier(0);
                asm volatile("s_nop 15");
#pragma unroll
                for (int h = 0; h < 8; ++h) {
#pragma unroll
                    for (int r = 0; r < 4; ++r) asm volatile("v_fma_f32 %0, %1, |%2|, %0" : "+v"(tot[r]) : "v"(w[hh + h]), "v"(acc[h][r])); } }
            { typedef _Float16 h16x4 __attribute__((ext_vector_type(4))); h16x4 hv; hv[0] = (_Float16)tot[0]; hv[1] = (_Float16)tot[1]; hv[2] = (_Float16)tot[2]; hv[3] = (_Float16)tot[3]; *(h16x4*)(orow + s) = hv; }
        }
    }
}

__device__ __forceinline__ void p4_gla_local(const Frame& F) {
    const bf16* z = (const bf16*)(F.ws + WS_Z); const float* bA = (const float*)(F.ws + WS_BA); float* dS = (float*)(F.ws + WS_DS);
    LAS bf16* vT = (LAS bf16*)F.lds;
    LAS bf16* kT = vT + 128 * 72;
    const int r32 = F.lane & 31, hi = F.lane >> 5, s = F.tid >> 3, d8 = (F.tid & 7) * 8, e16 = (F.tid & 7) * 16;
    u32x4 kw, vw0, vw1; f32x4 b0, b1, e0, e1;
#define GLA_LOAD(u_) do { const int c_ = (u_) / 12, h_ = (u_) % 12, t0_ = c_ * 64; kw = *(const u32x4*)(z + (size_t)(t0_ + s) * ZW + ZK_A + h_ * 64 + d8); \
        const float* bp_ = bA + (size_t)(t0_ + s) * 768 + h_ * 64 + d8; const float* be_ = bA + (size_t)(t0_ + 63) * 768 + h_ * 64 + d8; \
        b0 = *(const f32x4*)bp_; b1 = *(const f32x4*)(bp_ + 4); e0 = *(const f32x4*)be_; e1 = *(const f32x4*)(be_ + 4); \
        const bf16* vp_ = z + (size_t)(t0_ + s) * ZW + ZV_A + h_ * 128 + e16; vw0 = *(const u32x4*)vp_; vw1 = *(const u32x4*)(vp_ + 8); } while (0)
    int u = blockIdx.x; if (u < NCH * 12) GLA_LOAD(u);
    for (; u < NCH * 12; u += F.G) {
        __syncthreads();
        { float kv[8]; unpack8(kw, kv);
#pragma unroll
          for (int j = 0; j < 4; ++j) { kT[(d8 + j) * 72 + s] = f2bf(kv[j] * __expf(e0[j] - b0[j])); kT[(d8 + 4 + j) * 72 + s] = f2bf(kv[4 + j] * __expf(e1[j] - b1[j])); }
          const unsigned ww[8] = {vw0.x, vw0.y, vw0.z, vw0.w, vw1.x, vw1.y, vw1.z, vw1.w};
#pragma unroll
          for (int j = 0; j < 8; ++j) { vT[(e16 + 2 * j) * 72 + s] = (bf16)(ww[j] & 0xffffu); vT[(e16 + 2 * j + 1) * 72 + s] = (bf16)(ww[j] >> 16); } }
        __syncthreads();
        if (u + F.G < NCH * 12) GLA_LOAD(u + F.G);
        const int et = F.wave >> 1, dt = F.wave & 1; f32x16 acc = zero16();
#pragma unroll
        for (int kk = 0; kk < 4; ++kk) { const bf16x8 a = *(const LAS bf16x8*)(kT + (32 * dt + r32) * 72 + 16 * kk + 8 * hi), b = *(const LAS bf16x8*)(vT + (32 * et + r32) * 72 + 16 * kk + 8 * hi); acc = mfma32(a, b, acc); }
        float* o = dS + ((size_t)u * 128 + 32 * et + r32) * 64 + 32 * dt + 4 * hi;
#pragma unroll
        for (int g = 0; g < 4; ++g) *(f32x4*)(o + 8 * g) = (f32x4){acc[4 * g], acc[4 * g + 1], acc[4 * g + 2], acc[4 * g + 3]};
    }
#undef GLA_LOAD
}

__device__ __forceinline__ void p4_mlstm_local(const Frame& F) {
    const bf16* z = (const bf16*)(F.ws + WS_Z); const bf16* ck = (const bf16*)(F.ws + WS_CK); float* mg = (float*)(F.ws + WS_MG); float* dC = (float*)(F.ws + WS_DC);
    LAS bf16* vT = (LAS bf16*)F.lds;
    LAS bf16* kT = vT + 256 * 72;
    LAS float* wsl = (LAS float*)(kT + 128 * 72);
    const int r32 = F.lane & 31, hi = F.lane >> 5, s = F.tid >> 3, d16 = (F.tid & 7) * 16, e32 = (F.tid & 7) * 32;
    u32x4 kw0, kw1, vw[4]; float gbs = 0.f, gig = 0.f;
#define ML_LOAD(u_) do { const int c_ = (u_) / 6, h_ = (u_) % 6, t0_ = c_ * 64; const bf16* kp_ = ck + (size_t)(t0_ + s) * 768 + h_ * 128 + d16; kw0 = *(const u32x4*)kp_; kw1 = *(const u32x4*)(kp_ + 8); \
        const bf16* vp_ = z + (size_t)(t0_ + s) * ZW + ZV_C + h_ * 256 + e32; _Pragma("unroll") for (int q_ = 0; q_ < 4; ++q_) vw[q_] = *(const u32x4*)(vp_ + 8 * q_); \
        if (F.wave == 0) { gbs = mg[MG_B + (size_t)(t0_ + F.lane) * 8 + h_]; gig = mg[MG_I + (size_t)(t0_ + F.lane) * 8 + h_]; } } while (0)
    int u = blockIdx.x; if (u < NCH * 6) ML_LOAD(u);
    for (; u < NCH * 6; u += F.G) {
        __syncthreads();
        if (F.wave == 0) { const float be = __int_as_float(__builtin_amdgcn_readlane(__float_as_int(gbs), 63));
            const float a = be - gbs + gig; const float ml = wave_max(a, F.lane); wsl[F.lane] = __expf(a - ml); if (F.lane == 0) { mg[MG_ML + (size_t)u * 2] = be; mg[MG_ML + (size_t)u * 2 + 1] = ml; } }
        __syncthreads();
        { const float wsv = wsl[s]; float k0[8], k1[8]; unpack8(kw0, k0); unpack8(kw1, k1);
#pragma unroll
          for (int j = 0; j < 8; ++j) { kT[(d16 + j) * 72 + s] = f2bf(k0[j] * wsv); kT[(d16 + 8 + j) * 72 + s] = f2bf(k1[j] * wsv); }
#pragma unroll
          for (int q = 0; q < 4; ++q) { const unsigned ww[4] = {vw[q].x, vw[q].y, vw[q].z, vw[q].w};
#pragma unroll
              for (int j = 0; j < 4; ++j) { vT[(e32 + 8 * q + 2 * j) * 72 + s] = (bf16)(ww[j] & 0xffffu); vT[(e32 + 8 * q + 2 * j + 1) * 72 + s] = (bf16)(ww[j] >> 16); } } }
        __syncthreads();
        if (u + F.G < NCH * 6) ML_LOAD(u + F.G);
        if (F.tid < 128) { float sum = 0.f; const LAS bf16* kr = kT + F.tid * 72;
#pragma unroll 8
            for (int ss = 0; ss < 64; ++ss) sum += bf2f(kr[ss]);
            mg[MG_DN + (size_t)u * 128 + F.tid] = sum; }
        const int et = F.wave; bf16x8 bv[4];
#pragma unroll
        for (int kk = 0; kk < 4; ++kk) bv[kk] = *(const LAS bf16x8*)(vT + (32 * et + r32) * 72 + 16 * kk + 8 * hi);
        float* o = dC + ((size_t)u * 256 + 32 * et + r32) * 128 + 4 * hi;
#pragma unroll
        for (int dt = 0; dt < 4; ++dt) { f32x16 acc = zero16();
#pragma unroll
            for (int kk = 0; kk < 4; ++kk) { const bf16x8 a = *(const LAS bf16x8*)(kT + (32 * dt + r32) * 72 + 16 * kk + 8 * hi); acc = mfma32(a, bv[kk], acc); }
#pragma unroll
            for (int g = 0; g < 4; ++g) *(f32x4*)(o + 32 * dt + 8 * g) = (f32x4){acc[4 * g], acc[4 * g + 1], acc[4 * g + 2], acc[4 * g + 3]}; }
    }
#undef ML_LOAD
}

#ifndef SCAN_B
#define SCAN_B 16
#endif
__device__ __forceinline__ void p5_scans(const Frame& F) {
    const float* bA = (const float*)(F.ws + WS_BA); const float* dS = (const float*)(F.ws + WS_DS); bf16* SP = (bf16*)(F.ws + WS_SP);
    float* mg = (float*)(F.ws + WS_MG); const float* dC = (const float*)(F.ws + WS_DC); bf16* CP = (bf16*)(F.ws + WS_CP);
    for (int grp = blockIdx.x + F.G * F.wave; grp < 1155; grp += F.G * 8) {
        const int l = F.lane;
        if (grp < 384) {
            const int i = grp * 64 + l, h = i >> 11, rem = i & 2047, e = rem >> 4, d4 = (rem & 15) * 4;
            f32x4 S = {0.f, 0.f, 0.f, 0.f};
            for (int c0 = 0; c0 < NCH; c0 += SCAN_B) { f32x4 dl[SCAN_B]; f32x4 dc[SCAN_B];
#pragma unroll
                for (int k = 0; k < SCAN_B; ++k) { const int c = c0 + k; dl[k] = *(const f32x4*)(dS + ((size_t)(c * 12 + h) * 128 + e) * 64 + d4); dc[k] = *(const f32x4*)(bA + (size_t)(c * 64 + 63) * 768 + h * 64 + d4); }
#pragma unroll
                for (int k = 0; k < SCAN_B; ++k) { const int c = c0 + k; u32x2 w; w.x = pk2(S[0], S[1]); w.y = pk2(S[2], S[3]); *(u32x2*)(SP + ((size_t)(c * 12 + h) * 128 + e) * 64 + d4) = w;
                    const float dv[4] = {dl[k][0], dl[k][1], dl[k][2], dl[k][3]};
#pragma unroll
                    for (int q = 0; q < 4; ++q) S[q] = __expf(dc[k][q]) * S[q] + dv[q]; } }
        } else {
            const int i = (grp - 384) * 64 + l; const bool isn = i >= 49152; const int ii = isn ? i - 49152 : i;
            const int h = isn ? (ii >> 5) : (ii >> 13), rem = ii & 8191, e = rem >> 5, d4 = (ii & 31) * 4;
            f32x4 S = {0.f, 0.f, 0.f, 0.f}; float m = 0.f;
            for (int c0 = 0; c0 < NCH; c0 += SCAN_B) { f32x4 dl[SCAN_B]; f32x2 ml[SCAN_B];
#pragma unroll
                for (int k = 0; k < SCAN_B; ++k) { const int c = c0 + k; ml[k] = *(const f32x2*)(mg + MG_ML + (size_t)(c * 6 + h) * 2);
                    if (isn) dl[k] = *(const f32x4*)(mg + MG_DN + (size_t)(c * 6 + h) * 128 + d4);
                    else dl[k] = *(const f32x4*)(dC + ((size_t)(c * 6 + h) * 256 + e) * 128 + d4); }
#pragma unroll
                for (int k = 0; k < SCAN_B; ++k) { const int c = c0 + k;
                    if (isn) { *(f32x4*)(mg + MG_NP + (size_t)(c * 6 + h) * 128 + d4) = S; if (d4 == 0) mg[MG_MP + (size_t)(c * 6 + h)] = m; }
                    else { u32x2 w; w.x = pk2(S[0], S[1]); w.y = pk2(S[2], S[3]); *(u32x2*)(CP + ((size_t)(c * 6 + h) * 256 + e) * 128 + d4) = w; }
                    const float a_state = ml[k][0] + m, m_new = fmaxf(a_state, ml[k][1]), f1 = __expf(a_state - m_new), f2 = __expf(ml[k][1] - m_new);
#pragma unroll
                    for (int q = 0; q < 4; ++q) S[q] = f1 * S[q] + f2 * dl[k][q];
                    m = m_new; } }
        }
    }
}

__device__ __forceinline__ unsigned long long perm_word(unsigned long long x) {
    unsigned long long t;
    t = ((x >> 4) ^ x) & 0x00F000F000F000F0ull; x ^= t ^ (t << 4);
    t = ((x >> 8) ^ x) & 0x0000FF000000FF00ull; x ^= t ^ (t << 8);
    t = ((x >> 16) ^ x) & 0x00000000FFFF0000ull; x ^= t ^ (t << 16);
    return x;
}
__device__ __forceinline__ void p5_select(const Frame& F) {
    const _Float16* sc = (const _Float16*)(F.ws + WS_SCORE); unsigned long long* mask = (unsigned long long*)(F.ws + WS_MASK);
    LAS unsigned char* wl = F.lds + F.wave * 12304;
    LAS unsigned* hist = (LAS unsigned*)wl;
    LAS unsigned* words = (LAS unsigned*)(wl + 8192);
    LAS float* cval = (LAS float*)(wl + 8192 + 2048);
    LAS int* ckey = (LAS int*)(wl + 8192 + 3072);
    const float PINF = __builtin_inff();
    for (int t = F.gw; t < SEQ; t += F.NGW) {
        int lane = F.lane; asm volatile("" : "+v"(lane));
        const unsigned long long lt_mask = (1ull << lane) - 1ull; const int lane8 = lane * 8;
        const int n = t + 1, nw = 4 * (t / 256 + 1), ng = (n + 63) >> 6;
        const _Float16* row = sc + (size_t)t * SEQ; unsigned long long* mrow = mask + (size_t)t * 256;
        if (n <= 256) {
            if (lane < nw) { const int k0 = lane * 64; const unsigned long long w = (t >= k0 + 63) ? ~0ull : (t < k0 ? 0ull : ((2ull << (t - k0)) - 1ull)); mrow[lane] = perm_word(w); }
            continue; }
        typedef _Float16 h16x8 __attribute__((ext_vector_type(8))); typedef _Float16 h16x2 __attribute__((ext_vector_type(2)));
        const int ng8 = (n + 511) >> 9, glast = ng8 - 1; const h16x8* row8 = (const h16x8*)row + lane;
        u32x4 vv[32];
#pragma unroll
        for (int g = 0; g < 32; ++g) vv[g] = *(const u32x4*)(row8 + (g < ng8 ? g : 0) * 64);
        int nvl = n - 512 * glast - lane8; nvl = nvl < 0 ? 0 : (nvl > 8 ? 8 : nvl); const unsigned vlast = (1u << nvl) - 1u;
#define SEL_FILL(G, FILLPAIR) do { unsigned* d_ = (unsigned*)&vv[G]; _Pragma("unroll") for (int q_ = 0; q_ < 4; ++q_) { \
            const unsigned keep_ = (((vlast >> (2 * q_)) & 1u) ? 0x0000ffffu : 0u) | (((vlast >> (2 * q_ + 1)) & 1u) ? 0xffff0000u : 0u); d_[q_] = (d_[q_] & keep_) | ((FILLPAIR) & ~keep_); } } while (0)
#pragma unroll
        for (int g = 0; g < 32; ++g) if (g == glast) { const unsigned f0 = (unsigned)__builtin_amdgcn_readfirstlane((int)vv[g].x) & 0xffffu; SEL_FILL(g, f0 | (f0 << 16)); }
        h16x2 pmin = {(_Float16)65504.f, (_Float16)65504.f}, pmax = {(_Float16)-65504.f, (_Float16)-65504.f};
#pragma unroll
        for (int g = 0; g < 32; ++g) if (g < ng8) {
#pragma unroll
            for (int q = 0; q < 4; ++q) { const h16x2 x = __builtin_bit_cast(h16x2, ((const unsigned*)&vv[g])[q]); pmin = __builtin_elementwise_min(pmin, x); pmax = __builtin_elementwise_max(pmax, x); } }
        float lmin = fminf((float)pmin[0], (float)pmin[1]), lmax = fmaxf((float)pmax[0], (float)pmax[1]);
        lmin = -wave_max(-lmin, lane); lmax = wave_max(lmax, lane);
        const float span = lmax - lmin, lo = lmin, scale = span > 0.f ? 2047.0f / span : 0.f, los = -lo * scale;
        { const unsigned fm = (unsigned)__builtin_bit_cast(unsigned short, (_Float16)lmin);
#pragma unroll
          for (int g = 0; g < 32; ++g) if (g == glast) SEL_FILL(g, fm | (fm << 16)); }
#undef SEL_FILL
#pragma unroll
        for (int k = 0; k < 8; ++k) *(LAS u32x4*)(hist + (k * 64 + lane) * 4) = (u32x4){0u, 0u, 0u, 0u};
#pragma unroll
        for (int k = 0; k < 2; ++k) *(LAS u32x4*)(words + (k * 64 + lane) * 4) = (u32x4){0u, 0u, 0u, 0u};
#define SEL_BIN(G, J) ({ const h16x2 x_ = __builtin_bit_cast(h16x2, ((const unsigned*)&vv[G])[(J) >> 1]); int b_ = (int)fmaf((float)x_[(J) & 1], scale, los); b_ = b_ < 0 ? 0 : (b_ > 2047 ? 2047 : b_); b_; })
#pragma unroll
        for (int g = 0; g < 32; ++g) asm volatile("" : "+v"(vv[g]));
#pragma unroll
        for (int g = 0; g < 32; ++g) if (g < ng8) {
#pragma unroll
            for (int j = 0; j < 8; ++j) { const int b = SEL_BIN(g, j); __hip_atomic_fetch_add(&hist[b], 1u, __ATOMIC_RELAXED, __HIP_MEMORY_SCOPE_WORKGROUP); } }
        unsigned mine = 0;
#pragma unroll
        for (int q = 0; q < 8; ++q) { const u32x4 x = *(const LAS u32x4*)(hist + lane * 32 + q * 4); mine += (x.x + x.y) + (x.z + x.w); }
        unsigned suf = mine;
#pragma unroll
        for (int o = 1; o < 64; o <<= 1) { const unsigned nb = shdn_u(suf, o, lane); if (lane + o < 64) suf += nb; }
        unsigned above = suf - mine; int Bl = -1; unsigned cal = 0;
        if (above < 256u && above + mine >= 256u) {
            for (int q = 31; q >= 0; --q) { const unsigned hq = hist[lane * 32 + q]; if (Bl < 0 && above + hq >= 256u) { Bl = lane * 32 + q; cal = above; } above += hq; } }
        const unsigned long long hitm = __ballot(Bl >= 0); const int src = hitm ? __builtin_ctzll(hitm) : 0;
        const int Bs = __builtin_amdgcn_readlane(Bl, src); const unsigned cnt_above = (unsigned)__builtin_amdgcn_readlane((int)cal, src);
#pragma unroll
        for (int g = 0; g < 32; ++g) asm volatile("" : "+v"(vv[g]));
        LAS unsigned char* wbytes = (LAS unsigned char*)words; LAS unsigned* mcnt = (LAS unsigned*)(ckey + 256);
        if (lane == 0) *mcnt = 0u;
#pragma unroll
        for (int g = 0; g < 32; ++g) if (g < ng8) { int b[8]; unsigned abits = 0u; bool anyc = false;
#pragma unroll
            for (int j = 7; j >= 0; --j) { b[j] = SEL_BIN(g, j); abits = __builtin_amdgcn_alignbit(abits, (unsigned)(Bs - b[j]), 31); anyc |= (b[j] == Bs); }
            const unsigned vm = (g == glast) ? vlast : 0xffu;
            wbytes[g * 64 + lane] = (unsigned char)(abits & vm);
            if (anyc) {
#pragma unroll
                for (int j = 0; j < 8; ++j) if (b[j] == Bs && ((vm >> j) & 1u)) { const unsigned pos = __hip_atomic_fetch_add(mcnt, 1u, __ATOMIC_RELAXED, __HIP_MEMORY_SCOPE_WORKGROUP);
                    if (pos < 256u) { const h16x2 x = __builtin_bit_cast(h16x2, ((const unsigned*)&vv[g])[j >> 1]); cval[pos] = (float)x[j & 1]; ckey[pos] = lane8 + (g * 512 + j); } } } }
#undef SEL_BIN
        const unsigned m = *mcnt;
        const unsigned need = 256u - cnt_above;
        if (m <= 256u) {
            for (unsigned c = lane; c < m; c += 64) { const float mv = cval[c]; const int mk = ckey[c]; unsigned rank = 0;
                for (unsigned j = 0; j < m; ++j) { const float ov = cval[j]; const int ok = ckey[j]; rank += (ov > mv || (ov == mv && ok < mk)) ? 1u : 0u; }
                if (rank < need) __hip_atomic_fetch_or(&words[2 * (mk >> 6) + ((mk >> 5) & 1)], 1u << (mk & 31), __ATOMIC_RELAXED, __HIP_MEMORY_SCOPE_WORKGROUP); }
        } else {
            for (int g = 0; g < ng; ++g) { const int key = g * 64 + lane; int b = -1; if (key < n) { b = (int)fmaf((float)row[key], scale, los); b = b < 0 ? 0 : (b > 2047 ? 2047 : b); }
                const unsigned long long bc = __ballot(b == Bs); if (lane == 0) { words[2 * g] |= (unsigned)bc; words[2 * g + 1] |= (unsigned)(bc >> 32); } }
        }
#pragma unroll
        for (int k = 0; k < 4; ++k) { const int w = lane + 64 * k; if (w < nw) { const unsigned long long x = (unsigned long long)words[2 * w] | ((unsigned long long)words[2 * w + 1] << 32); mrow[w] = perm_word(x); } }
    }
}

__device__ __forceinline__ void p6_gla_out(const Frame& F, const float* gain) {
    const bf16* z = (const bf16*)(F.ws + WS_Z); const float* bA = (const float*)(F.ws + WS_BA); const bf16* SP = (const bf16*)(F.ws + WS_SP); bf16* y = (bf16*)(F.ws + WS_Y);
    LAS bf16* qd = (LAS bf16*)F.lds;
    LAS bf16* ki = qd + 64 * 72;
    LAS bf16* vT = ki + 64 * 72;
    LAS bf16* scl = vT + 128 * 72;
    LAS float* part = (LAS float*)(scl + 64 * 72);
    const int r32 = F.lane & 31, hi = F.lane >> 5, s = F.tid >> 3, d8 = (F.tid & 7) * 8, e16 = (F.tid & 7) * 16;
    u32x4 qw, kw, vw0, vw1; f32x4 b0, b1;
#define GO_LOAD(u_) do { const int c_ = (u_) / 12, h_ = (u_) % 12, t0_ = c_ * 64; const bf16* zr_ = z + (size_t)(t0_ + s) * ZW; qw = *(const u32x4*)(zr_ + ZQ_A + h_ * 64 + d8); kw = *(const u32x4*)(zr_ + ZK_A + h_ * 64 + d8); \
        const float* bp_ = bA + (size_t)(t0_ + s) * 768 + h_ * 64 + d8; b0 = *(const f32x4*)bp_; b1 = *(const f32x4*)(bp_ + 4); vw0 = *(const u32x4*)(zr_ + ZV_A + h_ * 128 + e16); vw1 = *(const u32x4*)(zr_ + ZV_A + h_ * 128 + e16 + 8); } while (0)
    int u = blockIdx.x; if (u < NCH * 12) GO_LOAD(u);
    for (; u < NCH * 12; u += F.G) {
        const int c = u / 12, h = u % 12, t0 = c * 64;
        __syncthreads();
        { float qv[8], kv[8], qo[8], ko[8]; unpack8(qw, qv); unpack8(kw, kv);
#pragma unroll
          for (int j = 0; j < 4; ++j) { const float ea = __expf(b0[j]), eb = __expf(b1[j]); qo[j] = qv[j] * 0.125f * ea; qo[4 + j] = qv[4 + j] * 0.125f * eb; ko[j] = kv[j] / ea; ko[4 + j] = kv[4 + j] / eb; }
          *(LAS u32x4*)(qd + s * 72 + d8) = pack8f(qo); *(LAS u32x4*)(ki + s * 72 + d8) = pack8f(ko);
          const unsigned ww[8] = {vw0.x, vw0.y, vw0.z, vw0.w, vw1.x, vw1.y, vw1.z, vw1.w};
#pragma unroll
          for (int j = 0; j < 8; ++j) { vT[(e16 + 2 * j) * 72 + s] = (bf16)(ww[j] & 0xffffu); vT[(e16 + 2 * j + 1) * 72 + s] = (bf16)(ww[j] >> 16); } }
        __syncthreads();
        if (u + F.G < NCH * 12) GO_LOAD(u + F.G);
        const int et = F.wave >> 1, tt = F.wave & 1, t = 32 * tt + r32;
        bf16x8 sa[4]; u32x2 gzv[4];
        { const bf16* sp = SP + ((size_t)u * 128 + 32 * et + r32) * 64 + 8 * hi;
#pragma unroll
          for (int kk = 0; kk < 4; ++kk) sa[kk] = *(const bf16x8*)(sp + 16 * kk);
#pragma unroll
          for (int g = 0; g < 4; ++g) gzv[g] = *(const u32x2*)(z + (size_t)(t0 + t) * ZW + ZGATE_A + h * 128 + 32 * et + 8 * g + 4 * hi); }
        if (F.wave < 4) { const int st = F.wave >> 1; f32x16 acc = zero16();
#pragma unroll
            for (int kk = 0; kk < 4; ++kk) { const bf16x8 a = *(const LAS bf16x8*)(ki + (32 * st + r32) * 72 + 16 * kk + 8 * hi), b = *(const LAS bf16x8*)(qd + (32 * tt + r32) * 72 + 16 * kk + 8 * hi); acc = mfma32(a, b, acc); }
#pragma unroll
            for (int g = 0; g < 4; ++g) { const int sb = 32 * st + 8 * g + 4 * hi; float m[4];
#pragma unroll
                for (int j = 0; j < 4; ++j) m[j] = (sb + j <= t) ? acc[4 * g + j] : 0.f;
                u32x2 w; w.x = pk2(m[0], m[1]); w.y = pk2(m[2], m[3]); *(LAS u32x2*)(scl + t * 72 + sb) = w; } }
        __syncthreads();
        f32x16 acc = zero16();
#pragma unroll
        for (int kk = 0; kk < 4; ++kk) { const bf16x8 b = *(const LAS bf16x8*)(qd + t * 72 + 16 * kk + 8 * hi); acc = mfma32(sa[kk], b, acc); }
#pragma unroll
        for (int kk = 0; kk < 4; ++kk) { const bf16x8 a = *(const LAS bf16x8*)(vT + (32 * et + r32) * 72 + 16 * kk + 8 * hi), b = *(const LAS bf16x8*)(scl + t * 72 + 16 * kk + 8 * hi); acc = mfma32(a, b, acc); }
        float ss = 0.f;
#pragma unroll
        for (int r = 0; r < 16; ++r) ss += acc[r] * acc[r];
        ss += shx(ss, 32, F.lane);
        if (hi == 0) part[t * 4 + et] = ss;
        __syncthreads();
        const f32x4 pp = *(const LAS f32x4*)(part + t * 4); const float rs = 1.0f / sqrtf(((pp[0] + pp[1]) + (pp[2] + pp[3])) * (1.0f / 128.0f) + NORM_EPS);
#pragma unroll
        for (int g = 0; g < 4; ++g) { const int e0 = 32 * et + 8 * g + 4 * hi; const f32x4 gv = *(const f32x4*)(gain + h * 128 + e0);
            const u32x2 gz = gzv[g]; const float ga[4] = {bflo(gz.x), bfhi(gz.x), bflo(gz.y), bfhi(gz.y)}; float o[4];
#pragma unroll
            for (int j = 0; j < 4; ++j) o[j] = acc[4 * g + j] * rs * gv[j] * siluf_(ga[j]);
            u32x2 w; w.x = pk2(o[0], o[1]); w.y = pk2(o[2], o[3]); *(u32x2*)(y + (size_t)(t0 + t) * DM + YA + h * 128 + e0) = w; }
    }
#undef GO_LOAD
}

__device__ __forceinline__ void p6_mlstm_out(const Frame& F, const float* gain) {
    const bf16* z = (const bf16*)(F.ws + WS_Z); const bf16* cq = (const bf16*)(F.ws + WS_CQ); const bf16* ck = (const bf16*)(F.ws + WS_CK); const float* mg = (const float*)(F.ws + WS_MG);
    const bf16* CP = (const bf16*)(F.ws + WS_CP); bf16* y = (bf16*)(F.ws + WS_Y);
    LAS bf16* qs = (LAS bf16*)F.lds;
    LAS bf16* ks = qs + 64 * 136;
    LAS bf16* vT = ks + 64 * 136;
    LAS bf16* pw = vT + 256 * 72;
    LAS float* fl = (LAS float*)(pw + 64 * 72);
    LAS float* bc = fl;
    LAS float* ig = fl + 64;
    LAS float* mt = fl + 128;
    LAS float* wi = fl + 192;
    LAS float* qn = fl + 256;
    LAS float* rp = fl + 320;
    LAS float* np = fl + 448;
    LAS float* sp = fl + 576;
    const int r32 = F.lane & 31, hi = F.lane >> 5, s = F.tid >> 3, d16 = (F.tid & 7) * 16, e32 = (F.tid & 7) * 32;
    u32x4 qw0, qw1, kw0, kw1, vw[4]; float gb = 0.f, gi = 0.f, gn0 = 0.f, gn1 = 0.f, gmp = 0.f;
#define MO_LOAD(u_) do { const int c_ = (u_) / 6, h_ = (u_) % 6, t0_ = c_ * 64; const bf16* qp_ = cq + (size_t)(t0_ + s) * 768 + h_ * 128 + d16; const bf16* kp_ = ck + (size_t)(t0_ + s) * 768 + h_ * 128 + d16; \
        qw0 = *(const u32x4*)qp_; qw1 = *(const u32x4*)(qp_ + 8); kw0 = *(const u32x4*)kp_; kw1 = *(const u32x4*)(kp_ + 8); \
        const bf16* vp_ = z + (size_t)(t0_ + s) * ZW + ZV_C + h_ * 256 + e32; _Pragma("unroll") for (int q_ = 0; q_ < 4; ++q_) vw[q_] = *(const u32x4*)(vp_ + 8 * q_); \
        gmp = mg[MG_MP + (size_t)(u_)]; \
        if (F.wave == 0) { gb = mg[MG_B + (size_t)(t0_ + F.lane) * 8 + h_]; gi = mg[MG_I + (size_t)(t0_ + F.lane) * 8 + h_]; } \
        if (F.wave == 1) { gn0 = mg[MG_NP + (size_t)(u_) * 128 + F.lane]; gn1 = mg[MG_NP + (size_t)(u_) * 128 + 64 + F.lane]; } } while (0)
    int u = blockIdx.x; if (u < NCH * 6) MO_LOAD(u);
    for (; u < NCH * 6; u += F.G) {
        const int c = u / 6, h = u % 6, t0 = c * 64;
        __syncthreads();
        { *(LAS u32x4*)(qs + s * 136 + d16) = qw0; *(LAS u32x4*)(qs + s * 136 + d16 + 8) = qw1; *(LAS u32x4*)(ks + s * 136 + d16) = kw0; *(LAS u32x4*)(ks + s * 136 + d16 + 8) = kw1;
#pragma unroll
          for (int q = 0; q < 4; ++q) { const unsigned ww[4] = {vw[q].x, vw[q].y, vw[q].z, vw[q].w};
#pragma unroll
              for (int j = 0; j < 4; ++j) { vT[(e32 + 8 * q + 2 * j) * 72 + s] = (bf16)(ww[j] & 0xffffu); vT[(e32 + 8 * q + 2 * j + 1) * 72 + s] = (bf16)(ww[j] >> 16); } } }
        const float m_prev = gmp;
        if (F.wave == 0) { const float b = gb, ii = gi; float pm = ii - b;
#pragma unroll
            for (int o = 1; o < 64; o <<= 1) { const float nb = shup(pm, o, F.lane); if (F.lane >= o) pm = fmaxf(pm, nb); }
            const float m = b + fmaxf(m_prev, pm); bc[F.lane] = b; ig[F.lane] = ii; mt[F.lane] = m; wi[F.lane] = __expf(b + m_prev - m); }
        if (F.wave == 1) { np[F.lane] = gn0; np[64 + F.lane] = gn1; }
        __syncthreads();
        if (u + F.G < NCH * 6) MO_LOAD(u + F.G);
        const int et = F.wave; bf16x8 ca[8];
        { const bf16* cp = CP + ((size_t)u * 256 + 32 * et + r32) * 128 + 8 * hi;
#pragma unroll
          for (int kk = 0; kk < 8; ++kk) ca[kk] = *(const bf16x8*)(cp + 16 * kk); }
        if (F.wave >= 4) { const int tq = (F.tid - 256) >> 2, qq = (F.tid - 256) & 3; float s = 0.f;
#pragma unroll 8
            for (int d = 0; d < 32; ++d) s += bf2f(qs[tq * 136 + qq * 32 + d]) * np[qq * 32 + d];
            s += shx(s, 1, F.lane); s += shx(s, 2, F.lane); if (qq == 0) qn[tq] = s; }
        else { const int st = F.wave >> 1, tt = F.wave & 1, t = 32 * tt + r32; f32x16 acc = zero16();
#pragma unroll
            for (int kk = 0; kk < 8; ++kk) { const bf16x8 a = *(const LAS bf16x8*)(ks + (32 * st + r32) * 136 + 16 * kk + 8 * hi), b = *(const LAS bf16x8*)(qs + t * 136 + 16 * kk + 8 * hi); acc = mfma32(a, b, acc); }
            const float bt = bc[t], mtt = mt[t]; float rsum = 0.f;
#pragma unroll
            for (int g = 0; g < 4; ++g) { const int sb = 32 * st + 8 * g + 4 * hi; float m[4];
#pragma unroll
                for (int j = 0; j < 4; ++j) { const int s = sb + j; const float w = (s <= t) ? __expf(bt - bc[s] + ig[s] - mtt) : 0.f; m[j] = acc[4 * g + j] * w; rsum += m[j]; }
                u32x2 w2; w2.x = pk2(m[0], m[1]); w2.y = pk2(m[2], m[3]); *(LAS u32x2*)(pw + t * 72 + sb) = w2; }
            rsum += shx(rsum, 32, F.lane); if (hi == 0) rp[t * 2 + st] = rsum; }
        __syncthreads();
        f32x16 hv[2];
        { bf16x8 va[4];
#pragma unroll
          for (int kk = 0; kk < 4; ++kk) va[kk] = *(const LAS bf16x8*)(vT + (32 * et + r32) * 72 + 16 * kk + 8 * hi);
#pragma unroll
          for (int tt = 0; tt < 2; ++tt) { const int t = 32 * tt + r32; f32x16 aI = zero16(), aA = zero16();
#pragma unroll
              for (int kk = 0; kk < 8; ++kk) { const bf16x8 b = *(const LAS bf16x8*)(qs + t * 136 + 16 * kk + 8 * hi); aI = mfma32(ca[kk], b, aI); }
#pragma unroll
              for (int kk = 0; kk < 4; ++kk) { const bf16x8 b = *(const LAS bf16x8*)(pw + t * 72 + 16 * kk + 8 * hi); aA = mfma32(va[kk], b, aA); }
              const float w = wi[t], den = w * qn[t] + rp[t * 2] + rp[t * 2 + 1], dn = 1.0f / fmaxf(fabsf(den), __expf(-mt[t])); float ss = 0.f;
#pragma unroll
              for (int r = 0; r < 16; ++r) { const float x = (w * aI[r] + aA[r]) * dn; hv[tt][r] = x; ss += x * x; }
              ss += shx(ss, 32, F.lane); if (hi == 0) sp[t * 8 + et] = ss; } }
        __syncthreads();
#pragma unroll
        for (int tt = 0; tt < 2; ++tt) { const int t = 32 * tt + r32; const f32x4 p0 = *(const LAS f32x4*)(sp + t * 8), p1 = *(const LAS f32x4*)(sp + t * 8 + 4);
            const float rs = 1.0f / sqrtf((((p0[0] + p0[1]) + (p0[2] + p0[3])) + ((p1[0] + p1[1]) + (p1[2] + p1[3]))) * (1.0f / 256.0f) + NORM_EPS);
            const bf16* zr = z + (size_t)(t0 + t) * ZW + h * 256;
#pragma unroll
            for (int g = 0; g < 4; ++g) { const int e0 = 32 * et + 8 * g + 4 * hi; const f32x4 gv = *(const f32x4*)(gain + h * 256 + e0);
                const u32x2 oz = *(const u32x2*)(zr + ZO_C + e0), gz = *(const u32x2*)(zr + ZGATE_C + e0);
                const float oa[4] = {bflo(oz.x), bfhi(oz.x), bflo(oz.y), bfhi(oz.y)}, ga[4] = {bflo(gz.x), bfhi(gz.x), bflo(gz.y), bfhi(gz.y)}; float o[4];
#pragma unroll
                for (int j = 0; j < 4; ++j) o[j] = hv[tt][4 * g + j] * rs * gv[j] * sigmoidf_(oa[j]) * siluf_(ga[j]);
                u32x2 w; w.x = pk2(o[0], o[1]); w.y = pk2(o[2], o[3]); *(u32x2*)(y + (size_t)(t0 + t) * DM + YC + h * 256 + e0) = w; } }
    }
#undef MO_LOAD
}

namespace dsa {
constexpr int D = 128, NW = 8, QBLK = 32, KVBLK = 64, QB = NW * QBLK;
constexpr int SHM_V = KVBLK * D * 2, SHM_K = KVBLK * D * 2;
constexpr int LDS_BYTES = 2 * SHM_V + 2 * SHM_K + NW * 64 * 4;
constexpr float SCALE = 0.08838834764831845f;
constexpr float THR = 8.f;
constexpr bool WSKIP = false;
constexpr size_t VOFF = (WS_VA - WS_KA) / 2;
typedef short s16x4 __attribute__((ext_vector_type(4)));
template <class A, class Bt> struct same_t { static constexpr bool v = false; };
template <class A> struct same_t<A, A> { static constexpr bool v = true; };
#define KSWZ(row, colB) ((row) * 256 + ((colB) ^ (((row) & 7) << 4)))
#define SBAR() __builtin_amdgcn_sched_barrier(0)
__device__ __forceinline__ int v_st(int k, int c) { const int kk = (k & ~0xC) | ((k & 4) << 1) | ((k & 8) >> 1); return ((kk >> 3) * 4 + (c >> 5)) * 512 + ((kk & 7) * 32 + (c & 31)) * 2; }
__device__ __forceinline__ int v_rd_base(int lane) { return ((lane & 3) << 3) | (((lane >> 2) & 3) << 6) | (((lane >> 4) & 1) << 5) | (((lane >> 5) & 1) << 8); }
constexpr int v_rd_off(int d0, int ks, int half) { return d0 * 512 + ks * 4096 + half * 2048; }
__device__ __forceinline__ unsigned cvtpk(float lo, float hi) {
    unsigned r; asm volatile("v_cvt_pk_bf16_f32 %0, %1, %2" : "=v"(r) : "v"(lo), "v"(hi)); return r;
}
__device__ __forceinline__ bf16x8 pack8(f32x4 a, f32x4 b) {
    u32x4 w = {cvtpk(a[0], a[1]), cvtpk(a[2], a[3]), cvtpk(b[0], b[1]), cvtpk(b[2], b[3])};
    return *reinterpret_cast<bf16x8*>(&w);
}
template <class T> __device__ __forceinline__ bf16x8 load8(const T* p) {
    if constexpr (same_t<T, float>::v) { return pack8(*(const f32x4*)p, *(const f32x4*)(p + 4)); }
    else { return *reinterpret_cast<const bf16x8*>(p); }
}
__device__ __forceinline__ void mask_bits(f32x16& p0, f32x16& p1, unsigned w) {
#pragma unroll
    for (int r = 0; r < 16; ++r) {
        const unsigned m0 = (unsigned)__builtin_amdgcn_sbfe((int)w, r, 1), m1 = (unsigned)__builtin_amdgcn_sbfe((int)w, 16 + r, 1);
        p0[r] = __uint_as_float((__float_as_uint(p0[r]) & m0) | (0xff800000u & ~m0));
        p1[r] = __uint_as_float((__float_as_uint(p1[r]) & m1) | (0xff800000u & ~m1));
    }
}
__device__ __forceinline__ void partialSM(f32x16& p0, f32x16& p1, float& m_reg, float& mn, float& alpha) {
    float pmax = p0[0]; for (int r = 1; r < 16; ++r) pmax = fmaxf(pmax, p0[r]); for (int r = 0; r < 16; ++r) pmax = fmaxf(pmax, p1[r]);
    { auto rr = __builtin_amdgcn_permlane32_swap(__float_as_uint(pmax), __float_as_uint(pmax), false, false);
      pmax = fmaxf(__uint_as_float(rr[0]), __uint_as_float(rr[1])); }
    constexpr float C2 = 1.4426950408889634f * SCALE;
    if (__builtin_expect(__all((pmax - m_reg) * SCALE <= THR), 1)) { mn = m_reg; alpha = 1.f; }
    else { mn = fmaxf(m_reg, pmax); alpha = __builtin_amdgcn_exp2f((m_reg - mn) * C2); m_reg = mn; }
    const float mnL = -mn * C2;
    for (int r = 0; r < 16; ++r) p0[r] = fmaf(p0[r], C2, mnL); for (int r = 0; r < 16; ++r) p1[r] = fmaf(p1[r], C2, mnL);
    for (int r = 0; r < 16; ++r) p0[r] = __builtin_amdgcn_exp2f(p0[r]);
}
__device__ __forceinline__ void finishSM(f32x16& p0, f32x16& p1, float alpha, float& l_reg, bf16x8& pa0, bf16x8& pa1, bf16x8& pa2, bf16x8& pa3) {
    for (int r = 0; r < 16; ++r) p1[r] = __builtin_amdgcn_exp2f(p1[r]);
    float ps = 0; for (int r = 0; r < 16; ++r) ps += p0[r]; for (int r = 0; r < 16; ++r) ps += p1[r];
    { auto rr = __builtin_amdgcn_permlane32_swap(__float_as_uint(ps), __float_as_uint(ps), false, false);
      ps = __uint_as_float(rr[0]) + __uint_as_float(rr[1]); }
    l_reg = l_reg * alpha + ps;
#define PK4(P, B_, OUT) do { unsigned a0 = cvtpk(P[B_+0], P[B_+1]), a1 = cvtpk(P[B_+2], P[B_+3]);                          \
        unsigned b0 = cvtpk(P[B_+4], P[B_+5]), b1 = cvtpk(P[B_+6], P[B_+7]);                                             \
        auto r0 = __builtin_amdgcn_permlane32_swap(a0, b0, false, false); auto r1 = __builtin_amdgcn_permlane32_swap(a1, b1, false, false); \
        u32x4 w = {r0[0], r1[0], r0[1], r1[1]}; OUT = *reinterpret_cast<bf16x8*>(&w); } while (0)
    PK4(p0, 0, pa0); PK4(p0, 8, pa1); PK4(p1, 0, pa2); PK4(p1, 8, pa3);
#undef PK4
}
template <int KB, bool SK>
__device__ __forceinline__ void qkt(f32x16& p0, f32x16& p1, const char* K_lds, int r32, int hi, const bf16x8* qr, bool act) {
    if (SK && !act) { const float NEG = -__builtin_inff();
#pragma unroll
        for (int r = 0; r < 16; ++r) { p0[r] = NEG; p1[r] = NEG; } return; }
    p0 = f32x16{}; p1 = f32x16{};
    const char* kb[4];
#pragma unroll
    for (int dd = 0; dd < 4; ++dd) kb[dd] = K_lds + KB * SHM_K + KSWZ(r32, (dd * 16 + hi * 8) * 2);
#pragma unroll
    for (int d0 = 0; d0 < 8; ++d0) { const char* a = kb[d0 & 3] + (d0 >> 2) * 128;
        bf16x8 b0 = *reinterpret_cast<const bf16x8*>(a);
        bf16x8 b1 = *reinterpret_cast<const bf16x8*>(a + 32 * 256);
        p0 = __builtin_amdgcn_mfma_f32_32x32x16_bf16(b0, qr[d0], p0, 0, 0, 0);
        p1 = __builtin_amdgcn_mfma_f32_32x32x16_bf16(b1, qr[d0], p1, 0, 0, 0); }
}
template <int VB, bool SK>
__device__ __forceinline__ void pv_tile(f32x16* o, int vb0, bf16x8 pa0, bf16x8 pa1, bf16x8 pa2, bf16x8 pa3, bool act) {
    if (SK && !act) return;
#define TRRD(dst, off) asm volatile("ds_read_b64_tr_b16 %0, %1 offset:%2" : "=&v"(dst) : "v"(vb0), "i"(off) : "memory")
#define PV_D0(d0) do { s16x4 l0, l1, l2, l3, h0, h1, h2, h3; constexpr int b_ = VB * SHM_V + v_rd_off(d0, 0, 0);     \
        TRRD(l0, b_); TRRD(h0, b_ + 2048); TRRD(l1, b_ + 4096); TRRD(h1, b_ + 6144); TRRD(l2, b_ + 8192); TRRD(h2, b_ + 10240); TRRD(l3, b_ + 12288); TRRD(h3, b_ + 14336); \
        asm volatile("s_waitcnt lgkmcnt(0)" ::: "memory"); SBAR();                 \
        o[d0] = __builtin_amdgcn_mfma_f32_32x32x16_bf16(pa0, (bf16x8){l0[0], l0[1], l0[2], l0[3], h0[0], h0[1], h0[2], h0[3]}, o[d0], 0, 0, 0);   \
        o[d0] = __builtin_amdgcn_mfma_f32_32x32x16_bf16(pa1, (bf16x8){l1[0], l1[1], l1[2], l1[3], h1[0], h1[1], h1[2], h1[3]}, o[d0], 0, 0, 0);   \
        o[d0] = __builtin_amdgcn_mfma_f32_32x32x16_bf16(pa2, (bf16x8){l2[0], l2[1], l2[2], l2[3], h2[0], h2[1], h2[2], h2[3]}, o[d0], 0, 0, 0);   \
        o[d0] = __builtin_amdgcn_mfma_f32_32x32x16_bf16(pa3, (bf16x8){l3[0], l3[1], l3[2], l3[3], h3[0], h3[1], h3[2], h3[3]}, o[d0], 0, 0, 0); } while (0)
    PV_D0(0); PV_D0(1); PV_D0(2); PV_D0(3);
#undef PV_D0
#undef TRRD
}
template <class TIn, class TOut> struct BlockRef { const TIn* Q; const TIn* K; const unsigned long long* M; int P0; };
template <class TIn> struct Seam {
    bf16x8 qr[8];
    bf16x8 st_v0, st_v1, st_k0, st_k1; f32x4 sf0, sf1, sf2, sf3;
    f32x4 tq[16];
};
__device__ __forceinline__ int swa_jlo(int P0, int W) { const int lowk = P0 - W + 1; return lowk > 0 ? lowk / KVBLK : 0; }
#define ROW(p, k0, rr) ((p) + (size_t)((k0) + (rr)) * D + sc)
#define VMW() asm volatile("s_waitcnt vmcnt(0)" ::: "memory")
#define VMWN(n) asm volatile("s_waitcnt vmcnt(%0)" :: "i"(n) : "memory")
#define SLOAD_H(Kp, Vp, k0) do { S.st_v0 = load8<TIn>(ROW(Vp, k0, sr)); S.st_v1 = load8<TIn>(ROW(Vp, k0, 32 + sr));              \
                         S.st_k0 = load8<TIn>(ROW(Kp, k0, sr)); S.st_k1 = load8<TIn>(ROW(Kp, k0, 32 + sr)); } while (0)
#define SWRITE_HK(bf) do { *(bf16x8*)(K_lds + (bf) * SHM_K + kws) = S.st_k0; *(bf16x8*)(K_lds + (bf) * SHM_K + kws + 32 * 256) = S.st_k1; } while (0)
#define SWRITE_HV(bf) do { *(bf16x8*)(V_lds + (bf) * SHM_V + vst0) = S.st_v0; *(bf16x8*)(V_lds + (bf) * SHM_V + vst1) = S.st_v1; } while (0)
#define SWRITE_H(bf) do { SWRITE_HV(bf); SWRITE_HK(bf); } while (0)
#define SLOAD_F(p, k0) do { S.sf0 = *(const f32x4*)ROW(p, k0, sr); S.sf1 = *(const f32x4*)(ROW(p, k0, sr) + 4);                \
                            S.sf2 = *(const f32x4*)ROW(p, k0, 32 + sr); S.sf3 = *(const f32x4*)(ROW(p, k0, 32 + sr) + 4); } while (0)
#define SWRITE_KF(bf) do { *(bf16x8*)(K_lds + (bf) * SHM_K + kws) = pack8(S.sf0, S.sf1); *(bf16x8*)(K_lds + (bf) * SHM_K + kws + 32 * 256) = pack8(S.sf2, S.sf3); } while (0)
#define SWRITE_VF(bf) do { *(bf16x8*)(V_lds + (bf) * SHM_V + vst0) = pack8(S.sf0, S.sf1); *(bf16x8*)(V_lds + (bf) * SHM_V + vst1) = pack8(S.sf2, S.sf3); } while (0)
template <class TIn, class TOut>
__device__ __forceinline__ void causal_swa_prime(const BlockRef<TIn, TOut>& cur, int W, char* lds, Seam<TIn>& S) {
    constexpr bool F32 = same_t<TIn, float>::v;
    int tid_l = threadIdx.x; asm volatile("" : "+v"(tid_l));
    const int tid = tid_l, wid = __builtin_amdgcn_readfirstlane(tid >> 6), lane = tid & 63, r32 = lane & 31, hi = lane >> 5;
    const int sr = tid >> 4, sc = (tid & 15) * 8, kws = KSWZ(sr, sc * 2); char* K_lds = lds + 2 * SHM_V;
    const int kb0 = swa_jlo(cur.P0, W) * KVBLK;
    for (int d0 = 0; d0 < 8; ++d0) S.qr[d0] = load8<TIn>(cur.Q + (size_t)(wid * QBLK + r32) * D + d0 * 16 + hi * 8);
    if constexpr (F32) { SLOAD_F((const float*)cur.K, kb0); VMW(); SWRITE_KF(0); SBAR(); SLOAD_F((const float*)(cur.K + VOFF), kb0); }
    else { SLOAD_H(cur.K, (cur.K + VOFF), kb0); VMW(); SWRITE_HK(0); }
    __syncthreads();
}
template <class TIn, class TOut>
__device__ __forceinline__ void causal_swa_block(const BlockRef<TIn, TOut>& cur, const BlockRef<TIn, TOut>& nxt, int skv, int W, char* lds, Seam<TIn>& S) {
    constexpr bool F32 = same_t<TIn, float>::v;
    int tid_l = threadIdx.x; asm volatile("" : "+v"(tid_l));
    const int tid = tid_l, wid = __builtin_amdgcn_readfirstlane(tid >> 6), lane = tid & 63, r32 = lane & 31, hi = lane >> 5;
    const int j_lo = swa_jlo(cur.P0, W);
    int j_hi = (cur.P0 + QB - 1) / KVBLK + 1; if (j_hi > skv / KVBLK) j_hi = skv / KVBLK;
    const int NT = j_hi - j_lo;
    const int kbn = swa_jlo(nxt.P0, W) * KVBLK;
    const int qlo = cur.P0 + wid * QBLK, qm = qlo + r32 - 4 * hi;
    char* V_lds = lds; char* K_lds = lds + 2 * SHM_V;
    float* ws = (float*)(lds + 2 * SHM_V + 2 * SHM_K) + wid * 64; float* li_l = ws, * al_l = ws + 32;
    float m_reg = -1e30f, l_reg = 0; f32x16 o[4] = {};
    const int sr = tid >> 4, sc = (tid & 15) * 8, vst0 = v_st(sr, sc), vst1 = v_st(32 + sr, sc), kws = KSWZ(sr, sc * 2);
    const int vb0 = (int)(uintptr_t)V_lds + v_rd_base(lane);
    const TIn* Kh = cur.K; const TIn* Vh = (cur.K + VOFF);
#define RESC(a) do { if (__any((a) < 1.f)) { if (hi == 0) al_l[r32] = (a); asm volatile("s_waitcnt lgkmcnt(0)" ::: "memory");              \
                     for (int d_ = 0; d_ < 4; ++d_) for (int r = 0; r < 16; ++r) o[d_][r] *= al_l[crow(r, hi)]; } } while (0)
#define KBASE(t) ((j_lo + (t)) * KVBLK)
#define ACT(t) (KBASE(t) <= qlo + QBLK - 1 && KBASE(t) + KVBLK - 1 >= qlo - W + 1)
#define MASKT(P0_, P1_, MW_) mask_bits(P0_, P1_, MW_)
    constexpr int NQL = F32 ? 16 : 8;
    constexpr bool SK = WSKIP && !F32;
#define SEAM_K0() do { VMWN(NQL); if constexpr (F32) { SWRITE_KF(0); SBAR(); SLOAD_F((const float*)(nxt.K + VOFF), kbn); } else { SWRITE_HK(0); } SBAR(); } while (0)
    f32x16 pA0, pA1, pB0, pB1; float mnA, mnB, alA, alB; bf16x8 pa0, pa1, pa2, pa3;
    const unsigned* M32 = (const unsigned*)cur.M;
#define MOFF() ({ int l_ = lane; asm volatile("" : "+v"(l_)); (unsigned)(wid * QBLK + (l_ & 31)) * 512u + (unsigned)(l_ >> 5); })
    unsigned mw = M32[MOFF()];
    if constexpr (F32) { VMW(); SWRITE_VF(0); SBAR(); } else { SWRITE_HV(0); SBAR(); }
    if (NT > 1) { if constexpr (F32) SLOAD_F((const float*)Kh, KBASE(1)); else SLOAD_H(Kh, Vh, KBASE(1)); }
    SBAR(); qkt<0, SK>(pA0, pA1, K_lds, r32, hi, S.qr, ACT(0));
    if constexpr (F32) { if (NT > 1) { VMW(); SWRITE_KF(1); SBAR(); SLOAD_F((const float*)Vh, KBASE(1)); } }
    MASKT(pA0, pA1, mw); partialSM(pA0, pA1, m_reg, mnA, alA);
    if (NT > 1) { VMW(); if constexpr (F32) { SWRITE_VF(1); SBAR(); if (NT > 2) SLOAD_F((const float*)Kh, KBASE(2)); } else SWRITE_H(1); }
    __syncthreads();
#define HALF_STEP(PX0, PX1, mnX, alX, PY0, PY1, alY, t, KB, VB, SB) do {                                                      \
        mw = M32[MOFF() + 2u * (unsigned)(t)];                                                                                     \
        SBAR(); qkt<KB, SK>(PX0, PX1, K_lds, r32, hi, S.qr, ACT(t));                                             \
        finishSM(PY0, PY1, alY, l_reg, pa0, pa1, pa2, pa3); SBAR();                                                           \
        if ((t) + 1 < NT) { if constexpr (F32) { VMW(); SWRITE_KF(SB); SBAR(); SLOAD_F((const float*)Vh, KBASE((t) + 1)); }  \
                            else { SLOAD_H(Kh, Vh, KBASE((t) + 1)); } SBAR(); }                                               \
        pv_tile<VB, SK>(o, vb0, pa0, pa1, pa2, pa3, ACT((t) - 1)); MASKT(PX0, PX1, mw); partialSM(PX0, PX1, m_reg, mnX, alX);                                        \
        __syncthreads();                                                                                                      \
        if ((t) + 1 < NT) { VMW(); if constexpr (F32) { SWRITE_VF(SB); SBAR(); if ((t) + 2 < NT) SLOAD_F((const float*)Kh, KBASE((t) + 2)); } \
                            else { SWRITE_H(SB); } }                                                                          \
        RESC(alX); __syncthreads(); } while (0)
    for (int t = 1; t + 1 < NT; t += 2) {
        HALF_STEP(pB0, pB1, mnB, alB, pA0, pA1, alA, t, 1, 0, 0);
        HALF_STEP(pA0, pA1, mnA, alA, pB0, pB1, alB, t + 1, 0, 1, 1);
    }
    const bool even = (NT & 1) == 0;
    if (even) { mw = M32[MOFF() + 2u * (unsigned)(NT - 1)]; SBAR(); qkt<1, SK>(pB0, pB1, K_lds, r32, hi, S.qr, ACT(NT - 1)); SBAR(); }
#define QROW(e) (nxt.Q + (size_t)(wid * QBLK + r32) * D + ((e) >> 1) * 16 + hi * 8 + ((e) & 1) * 4)
    if constexpr (F32) { SLOAD_F((const float*)nxt.K, kbn); SBAR();
#pragma unroll
        for (int e = 0; e < 8; ++e) S.tq[e] = *(const f32x4*)QROW(e); }
    else { SLOAD_H(nxt.K, (nxt.K + VOFF), kbn); SBAR();
#pragma unroll
        for (int d0 = 0; d0 < 8; ++d0) S.qr[d0] = load8<TIn>(nxt.Q + (size_t)(wid * QBLK + r32) * D + d0 * 16 + hi * 8); }
    SBAR();
    finishSM(pA0, pA1, alA, l_reg, pa0, pa1, pa2, pa3); SBAR();
    if constexpr (F32) {
#pragma unroll
        for (int e = 8; e < 16; ++e) S.tq[e] = *(const f32x4*)QROW(e); SBAR(); }
#undef QROW
    pv_tile<0, SK>(o, vb0, pa0, pa1, pa2, pa3, ACT(even ? NT - 2 : NT - 1));
    if (even) { MASKT(pB0, pB1, mw); partialSM(pB0, pB1, m_reg, mnB, alB); __syncthreads(); RESC(alB);
        finishSM(pB0, pB1, alB, l_reg, pa0, pa1, pa2, pa3); SBAR(); pv_tile<1, SK>(o, vb0, pa0, pa1, pa2, pa3, ACT(NT - 1)); }
    SBAR(); SEAM_K0();
    if (hi == 0) li_l[r32] = l_reg; asm volatile("s_waitcnt lgkmcnt(0)" ::: "memory");
    float rli[16];
#pragma unroll
    for (int r = 0; r < 16; ++r) rli[r] = __builtin_amdgcn_rcpf(li_l[crow(r, hi)]);
    TOut* Ow = ((TOut*)cur.Q) + (size_t)(wid * QBLK) * D;
#pragma unroll
    for (int r = 0; r < 16; ++r) { const int orow = crow(r, hi);
#pragma unroll
        for (int d0 = 0; d0 < 4; ++d0) { const float v = o[d0][r] * rli[r];
            if constexpr (same_t<TOut, float>::v) { Ow[(size_t)orow * D + d0 * 32 + r32] = v; }
            else { const float vn = __int_as_float(__builtin_amdgcn_ds_swizzle(__float_as_int(v), 0x041F));
                   if ((r32 & 1) == 0) *(unsigned*)(Ow + (size_t)orow * D + d0 * 32 + r32) = cvtpk(v, vn); } } }
    if constexpr (F32) {
#pragma unroll
        for (int d0 = 0; d0 < 8; ++d0) S.qr[d0] = pack8(S.tq[2 * d0], S.tq[2 * d0 + 1]); }
    __syncthreads();
#undef RESC
#undef KBASE
#undef ACT
#undef MASKT
#undef MOFF
#undef SEAM_K0
#undef HALF_STEP
}
#undef ROW
#undef VMW
#undef VMWN
#undef SLOAD_H
#undef SWRITE_HK
#undef SWRITE_HV
#undef SWRITE_H
#undef SLOAD_F
#undef SWRITE_KF
#undef SWRITE_VF

}

__device__ __forceinline__ void p6_dsa_attention(const Frame& F, char* lds_generic) {
    typedef dsa::BlockRef<unsigned short, unsigned short> Ref;
    const bf16* qA = (const bf16*)(F.ws + WS_QA); const bf16* kA = (const bf16*)(F.ws + WS_KA);
    const unsigned long long* mask = (const unsigned long long*)(F.ws + WS_MASK); const bf16* zz = (const bf16*)(F.ws + WS_Z); bf16* yy = (bf16*)(F.ws + WS_Y);
    constexpr int NQB = SEQ / dsa::QB, NITEM = 8 * (NQB / 2);
#define DSA_MKREF(R, item_, pass_) do { const int h_ = (item_) & 7, yy_ = (item_) >> 3, qb_ = (pass_) ? (NQB - 1 - yy_) : yy_, P0_ = qb_ * dsa::QB; \
        R.Q = qA + ((size_t)h_ * SEQ + P0_) * 128; R.K = kA + (size_t)h_ * SEQ * 128; R.M = mask + (size_t)P0_ * 256; R.P0 = P0_; } while (0)
    int item = blockIdx.x; if (item >= NITEM) return;
    int pass = 0; Ref cur; DSA_MKREF(cur, item, 0);
    dsa::Seam<unsigned short> S;
    __syncthreads();
    dsa::causal_swa_prime<unsigned short, unsigned short>(cur, 1 << 30, lds_generic, S);
    for (;;) {
        const bool more_pass = pass == 0, more_item = item + F.G < NITEM, last = !more_pass && !more_item;
        int itn = item, pn = pass + 1; if (!more_pass) { pn = 0; itn = more_item ? item + F.G : item; }
        Ref nxt = cur; if (!last) DSA_MKREF(nxt, itn, pn);
        dsa::causal_swa_block<unsigned short, unsigned short>(cur, nxt, SEQ, 1 << 30, lds_generic, S);
        if (!more_pass) {
            asm volatile("s_waitcnt vmcnt(0)" ::: "memory"); __syncthreads();
            __builtin_amdgcn_fence(__ATOMIC_ACQUIRE, "agent"); asm volatile("s_waitcnt vmcnt(0)" ::: "memory");
            const int h_ = item & 7, yy_ = item >> 3;
#pragma unroll 1
            for (int ps = 0; ps < 2; ++ps) { const int P0_ = (ps ? (NQB - 1 - yy_) : yy_) * dsa::QB;
#pragma unroll 1
                for (int i = F.tid; i < dsa::QB * 16; i += NTHR) { const int row = P0_ + (i >> 4), c8 = i & 15; float o[8], g[8];
                    unpack8(*(const u32x4*)(qA + ((size_t)h_ * SEQ + row) * 128 + c8 * 8), o); unpack8(*(const u32x4*)(zz + (size_t)row * ZW + ZGATE_B + h_ * 128 + c8 * 8), g);
#pragma unroll
                    for (int j = 0; j < 8; ++j) o[j] *= siluf_(g[j]);
                    *(u32x4*)(yy + (size_t)row * DM + YB + h_ * 128 + c8 * 8) = pack8f(o); } } }
        if (last) break;
        cur = nxt; item = itn; pass = pn;
    }
#undef DSA_MKREF
}

#ifdef DBG_CHECK
constexpr int DBG_T = 1024;
#if DBG_CHECK == 0
__device__ __forceinline__ void dbg_gla_seq(const Frame& F, float* ref) {
    const bf16* z = (const bf16*)(F.ws + WS_Z); const float* bA = (const float*)(F.ws + WS_BA);
    const int i4 = blockIdx.x * NTHR + F.tid; if (i4 >= 12 * 128 * 4) return;
    const int i = i4 >> 2, dq = (i4 & 3) * 16, h = i >> 7, e = i & 127; float S[16];
#pragma unroll
    for (int d = 0; d < 16; ++d) S[d] = 0.f;
    for (int t = 0; t < DBG_T; ++t) { const bf16* zr = z + (size_t)t * ZW; const float ve = bf2f(zr[ZV_A + h * 128 + e]); float o = 0.f;
#pragma unroll
        for (int d = 0; d < 16; ++d) { const float bt = bA[(size_t)t * 768 + h * 64 + dq + d], bp = (t & 63) ? bA[(size_t)(t - 1) * 768 + h * 64 + dq + d] : 0.f;
            S[d] = expf(bt - bp) * S[d] + bf2f(zr[ZK_A + h * 64 + dq + d]) * ve; o += bf2f(zr[ZQ_A + h * 64 + dq + d]) * 0.125f * S[d]; }
        o += shx(o, 1, F.lane); o += shx(o, 2, F.lane);
        if ((i4 & 3) == 0) ref[(size_t)t * 1536 + i] = o; }
}
#endif
#if DBG_CHECK == 1
__device__ __forceinline__ void dbg_mlstm_seq(const Frame& F, float* ref) {
    const bf16* z = (const bf16*)(F.ws + WS_Z); const bf16* cq = (const bf16*)(F.ws + WS_CQ); const bf16* ck = (const bf16*)(F.ws + WS_CK); const float* mg = (const float*)(F.ws + WS_MG);
    const int i = blockIdx.x * NTHR + F.tid; if (i >= 6 * 256) return;
    const int h = i >> 8, e = i & 255; float C[128]; float m = 0.f;
#pragma unroll
    for (int d = 0; d < 128; ++d) C[d] = 0.f;
    for (int t = 0; t < DBG_T; ++t) { const float bt = mg[MG_B + (size_t)t * 8 + h], bp = (t & 63) ? mg[MG_B + (size_t)(t - 1) * 8 + h] : 0.f, lf = bt - bp, ig = mg[MG_I + (size_t)t * 8 + h];
        const float mn = fmaxf(lf + m, ig), fa = expf(lf + m - mn), ia = expf(ig - mn); m = mn;
        const float ve = bf2f(z[(size_t)t * ZW + ZV_C + h * 256 + e]); float o = 0.f;
#pragma unroll
        for (int d = 0; d < 128; ++d) { C[d] = fa * C[d] + ia * bf2f(ck[(size_t)t * 768 + h * 128 + d]) * ve; o += bf2f(cq[(size_t)t * 768 + h * 128 + d]) * C[d]; }
        ref[(size_t)t * 1536 + i] = o;
#ifdef DBG_STATE
        if (t == 63) { const bf16* CP = (const bf16*)(F.ws + WS_CP); const float mp = mg[MG_MP + 6 + h]; float md = 0.f, mx = 0.f;
#pragma unroll
            for (int d = 0; d < 128; ++d) { const float a = bf2f(CP[((size_t)(6 + h) * 256 + e) * 128 + d]) * expf(mp - m), b = C[d]; md = fmaxf(md, fabsf(a - b)); mx = fmaxf(mx, fabsf(b)); }
            md = wave_max(md, F.lane); mx = wave_max(mx, F.lane);
            if (F.lane == 0) atomicMax((unsigned*)(F.ws + WS_CTL) + 2049, __float_as_uint(md / mx)); }
#endif
    }
}
#endif
__device__ __forceinline__ void dbg_compare(const Frame& F, const float* ref, const float* gainA, const float* gainC, int which, unsigned* res) {
    const bf16* z = (const bf16*)(F.ws + WS_Z); const bf16* y = (const bf16*)(F.ws + WS_Y);
    const int NH = which ? 6 : 12, HD = which ? 256 : 128;
    for (int u = F.gw; u < DBG_T * NH; u += F.NGW) { const int t = u / NH, h = u % NH; float ss = 0.f;
        for (int e = F.lane; e < HD; e += 64) { const float v = ref[(size_t)t * 1536 + h * HD + e]; ss += v * v; }
        ss = wave_sum(ss, F.lane); const float rs = 1.0f / sqrtf(ss / HD + NORM_EPS); float md = 0.f;
        for (int e = F.lane; e < HD; e += 64) { float v = ref[(size_t)t * 1536 + h * HD + e] * rs; float got;
            if (which) { v *= gainC[h * 256 + e] * sigmoidf_(bf2f(z[(size_t)t * ZW + ZO_C + h * 256 + e])) * siluf_(bf2f(z[(size_t)t * ZW + ZGATE_C + h * 256 + e])); got = bf2f(y[(size_t)t * DM + YC + h * 256 + e]); }
            else { v *= gainA[h * 128 + e] * siluf_(bf2f(z[(size_t)t * ZW + ZGATE_A + h * 128 + e])); got = bf2f(y[(size_t)t * DM + YA + h * 128 + e]); }
            md = fmaxf(md, fabsf(got - v)); }
        md = wave_max(md, F.lane); if (F.lane == 0) atomicMax(res, __float_as_uint(md)); }
}
#endif

struct Args { const void* in[18]; float* out; unsigned char* ws; };
#ifndef MIX_GLA
#define MIX_GLA 1
#endif
#ifndef MIX_MLSTM
#define MIX_MLSTM 1
#endif
#ifndef MIX_DSA
#define MIX_DSA 1
#endif

__global__ void __launch_bounds__(NTHR, 2) trunk_fwd(Args args) {
    extern __shared__ __attribute__((aligned(16))) unsigned char lds[];
    Frame F;
    F.lds = (LAS unsigned char*)lds; F.ws = args.ws;
    F.tid = threadIdx.x; F.lane = F.tid & 63; F.wave = __builtin_amdgcn_readfirstlane(F.tid >> 6);
    F.G = gridDim.x; { const int bx = blockIdx.x; F.vcu = (F.G % 8 == 0) ? (bx % 8) * (F.G / 8) + bx / 8 : bx; }
    F.gw = F.vcu * NWAVES + F.wave; F.NGW = F.G * NWAVES;
    volatile LAS unsigned* MISC = (volatile LAS unsigned*)(F.lds + MISC_OFF);
    for (int u = F.tid; u < (LDS_BYTES - RING_BYTES) / 4; u += NTHR) ((LAS unsigned*)(F.lds + RING_BYTES))[u] = 0u;
    __syncthreads();
    XcdBarrier bar = xcd_barrier_post((unsigned*)(F.ws + WS_CTL) + CW_BAR, MISC + 8);
#define GRID_BAR() do { size_t zb_ = 0; asm volatile("" : "+s"(zb_)); unsigned x_ = bar.x; asm volatile("" : "+s"(x_)); XcdBarrier b_; b_.bar = (unsigned*)(args.ws + zb_ + WS_CTL) + CW_BAR; b_.x = x_; b_.st = bar.st; xcd_barrier(b_); } while (0)
#define IN(k) ((const float*)args.in[k])
#define PHASE_BEGIN() do { size_t z_ = 0; asm volatile("" : "+s"(z_)); F.ws = args.ws + z_; unsigned lz_ = 0; asm volatile("" : "+s"(lz_)); F.lds = (LAS unsigned char*)lds + lz_; int t_ = threadIdx.x; asm volatile("" : "+v"(t_)); F.tid = t_; F.lane = t_ & 63; F.wave = __builtin_amdgcn_readfirstlane(t_ >> 6); \
        F.gw = F.vcu * NWAVES + F.wave; U = (bf16*)(F.ws + WS_U); Z = (bf16*)(F.ws + WS_Z); Y = (bf16*)(F.ws + WS_Y); PP = (bf16*)(F.ws + WS_PP); H = (float*)(F.ws + WS_H); } while (0)

    bf16 *U, *Z, *Y, *PP; float* H;

#ifndef DMASK
#define DMASK 0
#endif
#define REP(n) for (int rep_ = 0; rep_ < (((DMASK >> (n)) & 1) ? 2 : 1); ++rep_)
#ifndef ONLY
#define PH(n) 1
#else
#define PH(n) ((n) == ONLY)
#endif
    REP(0) { PHASE_BEGIN(); } REP(0) if (PH(0)) p0_prologue(F, IN(4), IN(13), IN(15), IN(16), IN(1), (const int*)args.in[2], IN(3), IN(14), IN(0));
    GRID_BAR();
    for (int L = 0; L < DEPTH; ++L) {

        REP(1) { PHASE_BEGIN(); } REP(1) if (PH(1)) { if (L > 0) { reduce_rstd(F); GRID_BAR(); } }
        REP(2) { PHASE_BEGIN(); } REP(2) if (PH(2)) { pg8::Gemm g{U, (const bf16*)(F.ws + WS_WIN) + (size_t)L * ZW * DM, SEQ, ZW, DM}; pg8::StaticOrder S; S.init(SEQ, ZW, F.G, (int)blockIdx.x);
          pg8::EpiBf16Row E{Z, ZW, (const float*)(F.ws + WS_RSTD), (bf16*)(F.ws + WS_QA), (bf16*)(F.ws + WS_IQ), (bf16*)(F.ws + WS_IK), ZQ_B, ZGATE_B, ZIQ, ZIK, SEQ};
          pg8::gemm_phase<pg8::EpiBf16Row, pg8::StaticOrder, true, true>(F.lds, g, S, E); }
        GRID_BAR();
        REP(3) { PHASE_BEGIN(); } REP(3) if (PH(3)) p3_prep(F, IN(8) + (size_t)L * 4 * 768, IN(9) + (size_t)L * 4 * 768, IN(10) + L * 6, IN(11) + L * 6, IN(5) + (size_t)L * 16 * 768, IN(6) + (size_t)L * 768);
        GRID_BAR();
#if MIX_DSA
        REP(4) { PHASE_BEGIN(); } REP(4) if (PH(4)) p4_index_scores(F);
#endif
#if MIX_GLA
        REP(5) { PHASE_BEGIN(); } REP(5) if (PH(5)) p4_gla_local(F);
#endif
#if MIX_MLSTM
        REP(6) { PHASE_BEGIN(); } REP(6) if (PH(6)) p4_mlstm_local(F);
#endif
        GRID_BAR();
#if MIX_GLA || MIX_MLSTM
        REP(7) { PHASE_BEGIN(); } REP(7) if (PH(7)) p5_scans(F);
#endif
#if MIX_DSA
        REP(8) { PHASE_BEGIN(); } REP(8) if (PH(8)) p5_select(F);
#endif
        GRID_BAR();
#if MIX_DSA
        REP(9) { PHASE_BEGIN(); } REP(9) if (PH(9)) p6_dsa_attention(F, (char*)lds);
#else
        { unsigned zz_ = 0; asm volatile("" : "+v"(zz_));
        for (int i = blockIdx.x * NTHR + F.tid; i < SEQ * 128; i += F.G * NTHR) { const int t = i >> 7, c8 = i & 127; *(u32x4*)(Y + (size_t)t * DM + YB + c8 * 8) = (u32x4){zz_, zz_, zz_, zz_}; } }
#endif
#if MIX_GLA
        REP(10) { PHASE_BEGIN(); } REP(10) if (PH(10)) p6_gla_out(F, IN(7) + (size_t)L * 1536);
#else
        { unsigned zz_ = 0; asm volatile("" : "+v"(zz_));
        for (int i = blockIdx.x * NTHR + F.tid; i < SEQ * 192; i += F.G * NTHR) { const int t = i / 192, c8 = i % 192; *(u32x4*)(Y + (size_t)t * DM + YA + c8 * 8) = (u32x4){zz_, zz_, zz_, zz_}; } }
#endif
#if MIX_MLSTM
        REP(11) { PHASE_BEGIN(); } REP(11) if (PH(11)) p6_mlstm_out(F, IN(12) + (size_t)L * 1536);
#else
        { unsigned zz_ = 0; asm volatile("" : "+v"(zz_));
        for (int i = blockIdx.x * NTHR + F.tid; i < SEQ * 192; i += F.G * NTHR) { const int t = i / 192, c8 = i % 192; *(u32x4*)(Y + (size_t)t * DM + YC + c8 * 8) = (u32x4){zz_, zz_, zz_, zz_}; } }
#endif
        GRID_BAR();
#ifdef DBG_CHECK
        if (L == 0) { PHASE_BEGIN(); float* ref = (float*)(F.ws + WS_SCORE); unsigned* res = (unsigned*)(F.ws + WS_CTL) + 2048;
#if DBG_CHECK == 0
            dbg_gla_seq(F, ref);
#else
            dbg_mlstm_seq(F, ref);
#endif
            GRID_BAR();
            PHASE_BEGIN(); dbg_compare(F, (const float*)(F.ws + WS_SCORE), IN(7), IN(12), DBG_CHECK, (unsigned*)(F.ws + WS_CTL) + 2048);
            GRID_BAR(); }
#endif
        REP(12) { PHASE_BEGIN(); } REP(12) if (PH(12)) { pg8::Gemm g{Y, (const bf16*)(F.ws + WS_WOUT) + (size_t)L * DM * DM, SEQ, DM, DM}; pg8::StaticOrder S; S.init(SEQ, DM, F.G, (int)blockIdx.x);
          pg8::EpiResB E{U, (bf16*)(F.ws + WS_HB2), (float*)(F.ws + WS_PART), DM};
          pg8::gemm_phase<pg8::EpiResB, pg8::StaticOrder, true, true>(F.lds, g, S, E); }
        GRID_BAR();
        REP(13) { PHASE_BEGIN(); } REP(13) if (PH(13)) reduce_rstd(F);
        REP(14) { PHASE_BEGIN(); } REP(14) if (PH(14)) { pg8::Gemm g{(const bf16*)(F.ws + WS_PBF) + (size_t)L * SEQ * DPLE, (const bf16*)(F.ws + WS_WPLE) + (size_t)L * DM * DPLE, SEQ, DM, DPLE}; pg8::StaticOrder S; S.init(SEQ, DM, F.G, (int)blockIdx.x);
          pg8::EpiBf16<0> E{PP, DM, nullptr, 0, 0, 1.f};
          pg8::gemm_phase<pg8::EpiBf16<0>, pg8::StaticOrder, true, true>(F.lds, g, S, E); }
        GRID_BAR();
        REP(15) { PHASE_BEGIN(); } REP(15) if (PH(15)) { pg8::Gemm g{(const bf16*)(F.ws + WS_HB2), (const bf16*)(F.ws + WS_WGATE) + (size_t)L * DM * DM, SEQ, DM, DM}; pg8::StaticOrder S; S.init(SEQ, DM, F.G, (int)blockIdx.x);
          pg8::EpiGateB E{(const bf16*)(F.ws + WS_HB2), PP, (const float*)(F.ws + WS_RSTD), U, (float*)(F.ws + WS_PART), DM};
          pg8::gemm_phase<pg8::EpiGateB, pg8::StaticOrder, true, true>(F.lds, g, S, E); }
        GRID_BAR();
    }
    REP(16) { PHASE_BEGIN(); } REP(16) if (PH(16)) rmsnorm_b2f(F, U, IN(17), args.out);
#ifdef DBG_CHECK
#ifdef DBG_STATE
#define DBG_WORD 2049
#else
#define DBG_WORD 2048
#endif
    GRID_BAR();
    if (blockIdx.x == 0 && threadIdx.x == 0) args.out[0] = 10000.0f * __uint_as_float(__hip_atomic_load((unsigned*)(args.ws + WS_CTL) + DBG_WORD, __ATOMIC_RELAXED, __HIP_MEMORY_SCOPE_AGENT));
#endif
}

extern "C" void kernel_launch(void* const* d_in, const int* in_sizes, int n_in, void* d_out, int out_size, void* d_ws, size_t ws_size, hipStream_t stream) {
    static int grid = 0;
    if (grid == 0) {
        if (n_in != 18 || out_size != SEQ * DM || ws_size < WS_END) { fprintf(stderr, "kernel_launch: unexpected shapes (n_in %d, out %d, ws %zu < %zu)\n", n_in, out_size, ws_size, (size_t)WS_END); grid = -1; return; }
        int dev = 0, cus = 0, per_cu = 0;
        if (hipGetDevice(&dev) != hipSuccess || hipDeviceGetAttribute(&cus, hipDeviceAttributeMultiprocessorCount, dev) != hipSuccess) { grid = -1; return; }
        if (hipFuncSetAttribute((const void*)trunk_fwd, hipFuncAttributeMaxDynamicSharedMemorySize, LDS_BYTES) != hipSuccess) { fprintf(stderr, "kernel_launch: hipFuncSetAttribute failed\n"); grid = -1; return; }
        if (hipOccupancyMaxActiveBlocksPerMultiprocessor(&per_cu, (const void*)trunk_fwd, NTHR, LDS_BYTES) != hipSuccess || per_cu < 1) fprintf(stderr, "kernel_launch: occupancy query says %d\n", per_cu);
        (void)hipGetLastError();
        grid = cus;
    }
    if (grid < 0) return;
    if (hipMemsetAsync((char*)d_ws + WS_CTL, 0, CTL_ZERO_BYTES, stream) != hipSuccess) return;
    Args a{};
    for (int i = 0; i < 18; ++i) a.in[i] = d_in[i];
    a.out = (float*)d_out; a.ws = (unsigned char*)d_ws;
    hipLaunchKernelGGL(trunk_fwd, dim3(grid), dim3(NTHR), LDS_BYTES, stream, a);
}
```

```cpp
#include <hip/hip_runtime.h>
#include <cstdio>
#include <cstdint>
namespace pg8 {
#define PG8_LAS __attribute__((address_space(3)))
typedef unsigned short bf16_t;
typedef short bf16x8 __attribute__((ext_vector_type(8)));
typedef float f32x4 __attribute__((ext_vector_type(4)));
typedef unsigned u32x4 __attribute__((ext_vector_type(4)));
constexpr int BM = 256, BK = 64, HALF = 128, HTB = HALF * BK * 2  , STAGE_BYTES = 8 * HTB, NXCD = 8, WGM = 8;

__host__ __device__ __forceinline__ int lds_byte(int r, int c) { const int st = (r >> 4) * 2 + (c >> 5), rr = r & 15, cc = c & 31, ob = rr * 64 + cc * 2; return st * 1024 + (ob ^ (((ob >> 9) & 1) << 5)); }
__host__ __device__ __forceinline__ void stage_rc(int b, int& R, int& C) { const int st = b / 1024, sb = b % 1024, swz = sb ^ (((sb >> 9) & 1) << 5); R = (st >> 1) * 16 + swz / 64; C = (st & 1) * 32 + (swz % 64) / 2; }
__host__ __device__ __forceinline__ int perm32(int rho) { const int n = rho >> 4, i = rho & 15; return 8 * (i >> 2) + 4 * n + (i & 3); }

struct Unit { int pm, pn; };
struct Gemm { const bf16_t* A; const bf16_t* Bt; int M, N, K; };

struct StaticOrder {
    int nM, nN, nwg, G, c;
    __host__ __device__ void init(int M, int N, int G_, int c_) { nM = M / BM; nN = N / BM; nwg = nM * nN; G = G_; c = c_; }
    __host__ __device__ bool next(int i, Unit& u) const {
        const long L = (long)i * G + c; if (L >= nwg) return false;
        int wgid = (int)L; { const int q = nwg / NXCD, r = nwg % NXCD, xcd = wgid % NXCD, off = wgid / NXCD; wgid = (xcd < r ? xcd * (q + 1) : r * (q + 1) + (xcd - r) * q) + off; }
        const int nig = WGM * nN, gid = wgid / nig, fm = gid * WGM, gsz = (nM - fm) < WGM ? (nM - fm) : WGM;
        u.pm = fm + ((wgid % nig) % gsz); u.pn = (wgid % nig) / gsz; return true;
    }
    __device__ __forceinline__ void a_ready(const Unit&) const {}
    __device__ __forceinline__ void done(const Unit&) const {}
};

__device__ __forceinline__ unsigned cvt_pk_bf16(float lo, float hi) { unsigned r; asm volatile("v_cvt_pk_bf16_f32 %0, %1, %2" : "=v"(r) : "v"(lo), "v"(hi)); return r; }
typedef float f32x2 __attribute__((ext_vector_type(2)));
__device__ __forceinline__ f32x2 gelu_pk(f32x2 v) {
    const f32x2 av = __builtin_elementwise_abs(v), d = av * 0.2316418882f + 1.0f;
    f32x2 t; t.x = __builtin_amdgcn_rcpf(d.x); t.y = __builtin_amdgcn_rcpf(d.y);
    f32x2 q = t * 0.5307027145f + (-0.7265760135f); q = q * t + 0.7107068705f; q = q * t + (-0.142248368f); q = q * t + 0.127414796f; q = q * t;
    const f32x2 s = (v * v) * (-0.72134752044f);
    f32x2 e; e.x = __builtin_amdgcn_exp2f(s.x); e.y = __builtin_amdgcn_exp2f(s.y);
    const f32x2 m = v * (q * e), r = v - m;
    f32x2 o; o.x = v.x < 0.f ? m.x : r.x; o.y = v.y < 0.f ? m.y : r.y; return o;
}

template <int ACT  > struct EpiBf16 {
    static constexpr bool PERM = true, AFTER_DRAIN = false; static_assert(ACT == 0 || ACT == 1, "EpiBf16: ACT is 0 (none) or 1 (gelu_pk)");
    bf16_t* O; int ldc; const float* bias; int split_cols; size_t split_stride; float scale0;
    __device__ __forceinline__ void operator()(const f32x4 (&acc)[2][2][4][2], const Unit& u, int wr, int wc, int fr, int fq) const {
        const int row0 = u.pm * BM + wr * 64 + fr; int colt = u.pn * BM; bf16_t* base = O;
        float sc = 1.f; if (split_cols) { const int t = colt / split_cols; base += (size_t)t * split_stride; colt -= t * split_cols; if (t == 0) sc = scale0; }
        const int col0 = colt + wc * 32 + 8 * fq, bcol0 = u.pn * BM + wc * 32 + 8 * fq;
        f32x4 bv[2][2];
#pragma unroll
        for (int bj = 0; bj < 2; ++bj)
#pragma unroll
            for (int n = 0; n < 2; ++n) bv[bj][n] = bias ? *(const f32x4*)(bias + bcol0 + bj * HALF + 4 * n) : (f32x4){0.f, 0.f, 0.f, 0.f};
#pragma unroll
        for (int ai = 0; ai < 2; ++ai)
#pragma unroll
            for (int m = 0; m < 4; ++m) { bf16_t* rowp = base + (size_t)(row0 + ai * HALF + m * 16) * ldc + col0;
#pragma unroll
                for (int bj = 0; bj < 2; ++bj) { f32x4 v0 = acc[ai][bj][m][0] + bv[bj][0], v1 = acc[ai][bj][m][1] + bv[bj][1];
                    if (ACT == 1) { f32x2 a = gelu_pk((f32x2){v0[0], v0[1]}), b = gelu_pk((f32x2){v0[2], v0[3]}), c = gelu_pk((f32x2){v1[0], v1[1]}), d = gelu_pk((f32x2){v1[2], v1[3]});
                        v0 = (f32x4){a.x, a.y, b.x, b.y}; v1 = (f32x4){c.x, c.y, d.x, d.y}; }
                    v0 = v0 * sc; v1 = v1 * sc; u32x4 w; w.x = cvt_pk_bf16(v0[0], v0[1]); w.y = cvt_pk_bf16(v0[2], v0[3]); w.z = cvt_pk_bf16(v1[0], v1[1]); w.w = cvt_pk_bf16(v1[2], v1[3]);
                    *(u32x4*)(rowp + bj * HALF) = w; } }
    }
};

struct EpiResF32 {
    static constexpr bool PERM = false, AFTER_DRAIN = false;
    const float* base; float* out; int ldc;
    __device__ __forceinline__ void operator()(const f32x4 (&acc)[2][2][4][2], const Unit& u, int wr, int wc, int fr, int fq) const {
        const int row0 = u.pm * BM + wr * 64 + fr, col0 = u.pn * BM + wc * 32 + 4 * fq;
#pragma unroll
        for (int ai = 0; ai < 2; ++ai)
#pragma unroll
            for (int m = 0; m < 4; ++m) { const size_t off = (size_t)(row0 + ai * HALF + m * 16) * ldc + col0;
#pragma unroll
                for (int bj = 0; bj < 2; ++bj)
#pragma unroll
                    for (int n = 0; n < 2; ++n) { const f32x4 b = *(const f32x4*)(base + off + bj * HALF + n * 16); *(f32x4*)(out + off + bj * HALF + n * 16) = b + acc[ai][bj][m][n]; }
                asm volatile("" ::: "memory"); }
    }
};
struct EpiGate {
    static constexpr bool PERM = false, AFTER_DRAIN = false;
    float* h; const bf16_t* pp; int ldc;
    __device__ __forceinline__ void operator()(const f32x4 (&acc)[2][2][4][2], const Unit& u, int wr, int wc, int fr, int fq) const {
        typedef unsigned u32x2v __attribute__((ext_vector_type(2)));
        const int row0 = u.pm * BM + wr * 64 + fr, col0 = u.pn * BM + wc * 32 + 4 * fq;
#pragma unroll
        for (int ai = 0; ai < 2; ++ai)
#pragma unroll
            for (int m = 0; m < 4; ++m) { const size_t off = (size_t)(row0 + ai * HALF + m * 16) * ldc + col0;
#pragma unroll
                for (int bj = 0; bj < 2; ++bj)
#pragma unroll
                    for (int n = 0; n < 2; ++n) { const size_t o = off + bj * HALF + n * 16;
                        const f32x4 hv = *(const f32x4*)(h + o); const u32x2v pv = *(const u32x2v*)(pp + o); const f32x4 a = acc[ai][bj][m][n];
                        f32x4 p; p[0] = __uint_as_float(pv.x << 16); p[1] = __uint_as_float(pv.x & 0xffff0000u); p[2] = __uint_as_float(pv.y << 16); p[3] = __uint_as_float(pv.y & 0xffff0000u);
                        f32x4 r;
#pragma unroll
                        for (int j = 0; j < 4; ++j) { const float g = __builtin_amdgcn_rcpf(1.0f + __expf(-a[j])); r[j] = hv[j] + g * p[j]; }
                        *(f32x4*)(h + o) = r; }
                asm volatile("" ::: "memory"); }
    }
};

__device__ __forceinline__ float shx16(float v, int o, int lane) { return __int_as_float(__builtin_amdgcn_ds_bpermute((lane ^ o) << 2, __float_as_int(v))); }
struct EpiBf16Row {
    static constexpr bool PERM = true, AFTER_DRAIN = false;
    bf16_t* O; int ldc; const float* rs; bf16_t* hm; bf16_t* iq; bf16_t* ik; int c_hm0, c_hm1, c_iq0, c_ik0, seq;
    __device__ __forceinline__ void operator()(const f32x4 (&acc)[2][2][4][2], const Unit& u, int wr, int wc, int fr, int fq) const {
        const int row0 = u.pm * BM + wr * 64 + fr;
        bf16_t* bp[2]; size_t rstride[2]; bool live[2];
#pragma unroll
        for (int bj = 0; bj < 2; ++bj) { const int colb = u.pn * BM + bj * HALF; live[bj] = true;
            if (colb >= c_hm0 && colb < c_hm1) { const int rel = colb - c_hm0, which = rel >> 10, hh = (rel >> 7) & 7; bp[bj] = hm + ((size_t)(which * 8 + hh) * seq) * 128 + wc * 32 + 8 * fq; rstride[bj] = 128; }
            else if (colb >= c_iq0 && colb < c_ik0) { bp[bj] = iq + (colb - c_iq0) + wc * 32 + 8 * fq; rstride[bj] = 1024; }
            else if (colb == c_ik0) { bp[bj] = ik + wc * 32 + 8 * fq; rstride[bj] = 64; live[bj] = wc < 2; }
            else { bp[bj] = O + colb + wc * 32 + 8 * fq; rstride[bj] = (size_t)ldc; } }
#pragma unroll
        for (int ai = 0; ai < 2; ++ai)
#pragma unroll
            for (int m = 0; m < 4; ++m) { const int row = row0 + ai * HALF + m * 16; const float s = rs[row];
#pragma unroll
                for (int bj = 0; bj < 2; ++bj) { const f32x4 v0 = acc[ai][bj][m][0] * s, v1 = acc[ai][bj][m][1] * s;
                    u32x4 w; w.x = cvt_pk_bf16(v0[0], v0[1]); w.y = cvt_pk_bf16(v0[2], v0[3]); w.z = cvt_pk_bf16(v1[0], v1[1]); w.w = cvt_pk_bf16(v1[2], v1[3]);
                    if (live[bj]) *(u32x4*)(bp[bj] + (size_t)row * rstride[bj]) = w; } }
    }
};
struct EpiResF32N {
    static constexpr bool PERM = false, AFTER_DRAIN = false;
    const float* base; float* out; bf16_t* hb; float* part; int ldc;
    __device__ __forceinline__ void operator()(const f32x4 (&acc)[2][2][4][2], const Unit& u, int wr, int wc, int fr, int fq) const {
        typedef unsigned u32x2v __attribute__((ext_vector_type(2)));
        const int row0 = u.pm * BM + wr * 64 + fr, col0 = u.pn * BM + wc * 32 + 4 * fq, lane = fq * 16 + fr;
#pragma unroll
        for (int ai = 0; ai < 2; ++ai)
#pragma unroll
            for (int m = 0; m < 4; ++m) { const int row = row0 + ai * HALF + m * 16; const size_t off = (size_t)row * ldc + col0; float ss = 0.f;
#pragma unroll
                for (int bj = 0; bj < 2; ++bj)
#pragma unroll
                    for (int n = 0; n < 2; ++n) { const size_t o = off + bj * HALF + n * 16; const f32x4 r = *(const f32x4*)(base + o) + acc[ai][bj][m][n]; *(f32x4*)(out + o) = r;
                        u32x2v w; w.x = cvt_pk_bf16(r[0], r[1]); w.y = cvt_pk_bf16(r[2], r[3]); *(u32x2v*)(hb + o) = w; ss += (r[0] * r[0] + r[1] * r[1]) + (r[2] * r[2] + r[3] * r[3]); }
                ss += shx16(ss, 16, lane); ss += shx16(ss, 32, lane);
                if (fq == 0) part[(size_t)row * 64 + u.pn * 4 + wc] = ss;
                if (m & 1) asm volatile("" ::: "memory"); }
    }
};
struct EpiGateN {
    static constexpr bool PERM = false, AFTER_DRAIN = false;
    float* h; const bf16_t* pp; const float* rs; bf16_t* hb; float* part; int ldc;
    __device__ __forceinline__ void operator()(const f32x4 (&acc)[2][2][4][2], const Unit& u, int wr, int wc, int fr, int fq) const {
        typedef unsigned u32x2v __attribute__((ext_vector_type(2)));
        const int row0 = u.pm * BM + wr * 64 + fr, col0 = u.pn * BM + wc * 32 + 4 * fq, lane = fq * 16 + fr;
#pragma unroll
        for (int ai = 0; ai < 2; ++ai)
#pragma unroll
            for (int m = 0; m < 4; ++m) { const int row = row0 + ai * HALF + m * 16; const size_t off = (size_t)row * ldc + col0; const float s = rs[row]; float ss = 0.f;
#pragma unroll
                for (int bj = 0; bj < 2; ++bj)
#pragma unroll
                    for (int n = 0; n < 2; ++n) { const size_t o = off + bj * HALF + n * 16;
                        const f32x4 hv = *(const f32x4*)(h + o); const u32x2v pv = *(const u32x2v*)(pp + o); const f32x4 a = acc[ai][bj][m][n] * s;
                        f32x4 p; p[0] = __uint_as_float(pv.x << 16); p[1] = __uint_as_float(pv.x & 0xffff0000u); p[2] = __uint_as_float(pv.y << 16); p[3] = __uint_as_float(pv.y & 0xffff0000u);
                        f32x4 r;
#pragma unroll
                        for (int j = 0; j < 4; ++j) { const float g = __builtin_amdgcn_rcpf(1.0f + __expf(-a[j])); r[j] = hv[j] + g * p[j]; }
                        *(f32x4*)(h + o) = r; u32x2v w; w.x = cvt_pk_bf16(r[0], r[1]); w.y = cvt_pk_bf16(r[2], r[3]); *(u32x2v*)(hb + o) = w; ss += (r[0] * r[0] + r[1] * r[1]) + (r[2] * r[2] + r[3] * r[3]); }
                ss += shx16(ss, 16, lane); ss += shx16(ss, 32, lane);
                if (fq == 0) part[(size_t)row * 64 + u.pn * 4 + wc] = ss;
                if (m & 1) asm volatile("" ::: "memory"); }
    }
};

__device__ __forceinline__ void unpk8(const u32x4 w, float (&f)[8]) { f[0] = __uint_as_float(w.x << 16); f[1] = __uint_as_float(w.x & 0xffff0000u); f[2] = __uint_as_float(w.y << 16); f[3] = __uint_as_float(w.y & 0xffff0000u);
    f[4] = __uint_as_float(w.z << 16); f[5] = __uint_as_float(w.z & 0xffff0000u); f[6] = __uint_as_float(w.w << 16); f[7] = __uint_as_float(w.w & 0xffff0000u); }
struct EpiResB {
    static constexpr bool PERM = true, AFTER_DRAIN = false;
    const bf16_t* base; bf16_t* out; float* part; int ldc;
    __device__ __forceinline__ void operator()(const f32x4 (&acc)[2][2][4][2], const Unit& u, int wr, int wc, int fr, int fq) const {
        const int row0 = u.pm * BM + wr * 64 + fr, col0 = u.pn * BM + wc * 32 + 8 * fq, lane = fq * 16 + fr;
#pragma unroll
        for (int ai = 0; ai < 2; ++ai)
#pragma unroll
            for (int m = 0; m < 4; ++m) { const int row = row0 + ai * HALF + m * 16; const size_t off = (size_t)row * ldc + col0; float ss = 0.f;
#pragma unroll
                for (int bj = 0; bj < 2; ++bj) { const size_t o = off + bj * HALF; float b[8], r[8]; unpk8(*(const u32x4*)(base + o), b);
#pragma unroll
                    for (int j = 0; j < 4; ++j) { r[j] = b[j] + acc[ai][bj][m][0][j]; r[4 + j] = b[4 + j] + acc[ai][bj][m][1][j]; }
                    u32x4 w; w.x = cvt_pk_bf16(r[0], r[1]); w.y = cvt_pk_bf16(r[2], r[3]); w.z = cvt_pk_bf16(r[4], r[5]); w.w = cvt_pk_bf16(r[6], r[7]); *(u32x4*)(out + o) = w;
#pragma unroll
                    for (int j = 0; j < 8; ++j) ss += r[j] * r[j]; }
                ss += shx16(ss, 16, lane); ss += shx16(ss, 32, lane);
                if (fq == 0) part[(size_t)row * 64 + u.pn * 4 + wc] = ss;
                if (m & 1) asm volatile("" ::: "memory"); }
    }
};
struct EpiGateB {
    static constexpr bool PERM = true, AFTER_DRAIN = false;
    const bf16_t* hin; const bf16_t* pp; const float* rs; bf16_t* out; float* part; int ldc;
    __device__ __forceinline__ void operator()(const f32x4 (&acc)[2][2][4][2], const Unit& u, int wr, int wc, int fr, int fq) const {
        const int row0 = u.pm * BM + wr * 64 + fr, col0 = u.pn * BM + wc * 32 + 8 * fq, lane = fq * 16 + fr;
#pragma unroll
        for (int ai = 0; ai < 2; ++ai)
#pragma unroll
            for (int m = 0; m < 4; ++m) { const int row = row0 + ai * HALF + m * 16; const size_t off = (size_t)row * ldc + col0; const float s = rs[row]; float ss = 0.f;
#pragma unroll
                for (int bj = 0; bj < 2; ++bj) { const size_t o = off + bj * HALF; float hf[8], pf[8], r[8]; unpk8(*(const u32x4*)(hin + o), hf); unpk8(*(const u32x4*)(pp + o), pf);
#pragma unroll
                    for (int j = 0; j < 8; ++j) { const float a = (j < 4 ? acc[ai][bj][m][0][j & 3] : acc[ai][bj][m][1][j & 3]) * s; const float g = __builtin_amdgcn_rcpf(1.0f + __expf(-a)); r[j] = hf[j] + g * pf[j]; }
                    u32x4 w; w.x = cvt_pk_bf16(r[0], r[1]); w.y = cvt_pk_bf16(r[2], r[3]); w.z = cvt_pk_bf16(r[4], r[5]); w.w = cvt_pk_bf16(r[6], r[7]); *(u32x4*)(out + o) = w;
#pragma unroll
                    for (int j = 0; j < 8; ++j) ss += r[j] * r[j]; }
                ss += shx16(ss, 16, lane); ss += shx16(ss, 32, lane);
                if (fq == 0) part[(size_t)row * 64 + u.pn * 4 + wc] = ss;
                if (m & 1) asm volatile("" ::: "memory"); }
    }
};
template <class Epi, class Sched, bool ALIGN_EPI = false, bool SP2 = false>
__device__ __forceinline__ void gemm_phase(PG8_LAS unsigned char* lds, const Gemm g, const Sched& S, const Epi& E) {
    int tid_ = threadIdx.x; asm volatile("" : "+v"(tid_));
    const int tid = tid_, wid = __builtin_amdgcn_readfirstlane(tid >> 6), lane = tid & 63, wr = wid >> 2, wc = wid & 3, fr = lane & 15, fq = lane >> 4;
    const int K = g.K, nt = K / BK;
    unsigned voffA[2], voffB[2];
#pragma unroll
    for (int i = 0; i < 2; ++i) { int R, C; stage_rc(tid * 16 + i * 8192, R, C); const int Rb = Epi::PERM ? ((R & ~31) + perm32(R & 31)) : R;
        voffA[i] = (unsigned)(R * K + C) * 2u; voffB[i] = (unsigned)(Rb * K + C) * 2u; }
    const size_t kstep = (size_t)(BK * 2);
    const size_t hstep = (size_t)HALF * K * 2;
    const size_t tstep = 2 * hstep;
    const unsigned ldsw = (unsigned)wid * 1024u;
    const int aoff = lds_byte(wr * 64 + fr, fq * 8), boff = lds_byte(wc * 32 + fr, fq * 8);
#define PG8_SA(b, h) (((b) * 2 + (h)) * HTB)
#define PG8_SB(b, h) ((4 + (b) * 2 + (h)) * HTB)
#define PG8_STAGE(bufoff, gbase, voff) do { _Pragma("unroll") for (int _i = 0; _i < 2; ++_i) \
        __builtin_amdgcn_global_load_lds((const unsigned*)((const char*)(gbase) + (voff)[_i]), (PG8_LAS unsigned*)(lds + (bufoff) + ldsw + _i * 8192), 16, 0, 0); } while (0)
#define PG8_LDA(dst, b, h) do { _Pragma("unroll") for (int m = 0; m < 4; ++m) _Pragma("unroll") for (int k = 0; k < 2; ++k) dst[m][k] = *(const PG8_LAS bf16x8*)(lds + PG8_SA(b, h) + aoff + m * 2048 + k * 1024); } while (0)
#define PG8_LDB(dst, b, h) do { _Pragma("unroll") for (int n = 0; n < 2; ++n) _Pragma("unroll") for (int k = 0; k < 2; ++k) dst[n][k] = *(const PG8_LAS bf16x8*)(lds + PG8_SB(b, h) + boff + n * 2048 + k * 1024); } while (0)
#define PG8_MMA(ai, bj, At, Bt) do { __builtin_amdgcn_s_setprio(1); _Pragma("unroll") for (int m = 0; m < 4; ++m) _Pragma("unroll") for (int n = 0; n < 2; ++n) _Pragma("unroll") for (int k = 0; k < 2; ++k) \
        acc[ai][bj][m][n] = __builtin_amdgcn_mfma_f32_16x16x32_bf16(Bt[n][k], At[m][k], acc[ai][bj][m][n], 0, 0, 0); __builtin_amdgcn_s_setprio(0); } while (0)
#define PG8_WAIT_V(n) asm volatile("s_waitcnt vmcnt(" #n ")" ::: "memory")
#define PG8_WAIT_L(n) asm volatile("s_waitcnt lgkmcnt(" #n ")" ::: "memory")
#define PG8_BAR __builtin_amdgcn_s_barrier()
#define PG8_SCHED __builtin_amdgcn_sched_barrier(0)
    Unit cur, nxt; int ui = 0;
    if (!S.next(0, cur)) return;
    f32x4 acc[2][2][4][2];
#pragma unroll
    for (int a = 0; a < 2; ++a)
#pragma unroll
        for (int b = 0; b < 2; ++b)
#pragma unroll
            for (int m = 0; m < 4; ++m)
#pragma unroll
                for (int n = 0; n < 2; ++n) acc[a][b][m][n] = (f32x4){0.f, 0.f, 0.f, 0.f};
    bf16x8 At[4][2], B0[2][2], B1[2][2];
    const char* cA = (const char*)g.A + (size_t)cur.pm * tstep; const char* cB = (const char*)g.Bt + (size_t)cur.pn * tstep;
    S.a_ready(cur);
    if constexpr (SP2) {
        PG8_STAGE(PG8_SB(0, 0), cB, voffB); PG8_STAGE(PG8_SB(0, 1), cB + hstep, voffB); PG8_STAGE(PG8_SA(0, 0), cA, voffA); PG8_STAGE(PG8_SA(0, 1), cA + hstep, voffA);
        if (wr == 1) PG8_BAR;
        PG8_WAIT_V(2); PG8_BAR;
        PG8_STAGE(PG8_SB(1, 0), cB + kstep, voffB); PG8_STAGE(PG8_SA(1, 0), cA + kstep, voffA); PG8_STAGE(PG8_SB(1, 1), cB + hstep + kstep, voffB);
        PG8_WAIT_V(6); PG8_BAR;
    } else {
        PG8_STAGE(PG8_SB(0, 0), cB, voffB); PG8_STAGE(PG8_SA(0, 0), cA, voffA); PG8_STAGE(PG8_SB(0, 1), cB + hstep, voffB); PG8_STAGE(PG8_SA(0, 1), cA + hstep, voffA);
        if (wr == 1) PG8_BAR;
        PG8_WAIT_V(4); PG8_BAR;
        PG8_STAGE(PG8_SB(1, 0), cB + kstep, voffB); PG8_STAGE(PG8_SA(1, 0), cA + kstep, voffA); PG8_STAGE(PG8_SB(1, 1), cB + hstep + kstep, voffB);
        PG8_WAIT_V(6); PG8_BAR;
    }
    for (;;) {
        const bool has_next = S.next(ui + 1, nxt);
        const char* nA = has_next ? (const char*)g.A + (size_t)nxt.pm * tstep : cA; const char* nB = has_next ? (const char*)g.Bt + (size_t)nxt.pn * tstep : cB;
#pragma nounroll
        for (int t = 0; t < nt; t += 2) {
            const bool last = (t == nt - 2);
            const char* a1 = cA + (size_t)(t + 1) * kstep;
            const char* a2 = last ? nA : cA + (size_t)(t + 2) * kstep; const char* b2 = last ? nB : cB + (size_t)(t + 2) * kstep;
            const char* a3 = a2 + kstep; const char* b3 = b2 + kstep;
            if (last && has_next) S.a_ready(nxt);
            if constexpr (SP2) {
            PG8_LDB(B0, 0, 0); PG8_LDB(B1, 0, 1); PG8_SCHED; PG8_LDA(At, 0, 0); PG8_STAGE(PG8_SA(1, 1), a1 + hstep, voffA);
            PG8_WAIT_V(8); PG8_WAIT_L(0); PG8_BAR; PG8_MMA(0, 0, At, B0); PG8_MMA(0, 1, At, B1); PG8_BAR; PG8_SCHED;
            PG8_LDA(At, 0, 1); PG8_STAGE(PG8_SB(0, 0), b2, voffB); PG8_STAGE(PG8_SB(0, 1), b2 + hstep, voffB); PG8_STAGE(PG8_SA(0, 0), a2, voffA);
            PG8_WAIT_V(8); PG8_WAIT_L(0); PG8_BAR; PG8_MMA(1, 0, At, B0); PG8_MMA(1, 1, At, B1); PG8_BAR; PG8_SCHED;
            PG8_LDB(B0, 1, 0); PG8_LDB(B1, 1, 1); PG8_SCHED; PG8_LDA(At, 1, 0); PG8_STAGE(PG8_SA(0, 1), a2 + hstep, voffA);
            PG8_WAIT_V(8); PG8_WAIT_L(0); PG8_BAR; PG8_MMA(0, 0, At, B0); PG8_MMA(0, 1, At, B1); PG8_BAR; PG8_SCHED;
            PG8_LDA(At, 1, 1); PG8_STAGE(PG8_SB(1, 0), b3, voffB); PG8_STAGE(PG8_SB(1, 1), b3 + hstep, voffB); PG8_STAGE(PG8_SA(1, 0), a3, voffA);
            PG8_WAIT_V(8); PG8_WAIT_L(0); PG8_BAR; PG8_MMA(1, 0, At, B0); PG8_MMA(1, 1, At, B1); PG8_BAR; PG8_SCHED;
            } else {
            PG8_LDB(B0, 0, 0); PG8_SCHED; PG8_LDA(At, 0, 0); PG8_STAGE(PG8_SA(1, 1), a1 + hstep, voffA);
            PG8_WAIT_L(8); PG8_BAR; PG8_WAIT_L(0); PG8_MMA(0, 0, At, B0); PG8_BAR; PG8_SCHED;
            PG8_LDB(B1, 0, 1); PG8_STAGE(PG8_SB(0, 0), b2, voffB);
            PG8_BAR; PG8_WAIT_L(0); PG8_MMA(0, 1, At, B1); PG8_BAR;
            PG8_LDA(At, 0, 1); PG8_STAGE(PG8_SA(0, 0), a2, voffA);
            PG8_BAR; PG8_WAIT_L(0); PG8_MMA(1, 0, At, B0); PG8_BAR; PG8_SCHED;
            PG8_STAGE(PG8_SB(0, 1), b2 + hstep, voffB);
            PG8_WAIT_V(6); PG8_BAR; PG8_MMA(1, 1, At, B1); PG8_BAR;
            PG8_LDB(B0, 1, 0); PG8_SCHED; PG8_LDA(At, 1, 0); PG8_STAGE(PG8_SA(0, 1), a2 + hstep, voffA);
            PG8_WAIT_L(8); PG8_BAR; PG8_WAIT_L(0); PG8_MMA(0, 0, At, B0); PG8_BAR; PG8_SCHED;
            PG8_LDB(B1, 1, 1); PG8_STAGE(PG8_SB(1, 0), b3, voffB);
            PG8_BAR; PG8_WAIT_L(0); PG8_MMA(0, 1, At, B1); PG8_BAR;
            PG8_LDA(At, 1, 1); PG8_STAGE(PG8_SA(1, 0), a3, voffA);
            PG8_BAR; PG8_WAIT_L(0); PG8_MMA(1, 0, At, B0); PG8_BAR; PG8_SCHED;
            PG8_STAGE(PG8_SB(1, 1), b3 + hstep, voffB);
            PG8_WAIT_V(6); PG8_BAR; PG8_MMA(1, 1, At, B1); PG8_BAR;
            }
        }
        if constexpr (ALIGN_EPI) { if (wr == 0) PG8_BAR; }
        if constexpr (!Epi::AFTER_DRAIN) { E(acc, cur, wr, wc, fr, fq); S.done(cur); }
        if (!has_next) break;
#pragma unroll
        for (int a = 0; a < 2; ++a)
#pragma unroll
            for (int b = 0; b < 2; ++b)
#pragma unroll
                for (int m = 0; m < 4; ++m)
#pragma unroll
                    for (int n = 0; n < 2; ++n) acc[a][b][m][n] = (f32x4){0.f, 0.f, 0.f, 0.f};
        cur = nxt; cA = nA; cB = nB; ++ui;
        if constexpr (ALIGN_EPI) { if (wr == 1) PG8_BAR; }
    }
    PG8_WAIT_V(0);
    if constexpr (!ALIGN_EPI) { if (wr == 0) PG8_BAR; }
    PG8_BAR;
    if constexpr (Epi::AFTER_DRAIN) { E.fused(acc, cur, wr, wc, fr, fq, lds, wid, lane); S.done(cur); }
#undef PG8_SA
#undef PG8_SB
#undef PG8_STAGE
#undef PG8_LDA
#undef PG8_LDB
#undef PG8_MMA
#undef PG8_WAIT_V
#undef PG8_WAIT_L
#undef PG8_BAR
#undef PG8_SCHED
}
}

constexpr int SEQ = 16384, DM = 4096, DEPTH = 4, DPLE = 256;
constexpr int INW = 15980;
constexpr int ZW = 16384;
constexpr float NORM_EPS = 1e-6f;
constexpr int ZQ_A = 0, ZK_A = 768, ZV_A = 1536, ZLOW = 3072, ZGATE_A = 3200;
constexpr int ZQ_B = 4736, ZK_B = 5760, ZV_B = 6784, ZGATE_B = 7808, ZIQ = 8832, ZIK = 9856, ZIW = 9984;
constexpr int ZQ_C = 10112, ZK_C = 10880, ZV_C = 11648, ZIF = 13184, ZO_C = 13312, ZGATE_C = 14848;
constexpr int YA = 0, YB = 1536, YC = 2560;
constexpr int NCH = SEQ / 64;

constexpr size_t MiB = 1u << 20;
constexpr size_t WS_CTL = 0, CTL_ZERO_BYTES = 1 * MiB;
constexpr size_t WS_ROPE = 1 * MiB;
constexpr size_t WS_PBF = 4 * MiB;
constexpr size_t WS_WPLE = 36 * MiB;
constexpr size_t WS_WOUT = 44 * MiB;
constexpr size_t WS_WGATE = 172 * MiB;
constexpr size_t WS_WIN = 300 * MiB;
constexpr size_t WS_H = 812 * MiB;
constexpr size_t WS_QT = 812 * MiB;
constexpr size_t WS_U = 1068 * MiB;
constexpr size_t WS_Z = 1196 * MiB;
constexpr size_t WS_Y = 1708 * MiB;
constexpr size_t WS_PP = 1836 * MiB;
constexpr size_t WS_QA = 1964 * MiB, WS_KA = 1996 * MiB, WS_VA = 2028 * MiB;
constexpr size_t WS_IQ = 2060 * MiB;
constexpr size_t WS_IK = 2092 * MiB;
constexpr size_t WS_IW = 2094 * MiB;
constexpr size_t WS_MASK = 2096 * MiB;
constexpr size_t WS_BA = 2128 * MiB;
constexpr size_t WS_DS = 2176 * MiB;
constexpr size_t WS_SP = 2272 * MiB;
constexpr size_t WS_CQ = 2320 * MiB, WS_CK = 2344 * MiB;
constexpr size_t WS_MG = 2368 * MiB;
constexpr size_t WS_DC = 2372 * MiB;
constexpr size_t WS_CP = 2564 * MiB;
constexpr size_t WS_SCORE = 2660 * MiB;
constexpr size_t WS_HB2 = 3684 * MiB;
constexpr size_t WS_PART = 3812 * MiB;
constexpr size_t WS_RSTD = 3816 * MiB;
constexpr size_t WS_END = 3818 * MiB;
constexpr size_t MG_B = 0;
constexpr size_t MG_I = MG_B + (size_t)SEQ * 8;
constexpr size_t MG_ML = MG_I + (size_t)SEQ * 8;
constexpr size_t MG_MP = MG_ML + (size_t)NCH * 6 * 2;
constexpr size_t MG_DN = MG_MP + (size_t)NCH * 6;
constexpr size_t MG_NP = MG_DN + (size_t)NCH * 6 * 128;
static_assert((MG_NP + (size_t)NCH * 6 * 128) * 4 <= 4 * MiB, "mLSTM small arrays fit");

constexpr int CW_BAR = 4096;

constexpr int RING_BYTES = 131072;
constexpr int MISC_OFF = RING_BYTES + 320;
constexpr int LDS_BYTES = 147456;
constexpr int NWAVES = 8, NTHR = 512;

#define GAS __attribute__((address_space(1)))
#define LAS __attribute__((address_space(3)))
typedef unsigned short bf16;
typedef unsigned u32x4 __attribute__((ext_vector_type(4)));
typedef unsigned u32x2 __attribute__((ext_vector_type(2)));
typedef float f32x4 __attribute__((ext_vector_type(4)));
typedef float f32x2 __attribute__((ext_vector_type(2)));
typedef float f32x16 __attribute__((ext_vector_type(16)));
typedef short bf16x8 __attribute__((ext_vector_type(8)));
typedef short bf16x4 __attribute__((ext_vector_type(4)));
#define LDS_WAIT() asm volatile("s_waitcnt lgkmcnt(0)" ::: "memory")
#define VM_WAIT() asm volatile("s_waitcnt vmcnt(0)" ::: "memory")
#define TPOS(row_, s_, sh_) ((row_) * 72 + (((((s_) >> 3) ^ ((row_) >> (sh_))) & 7) << 3) + ((s_) & 7))
#define TRD(row_, chunk_, sh_) ((row_) * 72 + ((((chunk_) ^ ((row_) >> (sh_))) & 7) << 3))

__device__ __forceinline__ float bf2f(unsigned short b) { return __uint_as_float((unsigned)b << 16); }
__device__ __forceinline__ float bflo(unsigned w) { return __uint_as_float(w << 16); }
__device__ __forceinline__ float bfhi(unsigned w) { return __uint_as_float(w & 0xffff0000u); }
typedef __bf16 bf16x2_t __attribute__((ext_vector_type(2)));
__device__ __forceinline__ unsigned pk2(float lo, float hi) { const f32x2 v = {lo, hi}; const bf16x2_t b = __builtin_convertvector(v, bf16x2_t); return __builtin_bit_cast(unsigned, b); }
__device__ __forceinline__ unsigned short f2bf(float f) { return (unsigned short)(pk2(f, 0.f) & 0xffffu); }
__device__ __forceinline__ float shx(float v, int o, int lane) { return __int_as_float(__builtin_amdgcn_ds_bpermute((lane ^ o) << 2, __float_as_int(v))); }
__device__ __forceinline__ float shup(float v, int o, int lane) { return __int_as_float(__builtin_amdgcn_ds_bpermute(((lane - o) & 63) << 2, __float_as_int(v))); }
__device__ __forceinline__ unsigned shdn_u(unsigned v, int o, int lane) { return (unsigned)__builtin_amdgcn_ds_bpermute(((lane + o) & 63) << 2, (int)v); }
__device__ __forceinline__ float wave_sum(float v, int lane) {
#pragma unroll
    for (int o = 1; o < 64; o <<= 1) v += shx(v, o, lane);
    return v;
}
__device__ __forceinline__ float wave_max(float v, int lane) {
#pragma unroll
    for (int o = 1; o < 64; o <<= 1) v = fmaxf(v, shx(v, o, lane));
    return v;
}
__device__ __forceinline__ float log_sigmoidf(float x) { return fminf(x, 0.f) - log1pf(expf(-fabsf(x))); }
__device__ __forceinline__ float sigmoidf_(float x) { return __builtin_amdgcn_rcpf(1.0f + __expf(-x)); }
__device__ __forceinline__ float siluf_(float x) { return x * __builtin_amdgcn_rcpf(1.0f + __expf(-x)); }
__device__ __forceinline__ int crow(int r, int hi) { return (r & 3) + 8 * (r >> 2) + 4 * hi; }
__device__ __forceinline__ void unpack8(const u32x4 w, float (&f)[8]) { f[0] = bflo(w.x); f[1] = bfhi(w.x); f[2] = bflo(w.y); f[3] = bfhi(w.y); f[4] = bflo(w.z); f[5] = bfhi(w.z); f[6] = bflo(w.w); f[7] = bfhi(w.w); }
__device__ __forceinline__ u32x4 pack8f(const float (&f)[8]) { u32x4 o; o.x = pk2(f[0], f[1]); o.y = pk2(f[2], f[3]); o.z = pk2(f[4], f[5]); o.w = pk2(f[6], f[7]); return o; }
__device__ __forceinline__ int hw_lane() { int l; asm volatile("v_mbcnt_lo_u32_b32 %0, -1, 0\n\tv_mbcnt_hi_u32_b32 %0, -1, %0" : "=v"(l)); return l; }
#define XB_TMO      128
#define XB_XCNT(j)  (256  + 64 * (j))
#define XB_XSUB(j)  (1280 + 64 * (j))
#define XB_XGEN(j)  (2304 + 64 * (j))
#define XB_TOP      3328
#define XB_TOPGEN   3392
#define XCD_BAR_WORDS 3456
#define XB_SPIN_CAP (1u << 18)

__device__ __forceinline__ unsigned xb_ld(unsigned* p)              { return __hip_atomic_load(p, __ATOMIC_RELAXED, __HIP_MEMORY_SCOPE_AGENT); }
__device__ __forceinline__ unsigned xb_add(unsigned* p, unsigned v) { return __hip_atomic_fetch_add(p, v, __ATOMIC_RELAXED, __HIP_MEMORY_SCOPE_AGENT); }
__device__ __forceinline__ unsigned xb_xcc_id() { return (unsigned)__builtin_amdgcn_s_getreg((3 << 11) | 20) & 0xFu; }
#define XB_SPIN(cond, bar) do { unsigned _sp = 0; while (cond) { __builtin_amdgcn_s_sleep(1); \
    if ((++_sp & 255u) == 0u) { if (xb_ld(&(bar)[XB_TMO])) break; if (_sp > XB_SPIN_CAP) { atomicAdd(&(bar)[XB_TMO], 1u); break; } } } } while (0)

struct XcdBarrier {
    unsigned* bar; unsigned x;
    volatile LAS unsigned* st;
};

__device__ __forceinline__ XcdBarrier xcd_barrier_post(unsigned* bar, volatile LAS unsigned* st) {
    XcdBarrier b; b.bar = bar; b.x = xb_xcc_id(); b.st = st;
    if (threadIdx.x == 0) (void)xb_add(&bar[XB_XCNT(b.x)], 1u);
    return b;
}
__device__ __forceinline__ void xcd_barrier_complete(unsigned* bar, unsigned x, unsigned& nloc, unsigned& nx) {
    const unsigned G = gridDim.x * gridDim.y * gridDim.z;
    unsigned sum, cnt, mine, sp = 0u;
    for (;;) {
        sum = 0u; cnt = 0u; mine = 0u;
#pragma unroll
        for (unsigned j = 0; j < 16; ++j) { const unsigned c = xb_ld(&bar[XB_XCNT(j)]); sum += c; cnt += (c > 0u) ? 1u : 0u; mine = (j == x) ? c : mine; }
        if (sum == G) break;
        __builtin_amdgcn_s_sleep(1);
        if ((++sp & 255u) == 0u) { if (xb_ld(&bar[XB_TMO])) break; if (sp > XB_SPIN_CAP) { atomicAdd(&bar[XB_TMO], 1u); break; } }
    }
    nloc = mine > 0u ? mine : 1u; nx = cnt > 0u ? cnt : 1u;
}

__device__ __forceinline__ void xcd_barrier(const XcdBarrier& b) {
    asm volatile("s_waitcnt vmcnt(0)" ::: "memory");
    __syncthreads();
    if (threadIdx.x == 0) {
        unsigned* bar = b.bar;
        __builtin_amdgcn_s_waitcnt(0);
        unsigned nloc = b.st[0], nx = b.st[1];
        if (nloc == 0u) { xcd_barrier_complete(bar, b.x, nloc, nx); b.st[0] = nloc; b.st[1] = nx; }
        const unsigned old = xb_add(&bar[XB_XSUB(b.x)], 1u);
        const unsigned gen = old / nloc;
        if (old + 1u == (gen + 1u) * nloc) {
            __builtin_amdgcn_fence(__ATOMIC_RELEASE, "agent");
            asm volatile("s_waitcnt vmcnt(0)" ::: "memory");
            const unsigned og = xb_add(&bar[XB_TOP], 1u);
            const unsigned tg = og / nx;
            if (og + 1u == (tg + 1u) * nx) xb_add(&bar[XB_TOPGEN], 1u);
            else XB_SPIN(xb_ld(&bar[XB_TOPGEN]) == tg, bar);
            __builtin_amdgcn_fence(__ATOMIC_ACQUIRE, "agent");
            xb_add(&bar[XB_XGEN(b.x)], 1u);
            asm volatile("s_waitcnt vmcnt(0)" ::: "memory");
        } else {
            XB_SPIN(xb_ld(&bar[XB_XGEN(b.x)]) == gen, bar);
            __builtin_amdgcn_fence(__ATOMIC_ACQUIRE, "agent");
            asm volatile("s_waitcnt vmcnt(0)" ::: "memory");
        }
    }
    __syncthreads();
}

struct Frame {
    LAS unsigned char* lds;
    unsigned char* ws;
    int tid, lane, wave, G, vcu, gw, NGW;
};

__device__ __forceinline__ void zseg(int n0, int& src0, int& valid, float& cscale) {
    int d0, s0, sl;
    if (n0 < ZK_A) { d0 = ZQ_A; s0 = 0; sl = 768; }
    else if (n0 < ZV_A) { d0 = ZK_A; s0 = 768; sl = 768; }
    else if (n0 < ZLOW) { d0 = ZV_A; s0 = 1536; sl = 1536; }
    else if (n0 < ZGATE_A) { d0 = ZLOW; s0 = 3072; sl = 16; }
    else if (n0 < ZQ_B) { d0 = ZGATE_A; s0 = 3088; sl = 1536; }
    else if (n0 < ZK_B) { d0 = ZQ_B; s0 = 4624; sl = 1024; }
    else if (n0 < ZV_B) { d0 = ZK_B; s0 = 5648; sl = 1024; }
    else if (n0 < ZGATE_B) { d0 = ZV_B; s0 = 6672; sl = 1024; }
    else if (n0 < ZIQ) { d0 = ZGATE_B; s0 = 7696; sl = 1024; }
    else if (n0 < ZIK) { d0 = ZIQ; s0 = 8720; sl = 1024; }
    else if (n0 < ZIW) { d0 = ZIK; s0 = 9744; sl = 64; }
    else if (n0 < ZQ_C) { d0 = ZIW; s0 = 9808; sl = 16; }
    else if (n0 < ZK_C) { d0 = ZQ_C; s0 = 9824; sl = 768; }
    else if (n0 < ZV_C) { d0 = ZK_C; s0 = 10592; sl = 768; }
    else if (n0 < ZIF) { d0 = ZV_C; s0 = 11360; sl = 1536; }
    else if (n0 < ZO_C) { d0 = ZIF; s0 = 12896; sl = 12; }
    else if (n0 < ZGATE_C) { d0 = ZO_C; s0 = 12908; sl = 1536; }
    else { d0 = ZGATE_C; s0 = 14444; sl = 1536; }
    const int off = n0 - d0; int v = sl - off; v = v < 0 ? 0 : (v > 32 ? 32 : v);
    src0 = s0 + off; valid = v;
    cscale = (d0 == ZIQ) ? 0.0078125f : (d0 == ZIW) ? 2.0f : 1.0f;
}
__device__ __forceinline__ void transpose_item(const float* W, int K, int Nsrc, bf16* WT, int k0, int n0dst, int src0, int valid, LAS float* scr, int lane, const float* gk, const float cs = 1.0f) {
    const int j = lane & 31; const bool ok = j < valid;
    float vv[32];
    const float* wp = W + (size_t)(k0 + (lane >> 5)) * Nsrc + src0 + (ok ? j : 0);
#pragma unroll
    for (int i = 0; i < 32; ++i) vv[i] = wp[(size_t)(2 * i) * Nsrc];
#pragma unroll
    for (int i = 0; i < 32; ++i) { const int kk = 2 * i + (lane >> 5); const float gg = (gk ? gk[k0 + kk] : 1.0f) * cs; scr[kk * 33 + j] = ok ? vv[i] * gg : 0.f; }
    LDS_WAIT(); asm volatile("" ::: "memory");
    const int c = lane & 7;
#pragma unroll
    for (int jj = 0; jj < 4; ++jj) { const int n = (lane >> 3) + 8 * jj; const LAS float* s = scr + (8 * c) * 33 + n;
        u32x4 o; o.x = pk2(s[0 * 33], s[1 * 33]); o.y = pk2(s[2 * 33], s[3 * 33]); o.z = pk2(s[4 * 33], s[5 * 33]); o.w = pk2(s[6 * 33], s[7 * 33]);
        *(GAS u32x4*)(WT + (size_t)(n0dst + n) * K + k0 + 8 * c) = o; }
    LDS_WAIT(); asm volatile("" ::: "memory");
}
__device__ __forceinline__ void p0_prologue(const Frame& F, const float* w_in, const float* w_out, const float* w_ple_gate, const float* w_ple_proj, const float* pin, const int* pos, const float* g_in, const float* g_ple, const float* x) {
    LAS float* scr = (LAS float*)(F.lds + F.wave * 16384);
    constexpr int I_IN = (DM / 64) * (ZW / 32), I_SQ = (DM / 64) * (DM / 32), I_PL = (DPLE / 64) * (DM / 32), I_L = I_IN + 2 * I_SQ + I_PL;
    for (int it = F.gw; it < DEPTH * I_L; it += F.NGW) {
        const int L = it / I_L; int r = it - L * I_L;
        if (r < I_IN) { const int nb = r % (ZW / 32), kb = r / (ZW / 32); int s0, vd; float cs; zseg(nb * 32, s0, vd, cs);
            transpose_item(w_in + (size_t)L * DM * INW, DM, INW, (bf16*)(F.ws + WS_WIN) + (size_t)L * ZW * DM, kb * 64, nb * 32, s0, vd, scr, F.lane, g_in + (size_t)L * DM, cs); continue; }
        r -= I_IN;
        if (r < I_SQ) { const int nb = r % (DM / 32), kb = r / (DM / 32);
            transpose_item(w_out + (size_t)L * DM * DM, DM, DM, (bf16*)(F.ws + WS_WOUT) + (size_t)L * DM * DM, kb * 64, nb * 32, nb * 32, 32, scr, F.lane, nullptr); continue; }
        r -= I_SQ;
        if (r < I_SQ) { const int nb = r % (DM / 32), kb = r / (DM / 32);
            transpose_item(w_ple_gate + (size_t)L * DM * DM, DM, DM, (bf16*)(F.ws + WS_WGATE) + (size_t)L * DM * DM, kb * 64, nb * 32, nb * 32, 32, scr, F.lane, g_ple + (size_t)L * DM); continue; }
        r -= I_SQ;
        { const int nb = r % (DM / 32), kb = r / (DM / 32);
            transpose_item(w_ple_proj + (size_t)L * DPLE * DM, DPLE, DM, (bf16*)(F.ws + WS_WPLE) + (size_t)L * DM * DPLE, kb * 64, nb * 32, nb * 32, 32, scr, F.lane, nullptr); }
    }
    { bf16* hb = (bf16*)(F.ws + WS_U); float* rstd = (float*)(F.ws + WS_RSTD);
      for (int row = F.gw; row < SEQ; row += F.NGW) {
          const f32x4* xr = (const f32x4*)(x + (size_t)row * DM) + F.lane; f32x4 v[16]; float ss = 0.f;
#pragma unroll
          for (int j = 0; j < 16; ++j) { v[j] = xr[64 * j]; ss += (v[j][0] * v[j][0] + v[j][1] * v[j][1]) + (v[j][2] * v[j][2] + v[j][3] * v[j][3]); }
          ss = wave_sum(ss, F.lane); if (F.lane == 0) rstd[row] = 1.0f / sqrtf(ss * (1.0f / DM) + NORM_EPS);
          u32x2* o = (u32x2*)(hb + (size_t)row * DM) + F.lane;
#pragma unroll
          for (int j = 0; j < 16; ++j) { u32x2 w; w.x = pk2(v[j][0], v[j][1]); w.y = pk2(v[j][2], v[j][3]); o[64 * j] = w; } } }
    { const size_t n8 = (size_t)DEPTH * SEQ * DPLE / 8; bf16* pb = (bf16*)(F.ws + WS_PBF);
      for (size_t i = (size_t)blockIdx.x * NTHR + F.tid; i < n8; i += (size_t)F.G * NTHR) {
          const f32x4 a = *(const f32x4*)(pin + i * 8), b = *(const f32x4*)(pin + i * 8 + 4);
          u32x4 o; o.x = pk2(a[0], a[1]); o.y = pk2(a[2], a[3]); o.z = pk2(b[0], b[1]); o.w = pk2(b[2], b[3]);
          *(u32x4*)(pb + i * 8) = o; } }
    { float* cosA = (float*)(F.ws + WS_ROPE); float* sinA = cosA + (size_t)SEQ * 16; float* cosI = sinA + (size_t)SEQ * 16; float* sinI = cosI + (size_t)SEQ * 8;
      for (int i = blockIdx.x * NTHR + F.tid; i < SEQ * 24; i += F.G * NTHR) {
          const int t = i / 24, f = i % 24; const bool isA = f < 16; const int fi = isA ? f : f - 16; const double rot = isA ? 32.0 : 16.0;
          const float ex = -(float)(2 * fi) / (float)rot;
          const float inv = (float)exp((double)ex * 13.122363377404328);
          const float ang = (float)pos[t] * inv;
          const double a = (double)ang; const double n = rint(a * 0.15915494309189535);
          double rr = fma(-n, 6.283185307179586, a); rr = fma(-n, 2.4492935982947064e-16, rr);
          const float c = (float)cos(rr), s = (float)sin(rr);
          if (isA) { cosA[t * 16 + fi] = c; sinA[t * 16 + fi] = s; } else { cosI[t * 8 + fi] = c; sinI[t * 8 + fi] = s; } } }
}

__device__ __forceinline__ void reduce_rstd(const Frame& F) {
    const float* part = (const float*)(F.ws + WS_PART); float* rstd = (float*)(F.ws + WS_RSTD);
    for (int r4 = F.gw; r4 < SEQ / 4; r4 += F.NGW) { const int row = r4 * 4 + (F.lane >> 4); const f32x4 p = *(const f32x4*)(part + (size_t)row * 64 + (F.lane & 15) * 4);
        float s = (p[0] + p[1]) + (p[2] + p[3]); s += shx(s, 1, F.lane); s += shx(s, 2, F.lane); s += shx(s, 4, F.lane); s += shx(s, 8, F.lane);
        if ((F.lane & 15) == 0) rstd[row] = 1.0f / sqrtf(s * (1.0f / DM) + NORM_EPS); }
}
__device__ __forceinline__ void rmsnorm_to_bf16(const Frame& F, const float* src, const float* g, bf16* dst) {
    for (int row = F.gw; row < SEQ; row += F.NGW) {
        const f32x4* xr = (const f32x4*)(src + (size_t)row * DM) + F.lane; f32x4 v[16]; float ss = 0.f;
#pragma unroll
        for (int j = 0; j < 16; ++j) { v[j] = xr[64 * j]; ss += (v[j][0] * v[j][0] + v[j][1] * v[j][1]) + (v[j][2] * v[j][2] + v[j][3] * v[j][3]); }
        const float rs = 1.0f / sqrtf(wave_sum(ss, F.lane) * (1.0f / DM) + NORM_EPS);
        u32x2* o = (u32x2*)(dst + (size_t)row * DM) + F.lane;
#pragma unroll
        for (int j = 0; j < 16; ++j) { const f32x4 gv = ((const f32x4*)g)[F.lane + 64 * j]; u32x2 w; w.x = pk2(v[j][0] * rs * gv[0], v[j][1] * rs * gv[1]); w.y = pk2(v[j][2] * rs * gv[2], v[j][3] * rs * gv[3]); o[64 * j] = w; }
    }
}
__device__ __forceinline__ void rmsnorm_b2f(const Frame& F, const bf16* src, const float* g, float* dst) {
    for (int row = F.gw; row < SEQ; row += F.NGW) {
        const u32x4* xr = (const u32x4*)(src + (size_t)row * DM) + F.lane; float v[8][8]; float ss = 0.f;
#pragma unroll
        for (int j = 0; j < 8; ++j) { unpack8(xr[64 * j], v[j]);
#pragma unroll
            for (int q = 0; q < 8; ++q) ss += v[j][q] * v[j][q]; }
        const float rs = 1.0f / sqrtf(wave_sum(ss, F.lane) * (1.0f / DM) + NORM_EPS);
#pragma unroll
        for (int j = 0; j < 8; ++j) { const int c0 = (F.lane + 64 * j) * 8; const f32x4 g0 = *(const f32x4*)(g + c0), g1 = *(const f32x4*)(g + c0 + 4); f32x4 o0, o1;
#pragma unroll
            for (int q = 0; q < 4; ++q) { o0[q] = v[j][q] * rs * g0[q]; o1[q] = v[j][4 + q] * rs * g1[q]; }
            *(f32x4*)(dst + (size_t)row * DM + c0) = o0; *(f32x4*)(dst + (size_t)row * DM + c0 + 4) = o1; }
    }
}
__device__ __forceinline__ void rmsnorm_to_f32(const Frame& F, const float* src, const float* g, float* dst) {
    for (int row = F.gw; row < SEQ; row += F.NGW) {
        const f32x4* xr = (const f32x4*)(src + (size_t)row * DM) + F.lane; f32x4 v[16]; float ss = 0.f;
#pragma unroll
        for (int j = 0; j < 16; ++j) { v[j] = xr[64 * j]; ss += (v[j][0] * v[j][0] + v[j][1] * v[j][1]) + (v[j][2] * v[j][2] + v[j][3] * v[j][3]); }
        const float rs = 1.0f / sqrtf(wave_sum(ss, F.lane) * (1.0f / DM) + NORM_EPS);
        f32x4* o = (f32x4*)(dst + (size_t)row * DM) + F.lane;
#pragma unroll
        for (int j = 0; j < 16; ++j) { const f32x4 gv = ((const f32x4*)g)[F.lane + 64 * j]; f32x4 w; w[0] = v[j][0] * rs * gv[0]; w[1] = v[j][1] * rs * gv[1]; w[2] = v[j][2] * rs * gv[2]; w[3] = v[j][3] * rs * gv[3]; o[64 * j] = w; }
    }
}


__device__ __forceinline__ void p3_prep(const Frame& F, const float* wq, const float* wk, const float* b_ig, const float* b_fg, const float* wu, const float* bu) {
    const bf16* __restrict__ z = (const bf16*)(F.ws + WS_Z);
    const float* cosA = (const float*)(F.ws + WS_ROPE); const float* sinA = cosA + (size_t)SEQ * 16; const float* cosI = sinA + (size_t)SEQ * 16; const float* sinI = cosI + (size_t)SEQ * 8;
    const int gt = blockIdx.x * NTHR + F.tid, GT = F.G * NTHR;
#ifndef P3MASK
#define P3MASK 0
#endif
#define P3REP(k) for (int rep3_ = 0; rep3_ < (((P3MASK >> (k)) & 1) ? 2 : 1); ++rep3_)
    P3REP(1) { bf16* __restrict__ qk = (bf16*)(F.ws + WS_QA);
#pragma unroll 4
      for (int i = gt; i < 2 * 8 * SEQ; i += GT) { const int t = i & (SEQ - 1); bf16* p = qk + (size_t)i * 128;
          const u32x4 w0 = *(const u32x4*)p, w1 = *(const u32x4*)(p + 8), w2 = *(const u32x4*)(p + 16), w3 = *(const u32x4*)(p + 24);
          float x1[16], x2[16], o1[16], o2[16]; { float a[8]; unpack8(w0, a); for (int j = 0; j < 8; ++j) x1[j] = a[j]; unpack8(w1, a); for (int j = 0; j < 8; ++j) x1[8 + j] = a[j]; unpack8(w2, a); for (int j = 0; j < 8; ++j) x2[j] = a[j]; unpack8(w3, a); for (int j = 0; j < 8; ++j) x2[8 + j] = a[j]; }
          const float* cp = cosA + (size_t)t * 16; const float* sp = sinA + (size_t)t * 16;
#pragma unroll
          for (int j = 0; j < 16; ++j) { const float cc = cp[j], ss = sp[j]; o1[j] = x1[j] * cc - x2[j] * ss; o2[j] = x2[j] * cc + x1[j] * ss; }
          { float a[8]; for (int j = 0; j < 8; ++j) a[j] = o1[j]; *(u32x4*)p = pack8f(a); for (int j = 0; j < 8; ++j) a[j] = o1[8 + j]; *(u32x4*)(p + 8) = pack8f(a); for (int j = 0; j < 8; ++j) a[j] = o2[j]; *(u32x4*)(p + 16) = pack8f(a); for (int j = 0; j < 8; ++j) a[j] = o2[8 + j]; *(u32x4*)(p + 24) = pack8f(a); } } }
    P3REP(2) { bf16* __restrict__ iq = (bf16*)(F.ws + WS_IQ); bf16* __restrict__ ik = (bf16*)(F.ws + WS_IK); bf16* __restrict__ qt = (bf16*)(F.ws + WS_QT);
      for (int i = gt; i < SEQ * 8; i += GT) { const int t = i >> 3, c8 = i & 7;
          const float* cp = cosI + (size_t)t * 8; const float* sp = sinI + (size_t)t * 8;
          if (c8 == 1) { bf16* p = ik + (size_t)t * 64;
              float a[8], b[8], oa[8], ob[8]; unpack8(*(const u32x4*)p, a); unpack8(*(const u32x4*)(p + 8), b);
#pragma unroll
              for (int j = 0; j < 8; ++j) { const float cc = cp[j], ss = sp[j]; oa[j] = a[j] * cc - b[j] * ss; ob[j] = b[j] * cc + a[j] * ss; }
              *(u32x4*)p = pack8f(oa); *(u32x4*)(p + 8) = pack8f(ob);
          } else {
              float wv[16]; { const bf16* wp = z + (size_t)t * ZW + ZIW; float wa[8], wb[8]; unpack8(*(const u32x4*)wp, wa); unpack8(*(const u32x4*)(wp + 8), wb);
#pragma unroll
                for (int h = 0; h < 8; ++h) { wv[h] = wa[h]; wv[8 + h] = wb[h]; } }
              bf16* qo = qt + (size_t)t * 128;
              if (c8 == 0) { float sa[8], sb[8], cc[8], ss[8];
#pragma unroll
                  for (int j = 0; j < 8; ++j) { sa[j] = 0.f; sb[j] = 0.f; cc[j] = cp[j]; ss[j] = sp[j]; }
#pragma unroll
                  for (int h = 0; h < 16; ++h) { bf16* p = iq + ((size_t)t * 16 + h) * 64;
                      float a[8], b[8], oa[8], ob[8]; unpack8(*(const u32x4*)p, a); unpack8(*(const u32x4*)(p + 8), b);
#pragma unroll
                      for (int j = 0; j < 8; ++j) { oa[j] = a[j] * cc[j] - b[j] * ss[j]; ob[j] = b[j] * cc[j] + a[j] * ss[j]; }
                      const u32x4 pa = pack8f(oa), pb = pack8f(ob); *(u32x4*)p = pa; *(u32x4*)(p + 8) = pb; unpack8(pa, oa); unpack8(pb, ob);
#pragma unroll
                      for (int j = 0; j < 8; ++j) { sa[j] += wv[h] * oa[j]; sb[j] += wv[h] * ob[j]; } }
                  { const u32x4 hi = pack8f(sa); float r[8]; unpack8(hi, r);
#pragma unroll
                    for (int j = 0; j < 8; ++j) r[j] = sa[j] - r[j];
                    *(u32x4*)qo = hi; *(u32x4*)(qo + 64) = pack8f(r); }
                  { const u32x4 hi = pack8f(sb); float r[8]; unpack8(hi, r);
#pragma unroll
                    for (int j = 0; j < 8; ++j) r[j] = sb[j] - r[j];
                    *(u32x4*)(qo + 8) = hi; *(u32x4*)(qo + 72) = pack8f(r); }
              } else { float s8[8];
#pragma unroll
                  for (int j = 0; j < 8; ++j) s8[j] = 0.f;
#pragma unroll
                  for (int h = 0; h < 16; ++h) { float a[8]; unpack8(*(const u32x4*)(iq + ((size_t)t * 16 + h) * 64 + c8 * 8), a);
#pragma unroll
                      for (int j = 0; j < 8; ++j) s8[j] += wv[h] * a[j]; }
                  const u32x4 hi = pack8f(s8); float r[8]; unpack8(hi, r);
#pragma unroll
                  for (int j = 0; j < 8; ++j) r[j] = s8[j] - r[j];
                  *(u32x4*)(qo + c8 * 8) = hi; *(u32x4*)(qo + 64 + c8 * 8) = pack8f(r); } } } }
    P3REP(3) { bf16* __restrict__ cq = (bf16*)(F.ws + WS_CQ); bf16* __restrict__ ck = (bf16*)(F.ws + WS_CK);
      constexpr int PER = SEQ * 96;
#pragma unroll 4
      for (int i = gt; i < 2 * PER; i += GT) {
          const int which = i / PER, r = i - which * PER, c8 = r % 96, t = r / 96;
          const float* w = (which ? wk : wq) + c8 * 8; const int zc = (which ? ZK_C : ZQ_C) + c8 * 8; float acc[8];
#pragma unroll
          for (int j = 0; j < 8; ++j) acc[j] = 0.f;
#pragma unroll
          for (int tap = 0; tap < 4; ++tap) { const int ts = t - 3 + tap; if (ts >= 0) { float xv[8]; unpack8(*(const u32x4*)(z + (size_t)ts * ZW + zc), xv); const f32x4 w0 = *(const f32x4*)(w + tap * 768), w1 = *(const f32x4*)(w + tap * 768 + 4);
#pragma unroll
              for (int j = 0; j < 4; ++j) { acc[j] += xv[j] * w0[j]; acc[4 + j] += xv[4 + j] * w1[j]; } } }
          const float sc = which ? 1.0f : 0.08838834764831845f;
#pragma unroll
          for (int j = 0; j < 8; ++j) acc[j] = siluf_(acc[j]) * sc;
          *(u32x4*)((which ? ck : cq) + (size_t)t * 768 + c8 * 8) = pack8f(acc); } }
    P3REP(4) { float* mg = (float*)(F.ws + WS_MG);
      for (int u = F.gw; u < NCH * 6; u += F.NGW) { const int c = u / 6, h = u % 6, t = c * 64 + F.lane; const float bi = b_ig[h], bfg = b_fg[h];
          const float ci = bf2f(z[(size_t)t * ZW + ZIF + h]), cf = bf2f(z[(size_t)t * ZW + ZIF + 6 + h]);
          float v = log_sigmoidf(cf + bfg);
#pragma unroll
          for (int o = 1; o < 64; o <<= 1) { const float nb = shup(v, o, F.lane); if (F.lane >= o) v += nb; }
          mg[MG_B + (size_t)t * 8 + h] = v; mg[MG_I + (size_t)t * 8 + h] = ci + bi; } }
    P3REP(5) { float* bA = (float*)(F.ws + WS_BA); LAS float* al = (LAS float*)F.lds;
      for (int c = blockIdx.x; c < NCH; c += F.G) {
          __syncthreads();
          if (F.tid < 128) { const int s = F.tid >> 1, hf = F.tid & 1; float a[8]; unpack8(*(const u32x4*)(z + (size_t)(c * 64 + s) * ZW + ZLOW + hf * 8), a);
#pragma unroll
              for (int r = 0; r < 8; ++r) al[s * 16 + hf * 8 + r] = a[r]; }
          __syncthreads();
          for (int n = F.tid; n < 768; n += NTHR) { float wv[16];
#pragma unroll
              for (int r = 0; r < 16; ++r) wv[r] = wu[r * 768 + n];
              const float bb = bu[n]; float bs = 0.f; float* op = bA + (size_t)c * 64 * 768 + (n & ~3);
              const int ql = F.lane & 3;
              for (int s4 = 0; s4 < 64; s4 += 4) { float v[4];
#pragma unroll
                  for (int k = 0; k < 4; ++k) { const int s = s4 + k; const f32x4 a0 = *(const LAS f32x4*)(al + s * 16), a1 = *(const LAS f32x4*)(al + s * 16 + 4), a2 = *(const LAS f32x4*)(al + s * 16 + 8), a3 = *(const LAS f32x4*)(al + s * 16 + 12);
                      float x = bb;
#pragma unroll
                      for (int r = 0; r < 4; ++r) { x += a0[r] * wv[r]; x += a1[r] * wv[4 + r]; x += a2[r] * wv[8 + r]; x += a3[r] * wv[12 + r]; }
                      bs += (fminf(x, 0.f) - __logf(1.0f + __expf(-fabsf(x)))) * (1.0f / 16.0f); v[k] = bs; }
                  { const bool o1 = ql & 1, o2 = ql & 2;
                    const float x0 = o1 ? v[0] : v[1], x1 = o1 ? v[2] : v[3];
                    const float r0 = __int_as_float(__builtin_amdgcn_mov_dpp(__float_as_int(x0), 0xB1, 0xf, 0xf, false)), r1 = __int_as_float(__builtin_amdgcn_mov_dpp(__float_as_int(x1), 0xB1, 0xf, 0xf, false));
                    const float u0 = o1 ? r0 : v[0], u1 = o1 ? v[1] : r0, u2 = o1 ? r1 : v[2], u3 = o1 ? v[3] : r1;
                    const float y0 = o2 ? u0 : u2, y1 = o2 ? u1 : u3;
                    const float q0 = __int_as_float(__builtin_amdgcn_mov_dpp(__float_as_int(y0), 0x4E, 0xf, 0xf, false)), q1 = __int_as_float(__builtin_amdgcn_mov_dpp(__float_as_int(y1), 0x4E, 0xf, 0xf, false));
                    const f32x4 w = {o2 ? q0 : u0, o2 ? q1 : u1, o2 ? u2 : q0, o2 ? u3 : q1};
                    *(f32x4*)(op + (size_t)(s4 + ql) * 768) = w; } } } }
    }
}

__device__ __forceinline__ f32x16 mfma32(bf16x8 a, bf16x8 b, f32x16 c) { return __builtin_amdgcn_mfma_f32_32x32x16_bf16(a, b, c, 0, 0, 0); }
__device__ __forceinline__ f32x4 mfma16(bf16x8 a, bf16x8 b, f32x4 c) { return __builtin_amdgcn_mfma_f32_16x16x32_bf16(a, b, c, 0, 0, 0); }
__device__ __forceinline__ f32x16 zero16() { f32x16 z;
#pragma unroll
    for (int i = 0; i < 16; ++i) z[i] = 0.f;
    return z; }

__device__ __forceinline__ void p4_index_scores(const Frame& F) {
    const bf16* iq = (const bf16*)(F.ws + WS_IQ); const bf16* ik = (const bf16*)(F.ws + WS_IK); const bf16* zw = (const bf16*)(F.ws + WS_Z) + ZIW; _Float16* sc = (_Float16*)(F.ws + WS_SCORE);
    const int l15 = F.lane & 15, lq = F.lane >> 4;
    constexpr int NITEMS = 2112;
#define IDX_STAGE(j_, buf_) do { const int ln_ = hw_lane(); \
        _Pragma("unroll") for (int i_ = 0; i_ < 8; ++i_) { const int ci_ = i_ * 8 + F.wave, r_ = ci_ * 8 + (ln_ >> 3), c_ = (ln_ & 7) ^ ((r_ >> 1) & 7); \
            __builtin_amdgcn_global_load_lds((const unsigned*)(ik + (size_t)(512 * (j_) + r_) * 64 + c_ * 8), (LAS unsigned*)(F.lds + (buf_) * 65536 + ci_ * 1024), 16, 0, 0); } } while (0)
#define IDX_ADV(q_, d_, j_) do { if (++j_ > q_) { j_ = 0; if (++d_ == 4) { d_ = 0; ++q_; } } } while (0)
    const int i_beg = (int)(((long)blockIdx.x * NITEMS) / F.G), i_end = (int)(((long)(blockIdx.x + 1) * NITEMS) / F.G);
    int q4 = 0, d4 = 0, j = 0; { int r = i_beg; while (r >= 4 * (q4 + 1)) { r -= 4 * (q4 + 1); ++q4; } d4 = (r >= q4 + 1) + (r >= 2 * (q4 + 1)) + (r >= 3 * (q4 + 1)); j = r - d4 * (q4 + 1); }
    int par = 0; bool fresh = true;
    bf16x8 bq[16][2]; float w[16]; bf16x8 bt[4];
    if (i_beg < i_end) IDX_STAGE(j, 0);
    for (int bi = i_beg; bi < i_end; ++bi, par ^= 1) {
        const int g = 8 * (4 * q4 + d4) + F.wave, t0 = 16 * g, s0 = 512 * j;
        int s_end = s0 + 512; if (s_end > t0 + 16) s_end = t0 + 16;
        if (fresh) {
            const bf16* qp = iq + (size_t)(t0 + l15) * 1024 + 8 * lq;
#pragma unroll
            for (int h = 0; h < 16; ++h) { bq[h][0] = *(const bf16x8*)(qp + h * 64); bq[h][1] = *(const bf16x8*)(qp + h * 64 + 32); }
            { const bf16* wp = zw + (size_t)(t0 + l15) * ZW; float wa[8], wb[8]; unpack8(*(const u32x4*)wp, wa); unpack8(*(const u32x4*)(wp + 8), wb);
#pragma unroll
              for (int h = 0; h < 8; ++h) { w[h] = wa[h]; w[8 + h] = wb[h]; } }
            { const bf16* tp = (const bf16*)(F.ws + WS_QT) + (size_t)(t0 + l15) * 128 + 8 * lq; bt[0] = *(const bf16x8*)tp; bt[1] = *(const bf16x8*)(tp + 32); bt[2] = *(const bf16x8*)(tp + 64); bt[3] = *(const bf16x8*)(tp + 96); }
            VM_WAIT();
        } else asm volatile("s_waitcnt vmcnt(32)" ::: "memory");
        asm volatile("s_waitcnt lgkmcnt(0)" ::: "memory"); __builtin_amdgcn_s_barrier();
        int qn = q4, dn = d4, jn = j; IDX_ADV(qn, dn, jn);
        if (bi + 1 < i_end) IDX_STAGE(jn, par ^ 1);
        fresh = jn == 0;
        _Float16* orow = sc + (size_t)(t0 + l15) * SEQ + 4 * lq;
        const LAS unsigned char* kp0 = F.lds + par * 65536 + l15 * 128 + ((lq ^ (l15 >> 1)) << 4);
        const LAS unsigned char* kp1 = F.lds + par * 65536 + l15 * 128 + (((lq + 4) ^ (l15 >> 1)) << 4);
        for (int s = s0; s < s_end; s += 16) {
            const bf16x8 a0 = *(const LAS bf16x8*)kp0, a1 = *(const LAS bf16x8*)kp1; kp0 += 2048; kp1 += 2048;
            f32x4 tot = mfma16(a0, bt[0], (f32x4){0.f, 0.f, 0.f, 0.f});
#pragma unroll
            for (int hh = 0; hh < 16; hh += 8) { f32x4 acc[8];
                __builtin_amdgcn_s_setprio(1);
#pragma unroll
                for (int h = 0; h < 8; ++h) acc[h] = mfma16(a0, bq[hh + h][0], (f32x4){0.f, 0.f, 0.f, 0.f});
                if (hh == 0) { tot = mfma16(a1, bt[1], tot); tot = mfma16(a0, bt[2], tot); }
#pragma unroll
                for (int h = 0; h < 8; ++h) acc[h] = mfma16(a1, bq[hh + h][1], acc[h]);
                if (hh == 0) tot = mfma16(a1, bt[3], tot);
                __builtin_amdgcn_s_setprio(0);
                __builtin_amdgcn_sched_barrier(0);
                asm volatile("s_nop 15");
#pragma unroll
                for (int h = 0; h < 8; ++h) {
#pragma unroll
                    for (int r = 0; r < 4; ++r) asm volatile("v_fma_f32 %0, %1, |%2|, %0" : "+v"(tot[r]) : "v"(w[hh + h]), "v"(acc[h][r])); } }
            { typedef _Float16 h16x4 __attribute__((ext_vector_type(4))); h16x4 hv; hv[0] = (_Float16)tot[0]; hv[1] = (_Float16)tot[1]; hv[2] = (_Float16)tot[2]; hv[3] = (_Float16)tot[3]; *(h16x4*)(orow + s) = hv; }
        }
        q4 = qn; d4 = dn; j = jn;
    }
#undef IDX_STAGE
#undef IDX_ADV
}

#define DST_STORE2(ptr_, acc_, g_) do { unsigned ax_ = pk2(acc_[4 * (g_)], acc_[4 * (g_) + 1]), ay_ = pk2(acc_[4 * (g_) + 2], acc_[4 * (g_) + 3]), bx_ = pk2(acc_[4 * (g_) + 4], acc_[4 * (g_) + 5]), by_ = pk2(acc_[4 * (g_) + 6], acc_[4 * (g_) + 7]); \
        const auto rx_ = __builtin_amdgcn_permlane32_swap(ax_, bx_, false, false); const auto ry_ = __builtin_amdgcn_permlane32_swap(ay_, by_, false, false); \
        *(u32x4*)((ptr_) + 8 * ((g_) + hi)) = (u32x4){(unsigned)rx_[0], (unsigned)ry_[0], (unsigned)rx_[1], (unsigned)ry_[1]}; } while (0)
__device__ __forceinline__ void p4_gla_local(const Frame& F) {
    const bf16* z = (const bf16*)(F.ws + WS_Z); const float* bA = (const float*)(F.ws + WS_BA); bf16* dS = (bf16*)(F.ws + WS_DS);
    LAS bf16* vT = (LAS bf16*)F.lds;
    LAS bf16* kT = vT + 128 * 72;
    const int r32 = F.lane & 31, hi = F.lane >> 5, s = F.tid >> 3, d8 = (F.tid & 7) * 8, e16 = (F.tid & 7) * 16;
    u32x4 kw, vw0, vw1; f32x4 b0, b1, e0, e1;
#define GLA_LOAD(u_) do { const int c_ = (u_) / 12, h_ = (u_) % 12, t0_ = c_ * 64; kw = *(const u32x4*)(z + (size_t)(t0_ + s) * ZW + ZK_A + h_ * 64 + d8); \
        const float* bp_ = bA + (size_t)(t0_ + s) * 768 + h_ * 64 + d8; const float* be_ = bA + (size_t)(t0_ + 63) * 768 + h_ * 64 + d8; \
        b0 = *(const f32x4*)bp_; b1 = *(const f32x4*)(bp_ + 4); e0 = *(const f32x4*)be_; e1 = *(const f32x4*)(be_ + 4); \
        const bf16* vp_ = z + (size_t)(t0_ + s) * ZW + ZV_A + h_ * 128 + e16; vw0 = *(const u32x4*)vp_; vw1 = *(const u32x4*)(vp_ + 8); } while (0)
    int u = blockIdx.x; if (u < NCH * 12) GLA_LOAD(u);
    for (; u < NCH * 12; u += F.G) {
        __syncthreads();
        { float kv[8]; unpack8(kw, kv);
#pragma unroll
          for (int j = 0; j < 4; ++j) { kT[TPOS(d8 + j, s, 3)] = f2bf(kv[j] * __expf(e0[j] - b0[j])); kT[TPOS(d8 + 4 + j, s, 3)] = f2bf(kv[4 + j] * __expf(e1[j] - b1[j])); }
          const unsigned ww[8] = {vw0.x, vw0.y, vw0.z, vw0.w, vw1.x, vw1.y, vw1.z, vw1.w};
#pragma unroll
          for (int j = 0; j < 8; ++j) { vT[TPOS(e16 + 2 * j, s, 4)] = (bf16)(ww[j] & 0xffffu); vT[TPOS(e16 + 2 * j + 1, s, 4)] = (bf16)(ww[j] >> 16); } }
        __syncthreads();
        if (u + F.G < NCH * 12) GLA_LOAD(u + F.G);
        const int et = F.wave >> 1, dt = F.wave & 1; f32x16 acc = zero16();
#pragma unroll
        for (int kk = 0; kk < 4; ++kk) { const bf16x8 a = *(const LAS bf16x8*)(kT + TRD(32 * dt + r32, 2 * kk + hi, 3)), b = *(const LAS bf16x8*)(vT + TRD(32 * et + r32, 2 * kk + hi, 4)); acc = mfma32(a, b, acc); }
        bf16* o = dS + ((size_t)u * 128 + 32 * et + r32) * 64 + 32 * dt;
        DST_STORE2(o, acc, 0); DST_STORE2(o, acc, 2);
    }
#undef GLA_LOAD
}

__device__ __forceinline__ void p4_mlstm_local(const Frame& F) {
    const bf16* z = (const bf16*)(F.ws + WS_Z); const bf16* ck = (const bf16*)(F.ws + WS_CK); float* mg = (float*)(F.ws + WS_MG); bf16* dC = (bf16*)(F.ws + WS_DC);
    LAS bf16* vT = (LAS bf16*)F.lds;
    LAS bf16* kT = vT + 256 * 72;
    LAS float* wsl = (LAS float*)(kT + 128 * 72);
    const int r32 = F.lane & 31, hi = F.lane >> 5, s = F.tid >> 3, d16 = (F.tid & 7) * 16, e32 = (F.tid & 7) * 32;
    u32x4 kw0, kw1, vw[4]; float gbs = 0.f, gig = 0.f;
#define ML_LOAD(u_) do { const int c_ = (u_) / 6, h_ = (u_) % 6, t0_ = c_ * 64; const bf16* kp_ = ck + (size_t)(t0_ + s) * 768 + h_ * 128 + d16; kw0 = *(const u32x4*)kp_; kw1 = *(const u32x4*)(kp_ + 8); \
        const bf16* vp_ = z + (size_t)(t0_ + s) * ZW + ZV_C + h_ * 256 + e32; _Pragma("unroll") for (int q_ = 0; q_ < 4; ++q_) vw[q_] = *(const u32x4*)(vp_ + 8 * q_); \
        if (F.wave == 0) { gbs = mg[MG_B + (size_t)(t0_ + F.lane) * 8 + h_]; gig = mg[MG_I + (size_t)(t0_ + F.lane) * 8 + h_]; } } while (0)
    const bool bal = F.G == 256, heavy = ((int)blockIdx.x & 3) == 3; const int nun = bal ? (heavy ? 3 : 7) : (NCH * 6 - (int)blockIdx.x + F.G - 1) / F.G;
#define ML_UNIT(k_) (bal ? ((k_) < 3 ? 256 * (k_) + (int)blockIdx.x : 768 + 192 * ((k_) - 3) + (int)blockIdx.x - ((int)blockIdx.x >> 2)) : (int)blockIdx.x + (k_) * F.G)
    int u = ML_UNIT(0); if (nun > 0) ML_LOAD(u);
    for (int ku = 0; ku < nun; ++ku, u = ML_UNIT(ku)) {
        __syncthreads();
        if (F.wave == 0) { const float be = __int_as_float(__builtin_amdgcn_readlane(__float_as_int(gbs), 63));
            const float a = be - gbs + gig; const float ml = wave_max(a, F.lane); wsl[F.lane] = __expf(a - ml); if (F.lane == 0) { mg[MG_ML + (size_t)u * 2] = be; mg[MG_ML + (size_t)u * 2 + 1] = ml; } }
        __syncthreads();
        { const float wsv = wsl[s]; float k0[8], k1[8]; unpack8(kw0, k0); unpack8(kw1, k1);
#pragma unroll
          for (int j = 0; j < 8; ++j) { kT[TPOS(d16 + j, s, 4)] = f2bf(k0[j] * wsv); kT[TPOS(d16 + 8 + j, s, 4)] = f2bf(k1[j] * wsv); }
#pragma unroll
          for (int q = 0; q < 4; ++q) { const unsigned ww[4] = {vw[q].x, vw[q].y, vw[q].z, vw[q].w};
#pragma unroll
              for (int j = 0; j < 4; ++j) { vT[TPOS(e32 + 8 * q + 2 * j, s, 5)] = (bf16)(ww[j] & 0xffffu); vT[TPOS(e32 + 8 * q + 2 * j + 1, s, 5)] = (bf16)(ww[j] >> 16); } } }
        __syncthreads();
        if (ku + 1 < nun) ML_LOAD(ML_UNIT(ku + 1));
        if (F.tid < 128) { float sum = 0.f; const LAS bf16* kr = kT + F.tid * 72;
#pragma unroll 8
            for (int ss = 0; ss < 64; ++ss) sum += bf2f(kr[ss]);
            mg[MG_DN + (size_t)u * 128 + F.tid] = sum; }
        const int et = F.wave; bf16x8 bv[4];
#pragma unroll
        for (int kk = 0; kk < 4; ++kk) bv[kk] = *(const LAS bf16x8*)(vT + TRD(32 * et + r32, 2 * kk + hi, 5));
        bf16* o = dC + ((size_t)u * 256 + 32 * et + r32) * 128;
#pragma unroll
        for (int dt = 0; dt < 4; ++dt) { f32x16 acc = zero16();
#pragma unroll
            for (int kk = 0; kk < 4; ++kk) { const bf16x8 a = *(const LAS bf16x8*)(kT + TRD(32 * dt + r32, 2 * kk + hi, 4)); acc = mfma32(a, bv[kk], acc); }
            DST_STORE2(o + 32 * dt, acc, 0); DST_STORE2(o + 32 * dt, acc, 2); }
    }
#undef ML_LOAD
#undef ML_UNIT
}

__device__ __forceinline__ void p5_scans(const Frame& F) {
    const float* bA = (const float*)(F.ws + WS_BA); const bf16* dS = (const bf16*)(F.ws + WS_DS); bf16* SP = (bf16*)(F.ws + WS_SP);
    float* mg = (float*)(F.ws + WS_MG); const bf16* dC = (const bf16*)(F.ws + WS_DC); bf16* CP = (bf16*)(F.ws + WS_CP);
    for (int grp = blockIdx.x + F.G * F.wave; grp < 579; grp += F.G * 8) {
        const int l = F.lane;
        if (grp < 192) {
            constexpr int SB = 4;
            const int i = grp * 64 + l, h = i >> 10, rem = i & 1023, e = rem >> 3, d8 = (rem & 7) * 8;
            float S[8];
#pragma unroll
            for (int q = 0; q < 8; ++q) S[q] = 0.f;
            u32x4 dlA[SB], dlB[SB]; f32x4 dcA[SB][2], dcB[SB][2];
#define G_LOAD(DL, DC, c0_) do { _Pragma("unroll") for (int k = 0; k < SB; ++k) { const int c = (c0_) + k; DL[k] = *(const u32x4*)(dS + ((size_t)(c * 12 + h) * 128 + e) * 64 + d8); \
                const float* cp_ = bA + (size_t)(c * 64 + 63) * 768 + h * 64 + d8; DC[k][0] = *(const f32x4*)cp_; DC[k][1] = *(const f32x4*)(cp_ + 4); } } while (0)
#define G_STEP(DL, DC, c0_) do { _Pragma("unroll") for (int k = 0; k < SB; ++k) { const int c = (c0_) + k; *(u32x4*)(SP + ((size_t)(c * 12 + h) * 128 + e) * 64 + d8) = pack8f(S); float dv_[8]; unpack8(DL[k], dv_); \
                _Pragma("unroll") for (int q = 0; q < 8; ++q) S[q] = __expf(DC[k][q >> 2][q & 3]) * S[q] + dv_[q]; } } while (0)
            G_LOAD(dlA, dcA, 0);
            for (int c0 = 0; c0 < NCH; c0 += 2 * SB) {
                G_LOAD(dlB, dcB, c0 + SB); G_STEP(dlA, dcA, c0);
                if (c0 + 2 * SB < NCH) G_LOAD(dlA, dcA, c0 + 2 * SB);
                G_STEP(dlB, dcB, c0 + SB); }
#undef G_LOAD
#undef G_STEP
        } else if (grp < 576) {
            constexpr int SB = 8;
            const int i = (grp - 192) * 64 + l, h = i >> 12, rem = i & 4095, e = rem >> 4, d8 = (rem & 15) * 8;
            float S[8]; float m = 0.f;
#pragma unroll
            for (int q = 0; q < 8; ++q) S[q] = 0.f;
            u32x4 dlA[SB], dlB[SB]; f32x2 mlA[SB], mlB[SB];
#define M_LOAD(DL, ML, c0_) do { _Pragma("unroll") for (int k = 0; k < SB; ++k) { const int c = (c0_) + k; ML[k] = *(const f32x2*)(mg + MG_ML + (size_t)(c * 6 + h) * 2); \
                DL[k] = *(const u32x4*)(dC + ((size_t)(c * 6 + h) * 256 + e) * 128 + d8); } } while (0)
#define M_STEP(DL, ML, c0_) do { _Pragma("unroll") for (int k = 0; k < SB; ++k) { const int c = (c0_) + k; \
                *(u32x4*)(CP + ((size_t)(c * 6 + h) * 256 + e) * 128 + d8) = pack8f(S); float dv_[8]; unpack8(DL[k], dv_); \
                const float a_state = ML[k][0] + m, m_new = fmaxf(a_state, ML[k][1]), f1 = __expf(a_state - m_new), f2 = __expf(ML[k][1] - m_new); \
                _Pragma("unroll") for (int q = 0; q < 8; ++q) S[q] = f1 * S[q] + f2 * dv_[q]; \
                m = m_new; } } while (0)
            M_LOAD(dlA, mlA, 0);
            for (int c0 = 0; c0 < NCH; c0 += 2 * SB) {
                M_LOAD(dlB, mlB, c0 + SB); M_STEP(dlA, mlA, c0);
                if (c0 + 2 * SB < NCH) M_LOAD(dlA, mlA, c0 + 2 * SB);
                M_STEP(dlB, mlB, c0 + SB); }
#undef M_LOAD
#undef M_STEP
        } else {
            constexpr int SB = 8;
            const int ii = (grp - 576) * 64 + l, h = ii >> 5, d4 = (ii & 31) * 4;
            f32x4 S = {0.f, 0.f, 0.f, 0.f}; float m = 0.f;
            for (int c0 = 0; c0 < NCH; c0 += SB) { f32x4 dl[SB]; f32x2 ml[SB];
#pragma unroll
                for (int k = 0; k < SB; ++k) { const int c = c0 + k; ml[k] = *(const f32x2*)(mg + MG_ML + (size_t)(c * 6 + h) * 2); dl[k] = *(const f32x4*)(mg + MG_DN + (size_t)(c * 6 + h) * 128 + d4); }
#pragma unroll
                for (int k = 0; k < SB; ++k) { const int c = c0 + k;
                    *(f32x4*)(mg + MG_NP + (size_t)(c * 6 + h) * 128 + d4) = S; if (d4 == 0) mg[MG_MP + (size_t)(c * 6 + h)] = m;
                    const float a_state = ml[k][0] + m, m_new = fmaxf(a_state, ml[k][1]), f1 = __expf(a_state - m_new), f2 = __expf(ml[k][1] - m_new);
#pragma unroll
                    for (int q = 0; q < 4; ++q) S[q] = f1 * S[q] + f2 * dl[k][q];
                    m = m_new; } }
        }
    }
}

__device__ __forceinline__ unsigned long long perm_word(unsigned long long x) {
    unsigned long long t;
    t = ((x >> 4) ^ x) & 0x00F000F000F000F0ull; x ^= t ^ (t << 4);
    t = ((x >> 8) ^ x) & 0x0000FF000000FF00ull; x ^= t ^ (t << 8);
    t = ((x >> 16) ^ x) & 0x00000000FFFF0000ull; x ^= t ^ (t << 16);
    return x;
}
__device__ __forceinline__ void p5_select(const Frame& F, unsigned* ctr) {
    const _Float16* sc = (const _Float16*)(F.ws + WS_SCORE); unsigned long long* mask = (unsigned long long*)(F.ws + WS_MASK);
    LAS unsigned char* wl = F.lds + F.wave * 12304;
    LAS unsigned* hist = (LAS unsigned*)wl;
    LAS unsigned* words = (LAS unsigned*)(wl + 8192);
    LAS float* cval = (LAS float*)(wl + 8192 + 2048);
    LAS int* ckey = (LAS int*)(wl + 8192 + 3072);
    const float PINF = __builtin_inff();
    constexpr int SEL_DYN0 = 12288;
    int t = F.gw; unsigned nq_ = 0u;
    for (;;) {
        int lane = F.lane; asm volatile("" : "+v"(lane));
        if (t >= SEL_DYN0 - F.NGW) { if (lane == 0) nq_ = __hip_atomic_fetch_add(ctr, 1u, __ATOMIC_RELAXED, __HIP_MEMORY_SCOPE_AGENT); }
#define SEL_NEXT() do { if (t < SEL_DYN0 - F.NGW) t += F.NGW; else t = SEL_DYN0 + __builtin_amdgcn_readfirstlane((int)nq_); } while (0)
        if (t >= SEQ) break;
        const unsigned long long lt_mask = (1ull << lane) - 1ull; const int lane8 = lane * 8;
        const int n = t + 1, nw = 4 * (t / 256 + 1), ng = (n + 63) >> 6;
        const _Float16* row = sc + (size_t)t * SEQ; unsigned long long* mrow = mask + (size_t)t * 256;
        if (n <= 256) {
            if (lane < nw) { const int k0 = lane * 64; const unsigned long long w = (t >= k0 + 63) ? ~0ull : (t < k0 ? 0ull : ((2ull << (t - k0)) - 1ull)); mrow[lane] = perm_word(w); }
            SEL_NEXT(); continue; }
        typedef _Float16 h16x8 __attribute__((ext_vector_type(8))); typedef _Float16 h16x2 __attribute__((ext_vector_type(2)));
        const int ng8 = (n + 511) >> 9, glast = ng8 - 1; const h16x8* row8 = (const h16x8*)row + lane;
        u32x4 vv[32];
#pragma unroll
        for (int g = 0; g < 32; ++g) vv[g] = *(const u32x4*)(row8 + (g < ng8 ? g : 0) * 64);
        int nvl = n - 512 * glast - lane8; nvl = nvl < 0 ? 0 : (nvl > 8 ? 8 : nvl); const unsigned vlast = (1u << nvl) - 1u;
#define SEL_FILL(G, FILLPAIR) do { unsigned* d_ = (unsigned*)&vv[G]; _Pragma("unroll") for (int q_ = 0; q_ < 4; ++q_) { \
            const unsigned keep_ = (((vlast >> (2 * q_)) & 1u) ? 0x0000ffffu : 0u) | (((vlast >> (2 * q_ + 1)) & 1u) ? 0xffff0000u : 0u); d_[q_] = (d_[q_] & keep_) | ((FILLPAIR) & ~keep_); } } while (0)
#pragma unroll
        for (int g = 0; g < 32; ++g) if (g == glast) { const unsigned f0 = (unsigned)__builtin_amdgcn_readfirstlane((int)vv[g].x) & 0xffffu; SEL_FILL(g, f0 | (f0 << 16)); }
        h16x2 pmin = {(_Float16)65504.f, (_Float16)65504.f}, pmax = {(_Float16)-65504.f, (_Float16)-65504.f};
#pragma unroll
        for (int g = 0; g < 32; ++g) if (g < ng8) {
#pragma unroll
            for (int q = 0; q < 4; ++q) { const h16x2 x = __builtin_bit_cast(h16x2, ((const unsigned*)&vv[g])[q]); pmin = __builtin_elementwise_min(pmin, x); pmax = __builtin_elementwise_max(pmax, x); } }
        float lmin = fminf((float)pmin[0], (float)pmin[1]), lmax = fmaxf((float)pmax[0], (float)pmax[1]);
        lmin = -wave_max(-lmin, lane); lmax = wave_max(lmax, lane);
        const float span = lmax - lmin, lo = lmin, scale = span > 0.f ? 2047.0f / span : 0.f, los = -lo * scale;
        { const unsigned fm = (unsigned)__builtin_bit_cast(unsigned short, (_Float16)lmin);
#pragma unroll
          for (int g = 0; g < 32; ++g) if (g == glast) SEL_FILL(g, fm | (fm << 16)); }
#undef SEL_FILL
#pragma unroll
        for (int k = 0; k < 8; ++k) *(LAS u32x4*)(hist + (k * 64 + lane) * 4) = (u32x4){0u, 0u, 0u, 0u};
#pragma unroll
        for (int k = 0; k < 2; ++k) *(LAS u32x4*)(words + (k * 64 + lane) * 4) = (u32x4){0u, 0u, 0u, 0u};
#define SEL_BIN(G, J) ({ const h16x2 x_ = __builtin_bit_cast(h16x2, ((const unsigned*)&vv[G])[(J) >> 1]); int b_ = (int)fmaf((float)x_[(J) & 1], scale, los); b_ = b_ < 0 ? 0 : (b_ > 2047 ? 2047 : b_); b_; })
#pragma unroll
        for (int g = 0; g < 32; ++g) asm volatile("" : "+v"(vv[g]));
#pragma unroll
        for (int g = 0; g < 32; ++g) if (g < ng8) {
#pragma unroll
            for (int j = 0; j < 8; ++j) { const int b = SEL_BIN(g, j); __hip_atomic_fetch_add(&hist[b], 1u, __ATOMIC_RELAXED, __HIP_MEMORY_SCOPE_WORKGROUP); } }
        unsigned mine = 0;
#pragma unroll
        for (int q = 0; q < 8; ++q) { const u32x4 x = *(const LAS u32x4*)(hist + lane * 32 + q * 4); mine += (x.x + x.y) + (x.z + x.w); }
        unsigned suf = mine;
#pragma unroll
        for (int o = 1; o < 64; o <<= 1) { const unsigned nb = shdn_u(suf, o, lane); if (lane + o < 64) suf += nb; }
        unsigned above = suf - mine; int Bl = -1; unsigned cal = 0;
        if (above < 256u && above + mine >= 256u) {
            for (int q = 31; q >= 0; --q) { const unsigned hq = hist[lane * 32 + q]; if (Bl < 0 && above + hq >= 256u) { Bl = lane * 32 + q; cal = above; } above += hq; } }
        const unsigned long long hitm = __ballot(Bl >= 0); const int src = hitm ? __builtin_ctzll(hitm) : 0;
        const int Bs = __builtin_amdgcn_readlane(Bl, src); const unsigned cnt_above = (unsigned)__builtin_amdgcn_readlane((int)cal, src);
#pragma unroll
        for (int g = 0; g < 32; ++g) asm volatile("" : "+v"(vv[g]));
        LAS unsigned char* wbytes = (LAS unsigned char*)words; LAS unsigned* mcnt = (LAS unsigned*)(ckey + 256);
        if (lane == 0) *mcnt = 0u;
#pragma unroll
        for (int g = 0; g < 32; ++g) if (g < ng8) { int b[8]; unsigned abits = 0u; bool anyc = false;
#pragma unroll
            for (int j = 7; j >= 0; --j) { b[j] = SEL_BIN(g, j); abits = __builtin_amdgcn_alignbit(abits, (unsigned)(Bs - b[j]), 31); anyc |= (b[j] == Bs); }
            const unsigned vm = (g == glast) ? vlast : 0xffu;
            wbytes[g * 64 + lane] = (unsigned char)(abits & vm);
            if (anyc) {
#pragma unroll
                for (int j = 0; j < 8; ++j) if (b[j] == Bs && ((vm >> j) & 1u)) { const unsigned pos = __hip_atomic_fetch_add(mcnt, 1u, __ATOMIC_RELAXED, __HIP_MEMORY_SCOPE_WORKGROUP);
                    if (pos < 256u) { const h16x2 x = __builtin_bit_cast(h16x2, ((const unsigned*)&vv[g])[j >> 1]); cval[pos] = (float)x[j & 1]; ckey[pos] = lane8 + (g * 512 + j); } } } }
#undef SEL_BIN
        const unsigned m = *mcnt;
        const unsigned need = 256u - cnt_above;
        if (m <= 256u) {
            for (unsigned c = lane; c < m; c += 64) { const float mv = cval[c]; const int mk = ckey[c]; unsigned rank = 0;
                for (unsigned j = 0; j < m; ++j) { const float ov = cval[j]; const int ok = ckey[j]; rank += (ov > mv || (ov == mv && ok < mk)) ? 1u : 0u; }
                if (rank < need) __hip_atomic_fetch_or(&words[2 * (mk >> 6) + ((mk >> 5) & 1)], 1u << (mk & 31), __ATOMIC_RELAXED, __HIP_MEMORY_SCOPE_WORKGROUP); }
        } else {
            for (int g = 0; g < ng; ++g) { const int key = g * 64 + lane; int b = -1; if (key < n) { b = (int)fmaf((float)row[key], scale, los); b = b < 0 ? 0 : (b > 2047 ? 2047 : b); }
                const unsigned long long bc = __ballot(b == Bs); if (lane == 0) { words[2 * g] |= (unsigned)bc; words[2 * g + 1] |= (unsigned)(bc >> 32); } }
        }
#pragma unroll
        for (int k = 0; k < 4; ++k) { const int w = lane + 64 * k; if (w < nw) { const unsigned long long x = (unsigned long long)words[2 * w] | ((unsigned long long)words[2 * w + 1] << 32); mrow[w] = perm_word(x); } }
        SEL_NEXT();
    }
#undef SEL_NEXT
}

__device__ __forceinline__ void p6_gla_out(const Frame& F, const float* gain) {
    const bf16* z = (const bf16*)(F.ws + WS_Z); const float* bA = (const float*)(F.ws + WS_BA); const bf16* SP = (const bf16*)(F.ws + WS_SP); bf16* y = (bf16*)(F.ws + WS_Y);
    LAS bf16* qd = (LAS bf16*)F.lds;
    LAS bf16* ki = qd + 64 * 72;
    LAS bf16* vT = ki + 64 * 72;
    LAS bf16* scl = vT + 128 * 72;
    LAS float* part = (LAS float*)(scl + 64 * 72);
    const int r32 = F.lane & 31, hi = F.lane >> 5, s = F.tid >> 3, d8 = (F.tid & 7) * 8, e16 = (F.tid & 7) * 16;
    u32x4 qw, kw, vw0, vw1; f32x4 b0, b1;
#define GO_LOAD(u_) do { const int c_ = (u_) / 12, h_ = (u_) % 12, t0_ = c_ * 64; const bf16* zr_ = z + (size_t)(t0_ + s) * ZW; qw = *(const u32x4*)(zr_ + ZQ_A + h_ * 64 + d8); kw = *(const u32x4*)(zr_ + ZK_A + h_ * 64 + d8); \
        const float* bp_ = bA + (size_t)(t0_ + s) * 768 + h_ * 64 + d8; b0 = *(const f32x4*)bp_; b1 = *(const f32x4*)(bp_ + 4); vw0 = *(const u32x4*)(zr_ + ZV_A + h_ * 128 + e16); vw1 = *(const u32x4*)(zr_ + ZV_A + h_ * 128 + e16 + 8); } while (0)
    int u = blockIdx.x; if (u < NCH * 12) GO_LOAD(u);
    for (; u < NCH * 12; u += F.G) {
        const int c = u / 12, h = u % 12, t0 = c * 64;
        __syncthreads();
        { float qv[8], kv[8], qo[8], ko[8]; unpack8(qw, qv); unpack8(kw, kv);
#pragma unroll
          for (int j = 0; j < 4; ++j) { const float ea = __expf(b0[j]), eb = __expf(b1[j]); qo[j] = qv[j] * 0.125f * ea; qo[4 + j] = qv[4 + j] * 0.125f * eb; ko[j] = kv[j] / ea; ko[4 + j] = kv[4 + j] / eb; }
          *(LAS u32x4*)(qd + s * 72 + d8) = pack8f(qo); *(LAS u32x4*)(ki + s * 72 + d8) = pack8f(ko);
          const unsigned ww[8] = {vw0.x, vw0.y, vw0.z, vw0.w, vw1.x, vw1.y, vw1.z, vw1.w};
#pragma unroll
          for (int j = 0; j < 8; ++j) { vT[TPOS(e16 + 2 * j, s, 4)] = (bf16)(ww[j] & 0xffffu); vT[TPOS(e16 + 2 * j + 1, s, 4)] = (bf16)(ww[j] >> 16); } }
        __syncthreads();
        if (u + F.G < NCH * 12) GO_LOAD(u + F.G);
        const int et = F.wave >> 1, tt = F.wave & 1, t = 32 * tt + r32;
        bf16x8 sa[4]; u32x4 gzv[2];
        { const bf16* sp = SP + ((size_t)u * 128 + 32 * et + r32) * 64 + 8 * hi;
#pragma unroll
          for (int kk = 0; kk < 4; ++kk) sa[kk] = *(const bf16x8*)(sp + 16 * kk);
#pragma unroll
          for (int gp = 0; gp < 2; ++gp) gzv[gp] = *(const u32x4*)(z + (size_t)(t0 + t) * ZW + ZGATE_A + h * 128 + 32 * et + 8 * (2 * gp + hi)); }
        if (F.wave < 4) { const int st = F.wave >> 1; f32x16 acc = zero16();
#pragma unroll
            for (int kk = 0; kk < 4; ++kk) { const bf16x8 a = *(const LAS bf16x8*)(ki + (32 * st + r32) * 72 + 16 * kk + 8 * hi), b = *(const LAS bf16x8*)(qd + (32 * tt + r32) * 72 + 16 * kk + 8 * hi); acc = mfma32(a, b, acc); }
#pragma unroll
            for (int g = 0; g < 4; ++g) { const int sb = 32 * st + 8 * g + 4 * hi; float m[4];
#pragma unroll
                for (int j = 0; j < 4; ++j) m[j] = (sb + j <= t) ? acc[4 * g + j] : 0.f;
                u32x2 w; w.x = pk2(m[0], m[1]); w.y = pk2(m[2], m[3]); *(LAS u32x2*)(scl + t * 72 + sb) = w; } }
        __syncthreads();
        f32x16 acc = zero16();
#pragma unroll
        for (int kk = 0; kk < 4; ++kk) { const bf16x8 b = *(const LAS bf16x8*)(qd + t * 72 + 16 * kk + 8 * hi); acc = mfma32(sa[kk], b, acc); }
#pragma unroll
        for (int kk = 0; kk < 4; ++kk) { const bf16x8 a = *(const LAS bf16x8*)(vT + TRD(32 * et + r32, 2 * kk + hi, 4)), b = *(const LAS bf16x8*)(scl + t * 72 + 16 * kk + 8 * hi); acc = mfma32(a, b, acc); }
        float ss = 0.f;
#pragma unroll
        for (int r = 0; r < 16; ++r) ss += acc[r] * acc[r];
        ss += shx(ss, 32, F.lane);
        if (hi == 0) part[t * 4 + et] = ss;
        __syncthreads();
        const f32x4 pp = *(const LAS f32x4*)(part + t * 4); const float rs = 1.0f / sqrtf(((pp[0] + pp[1]) + (pp[2] + pp[3])) * (1.0f / 128.0f) + NORM_EPS);
#pragma unroll
        for (int gp = 0; gp < 2; ++gp) {
            float x[8];
#pragma unroll
            for (int j = 0; j < 4; ++j) { const auto r_ = __builtin_amdgcn_permlane32_swap(__float_as_uint(acc[8 * gp + j]), __float_as_uint(acc[8 * gp + 4 + j]), false, false); x[j] = __uint_as_float(r_[0]); x[4 + j] = __uint_as_float(r_[1]); }
            const int e0 = 32 * et + 8 * (2 * gp + hi); const f32x4 g0 = *(const f32x4*)(gain + h * 128 + e0), g1 = *(const f32x4*)(gain + h * 128 + e0 + 4);
            float ga[8], o[8]; unpack8(gzv[gp], ga);
#pragma unroll
            for (int j = 0; j < 8; ++j) o[j] = x[j] * rs * (j < 4 ? g0[j & 3] : g1[j & 3]) * siluf_(ga[j]);
            *(u32x4*)(y + (size_t)(t0 + t) * DM + YA + h * 128 + e0) = pack8f(o); }
    }
#undef GO_LOAD
}

__device__ __forceinline__ void p6_mlstm_out(const Frame& F, const float* gain) {
    const bf16* z = (const bf16*)(F.ws + WS_Z); const bf16* cq = (const bf16*)(F.ws + WS_CQ); const bf16* ck = (const bf16*)(F.ws + WS_CK); const float* mg = (const float*)(F.ws + WS_MG);
    const bf16* CP = (const bf16*)(F.ws + WS_CP); bf16* y = (bf16*)(F.ws + WS_Y);
    LAS bf16* qs = (LAS bf16*)F.lds;
    LAS bf16* ks = qs + 64 * 136;
    LAS bf16* vT = ks + 64 * 136;
    LAS bf16* pw = vT + 256 * 72;
    LAS float* fl = (LAS float*)(pw + 64 * 72);
    LAS float* bc = fl;
    LAS float* ig = fl + 64;
    LAS float* mt = fl + 128;
    LAS float* wi = fl + 192;
    LAS float* qn = fl + 256;
    LAS float* rp = fl + 320;
    LAS float* np = fl + 448;
    LAS float* sp = fl + 576;
    const int r32 = F.lane & 31, hi = F.lane >> 5, s = F.tid >> 3, d16 = (F.tid & 7) * 16, e32 = (F.tid & 7) * 32;
    u32x4 qw0, qw1, kw0, kw1, vw[4]; float gb = 0.f, gi = 0.f, gn0 = 0.f, gn1 = 0.f, gmp = 0.f;
#define MO_LOAD(u_) do { const int c_ = (u_) / 6, h_ = (u_) % 6, t0_ = c_ * 64; const bf16* qp_ = cq + (size_t)(t0_ + s) * 768 + h_ * 128 + d16; const bf16* kp_ = ck + (size_t)(t0_ + s) * 768 + h_ * 128 + d16; \
        qw0 = *(const u32x4*)qp_; qw1 = *(const u32x4*)(qp_ + 8); kw0 = *(const u32x4*)kp_; kw1 = *(const u32x4*)(kp_ + 8); \
        const bf16* vp_ = z + (size_t)(t0_ + s) * ZW + ZV_C + h_ * 256 + e32; _Pragma("unroll") for (int q_ = 0; q_ < 4; ++q_) vw[q_] = *(const u32x4*)(vp_ + 8 * q_); \
        gmp = mg[MG_MP + (size_t)(u_)]; \
        if (F.wave == 0) { gb = mg[MG_B + (size_t)(t0_ + F.lane) * 8 + h_]; gi = mg[MG_I + (size_t)(t0_ + F.lane) * 8 + h_]; } \
        if (F.wave == 1) { gn0 = mg[MG_NP + (size_t)(u_) * 128 + F.lane]; gn1 = mg[MG_NP + (size_t)(u_) * 128 + 64 + F.lane]; } } while (0)
    int u = blockIdx.x; if (u < NCH * 6) MO_LOAD(u);
    for (; u < NCH * 6; u += F.G) {
        const int c = u / 6, h = u % 6, t0 = c * 64;
        __syncthreads();
        { *(LAS u32x4*)(qs + s * 136 + d16) = qw0; *(LAS u32x4*)(qs + s * 136 + d16 + 8) = qw1; *(LAS u32x4*)(ks + s * 136 + d16) = kw0; *(LAS u32x4*)(ks + s * 136 + d16 + 8) = kw1;
#pragma unroll
          for (int q = 0; q < 4; ++q) { const unsigned ww[4] = {vw[q].x, vw[q].y, vw[q].z, vw[q].w};
#pragma unroll
              for (int j = 0; j < 4; ++j) { vT[TPOS(e32 + 8 * q + 2 * j, s, 5)] = (bf16)(ww[j] & 0xffffu); vT[TPOS(e32 + 8 * q + 2 * j + 1, s, 5)] = (bf16)(ww[j] >> 16); } } }
        const float m_prev = gmp;
        if (F.wave == 0) { const float b = gb, ii = gi; float pm = ii - b;
#pragma unroll
            for (int o = 1; o < 64; o <<= 1) { const float nb = shup(pm, o, F.lane); if (F.lane >= o) pm = fmaxf(pm, nb); }
            const float m = b + fmaxf(m_prev, pm); bc[F.lane] = b; ig[F.lane] = ii; mt[F.lane] = m; wi[F.lane] = __expf(b + m_prev - m); }
        if (F.wave == 1) { np[F.lane] = gn0; np[64 + F.lane] = gn1; }
        __syncthreads();
        if (u + F.G < NCH * 6) MO_LOAD(u + F.G);
        const int et = F.wave; bf16x8 ca[8];
        { const bf16* cp = CP + ((size_t)u * 256 + 32 * et + r32) * 128 + 8 * hi;
#pragma unroll
          for (int kk = 0; kk < 8; ++kk) ca[kk] = *(const bf16x8*)(cp + 16 * kk); }
        if (F.wave >= 4) { const int tq = (F.tid - 256) >> 2, qq = (F.tid - 256) & 3; float s = 0.f;
#pragma unroll 8
            for (int d = 0; d < 32; ++d) s += bf2f(qs[tq * 136 + qq * 32 + d]) * np[qq * 32 + d];
            s += shx(s, 1, F.lane); s += shx(s, 2, F.lane); if (qq == 0) qn[tq] = s; }
        else { const int st = F.wave >> 1, tt = F.wave & 1, t = 32 * tt + r32; f32x16 acc = zero16();
#pragma unroll
            for (int kk = 0; kk < 8; ++kk) { const bf16x8 a = *(const LAS bf16x8*)(ks + (32 * st + r32) * 136 + 16 * kk + 8 * hi), b = *(const LAS bf16x8*)(qs + t * 136 + 16 * kk + 8 * hi); acc = mfma32(a, b, acc); }
            const float bt = bc[t], mtt = mt[t]; float rsum = 0.f;
#pragma unroll
            for (int g = 0; g < 4; ++g) { const int sb = 32 * st + 8 * g + 4 * hi; float m[4];
#pragma unroll
                for (int j = 0; j < 4; ++j) { const int s = sb + j; const float w = (s <= t) ? __expf(bt - bc[s] + ig[s] - mtt) : 0.f; m[j] = acc[4 * g + j] * w; rsum += m[j]; }
                u32x2 w2; w2.x = pk2(m[0], m[1]); w2.y = pk2(m[2], m[3]); *(LAS u32x2*)(pw + t * 72 + sb) = w2; }
            rsum += shx(rsum, 32, F.lane); if (hi == 0) rp[t * 2 + st] = rsum; }
        __syncthreads();
        f32x16 hv[2];
        { bf16x8 va[4];
#pragma unroll
          for (int kk = 0; kk < 4; ++kk) va[kk] = *(const LAS bf16x8*)(vT + TRD(32 * et + r32, 2 * kk + hi, 5));
#pragma unroll
          for (int tt = 0; tt < 2; ++tt) { const int t = 32 * tt + r32; f32x16 aI = zero16(), aA = zero16();
#pragma unroll
              for (int kk = 0; kk < 8; ++kk) { const bf16x8 b = *(const LAS bf16x8*)(qs + t * 136 + 16 * kk + 8 * hi); aI = mfma32(ca[kk], b, aI); }
#pragma unroll
              for (int kk = 0; kk < 4; ++kk) { const bf16x8 b = *(const LAS bf16x8*)(pw + t * 72 + 16 * kk + 8 * hi); aA = mfma32(va[kk], b, aA); }
              const float w = wi[t], den = w * qn[t] + rp[t * 2] + rp[t * 2 + 1], dn = 1.0f / fmaxf(fabsf(den), __expf(-mt[t])); float ss = 0.f;
#pragma unroll
              for (int r = 0; r < 16; ++r) { const float x = (w * aI[r] + aA[r]) * dn; hv[tt][r] = x; ss += x * x; }
              ss += shx(ss, 32, F.lane); if (hi == 0) sp[t * 8 + et] = ss; } }
        __syncthreads();
#pragma unroll
        for (int tt = 0; tt < 2; ++tt) { const int t = 32 * tt + r32; const f32x4 p0 = *(const LAS f32x4*)(sp + t * 8), p1 = *(const LAS f32x4*)(sp + t * 8 + 4);
            const float rs = 1.0f / sqrtf((((p0[0] + p0[1]) + (p0[2] + p0[3])) + ((p1[0] + p1[1]) + (p1[2] + p1[3]))) * (1.0f / 256.0f) + NORM_EPS);
            const bf16* zr = z + (size_t)(t0 + t) * ZW + h * 256;
#pragma unroll
            for (int gp = 0; gp < 2; ++gp) {
                float x[8];
#pragma unroll
                for (int j = 0; j < 4; ++j) { const auto r_ = __builtin_amdgcn_permlane32_swap(__float_as_uint(hv[tt][8 * gp + j]), __float_as_uint(hv[tt][8 * gp + 4 + j]), false, false); x[j] = __uint_as_float(r_[0]); x[4 + j] = __uint_as_float(r_[1]); }
                const int e0 = 32 * et + 8 * (2 * gp + hi); const f32x4 g0 = *(const f32x4*)(gain + h * 256 + e0), g1 = *(const f32x4*)(gain + h * 256 + e0 + 4);
                float oa[8], ga[8], o[8]; unpack8(*(const u32x4*)(zr + ZO_C + e0), oa); unpack8(*(const u32x4*)(zr + ZGATE_C + e0), ga);
#pragma unroll
                for (int j = 0; j < 8; ++j) o[j] = x[j] * rs * (j < 4 ? g0[j & 3] : g1[j & 3]) * sigmoidf_(oa[j]) * siluf_(ga[j]);
                *(u32x4*)(y + (size_t)(t0 + t) * DM + YC + h * 256 + e0) = pack8f(o); } }
    }
#undef MO_LOAD
}

namespace dsa {
constexpr int D = 128, NW = 8, QBLK = 32, KVBLK = 64, QB = NW * QBLK;
constexpr int SHM_V = KVBLK * D * 2, SHM_K = KVBLK * D * 2;
constexpr int LDS_BYTES = 2 * SHM_V + 2 * SHM_K + NW * 64 * 4;
constexpr float SCALE = 0.08838834764831845f;
constexpr float THR = 8.f;
constexpr bool WSKIP = false;
constexpr size_t VOFF = (WS_VA - WS_KA) / 2;
typedef short s16x4 __attribute__((ext_vector_type(4)));
template <class A, class Bt> struct same_t { static constexpr bool v = false; };
template <class A> struct same_t<A, A> { static constexpr bool v = true; };
#define KSWZ(row, colB) ((row) * 256 + ((colB) ^ (((row) & 7) << 4)))
#define SBAR() __builtin_amdgcn_sched_barrier(0)
__device__ __forceinline__ int v_st(int k, int c) { const int kk = (k & ~0xC) | ((k & 4) << 1) | ((k & 8) >> 1); return ((kk >> 3) * 4 + (c >> 5)) * 512 + ((kk & 7) * 32 + (c & 31)) * 2; }
__device__ __forceinline__ int v_rd_base(int lane) { return ((lane & 3) << 3) | (((lane >> 2) & 3) << 6) | (((lane >> 4) & 1) << 5) | (((lane >> 5) & 1) << 8); }
constexpr int v_rd_off(int d0, int ks, int half) { return d0 * 512 + ks * 4096 + half * 2048; }
__device__ __forceinline__ unsigned cvtpk(float lo, float hi) {
    unsigned r; asm volatile("v_cvt_pk_bf16_f32 %0, %1, %2" : "=v"(r) : "v"(lo), "v"(hi)); return r;
}
__device__ __forceinline__ bf16x8 pack8(f32x4 a, f32x4 b) {
    u32x4 w = {cvtpk(a[0], a[1]), cvtpk(a[2], a[3]), cvtpk(b[0], b[1]), cvtpk(b[2], b[3])};
    return *reinterpret_cast<bf16x8*>(&w);
}
template <class T> __device__ __forceinline__ bf16x8 load8(const T* p) {
    if constexpr (same_t<T, float>::v) { return pack8(*(const f32x4*)p, *(const f32x4*)(p + 4)); }
    else { return *reinterpret_cast<const bf16x8*>(p); }
}
__device__ __forceinline__ void mask_bits(f32x16& p0, f32x16& p1, unsigned w) {
#pragma unroll
    for (int r = 0; r < 16; ++r) {
        const unsigned m0 = (unsigned)__builtin_amdgcn_sbfe((int)w, r, 1), m1 = (unsigned)__builtin_amdgcn_sbfe((int)w, 16 + r, 1);
        p0[r] = __uint_as_float((__float_as_uint(p0[r]) & m0) | (0xff800000u & ~m0));
        p1[r] = __uint_as_float((__float_as_uint(p1[r]) & m1) | (0xff800000u & ~m1));
    }
}
__device__ __forceinline__ void partialSM(f32x16& p0, f32x16& p1, float& m_reg, float& mn, float& alpha) {
    float pmax = p0[0]; for (int r = 1; r < 16; ++r) pmax = fmaxf(pmax, p0[r]); for (int r = 0; r < 16; ++r) pmax = fmaxf(pmax, p1[r]);
    { auto rr = __builtin_amdgcn_permlane32_swap(__float_as_uint(pmax), __float_as_uint(pmax), false, false);
      pmax = fmaxf(__uint_as_float(rr[0]), __uint_as_float(rr[1])); }
    constexpr float C2 = 1.4426950408889634f * SCALE;
    if (__builtin_expect(__all((pmax - m_reg) * SCALE <= THR), 1)) { mn = m_reg; alpha = 1.f; }
    else { mn = fmaxf(m_reg, pmax); alpha = __builtin_amdgcn_exp2f((m_reg - mn) * C2); m_reg = mn; }
    const float mnL = -mn * C2;
    for (int r = 0; r < 16; ++r) p0[r] = fmaf(p0[r], C2, mnL); for (int r = 0; r < 16; ++r) p1[r] = fmaf(p1[r], C2, mnL);
    for (int r = 0; r < 16; ++r) p0[r] = __builtin_amdgcn_exp2f(p0[r]);
}
__device__ __forceinline__ void finishSM(f32x16& p0, f32x16& p1, float alpha, float& l_reg, bf16x8& pa0, bf16x8& pa1, bf16x8& pa2, bf16x8& pa3) {
    for (int r = 0; r < 16; ++r) p1[r] = __builtin_amdgcn_exp2f(p1[r]);
    float ps = 0; for (int r = 0; r < 16; ++r) ps += p0[r]; for (int r = 0; r < 16; ++r) ps += p1[r];
    { auto rr = __builtin_amdgcn_permlane32_swap(__float_as_uint(ps), __float_as_uint(ps), false, false);
      ps = __uint_as_float(rr[0]) + __uint_as_float(rr[1]); }
    l_reg = l_reg * alpha + ps;
#define PK4(P, B_, OUT) do { unsigned a0 = cvtpk(P[B_+0], P[B_+1]), a1 = cvtpk(P[B_+2], P[B_+3]);                          \
        unsigned b0 = cvtpk(P[B_+4], P[B_+5]), b1 = cvtpk(P[B_+6], P[B_+7]);                                             \
        auto r0 = __builtin_amdgcn_permlane32_swap(a0, b0, false, false); auto r1 = __builtin_amdgcn_permlane32_swap(a1, b1, false, false); \
        u32x4 w = {r0[0], r1[0], r0[1], r1[1]}; OUT = *reinterpret_cast<bf16x8*>(&w); } while (0)
    PK4(p0, 0, pa0); PK4(p0, 8, pa1); PK4(p1, 0, pa2); PK4(p1, 8, pa3);
#undef PK4
}
template <int KB, bool SK>
__device__ __forceinline__ void qkt(f32x16& p0, f32x16& p1, const char* K_lds, int r32, int hi, const bf16x8* qr, bool act) {
    if (SK && !act) { const float NEG = -__builtin_inff();
#pragma unroll
        for (int r = 0; r < 16; ++r) { p0[r] = NEG; p1[r] = NEG; } return; }
    p0 = f32x16{}; p1 = f32x16{};
    const char* kb[4];
#pragma unroll
    for (int dd = 0; dd < 4; ++dd) kb[dd] = K_lds + KB * SHM_K + KSWZ(r32, (dd * 16 + hi * 8) * 2);
#pragma unroll
    for (int d0 = 0; d0 < 8; ++d0) { const char* a = kb[d0 & 3] + (d0 >> 2) * 128;
        bf16x8 b0 = *reinterpret_cast<const bf16x8*>(a);
        bf16x8 b1 = *reinterpret_cast<const bf16x8*>(a + 32 * 256);
        p0 = __builtin_amdgcn_mfma_f32_32x32x16_bf16(b0, qr[d0], p0, 0, 0, 0);
        p1 = __builtin_amdgcn_mfma_f32_32x32x16_bf16(b1, qr[d0], p1, 0, 0, 0); }
}
template <int VB, bool SK>
__device__ __forceinline__ void pv_tile(f32x16* o, int vb0, bf16x8 pa0, bf16x8 pa1, bf16x8 pa2, bf16x8 pa3, bool act) {
    if (SK && !act) return;
#define TRRD(dst, off) asm volatile("ds_read_b64_tr_b16 %0, %1 offset:%2" : "=&v"(dst) : "v"(vb0), "i"(off) : "memory")
#define PV_D0(d0) do { s16x4 l0, l1, l2, l3, h0, h1, h2, h3; constexpr int b_ = VB * SHM_V + v_rd_off(d0, 0, 0);     \
        TRRD(l0, b_); TRRD(h0, b_ + 2048); TRRD(l1, b_ + 4096); TRRD(h1, b_ + 6144); TRRD(l2, b_ + 8192); TRRD(h2, b_ + 10240); TRRD(l3, b_ + 12288); TRRD(h3, b_ + 14336); \
        asm volatile("s_waitcnt lgkmcnt(0)" ::: "memory"); SBAR();                 \
        o[d0] = __builtin_amdgcn_mfma_f32_32x32x16_bf16(pa0, (bf16x8){l0[0], l0[1], l0[2], l0[3], h0[0], h0[1], h0[2], h0[3]}, o[d0], 0, 0, 0);   \
        o[d0] = __builtin_amdgcn_mfma_f32_32x32x16_bf16(pa1, (bf16x8){l1[0], l1[1], l1[2], l1[3], h1[0], h1[1], h1[2], h1[3]}, o[d0], 0, 0, 0);   \
        o[d0] = __builtin_amdgcn_mfma_f32_32x32x16_bf16(pa2, (bf16x8){l2[0], l2[1], l2[2], l2[3], h2[0], h2[1], h2[2], h2[3]}, o[d0], 0, 0, 0);   \
        o[d0] = __builtin_amdgcn_mfma_f32_32x32x16_bf16(pa3, (bf16x8){l3[0], l3[1], l3[2], l3[3], h3[0], h3[1], h3[2], h3[3]}, o[d0], 0, 0, 0); } while (0)
    PV_D0(0); PV_D0(1); PV_D0(2); PV_D0(3);
#undef PV_D0
#undef TRRD
}
template <class TIn, class TOut> struct BlockRef { const TIn* Q; const TIn* K; const unsigned long long* M; int P0; const unsigned short* G; unsigned short* Y; };
template <class TIn> struct Seam {
    bf16x8 qr[8];
    bf16x8 st_v0, st_v1, st_k0, st_k1; f32x4 sf0, sf1, sf2, sf3;
    f32x4 tq[16];
};
__device__ __forceinline__ int swa_jlo(int P0, int W) { const int lowk = P0 - W + 1; return lowk > 0 ? lowk / KVBLK : 0; }
#define ROW(p, k0, rr) ((p) + (size_t)((k0) + (rr)) * D + sc)
#define VMW() asm volatile("s_waitcnt vmcnt(0)" ::: "memory")
#define VMWN(n) asm volatile("s_waitcnt vmcnt(%0)" :: "i"(n) : "memory")
#define SLOAD_H(Kp, Vp, k0) do { S.st_v0 = load8<TIn>(ROW(Vp, k0, sr)); S.st_v1 = load8<TIn>(ROW(Vp, k0, 32 + sr));              \
                         S.st_k0 = load8<TIn>(ROW(Kp, k0, sr)); S.st_k1 = load8<TIn>(ROW(Kp, k0, 32 + sr)); } while (0)
#define SWRITE_HK(bf) do { *(bf16x8*)(K_lds + (bf) * SHM_K + kws) = S.st_k0; *(bf16x8*)(K_lds + (bf) * SHM_K + kws + 32 * 256) = S.st_k1; } while (0)
#define SWRITE_HV(bf) do { *(bf16x8*)(V_lds + (bf) * SHM_V + vst0) = S.st_v0; *(bf16x8*)(V_lds + (bf) * SHM_V + vst1) = S.st_v1; } while (0)
#define SWRITE_H(bf) do { SWRITE_HV(bf); SWRITE_HK(bf); } while (0)
#define SLOAD_F(p, k0) do { S.sf0 = *(const f32x4*)ROW(p, k0, sr); S.sf1 = *(const f32x4*)(ROW(p, k0, sr) + 4);                \
                            S.sf2 = *(const f32x4*)ROW(p, k0, 32 + sr); S.sf3 = *(const f32x4*)(ROW(p, k0, 32 + sr) + 4); } while (0)
#define SWRITE_KF(bf) do { *(bf16x8*)(K_lds + (bf) * SHM_K + kws) = pack8(S.sf0, S.sf1); *(bf16x8*)(K_lds + (bf) * SHM_K + kws + 32 * 256) = pack8(S.sf2, S.sf3); } while (0)
#define SWRITE_VF(bf) do { *(bf16x8*)(V_lds + (bf) * SHM_V + vst0) = pack8(S.sf0, S.sf1); *(bf16x8*)(V_lds + (bf) * SHM_V + vst1) = pack8(S.sf2, S.sf3); } while (0)
template <class TIn, class TOut>
__device__ __forceinline__ void causal_swa_prime(const BlockRef<TIn, TOut>& cur, int W, char* lds, Seam<TIn>& S) {
    constexpr bool F32 = same_t<TIn, float>::v;
    int tid_l = threadIdx.x; asm volatile("" : "+v"(tid_l));
    const int tid = tid_l, wid = __builtin_amdgcn_readfirstlane(tid >> 6), lane = tid & 63, r32 = lane & 31, hi = lane >> 5;
    const int sr = tid >> 4, sc = (tid & 15) * 8, kws = KSWZ(sr, sc * 2); char* K_lds = lds + 2 * SHM_V;
    const int kb0 = swa_jlo(cur.P0, W) * KVBLK;
    for (int d0 = 0; d0 < 8; ++d0) S.qr[d0] = load8<TIn>(cur.Q + (size_t)(wid * QBLK + r32) * D + d0 * 16 + hi * 8);
    if constexpr (F32) { SLOAD_F((const float*)cur.K, kb0); VMW(); SWRITE_KF(0); SBAR(); SLOAD_F((const float*)(cur.K + VOFF), kb0); }
    else { SLOAD_H(cur.K, (cur.K + VOFF), kb0); VMW(); SWRITE_HK(0); }
    __syncthreads();
}
template <class TIn, class TOut>
__device__ __forceinline__ void causal_swa_block(const BlockRef<TIn, TOut>& cur, const BlockRef<TIn, TOut>& nxt, int skv, int W, char* lds, Seam<TIn>& S) {
    constexpr bool F32 = same_t<TIn, float>::v;
    int tid_l = threadIdx.x; asm volatile("" : "+v"(tid_l));
    const int tid = tid_l, wid = __builtin_amdgcn_readfirstlane(tid >> 6), lane = tid & 63, r32 = lane & 31, hi = lane >> 5;
    const int j_lo = swa_jlo(cur.P0, W);
    int j_hi = (cur.P0 + QB - 1) / KVBLK + 1; if (j_hi > skv / KVBLK) j_hi = skv / KVBLK;
    const int NT = j_hi - j_lo;
    const int kbn = swa_jlo(nxt.P0, W) * KVBLK;
    const int qlo = cur.P0 + wid * QBLK, qm = qlo + r32 - 4 * hi;
    char* V_lds = lds; char* K_lds = lds + 2 * SHM_V;
    float* ws = (float*)(lds + 2 * SHM_V + 2 * SHM_K) + wid * 64; float* li_l = ws, * al_l = ws + 32;
    float m_reg = -1e30f, l_reg = 0; f32x16 o[4] = {};
    const int sr = tid >> 4, sc = (tid & 15) * 8, vst0 = v_st(sr, sc), vst1 = v_st(32 + sr, sc), kws = KSWZ(sr, sc * 2);
    const int vb0 = (int)(uintptr_t)V_lds + v_rd_base(lane);
    const TIn* Kh = cur.K; const TIn* Vh = (cur.K + VOFF);
#define RESC(a) do { if (__any((a) < 1.f)) { if (hi == 0) al_l[r32] = (a); asm volatile("s_waitcnt lgkmcnt(0)" ::: "memory");              \
                     for (int d_ = 0; d_ < 4; ++d_) for (int r = 0; r < 16; ++r) o[d_][r] *= al_l[crow(r, hi)]; } } while (0)
#define KBASE(t) ((j_lo + (t)) * KVBLK)
#define ACT(t) (KBASE(t) <= qlo + QBLK - 1 && KBASE(t) + KVBLK - 1 >= qlo - W + 1)
#define MASKT(P0_, P1_, MW_) mask_bits(P0_, P1_, MW_)
    constexpr int NQL = F32 ? 16 : 8;
    constexpr bool SK = WSKIP && !F32;
#define SEAM_K0() do { VMWN(NQL); if constexpr (F32) { SWRITE_KF(0); SBAR(); SLOAD_F((const float*)(nxt.K + VOFF), kbn); } else { SWRITE_HK(0); } SBAR(); } while (0)
    f32x16 pA0, pA1, pB0, pB1; float mnA, mnB, alA, alB; bf16x8 pa0, pa1, pa2, pa3;
    const unsigned* M32 = (const unsigned*)cur.M;
#define MOFF() ({ int l_ = lane; asm volatile("" : "+v"(l_)); (unsigned)(wid * QBLK + (l_ & 31)) * 512u + (unsigned)(l_ >> 5); })
    unsigned mw = M32[MOFF()];
    if constexpr (F32) { VMW(); SWRITE_VF(0); SBAR(); } else { SWRITE_HV(0); SBAR(); }
    if (NT > 1) { if constexpr (F32) SLOAD_F((const float*)Kh, KBASE(1)); else SLOAD_H(Kh, Vh, KBASE(1)); }
    SBAR(); qkt<0, SK>(pA0, pA1, K_lds, r32, hi, S.qr, ACT(0));
    if constexpr (F32) { if (NT > 1) { VMW(); SWRITE_KF(1); SBAR(); SLOAD_F((const float*)Vh, KBASE(1)); } }
    MASKT(pA0, pA1, mw); partialSM(pA0, pA1, m_reg, mnA, alA);
    if (NT > 1) { VMW(); if constexpr (F32) { SWRITE_VF(1); SBAR(); if (NT > 2) SLOAD_F((const float*)Kh, KBASE(2)); } else SWRITE_H(1); }
    __syncthreads();
#define HALF_STEP(PX0, PX1, mnX, alX, PY0, PY1, alY, t, KB, VB, SB) do {                                                      \
        mw = M32[MOFF() + 2u * (unsigned)(t)];                                                                                     \
        SBAR(); qkt<KB, SK>(PX0, PX1, K_lds, r32, hi, S.qr, ACT(t));                                             \
        finishSM(PY0, PY1, alY, l_reg, pa0, pa1, pa2, pa3); SBAR();                                                           \
        if ((t) + 1 < NT) { if constexpr (F32) { VMW(); SWRITE_KF(SB); SBAR(); SLOAD_F((const float*)Vh, KBASE((t) + 1)); }  \
                            else { SLOAD_H(Kh, Vh, KBASE((t) + 1)); } SBAR(); }                                               \
        pv_tile<VB, SK>(o, vb0, pa0, pa1, pa2, pa3, ACT((t) - 1)); MASKT(PX0, PX1, mw); partialSM(PX0, PX1, m_reg, mnX, alX);                                        \
        __syncthreads();                                                                                                      \
        if ((t) + 1 < NT) { VMW(); if constexpr (F32) { SWRITE_VF(SB); SBAR(); if ((t) + 2 < NT) SLOAD_F((const float*)Kh, KBASE((t) + 2)); } \
                            else { SWRITE_H(SB); } }                                                                          \
        RESC(alX); __syncthreads(); } while (0)
    if (wid >= 4) __builtin_amdgcn_s_setprio(1);
    for (int t = 1; t + 1 < NT; t += 2) {
        HALF_STEP(pB0, pB1, mnB, alB, pA0, pA1, alA, t, 1, 0, 0);
        HALF_STEP(pA0, pA1, mnA, alA, pB0, pB1, alB, t + 1, 0, 1, 1);
    }
    __builtin_amdgcn_s_setprio(0);
    const bool even = (NT & 1) == 0;
    if (even) { mw = M32[MOFF() + 2u * (unsigned)(NT - 1)]; SBAR(); qkt<1, SK>(pB0, pB1, K_lds, r32, hi, S.qr, ACT(NT - 1)); SBAR(); }
#define QROW(e) (nxt.Q + (size_t)(wid * QBLK + r32) * D + ((e) >> 1) * 16 + hi * 8 + ((e) & 1) * 4)
    if constexpr (F32) { SLOAD_F((const float*)nxt.K, kbn); SBAR();
#pragma unroll
        for (int e = 0; e < 8; ++e) S.tq[e] = *(const f32x4*)QROW(e); }
    else { SLOAD_H(nxt.K, (nxt.K + VOFF), kbn); SBAR();
#pragma unroll
        for (int d0 = 0; d0 < 8; ++d0) S.qr[d0] = load8<TIn>(nxt.Q + (size_t)(wid * QBLK + r32) * D + d0 * 16 + hi * 8); }
    SBAR();
    finishSM(pA0, pA1, alA, l_reg, pa0, pa1, pa2, pa3); SBAR();
    if constexpr (F32) {
#pragma unroll
        for (int e = 8; e < 16; ++e) S.tq[e] = *(const f32x4*)QROW(e); SBAR(); }
#undef QROW
    pv_tile<0, SK>(o, vb0, pa0, pa1, pa2, pa3, ACT(even ? NT - 2 : NT - 1));
    if (even) { MASKT(pB0, pB1, mw); partialSM(pB0, pB1, m_reg, mnB, alB); __syncthreads(); RESC(alB);
        finishSM(pB0, pB1, alB, l_reg, pa0, pa1, pa2, pa3); SBAR(); pv_tile<1, SK>(o, vb0, pa0, pa1, pa2, pa3, ACT(NT - 1)); }
    SBAR(); SEAM_K0();
    if (hi == 0) li_l[r32] = l_reg; asm volatile("s_waitcnt lgkmcnt(0)" ::: "memory");
    float rli[16];
#pragma unroll
    for (int r = 0; r < 16; ++r) rli[r] = __builtin_amdgcn_rcpf(li_l[crow(r, hi)]);
    { unsigned short* ost = (unsigned short*)(lds + LDS_BYTES + wid * (16 * 136 * 2));
      const unsigned short* Gw = cur.G + (size_t)(wid * QBLK) * ZW; unsigned short* Yw = cur.Y + (size_t)(wid * QBLK) * DM;
#pragma unroll
      for (int ph = 0; ph < 2; ++ph) {
#pragma unroll
          for (int r = 8 * ph; r < 8 * ph + 8; ++r) { const int lrow = crow(r, hi) - 16 * ph;
#pragma unroll
              for (int d0 = 0; d0 < 4; ++d0) ost[lrow * 136 + d0 * 32 + r32] = f2bf(o[d0][r] * rli[r]); }
          asm volatile("s_waitcnt lgkmcnt(0)" ::: "memory");
#pragma unroll
          for (int i = 0; i < 4; ++i) { const int c = i * 64 + lane, lrow = c >> 4, d8 = (c & 15) * 8, row = 16 * ph + lrow; float ov[8], gv[8];
              unpack8(*(const u32x4*)(ost + lrow * 136 + d8), ov); unpack8(*(const u32x4*)(Gw + (size_t)row * ZW + d8), gv);
#pragma unroll
              for (int j = 0; j < 8; ++j) ov[j] *= siluf_(gv[j]);
              *(u32x4*)(Yw + (size_t)row * DM + d8) = pack8f(ov); }
          asm volatile("s_waitcnt lgkmcnt(0)" ::: "memory"); } }
    if constexpr (F32) {
#pragma unroll
        for (int d0 = 0; d0 < 8; ++d0) S.qr[d0] = pack8(S.tq[2 * d0], S.tq[2 * d0 + 1]); }
    __syncthreads();
#undef RESC
#undef KBASE
#undef ACT
#undef MASKT
#undef MOFF
#undef SEAM_K0
#undef HALF_STEP
}
#undef ROW
#undef VMW
#undef VMWN
#undef SLOAD_H
#undef SWRITE_HK
#undef SWRITE_HV
#undef SWRITE_H
#undef SLOAD_F
#undef SWRITE_KF
#undef SWRITE_VF

}

__device__ __forceinline__ void p6_dsa_attention(const Frame& F, char* lds_generic) {
    typedef dsa::BlockRef<unsigned short, unsigned short> Ref;
    const bf16* qA = (const bf16*)(F.ws + WS_QA); const bf16* kA = (const bf16*)(F.ws + WS_KA);
    const unsigned long long* mask = (const unsigned long long*)(F.ws + WS_MASK); const bf16* zz = (const bf16*)(F.ws + WS_Z); bf16* yy = (bf16*)(F.ws + WS_Y);
    constexpr int NQB = SEQ / dsa::QB, NITEM = 8 * (NQB / 2);
#define DSA_MKREF(R, item_, pass_) do { const int h_ = (item_) & 7, yy_ = (item_) >> 3, qb_ = (pass_) ? (NQB - 1 - yy_) : yy_, P0_ = qb_ * dsa::QB; \
        R.Q = qA + ((size_t)h_ * SEQ + P0_) * 128; R.K = kA + (size_t)h_ * SEQ * 128; R.M = mask + (size_t)P0_ * 256; R.P0 = P0_; R.G = zz + (size_t)P0_ * ZW + ZGATE_B + h_ * 128; R.Y = yy + (size_t)P0_ * DM + YB + h_ * 128; } while (0)
    int item = blockIdx.x; if (item >= NITEM) return;
    int pass = 0; Ref cur; DSA_MKREF(cur, item, 0);
    dsa::Seam<unsigned short> S;
    __syncthreads();
    dsa::causal_swa_prime<unsigned short, unsigned short>(cur, 1 << 30, lds_generic, S);
    for (;;) {
        const bool more_pass = pass == 0, more_item = item + F.G < NITEM, last = !more_pass && !more_item;
        int itn = item, pn = pass + 1; if (!more_pass) { pn = 0; itn = more_item ? item + F.G : item; }
        Ref nxt = cur; if (!last) DSA_MKREF(nxt, itn, pn);
        dsa::causal_swa_block<unsigned short, unsigned short>(cur, nxt, SEQ, 1 << 30, lds_generic, S);
        if (last) break;
        cur = nxt; item = itn; pass = pn;
    }
#undef DSA_MKREF
}

#ifdef DBG_CHECK
constexpr int DBG_T = 1024;
#if DBG_CHECK == 0
__device__ __forceinline__ void dbg_gla_seq(const Frame& F, float* ref) {
    const bf16* z = (const bf16*)(F.ws + WS_Z); const float* bA = (const float*)(F.ws + WS_BA);
    const int i4 = blockIdx.x * NTHR + F.tid; if (i4 >= 12 * 128 * 4) return;
    const int i = i4 >> 2, dq = (i4 & 3) * 16, h = i >> 7, e = i & 127; float S[16];
#pragma unroll
    for (int d = 0; d < 16; ++d) S[d] = 0.f;
    for (int t = 0; t < DBG_T; ++t) { const bf16* zr = z + (size_t)t * ZW; const float ve = bf2f(zr[ZV_A + h * 128 + e]); float o = 0.f;
#pragma unroll
        for (int d = 0; d < 16; ++d) { const float bt = bA[(size_t)t * 768 + h * 64 + dq + d], bp = (t & 63) ? bA[(size_t)(t - 1) * 768 + h * 64 + dq + d] : 0.f;
            S[d] = expf(bt - bp) * S[d] + bf2f(zr[ZK_A + h * 64 + dq + d]) * ve; o += bf2f(zr[ZQ_A + h * 64 + dq + d]) * 0.125f * S[d]; }
        o += shx(o, 1, F.lane); o += shx(o, 2, F.lane);
        if ((i4 & 3) == 0) ref[(size_t)t * 1536 + i] = o; }
}
#endif
#if DBG_CHECK == 1
__device__ __forceinline__ void dbg_mlstm_seq(const Frame& F, float* ref) {
    const bf16* z = (const bf16*)(F.ws + WS_Z); const bf16* cq = (const bf16*)(F.ws + WS_CQ); const bf16* ck = (const bf16*)(F.ws + WS_CK); const float* mg = (const float*)(F.ws + WS_MG);
    const int i = blockIdx.x * NTHR + F.tid; if (i >= 6 * 256) return;
    const int h = i >> 8, e = i & 255; float C[128]; float m = 0.f;
#pragma unroll
    for (int d = 0; d < 128; ++d) C[d] = 0.f;
    for (int t = 0; t < DBG_T; ++t) { const float bt = mg[MG_B + (size_t)t * 8 + h], bp = (t & 63) ? mg[MG_B + (size_t)(t - 1) * 8 + h] : 0.f, lf = bt - bp, ig = mg[MG_I + (size_t)t * 8 + h];
        const float mn = fmaxf(lf + m, ig), fa = expf(lf + m - mn), ia = expf(ig - mn); m = mn;
        const float ve = bf2f(z[(size_t)t * ZW + ZV_C + h * 256 + e]); float o = 0.f;
#pragma unroll
        for (int d = 0; d < 128; ++d) { C[d] = fa * C[d] + ia * bf2f(ck[(size_t)t * 768 + h * 128 + d]) * ve; o += bf2f(cq[(size_t)t * 768 + h * 128 + d]) * C[d]; }
        ref[(size_t)t * 1536 + i] = o;
#ifdef DBG_STATE
        if (t == 63) { const bf16* CP = (const bf16*)(F.ws + WS_CP); const float mp = mg[MG_MP + 6 + h]; float md = 0.f, mx = 0.f;
#pragma unroll
            for (int d = 0; d < 128; ++d) { const float a = bf2f(CP[((size_t)(6 + h) * 256 + e) * 128 + d]) * expf(mp - m), b = C[d]; md = fmaxf(md, fabsf(a - b)); mx = fmaxf(mx, fabsf(b)); }
            md = wave_max(md, F.lane); mx = wave_max(mx, F.lane);
            if (F.lane == 0) atomicMax((unsigned*)(F.ws + WS_CTL) + 2049, __float_as_uint(md / mx)); }
#endif
    }
}
#endif
__device__ __forceinline__ void dbg_compare(const Frame& F, const float* ref, const float* gainA, const float* gainC, int which, unsigned* res) {
    const bf16* z = (const bf16*)(F.ws + WS_Z); const bf16* y = (const bf16*)(F.ws + WS_Y);
    const int NH = which ? 6 : 12, HD = which ? 256 : 128;
    for (int u = F.gw; u < DBG_T * NH; u += F.NGW) { const int t = u / NH, h = u % NH; float ss = 0.f;
        for (int e = F.lane; e < HD; e += 64) { const float v = ref[(size_t)t * 1536 + h * HD + e]; ss += v * v; }
        ss = wave_sum(ss, F.lane); const float rs = 1.0f / sqrtf(ss / HD + NORM_EPS); float md = 0.f;
        for (int e = F.lane; e < HD; e += 64) { float v = ref[(size_t)t * 1536 + h * HD + e] * rs; float got;
            if (which) { v *= gainC[h * 256 + e] * sigmoidf_(bf2f(z[(size_t)t * ZW + ZO_C + h * 256 + e])) * siluf_(bf2f(z[(size_t)t * ZW + ZGATE_C + h * 256 + e])); got = bf2f(y[(size_t)t * DM + YC + h * 256 + e]); }
            else { v *= gainA[h * 128 + e] * siluf_(bf2f(z[(size_t)t * ZW + ZGATE_A + h * 128 + e])); got = bf2f(y[(size_t)t * DM + YA + h * 128 + e]); }
            md = fmaxf(md, fabsf(got - v)); }
        md = wave_max(md, F.lane); if (F.lane == 0) atomicMax(res, __float_as_uint(md)); }
}
#endif

struct Args { const void* in[18]; float* out; unsigned char* ws; };
#ifndef MIX_GLA
#define MIX_GLA 1
#endif
#ifndef MIX_MLSTM
#define MIX_MLSTM 1
#endif
#ifndef MIX_DSA
#define MIX_DSA 1
#endif

__global__ void __launch_bounds__(NTHR, 2) trunk_fwd(Args args) {
    extern __shared__ __attribute__((aligned(16))) unsigned char lds[];
    Frame F;
    F.lds = (LAS unsigned char*)lds; F.ws = args.ws;
    F.tid = threadIdx.x; F.lane = F.tid & 63; F.wave = __builtin_amdgcn_readfirstlane(F.tid >> 6);
    F.G = gridDim.x; { const int bx = blockIdx.x; F.vcu = (F.G % 8 == 0) ? (bx % 8) * (F.G / 8) + bx / 8 : bx; }
    F.gw = F.vcu * NWAVES + F.wave; F.NGW = F.G * NWAVES;
    volatile LAS unsigned* MISC = (volatile LAS unsigned*)(F.lds + MISC_OFF);
    for (int u = F.tid; u < (LDS_BYTES - RING_BYTES) / 4; u += NTHR) ((LAS unsigned*)(F.lds + RING_BYTES))[u] = 0u;
    __syncthreads();
    XcdBarrier bar = xcd_barrier_post((unsigned*)(F.ws + WS_CTL) + CW_BAR, MISC + 8);
#define GRID_BAR() do { size_t zb_ = 0; asm volatile("" : "+s"(zb_)); unsigned x_ = bar.x; asm volatile("" : "+s"(x_)); XcdBarrier b_; b_.bar = (unsigned*)(args.ws + zb_ + WS_CTL) + CW_BAR; b_.x = x_; b_.st = bar.st; xcd_barrier(b_); } while (0)
#define IN(k) ((const float*)args.in[k])
#define PHASE_BEGIN() do { size_t z_ = 0; asm volatile("" : "+s"(z_)); F.ws = args.ws + z_; unsigned lz_ = 0; asm volatile("" : "+s"(lz_)); F.lds = (LAS unsigned char*)lds + lz_; int t_ = threadIdx.x; asm volatile("" : "+v"(t_)); F.tid = t_; F.lane = t_ & 63; F.wave = __builtin_amdgcn_readfirstlane(t_ >> 6); \
        F.gw = F.vcu * NWAVES + F.wave; U = (bf16*)(F.ws + WS_U); Z = (bf16*)(F.ws + WS_Z); Y = (bf16*)(F.ws + WS_Y); PP = (bf16*)(F.ws + WS_PP); H = (float*)(F.ws + WS_H); } while (0)

    bf16 *U, *Z, *Y, *PP; float* H;

#ifndef DMASK
#define DMASK 0
#endif
#ifndef TPSHIFT
#define TPSHIFT 1.0f
#endif
#ifdef TPROBE
    unsigned long long tp_acc = 0, tp_t0 = 0; int tp_prev = -1;
#define TP_MARK(n) do { const unsigned long long t_ = __builtin_amdgcn_s_memrealtime(); if (tp_prev == TPROBE) tp_acc += t_ - tp_t0; tp_prev = (n); tp_t0 = t_; } while (0)
#else
#define TP_MARK(n) do { } while (0)
#endif
#define REP(n) for (int rep_ = 0; rep_ < (((DMASK >> (n)) & 1) ? 2 : 1); ++rep_)
#ifndef ONLY
#define PH(n) 1
#else
#define PH(n) ((n) == ONLY)
#endif
    TP_MARK(0); REP(0) { PHASE_BEGIN(); } REP(0) if (PH(0)) p0_prologue(F, IN(4), IN(13), IN(15), IN(16), IN(1), (const int*)args.in[2], IN(3), IN(14), IN(0));
    GRID_BAR();
    for (int L = 0; L < DEPTH; ++L) {

        TP_MARK(1); REP(1) { PHASE_BEGIN(); } REP(1) if (PH(1)) { if (L > 0) { reduce_rstd(F); GRID_BAR(); } }
        TP_MARK(2); REP(2) { PHASE_BEGIN(); } REP(2) if (PH(2)) { pg8::Gemm g{U, (const bf16*)(F.ws + WS_WIN) + (size_t)L * ZW * DM, SEQ, ZW, DM}; pg8::StaticOrder S; S.init(SEQ, ZW, F.G, (int)blockIdx.x);
          pg8::EpiBf16Row E{Z, ZW, (const float*)(F.ws + WS_RSTD), (bf16*)(F.ws + WS_QA), (bf16*)(F.ws + WS_IQ), (bf16*)(F.ws + WS_IK), ZQ_B, ZGATE_B, ZIQ, ZIK, SEQ};
          pg8::gemm_phase<pg8::EpiBf16Row, pg8::StaticOrder, true, true>(F.lds, g, S, E); }
        GRID_BAR();
        TP_MARK(3); REP(3) { PHASE_BEGIN(); } REP(3) if (PH(3)) p3_prep(F, IN(8) + (size_t)L * 4 * 768, IN(9) + (size_t)L * 4 * 768, IN(10) + L * 6, IN(11) + L * 6, IN(5) + (size_t)L * 16 * 768, IN(6) + (size_t)L * 768);
        GRID_BAR();
#if MIX_DSA
        TP_MARK(4); REP(4) { PHASE_BEGIN(); } REP(4) if (PH(4)) p4_index_scores(F);
#endif
#if MIX_GLA
        TP_MARK(5); REP(5) { PHASE_BEGIN(); } REP(5) if (PH(5)) p4_gla_local(F);
#endif
#if MIX_MLSTM
        TP_MARK(6); REP(6) { PHASE_BEGIN(); } REP(6) if (PH(6)) p4_mlstm_local(F);
#endif
        GRID_BAR();
#if MIX_GLA || MIX_MLSTM
        TP_MARK(7); REP(7) { PHASE_BEGIN(); } REP(7) if (PH(7)) p5_scans(F);
#endif
#if MIX_DSA
        TP_MARK(8); REP(8) { PHASE_BEGIN(); } REP(8) if (PH(8)) p5_select(F, (unsigned*)(F.ws + WS_CTL) + 8192 + 64 * L);
#endif
        GRID_BAR();
#if MIX_DSA
        TP_MARK(9); REP(9) { PHASE_BEGIN(); } REP(9) if (PH(9)) p6_dsa_attention(F, (char*)lds);
#else
        { unsigned zz_ = 0; asm volatile("" : "+v"(zz_));
        for (int i = blockIdx.x * NTHR + F.tid; i < SEQ * 128; i += F.G * NTHR) { const int t = i >> 7, c8 = i & 127; *(u32x4*)(Y + (size_t)t * DM + YB + c8 * 8) = (u32x4){zz_, zz_, zz_, zz_}; } }
#endif
#if MIX_GLA
        TP_MARK(10); REP(10) { PHASE_BEGIN(); } REP(10) if (PH(10)) p6_gla_out(F, IN(7) + (size_t)L * 1536);
#else
        { unsigned zz_ = 0; asm volatile("" : "+v"(zz_));
        for (int i = blockIdx.x * NTHR + F.tid; i < SEQ * 192; i += F.G * NTHR) { const int t = i / 192, c8 = i % 192; *(u32x4*)(Y + (size_t)t * DM + YA + c8 * 8) = (u32x4){zz_, zz_, zz_, zz_}; } }
#endif
#if MIX_MLSTM
        TP_MARK(11); REP(11) { PHASE_BEGIN(); } REP(11) if (PH(11)) p6_mlstm_out(F, IN(12) + (size_t)L * 1536);
#else
        { unsigned zz_ = 0; asm volatile("" : "+v"(zz_));
        for (int i = blockIdx.x * NTHR + F.tid; i < SEQ * 192; i += F.G * NTHR) { const int t = i / 192, c8 = i % 192; *(u32x4*)(Y + (size_t)t * DM + YC + c8 * 8) = (u32x4){zz_, zz_, zz_, zz_}; } }
#endif
        GRID_BAR();
#ifdef DBG_CHECK
        if (L == 0) { PHASE_BEGIN(); float* ref = (float*)(F.ws + WS_SCORE); unsigned* res = (unsigned*)(F.ws + WS_CTL) + 2048;
#if DBG_CHECK == 0
            dbg_gla_seq(F, ref);
#else
            dbg_mlstm_seq(F, ref);
#endif
            GRID_BAR();
            PHASE_BEGIN(); dbg_compare(F, (const float*)(F.ws + WS_SCORE), IN(7), IN(12), DBG_CHECK, (unsigned*)(F.ws + WS_CTL) + 2048);
            GRID_BAR(); }
#endif
        TP_MARK(12); REP(12) { PHASE_BEGIN(); } REP(12) if (PH(12)) { pg8::Gemm g{Y, (const bf16*)(F.ws + WS_WOUT) + (size_t)L * DM * DM, SEQ, DM, DM}; pg8::StaticOrder S; S.init(SEQ, DM, F.G, (int)blockIdx.x);
          pg8::EpiResB E{U, (bf16*)(F.ws + WS_HB2), (float*)(F.ws + WS_PART), DM};
          pg8::gemm_phase<pg8::EpiResB, pg8::StaticOrder, true, true>(F.lds, g, S, E); }
        GRID_BAR();
        TP_MARK(13); REP(13) { PHASE_BEGIN(); } REP(13) if (PH(13)) reduce_rstd(F);
        TP_MARK(14); REP(14) { PHASE_BEGIN(); } REP(14) if (PH(14)) { pg8::Gemm g{(const bf16*)(F.ws + WS_PBF) + (size_t)L * SEQ * DPLE, (const bf16*)(F.ws + WS_WPLE) + (size_t)L * DM * DPLE, SEQ, DM, DPLE}; pg8::StaticOrder S; S.init(SEQ, DM, F.G, (int)blockIdx.x);
          pg8::EpiBf16<0> E{PP, DM, nullptr, 0, 0, 1.f};
          pg8::gemm_phase<pg8::EpiBf16<0>, pg8::StaticOrder, true, true>(F.lds, g, S, E); }
        GRID_BAR();
        TP_MARK(15); REP(15) { PHASE_BEGIN(); } REP(15) if (PH(15)) { pg8::Gemm g{(const bf16*)(F.ws + WS_HB2), (const bf16*)(F.ws + WS_WGATE) + (size_t)L * DM * DM, SEQ, DM, DM}; pg8::StaticOrder S; S.init(SEQ, DM, F.G, (int)blockIdx.x);
          pg8::EpiGateB E{(const bf16*)(F.ws + WS_HB2), PP, (const float*)(F.ws + WS_RSTD), U, (float*)(F.ws + WS_PART), DM};
          pg8::gemm_phase<pg8::EpiGateB, pg8::StaticOrder, true, true>(F.lds, g, S, E); }
        GRID_BAR();
    }
    TP_MARK(16); REP(16) { PHASE_BEGIN(); } REP(16) if (PH(16)) rmsnorm_b2f(F, U, IN(17), args.out);
#ifdef TPROBE
    TP_MARK(99); GRID_BAR();
    if (blockIdx.x == 0 && threadIdx.x == 0) { const float us_ = 0.01f * (float)tp_acc * TPSHIFT; const float k_ = floorf(__logf(us_) * (1.0f / 0.0953102f)); args.out[0] = __expf((k_ + 0.5f) * 0.0953102f); }
#endif
#ifdef DBG_CHECK
#ifdef DBG_STATE
#define DBG_WORD 2049
#else
#define DBG_WORD 2048
#endif
    GRID_BAR();
    if (blockIdx.x == 0 && threadIdx.x == 0) args.out[0] = 10000.0f * __uint_as_float(__hip_atomic_load((unsigned*)(args.ws + WS_CTL) + DBG_WORD, __ATOMIC_RELAXED, __HIP_MEMORY_SCOPE_AGENT));
#endif
}

extern "C" void kernel_launch(void* const* d_in, const int* in_sizes, int n_in, void* d_out, int out_size, void* d_ws, size_t ws_size, hipStream_t stream) {
    static int grid = 0;
    if (grid == 0) {
        if (n_in != 18 || out_size != SEQ * DM || ws_size < WS_END) { fprintf(stderr, "kernel_launch: unexpected shapes (n_in %d, out %d, ws %zu < %zu)\n", n_in, out_size, ws_size, (size_t)WS_END); grid = -1; return; }
        int dev = 0, cus = 0, per_cu = 0;
        if (hipGetDevice(&dev) != hipSuccess || hipDeviceGetAttribute(&cus, hipDeviceAttributeMultiprocessorCount, dev) != hipSuccess) { grid = -1; return; }
        if (hipFuncSetAttribute((const void*)trunk_fwd, hipFuncAttributeMaxDynamicSharedMemorySize, LDS_BYTES) != hipSuccess) { fprintf(stderr, "kernel_launch: hipFuncSetAttribute failed\n"); grid = -1; return; }
        if (hipOccupancyMaxActiveBlocksPerMultiprocessor(&per_cu, (const void*)trunk_fwd, NTHR, LDS_BYTES) != hipSuccess || per_cu < 1) fprintf(stderr, "kernel_launch: occupancy query says %d\n", per_cu);
        (void)hipGetLastError();
        grid = cus;
    }
    if (grid < 0) return;
    if (hipMemsetAsync((char*)d_ws + WS_CTL, 0, CTL_ZERO_BYTES, stream) != hipSuccess) return;
    Args a{};
    for (int i = 0; i < 18; ++i) a.in[i] = d_in[i];
    a.out = (float*)d_out; a.ws = (unsigned char*)d_ws;
    hipLaunchKernelGGL(trunk_fwd, dim3(grid), dim3(NTHR), LDS_BYTES, stream, a);
}
```

```cpp
#include <hip/hip_runtime.h>
#include <cstdio>
#include <cstdint>
namespace pg8 {
#define PG8_LAS __attribute__((address_space(3)))
typedef unsigned short bf16_t;
typedef short bf16x8 __attribute__((ext_vector_type(8)));
typedef float f32x4 __attribute__((ext_vector_type(4)));
typedef unsigned u32x4 __attribute__((ext_vector_type(4)));
constexpr int BM = 256, BK = 64, HALF = 128, HTB = HALF * BK * 2  , STAGE_BYTES = 8 * HTB, NXCD = 8, WGM = 8;

__host__ __device__ __forceinline__ int lds_byte(int r, int c) { const int st = (r >> 4) * 2 + (c >> 5), rr = r & 15, cc = c & 31, ob = rr * 64 + cc * 2; return st * 1024 + (ob ^ (((ob >> 9) & 1) << 5)); }
__host__ __device__ __forceinline__ void stage_rc(int b, int& R, int& C) { const int st = b / 1024, sb = b % 1024, swz = sb ^ (((sb >> 9) & 1) << 5); R = (st >> 1) * 16 + swz / 64; C = (st & 1) * 32 + (swz % 64) / 2; }
__host__ __device__ __forceinline__ int perm32(int rho) { const int n = rho >> 4, i = rho & 15; return 8 * (i >> 2) + 4 * n + (i & 3); }

struct Unit { int pm, pn; };
struct Gemm { const bf16_t* A; const bf16_t* Bt; int M, N, K; };

struct StaticOrder {
    int nM, nN, nwg, G, c;
    __host__ __device__ void init(int M, int N, int G_, int c_) { nM = M / BM; nN = N / BM; nwg = nM * nN; G = G_; c = c_; }
    __host__ __device__ bool next(int i, Unit& u) const {
        const long L = (long)i * G + c; if (L >= nwg) return false;
        int wgid = (int)L; { const int q = nwg / NXCD, r = nwg % NXCD, xcd = wgid % NXCD, off = wgid / NXCD; wgid = (xcd < r ? xcd * (q + 1) : r * (q + 1) + (xcd - r) * q) + off; }
        const int nig = WGM * nN, gid = wgid / nig, fm = gid * WGM, gsz = (nM - fm) < WGM ? (nM - fm) : WGM;
        u.pm = fm + ((wgid % nig) % gsz); u.pn = (wgid % nig) / gsz; return true;
    }
    __device__ __forceinline__ void a_ready(const Unit&) const {}
    __device__ __forceinline__ void done(const Unit&) const {}
};

__device__ __forceinline__ unsigned cvt_pk_bf16(float lo, float hi) { unsigned r; asm volatile("v_cvt_pk_bf16_f32 %0, %1, %2" : "=v"(r) : "v"(lo), "v"(hi)); return r; }
typedef float f32x2 __attribute__((ext_vector_type(2)));
__device__ __forceinline__ f32x2 gelu_pk(f32x2 v) {
    const f32x2 av = __builtin_elementwise_abs(v), d = av * 0.2316418882f + 1.0f;
    f32x2 t; t.x = __builtin_amdgcn_rcpf(d.x); t.y = __builtin_amdgcn_rcpf(d.y);
    f32x2 q = t * 0.5307027145f + (-0.7265760135f); q = q * t + 0.7107068705f; q = q * t + (-0.142248368f); q = q * t + 0.127414796f; q = q * t;
    const f32x2 s = (v * v) * (-0.72134752044f);
    f32x2 e; e.x = __builtin_amdgcn_exp2f(s.x); e.y = __builtin_amdgcn_exp2f(s.y);
    const f32x2 m = v * (q * e), r = v - m;
    f32x2 o; o.x = v.x < 0.f ? m.x : r.x; o.y = v.y < 0.f ? m.y : r.y; return o;
}

template <int ACT  > struct EpiBf16 {
    static constexpr bool PERM = true, AFTER_DRAIN = false; static_assert(ACT == 0 || ACT == 1, "EpiBf16: ACT is 0 (none) or 1 (gelu_pk)");
    bf16_t* O; int ldc; const float* bias; int split_cols; size_t split_stride; float scale0;
    __device__ __forceinline__ void operator()(const f32x4 (&acc)[2][2][4][2], const Unit& u, int wr, int wc, int fr, int fq) const {
        const int row0 = u.pm * BM + wr * 64 + fr; int colt = u.pn * BM; bf16_t* base = O;
        float sc = 1.f; if (split_cols) { const int t = colt / split_cols; base += (size_t)t * split_stride; colt -= t * split_cols; if (t == 0) sc = scale0; }
        const int col0 = colt + wc * 32 + 8 * fq, bcol0 = u.pn * BM + wc * 32 + 8 * fq;
        f32x4 bv[2][2];
#pragma unroll
        for (int bj = 0; bj < 2; ++bj)
#pragma unroll
            for (int n = 0; n < 2; ++n) bv[bj][n] = bias ? *(const f32x4*)(bias + bcol0 + bj * HALF + 4 * n) : (f32x4){0.f, 0.f, 0.f, 0.f};
#pragma unroll
        for (int ai = 0; ai < 2; ++ai)
#pragma unroll
            for (int m = 0; m < 4; ++m) { bf16_t* rowp = base + (size_t)(row0 + ai * HALF + m * 16) * ldc + col0;
#pragma unroll
                for (int bj = 0; bj < 2; ++bj) { f32x4 v0 = acc[ai][bj][m][0] + bv[bj][0], v1 = acc[ai][bj][m][1] + bv[bj][1];
                    if (ACT == 1) { f32x2 a = gelu_pk((f32x2){v0[0], v0[1]}), b = gelu_pk((f32x2){v0[2], v0[3]}), c = gelu_pk((f32x2){v1[0], v1[1]}), d = gelu_pk((f32x2){v1[2], v1[3]});
                        v0 = (f32x4){a.x, a.y, b.x, b.y}; v1 = (f32x4){c.x, c.y, d.x, d.y}; }
                    v0 = v0 * sc; v1 = v1 * sc; u32x4 w; w.x = cvt_pk_bf16(v0[0], v0[1]); w.y = cvt_pk_bf16(v0[2], v0[3]); w.z = cvt_pk_bf16(v1[0], v1[1]); w.w = cvt_pk_bf16(v1[2], v1[3]);
                    *(u32x4*)(rowp + bj * HALF) = w; } }
    }
};

struct EpiResF32 {
    static constexpr bool PERM = false, AFTER_DRAIN = false;
    const float* base; float* out; int ldc;
    __device__ __forceinline__ void operator()(const f32x4 (&acc)[2][2][4][2], const Unit& u, int wr, int wc, int fr, int fq) const {
        const int row0 = u.pm * BM + wr * 64 + fr, col0 = u.pn * BM + wc * 32 + 4 * fq;
#pragma unroll
        for (int ai = 0; ai < 2; ++ai)
#pragma unroll
            for (int m = 0; m < 4; ++m) { const size_t off = (size_t)(row0 + ai * HALF + m * 16) * ldc + col0;
#pragma unroll
                for (int bj = 0; bj < 2; ++bj)
#pragma unroll
                    for (int n = 0; n < 2; ++n) { const f32x4 b = *(const f32x4*)(base + off + bj * HALF + n * 16); *(f32x4*)(out + off + bj * HALF + n * 16) = b + acc[ai][bj][m][n]; }
                asm volatile("" ::: "memory"); }
    }
};
struct EpiGate {
    static constexpr bool PERM = false, AFTER_DRAIN = false;
    float* h; const bf16_t* pp; int ldc;
    __device__ __forceinline__ void operator()(const f32x4 (&acc)[2][2][4][2], const Unit& u, int wr, int wc, int fr, int fq) const {
        typedef unsigned u32x2v __attribute__((ext_vector_type(2)));
        const int row0 = u.pm * BM + wr * 64 + fr, col0 = u.pn * BM + wc * 32 + 4 * fq;
#pragma unroll
        for (int ai = 0; ai < 2; ++ai)
#pragma unroll
            for (int m = 0; m < 4; ++m) { const size_t off = (size_t)(row0 + ai * HALF + m * 16) * ldc + col0;
#pragma unroll
                for (int bj = 0; bj < 2; ++bj)
#pragma unroll
                    for (int n = 0; n < 2; ++n) { const size_t o = off + bj * HALF + n * 16;
                        const f32x4 hv = *(const f32x4*)(h + o); const u32x2v pv = *(const u32x2v*)(pp + o); const f32x4 a = acc[ai][bj][m][n];
                        f32x4 p; p[0] = __uint_as_float(pv.x << 16); p[1] = __uint_as_float(pv.x & 0xffff0000u); p[2] = __uint_as_float(pv.y << 16); p[3] = __uint_as_float(pv.y & 0xffff0000u);
                        f32x4 r;
#pragma unroll
                        for (int j = 0; j < 4; ++j) { const float g = __builtin_amdgcn_rcpf(1.0f + __expf(-a[j])); r[j] = hv[j] + g * p[j]; }
                        *(f32x4*)(h + o) = r; }
                asm volatile("" ::: "memory"); }
    }
};

__device__ __forceinline__ float shx16(float v, int o, int lane) { return __int_as_float(__builtin_amdgcn_ds_bpermute((lane ^ o) << 2, __float_as_int(v))); }
struct EpiBf16Row {
    static constexpr bool PERM = true, AFTER_DRAIN = false;
    bf16_t* O; int ldc; const float* rs; bf16_t* hm; bf16_t* iq; bf16_t* ik; int c_hm0, c_hm1, c_iq0, c_ik0, seq;
    __device__ __forceinline__ void operator()(const f32x4 (&acc)[2][2][4][2], const Unit& u, int wr, int wc, int fr, int fq) const {
        const int row0 = u.pm * BM + wr * 64 + fr;
        bf16_t* bp[2]; size_t rstride[2]; bool live[2];
#pragma unroll
        for (int bj = 0; bj < 2; ++bj) { const int colb = u.pn * BM + bj * HALF; live[bj] = true;
            if (colb >= c_hm0 && colb < c_hm1) { const int rel = colb - c_hm0, which = rel >> 10, hh = (rel >> 7) & 7; bp[bj] = hm + ((size_t)(which * 8 + hh) * seq) * 128 + wc * 32 + 8 * fq; rstride[bj] = 128; }
            else if (colb >= c_iq0 && colb < c_ik0) { bp[bj] = iq + (colb - c_iq0) + wc * 32 + 8 * fq; rstride[bj] = 1024; }
            else if (colb == c_ik0) { bp[bj] = ik + wc * 32 + 8 * fq; rstride[bj] = 64; live[bj] = wc < 2; }
            else { bp[bj] = O + colb + wc * 32 + 8 * fq; rstride[bj] = (size_t)ldc; } }
#pragma unroll
        for (int ai = 0; ai < 2; ++ai)
#pragma unroll
            for (int m = 0; m < 4; ++m) { const int row = row0 + ai * HALF + m * 16; const float s = rs[row];
#pragma unroll
                for (int bj = 0; bj < 2; ++bj) { const f32x4 v0 = acc[ai][bj][m][0] * s, v1 = acc[ai][bj][m][1] * s;
                    u32x4 w; w.x = cvt_pk_bf16(v0[0], v0[1]); w.y = cvt_pk_bf16(v0[2], v0[3]); w.z = cvt_pk_bf16(v1[0], v1[1]); w.w = cvt_pk_bf16(v1[2], v1[3]);
                    if (live[bj]) *(u32x4*)(bp[bj] + (size_t)row * rstride[bj]) = w; } }
    }
};
struct EpiResF32N {
    static constexpr bool PERM = false, AFTER_DRAIN = false;
    const float* base; float* out; bf16_t* hb; float* part; int ldc;
    __device__ __forceinline__ void operator()(const f32x4 (&acc)[2][2][4][2], const Unit& u, int wr, int wc, int fr, int fq) const {
        typedef unsigned u32x2v __attribute__((ext_vector_type(2)));
        const int row0 = u.pm * BM + wr * 64 + fr, col0 = u.pn * BM + wc * 32 + 4 * fq, lane = fq * 16 + fr;
#pragma unroll
        for (int ai = 0; ai < 2; ++ai)
#pragma unroll
            for (int m = 0; m < 4; ++m) { const int row = row0 + ai * HALF + m * 16; const size_t off = (size_t)row * ldc + col0; float ss = 0.f;
#pragma unroll
                for (int bj = 0; bj < 2; ++bj)
#pragma unroll
                    for (int n = 0; n < 2; ++n) { const size_t o = off + bj * HALF + n * 16; const f32x4 r = *(const f32x4*)(base + o) + acc[ai][bj][m][n]; *(f32x4*)(out + o) = r;
                        u32x2v w; w.x = cvt_pk_bf16(r[0], r[1]); w.y = cvt_pk_bf16(r[2], r[3]); *(u32x2v*)(hb + o) = w; ss += (r[0] * r[0] + r[1] * r[1]) + (r[2] * r[2] + r[3] * r[3]); }
                ss += shx16(ss, 16, lane); ss += shx16(ss, 32, lane);
                if (fq == 0) part[(size_t)row * 64 + u.pn * 4 + wc] = ss;
                if (m & 1) asm volatile("" ::: "memory"); }
    }
};
struct EpiGateN {
    static constexpr bool PERM = false, AFTER_DRAIN = false;
    float* h; const bf16_t* pp; const float* rs; bf16_t* hb; float* part; int ldc;
    __device__ __forceinline__ void operator()(const f32x4 (&acc)[2][2][4][2], const Unit& u, int wr, int wc, int fr, int fq) const {
        typedef unsigned u32x2v __attribute__((ext_vector_type(2)));
        const int row0 = u.pm * BM + wr * 64 + fr, col0 = u.pn * BM + wc * 32 + 4 * fq, lane = fq * 16 + fr;
#pragma unroll
        for (int ai = 0; ai < 2; ++ai)
#pragma unroll
            for (int m = 0; m < 4; ++m) { const int row = row0 + ai * HALF + m * 16; const size_t off = (size_t)row * ldc + col0; const float s = rs[row]; float ss = 0.f;
#pragma unroll
                for (int bj = 0; bj < 2; ++bj)
#pragma unroll
                    for (int n = 0; n < 2; ++n) { const size_t o = off + bj * HALF + n * 16;
                        const f32x4 hv = *(const f32x4*)(h + o); const u32x2v pv = *(const u32x2v*)(pp + o); const f32x4 a = acc[ai][bj][m][n] * s;
                        f32x4 p; p[0] = __uint_as_float(pv.x << 16); p[1] = __uint_as_float(pv.x & 0xffff0000u); p[2] = __uint_as_float(pv.y << 16); p[3] = __uint_as_float(pv.y & 0xffff0000u);
                        f32x4 r;
#pragma unroll
                        for (int j = 0; j < 4; ++j) { const float g = __builtin_amdgcn_rcpf(1.0f + __expf(-a[j])); r[j] = hv[j] + g * p[j]; }
                        *(f32x4*)(h + o) = r; u32x2v w; w.x = cvt_pk_bf16(r[0], r[1]); w.y = cvt_pk_bf16(r[2], r[3]); *(u32x2v*)(hb + o) = w; ss += (r[0] * r[0] + r[1] * r[1]) + (r[2] * r[2] + r[3] * r[3]); }
                ss += shx16(ss, 16, lane); ss += shx16(ss, 32, lane);
                if (fq == 0) part[(size_t)row * 64 + u.pn * 4 + wc] = ss;
                if (m & 1) asm volatile("" ::: "memory"); }
    }
};

__device__ __forceinline__ void unpk8(const u32x4 w, float (&f)[8]) { f[0] = __uint_as_float(w.x << 16); f[1] = __uint_as_float(w.x & 0xffff0000u); f[2] = __uint_as_float(w.y << 16); f[3] = __uint_as_float(w.y & 0xffff0000u);
    f[4] = __uint_as_float(w.z << 16); f[5] = __uint_as_float(w.z & 0xffff0000u); f[6] = __uint_as_float(w.w << 16); f[7] = __uint_as_float(w.w & 0xffff0000u); }
struct EpiResB {
    static constexpr bool PERM = true, AFTER_DRAIN = false;
    const bf16_t* base; bf16_t* out; float* part; int ldc;
    __device__ __forceinline__ void operator()(const f32x4 (&acc)[2][2][4][2], const Unit& u, int wr, int wc, int fr, int fq) const {
        const int row0 = u.pm * BM + wr * 64 + fr, col0 = u.pn * BM + wc * 32 + 8 * fq, lane = fq * 16 + fr;
#pragma unroll
        for (int ai = 0; ai < 2; ++ai)
#pragma unroll
            for (int m = 0; m < 4; ++m) { const int row = row0 + ai * HALF + m * 16; const size_t off = (size_t)row * ldc + col0; float ss = 0.f;
#pragma unroll
                for (int bj = 0; bj < 2; ++bj) { const size_t o = off + bj * HALF; float b[8], r[8]; unpk8(*(const u32x4*)(base + o), b);
#pragma unroll
                    for (int j = 0; j < 4; ++j) { r[j] = b[j] + acc[ai][bj][m][0][j]; r[4 + j] = b[4 + j] + acc[ai][bj][m][1][j]; }
                    u32x4 w; w.x = cvt_pk_bf16(r[0], r[1]); w.y = cvt_pk_bf16(r[2], r[3]); w.z = cvt_pk_bf16(r[4], r[5]); w.w = cvt_pk_bf16(r[6], r[7]); *(u32x4*)(out + o) = w;
#pragma unroll
                    for (int j = 0; j < 8; ++j) ss += r[j] * r[j]; }
                ss += shx16(ss, 16, lane); ss += shx16(ss, 32, lane);
                if (fq == 0) part[(size_t)row * 64 + u.pn * 4 + wc] = ss;
                if (m & 1) asm volatile("" ::: "memory"); }
    }
};
struct EpiGateB {
    static constexpr bool PERM = true, AFTER_DRAIN = false;
    const bf16_t* hin; const bf16_t* pp; const float* rs; bf16_t* out; float* part; int ldc;
    __device__ __forceinline__ void operator()(const f32x4 (&acc)[2][2][4][2], const Unit& u, int wr, int wc, int fr, int fq) const {
        const int row0 = u.pm * BM + wr * 64 + fr, col0 = u.pn * BM + wc * 32 + 8 * fq, lane = fq * 16 + fr;
#pragma unroll
        for (int ai = 0; ai < 2; ++ai)
#pragma unroll
            for (int m = 0; m < 4; ++m) { const int row = row0 + ai * HALF + m * 16; const size_t off = (size_t)row * ldc + col0; const float s = rs[row]; float ss = 0.f;
#pragma unroll
                for (int bj = 0; bj < 2; ++bj) { const size_t o = off + bj * HALF; float hf[8], pf[8], r[8]; unpk8(*(const u32x4*)(hin + o), hf); unpk8(*(const u32x4*)(pp + o), pf);
#pragma unroll
                    for (int j = 0; j < 8; ++j) { const float a = (j < 4 ? acc[ai][bj][m][0][j & 3] : acc[ai][bj][m][1][j & 3]) * s; const float g = __builtin_amdgcn_rcpf(1.0f + __expf(-a)); r[j] = hf[j] + g * pf[j]; }
                    u32x4 w; w.x = cvt_pk_bf16(r[0], r[1]); w.y = cvt_pk_bf16(r[2], r[3]); w.z = cvt_pk_bf16(r[4], r[5]); w.w = cvt_pk_bf16(r[6], r[7]); *(u32x4*)(out + o) = w;
#pragma unroll
                    for (int j = 0; j < 8; ++j) ss += r[j] * r[j]; }
                ss += shx16(ss, 16, lane); ss += shx16(ss, 32, lane);
                if (fq == 0) part[(size_t)row * 64 + u.pn * 4 + wc] = ss;
                if (m & 1) asm volatile("" ::: "memory"); }
    }
};
template <class Epi, class Sched, bool ALIGN_EPI = false, bool SP2 = false>
__device__ __forceinline__ void gemm_phase(PG8_LAS unsigned char* lds, const Gemm g, const Sched& S, const Epi& E) {
    int tid_ = threadIdx.x; asm volatile("" : "+v"(tid_));
    const int tid = tid_, wid = __builtin_amdgcn_readfirstlane(tid >> 6), lane = tid & 63, wr = wid >> 2, wc = wid & 3, fr = lane & 15, fq = lane >> 4;
    const int K = g.K, nt = K / BK;
    unsigned voffA[2], voffB[2];
#pragma unroll
    for (int i = 0; i < 2; ++i) { int R, C; stage_rc(tid * 16 + i * 8192, R, C); const int Rb = Epi::PERM ? ((R & ~31) + perm32(R & 31)) : R;
        voffA[i] = (unsigned)(R * K + C) * 2u; voffB[i] = (unsigned)(Rb * K + C) * 2u; }
    const size_t kstep = (size_t)(BK * 2);
    const size_t hstep = (size_t)HALF * K * 2;
    const size_t tstep = 2 * hstep;
    const unsigned ldsw = (unsigned)wid * 1024u;
    const int aoff = lds_byte(wr * 64 + fr, fq * 8), boff = lds_byte(wc * 32 + fr, fq * 8);
#define PG8_SA(b, h) (((b) * 2 + (h)) * HTB)
#define PG8_SB(b, h) ((4 + (b) * 2 + (h)) * HTB)
#define PG8_STAGE(bufoff, gbase, voff) do { _Pragma("unroll") for (int _i = 0; _i < 2; ++_i) \
        __builtin_amdgcn_global_load_lds((const unsigned*)((const char*)(gbase) + (voff)[_i]), (PG8_LAS unsigned*)(lds + (bufoff) + ldsw + _i * 8192), 16, 0, 0); } while (0)
#define PG8_LDA(dst, b, h) do { _Pragma("unroll") for (int m = 0; m < 4; ++m) _Pragma("unroll") for (int k = 0; k < 2; ++k) dst[m][k] = *(const PG8_LAS bf16x8*)(lds + PG8_SA(b, h) + aoff + m * 2048 + k * 1024); } while (0)
#define PG8_LDB(dst, b, h) do { _Pragma("unroll") for (int n = 0; n < 2; ++n) _Pragma("unroll") for (int k = 0; k < 2; ++k) dst[n][k] = *(const PG8_LAS bf16x8*)(lds + PG8_SB(b, h) + boff + n * 2048 + k * 1024); } while (0)
#define PG8_MMA(ai, bj, At, Bt) do { __builtin_amdgcn_s_setprio(1); _Pragma("unroll") for (int m = 0; m < 4; ++m) _Pragma("unroll") for (int n = 0; n < 2; ++n) _Pragma("unroll") for (int k = 0; k < 2; ++k) \
        acc[ai][bj][m][n] = __builtin_amdgcn_mfma_f32_16x16x32_bf16(Bt[n][k], At[m][k], acc[ai][bj][m][n], 0, 0, 0); __builtin_amdgcn_s_setprio(0); } while (0)
#define PG8_WAIT_V(n) asm volatile("s_waitcnt vmcnt(" #n ")" ::: "memory")
#define PG8_WAIT_L(n) asm volatile("s_waitcnt lgkmcnt(" #n ")" ::: "memory")
#define PG8_BAR __builtin_amdgcn_s_barrier()
#define PG8_SCHED __builtin_amdgcn_sched_barrier(0)
    Unit cur, nxt; int ui = 0;
    if (!S.next(0, cur)) return;
    f32x4 acc[2][2][4][2];
#pragma unroll
    for (int a = 0; a < 2; ++a)
#pragma unroll
        for (int b = 0; b < 2; ++b)
#pragma unroll
            for (int m = 0; m < 4; ++m)
#pragma unroll
                for (int n = 0; n < 2; ++n) acc[a][b][m][n] = (f32x4){0.f, 0.f, 0.f, 0.f};
    bf16x8 At[4][2], B0[2][2], B1[2][2];
    const char* cA = (const char*)g.A + (size_t)cur.pm * tstep; const char* cB = (const char*)g.Bt + (size_t)cur.pn * tstep;
    S.a_ready(cur);
    if constexpr (SP2) {
        PG8_STAGE(PG8_SB(0, 0), cB, voffB); PG8_STAGE(PG8_SB(0, 1), cB + hstep, voffB); PG8_STAGE(PG8_SA(0, 0), cA, voffA); PG8_STAGE(PG8_SA(0, 1), cA + hstep, voffA);
        if (wr == 1) PG8_BAR;
        PG8_WAIT_V(2); PG8_BAR;
        PG8_STAGE(PG8_SB(1, 0), cB + kstep, voffB); PG8_STAGE(PG8_SA(1, 0), cA + kstep, voffA); PG8_STAGE(PG8_SB(1, 1), cB + hstep + kstep, voffB);
        PG8_WAIT_V(6); PG8_BAR;
    } else {
        PG8_STAGE(PG8_SB(0, 0), cB, voffB); PG8_STAGE(PG8_SA(0, 0), cA, voffA); PG8_STAGE(PG8_SB(0, 1), cB + hstep, voffB); PG8_STAGE(PG8_SA(0, 1), cA + hstep, voffA);
        if (wr == 1) PG8_BAR;
        PG8_WAIT_V(4); PG8_BAR;
        PG8_STAGE(PG8_SB(1, 0), cB + kstep, voffB); PG8_STAGE(PG8_SA(1, 0), cA + kstep, voffA); PG8_STAGE(PG8_SB(1, 1), cB + hstep + kstep, voffB);
        PG8_WAIT_V(6); PG8_BAR;
    }
    for (;;) {
        const bool has_next = S.next(ui + 1, nxt);
        const char* nA = has_next ? (const char*)g.A + (size_t)nxt.pm * tstep : cA; const char* nB = has_next ? (const char*)g.Bt + (size_t)nxt.pn * tstep : cB;
#pragma nounroll
        for (int t = 0; t < nt; t += 2) {
            const bool last = (t == nt - 2);
            const char* a1 = cA + (size_t)(t + 1) * kstep;
            const char* a2 = last ? nA : cA + (size_t)(t + 2) * kstep; const char* b2 = last ? nB : cB + (size_t)(t + 2) * kstep;
            const char* a3 = a2 + kstep; const char* b3 = b2 + kstep;
            if (last && has_next) S.a_ready(nxt);
            if constexpr (SP2) {
            PG8_LDB(B0, 0, 0); PG8_LDB(B1, 0, 1); PG8_SCHED; PG8_LDA(At, 0, 0); PG8_STAGE(PG8_SA(1, 1), a1 + hstep, voffA);
            PG8_WAIT_V(8); PG8_WAIT_L(0); PG8_BAR; PG8_MMA(0, 0, At, B0); PG8_MMA(0, 1, At, B1); PG8_BAR; PG8_SCHED;
            PG8_LDA(At, 0, 1); PG8_STAGE(PG8_SB(0, 0), b2, voffB); PG8_STAGE(PG8_SB(0, 1), b2 + hstep, voffB); PG8_STAGE(PG8_SA(0, 0), a2, voffA);
            PG8_WAIT_V(8); PG8_WAIT_L(0); PG8_BAR; PG8_MMA(1, 0, At, B0); PG8_MMA(1, 1, At, B1); PG8_BAR; PG8_SCHED;
            PG8_LDB(B0, 1, 0); PG8_LDB(B1, 1, 1); PG8_SCHED; PG8_LDA(At, 1, 0); PG8_STAGE(PG8_SA(0, 1), a2 + hstep, voffA);
            PG8_WAIT_V(8); PG8_WAIT_L(0); PG8_BAR; PG8_MMA(0, 0, At, B0); PG8_MMA(0, 1, At, B1); PG8_BAR; PG8_SCHED;
            PG8_LDA(At, 1, 1); PG8_STAGE(PG8_SB(1, 0), b3, voffB); PG8_STAGE(PG8_SB(1, 1), b3 + hstep, voffB); PG8_STAGE(PG8_SA(1, 0), a3, voffA);
            PG8_WAIT_V(8); PG8_WAIT_L(0); PG8_BAR; PG8_MMA(1, 0, At, B0); PG8_MMA(1, 1, At, B1); PG8_BAR; PG8_SCHED;
            } else {
            PG8_LDB(B0, 0, 0); PG8_SCHED; PG8_LDA(At, 0, 0); PG8_STAGE(PG8_SA(1, 1), a1 + hstep, voffA);
            PG8_WAIT_L(8); PG8_BAR; PG8_WAIT_L(0); PG8_MMA(0, 0, At, B0); PG8_BAR; PG8_SCHED;
            PG8_LDB(B1, 0, 1); PG8_STAGE(PG8_SB(0, 0), b2, voffB);
            PG8_BAR; PG8_WAIT_L(0); PG8_MMA(0, 1, At, B1); PG8_BAR;
            PG8_LDA(At, 0, 1); PG8_STAGE(PG8_SA(0, 0), a2, voffA);
            PG8_BAR; PG8_WAIT_L(0); PG8_MMA(1, 0, At, B0); PG8_BAR; PG8_SCHED;
            PG8_STAGE(PG8_SB(0, 1), b2 + hstep, voffB);
            PG8_WAIT_V(6); PG8_BAR; PG8_MMA(1, 1, At, B1); PG8_BAR;
            PG8_LDB(B0, 1, 0); PG8_SCHED; PG8_LDA(At, 1, 0); PG8_STAGE(PG8_SA(0, 1), a2 + hstep, voffA);
            PG8_WAIT_L(8); PG8_BAR; PG8_WAIT_L(0); PG8_MMA(0, 0, At, B0); PG8_BAR; PG8_SCHED;
            PG8_LDB(B1, 1, 1); PG8_STAGE(PG8_SB(1, 0), b3, voffB);
            PG8_BAR; PG8_WAIT_L(0); PG8_MMA(0, 1, At, B1); PG8_BAR;
            PG8_LDA(At, 1, 1); PG8_STAGE(PG8_SA(1, 0), a3, voffA);
            PG8_BAR; PG8_WAIT_L(0); PG8_MMA(1, 0, At, B0); PG8_BAR; PG8_SCHED;
            PG8_STAGE(PG8_SB(1, 1), b3 + hstep, voffB);
            PG8_WAIT_V(6); PG8_BAR; PG8_MMA(1, 1, At, B1); PG8_BAR;
            }
        }
        if constexpr (ALIGN_EPI) { if (wr == 0) PG8_BAR; }
        if constexpr (!Epi::AFTER_DRAIN) { E(acc, cur, wr, wc, fr, fq); S.done(cur); }
        if (!has_next) break;
#pragma unroll
        for (int a = 0; a < 2; ++a)
#pragma unroll
            for (int b = 0; b < 2; ++b)
#pragma unroll
                for (int m = 0; m < 4; ++m)
#pragma unroll
                    for (int n = 0; n < 2; ++n) acc[a][b][m][n] = (f32x4){0.f, 0.f, 0.f, 0.f};
        cur = nxt; cA = nA; cB = nB; ++ui;
        if constexpr (ALIGN_EPI) { if (wr == 1) PG8_BAR; }
    }
    PG8_WAIT_V(0);
    if constexpr (!ALIGN_EPI) { if (wr == 0) PG8_BAR; }
    PG8_BAR;
    if constexpr (Epi::AFTER_DRAIN) { E.fused(acc, cur, wr, wc, fr, fq, lds, wid, lane); S.done(cur); }
#undef PG8_SA
#undef PG8_SB
#undef PG8_STAGE
#undef PG8_LDA
#undef PG8_LDB
#undef PG8_MMA
#undef PG8_WAIT_V
#undef PG8_WAIT_L
#undef PG8_BAR
#undef PG8_SCHED
}
}

constexpr int SEQ = 16384, DM = 4096, DEPTH = 4, DPLE = 256;
constexpr int INW = 15980;
constexpr int ZW = 16384;
constexpr float NORM_EPS = 1e-6f;
constexpr int ZQ_A = 0, ZK_A = 768, ZV_A = 1536, ZLOW = 3072, ZGATE_A = 3200;
constexpr int ZQ_B = 4736, ZK_B = 5760, ZV_B = 6784, ZGATE_B = 7808, ZIQ = 8832, ZIK = 9856, ZIW = 9984;
constexpr int ZQ_C = 10112, ZK_C = 10880, ZV_C = 11648, ZIF = 13184, ZO_C = 13312, ZGATE_C = 14848;
constexpr int YA = 0, YB = 1536, YC = 2560;
constexpr int NCH = SEQ / 64;

constexpr size_t MiB = 1u << 20;
constexpr size_t WS_CTL = 0, CTL_ZERO_BYTES = 1 * MiB;
constexpr size_t WS_ROPE = 1 * MiB;
constexpr size_t WS_PBF = 4 * MiB;
constexpr size_t WS_WPLE = 36 * MiB;
constexpr size_t WS_WOUT = 44 * MiB;
constexpr size_t WS_WGATE = 172 * MiB;
constexpr size_t WS_WIN = 300 * MiB;
constexpr size_t WS_H = 812 * MiB;
constexpr size_t WS_QT = 812 * MiB;
constexpr size_t WS_U = 1068 * MiB;
constexpr size_t WS_Z = 1196 * MiB;
constexpr size_t WS_Y = 1708 * MiB;
constexpr size_t WS_PP = 1836 * MiB;
constexpr size_t WS_QA = 1964 * MiB, WS_KA = 1996 * MiB, WS_VA = 2028 * MiB;
constexpr size_t WS_IQ = 2060 * MiB;
constexpr size_t WS_IK = 2092 * MiB;
constexpr size_t WS_IW = 2094 * MiB;
constexpr size_t WS_MASK = 2096 * MiB;
constexpr size_t WS_BA = 2128 * MiB;
constexpr size_t WS_DS = 2176 * MiB;
constexpr size_t WS_SP = 2272 * MiB;
constexpr size_t WS_CQ = 2320 * MiB, WS_CK = 2344 * MiB;
constexpr size_t WS_MG = 2368 * MiB;
constexpr size_t WS_DC = 2372 * MiB;
constexpr size_t WS_CP = 2564 * MiB;
constexpr size_t WS_SCORE = 2660 * MiB;
constexpr size_t WS_HB2 = 3684 * MiB;
constexpr size_t WS_PART = 3812 * MiB;
constexpr size_t WS_RSTD = 3816 * MiB;
constexpr size_t WS_END = 3818 * MiB;
constexpr size_t MG_B = 0;
constexpr size_t MG_I = MG_B + (size_t)SEQ * 8;
constexpr size_t MG_ML = MG_I + (size_t)SEQ * 8;
constexpr size_t MG_MP = MG_ML + (size_t)NCH * 6 * 2;
constexpr size_t MG_DN = MG_MP + (size_t)NCH * 6;
constexpr size_t MG_NP = MG_DN + (size_t)NCH * 6 * 128;
static_assert((MG_NP + (size_t)NCH * 6 * 128) * 4 <= 4 * MiB, "mLSTM small arrays fit");

constexpr int CW_BAR = 4096;

constexpr int RING_BYTES = 131072;
constexpr int MISC_OFF = RING_BYTES + 320;
constexpr int LDS_BYTES = 147456;
constexpr int NWAVES = 8, NTHR = 512;

#define GAS __attribute__((address_space(1)))
#define LAS __attribute__((address_space(3)))
typedef unsigned short bf16;
typedef unsigned u32x4 __attribute__((ext_vector_type(4)));
typedef unsigned u32x2 __attribute__((ext_vector_type(2)));
typedef float f32x4 __attribute__((ext_vector_type(4)));
typedef float f32x2 __attribute__((ext_vector_type(2)));
typedef float f32x16 __attribute__((ext_vector_type(16)));
typedef short bf16x8 __attribute__((ext_vector_type(8)));
typedef short bf16x4 __attribute__((ext_vector_type(4)));
#define LDS_WAIT() asm volatile("s_waitcnt lgkmcnt(0)" ::: "memory")
#define VM_WAIT() asm volatile("s_waitcnt vmcnt(0)" ::: "memory")
#define TPOS(row_, s_, sh_) ((row_) * 72 + (((((s_) >> 3) ^ ((row_) >> (sh_))) & 7) << 3) + ((s_) & 7))
#define TRD(row_, chunk_, sh_) ((row_) * 72 + ((((chunk_) ^ ((row_) >> (sh_))) & 7) << 3))

__device__ __forceinline__ float bf2f(unsigned short b) { return __uint_as_float((unsigned)b << 16); }
__device__ __forceinline__ float bflo(unsigned w) { return __uint_as_float(w << 16); }
__device__ __forceinline__ float bfhi(unsigned w) { return __uint_as_float(w & 0xffff0000u); }
typedef __bf16 bf16x2_t __attribute__((ext_vector_type(2)));
__device__ __forceinline__ unsigned pk2(float lo, float hi) { const f32x2 v = {lo, hi}; const bf16x2_t b = __builtin_convertvector(v, bf16x2_t); return __builtin_bit_cast(unsigned, b); }
__device__ __forceinline__ unsigned short f2bf(float f) { return (unsigned short)(pk2(f, 0.f) & 0xffffu); }
__device__ __forceinline__ float shx(float v, int o, int lane) { return __int_as_float(__builtin_amdgcn_ds_bpermute((lane ^ o) << 2, __float_as_int(v))); }
__device__ __forceinline__ float shup(float v, int o, int lane) { return __int_as_float(__builtin_amdgcn_ds_bpermute(((lane - o) & 63) << 2, __float_as_int(v))); }
__device__ __forceinline__ unsigned shdn_u(unsigned v, int o, int lane) { return (unsigned)__builtin_amdgcn_ds_bpermute(((lane + o) & 63) << 2, (int)v); }
__device__ __forceinline__ float wave_sum(float v, int lane) {
#pragma unroll
    for (int o = 1; o < 64; o <<= 1) v += shx(v, o, lane);
    return v;
}
__device__ __forceinline__ float wave_max(float v, int lane) {
#pragma unroll
    for (int o = 1; o < 64; o <<= 1) v = fmaxf(v, shx(v, o, lane));
    return v;
}
__device__ __forceinline__ float log_sigmoidf(float x) { return fminf(x, 0.f) - log1pf(expf(-fabsf(x))); }
__device__ __forceinline__ float sigmoidf_(float x) { return __builtin_amdgcn_rcpf(1.0f + __expf(-x)); }
__device__ __forceinline__ float siluf_(float x) { return x * __builtin_amdgcn_rcpf(1.0f + __expf(-x)); }
__device__ __forceinline__ int crow(int r, int hi) { return (r & 3) + 8 * (r >> 2) + 4 * hi; }
__device__ __forceinline__ void unpack8(const u32x4 w, float (&f)[8]) { f[0] = bflo(w.x); f[1] = bfhi(w.x); f[2] = bflo(w.y); f[3] = bfhi(w.y); f[4] = bflo(w.z); f[5] = bfhi(w.z); f[6] = bflo(w.w); f[7] = bfhi(w.w); }
__device__ __forceinline__ u32x4 pack8f(const float (&f)[8]) { u32x4 o; o.x = pk2(f[0], f[1]); o.y = pk2(f[2], f[3]); o.z = pk2(f[4], f[5]); o.w = pk2(f[6], f[7]); return o; }
__device__ __forceinline__ int hw_lane() { int l; asm volatile("v_mbcnt_lo_u32_b32 %0, -1, 0\n\tv_mbcnt_hi_u32_b32 %0, -1, %0" : "=v"(l)); return l; }
#define XB_TMO      128
#define XB_XCNT(j)  (256  + 64 * (j))
#define XB_XSUB(j)  (1280 + 64 * (j))
#define XB_XGEN(j)  (2304 + 64 * (j))
#define XB_TOP      3328
#define XB_TOPGEN   3392
#define XCD_BAR_WORDS 3456
#define XB_SPIN_CAP (1u << 18)

__device__ __forceinline__ unsigned xb_ld(unsigned* p)              { return __hip_atomic_load(p, __ATOMIC_RELAXED, __HIP_MEMORY_SCOPE_AGENT); }
__device__ __forceinline__ unsigned xb_add(unsigned* p, unsigned v) { return __hip_atomic_fetch_add(p, v, __ATOMIC_RELAXED, __HIP_MEMORY_SCOPE_AGENT); }
__device__ __forceinline__ unsigned xb_xcc_id() { return (unsigned)__builtin_amdgcn_s_getreg((3 << 11) | 20) & 0xFu; }
#define XB_SPIN(cond, bar) do { unsigned _sp = 0; while (cond) { __builtin_amdgcn_s_sleep(1); \
    if ((++_sp & 255u) == 0u) { if (xb_ld(&(bar)[XB_TMO])) break; if (_sp > XB_SPIN_CAP) { atomicAdd(&(bar)[XB_TMO], 1u); break; } } } } while (0)

struct XcdBarrier {
    unsigned* bar; unsigned x;
    volatile LAS unsigned* st;
};

__device__ __forceinline__ XcdBarrier xcd_barrier_post(unsigned* bar, volatile LAS unsigned* st) {
    XcdBarrier b; b.bar = bar; b.x = xb_xcc_id(); b.st = st;
    if (threadIdx.x == 0) (void)xb_add(&bar[XB_XCNT(b.x)], 1u);
    return b;
}
__device__ __forceinline__ void xcd_barrier_complete(unsigned* bar, unsigned x, unsigned& nloc, unsigned& nx) {
    const unsigned G = gridDim.x * gridDim.y * gridDim.z;
    unsigned sum, cnt, mine, sp = 0u;
    for (;;) {
        sum = 0u; cnt = 0u; mine = 0u;
#pragma unroll
        for (unsigned j = 0; j < 16; ++j) { const unsigned c = xb_ld(&bar[XB_XCNT(j)]); sum += c; cnt += (c > 0u) ? 1u : 0u; mine = (j == x) ? c : mine; }
        if (sum == G) break;
        __builtin_amdgcn_s_sleep(1);
        if ((++sp & 255u) == 0u) { if (xb_ld(&bar[XB_TMO])) break; if (sp > XB_SPIN_CAP) { atomicAdd(&bar[XB_TMO], 1u); break; } }
    }
    nloc = mine > 0u ? mine : 1u; nx = cnt > 0u ? cnt : 1u;
}

__device__ __forceinline__ void xcd_barrier(const XcdBarrier& b) {
    asm volatile("s_waitcnt vmcnt(0)" ::: "memory");
    __syncthreads();
    if (threadIdx.x == 0) {
        unsigned* bar = b.bar;
        __builtin_amdgcn_s_waitcnt(0);
        unsigned nloc = b.st[0], nx = b.st[1];
        if (nloc == 0u) { xcd_barrier_complete(bar, b.x, nloc, nx); b.st[0] = nloc; b.st[1] = nx; }
        const unsigned old = xb_add(&bar[XB_XSUB(b.x)], 1u);
        const unsigned gen = old / nloc;
        if (old + 1u == (gen + 1u) * nloc) {
            __builtin_amdgcn_fence(__ATOMIC_RELEASE, "agent");
            asm volatile("s_waitcnt vmcnt(0)" ::: "memory");
            const unsigned og = xb_add(&bar[XB_TOP], 1u);
            const unsigned tg = og / nx;
            if (og + 1u == (tg + 1u) * nx) xb_add(&bar[XB_TOPGEN], 1u);
            else XB_SPIN(xb_ld(&bar[XB_TOPGEN]) == tg, bar);
            __builtin_amdgcn_fence(__ATOMIC_ACQUIRE, "agent");
            xb_add(&bar[XB_XGEN(b.x)], 1u);
            asm volatile("s_waitcnt vmcnt(0)" ::: "memory");
        } else {
            XB_SPIN(xb_ld(&bar[XB_XGEN(b.x)]) == gen, bar);
            __builtin_amdgcn_fence(__ATOMIC_ACQUIRE, "agent");
            asm volatile("s_waitcnt vmcnt(0)" ::: "memory");
        }
    }
    __syncthreads();
}

struct Frame {
    LAS unsigned char* lds;
    unsigned char* ws;
    int tid, lane, wave, G, vcu, gw, NGW;
};

__device__ __forceinline__ void zseg(int n0, int& src0, int& valid, float& cscale) {
    int d0, s0, sl;
    if (n0 < ZK_A) { d0 = ZQ_A; s0 = 0; sl = 768; }
    else if (n0 < ZV_A) { d0 = ZK_A; s0 = 768; sl = 768; }
    else if (n0 < ZLOW) { d0 = ZV_A; s0 = 1536; sl = 1536; }
    else if (n0 < ZGATE_A) { d0 = ZLOW; s0 = 3072; sl = 16; }
    else if (n0 < ZQ_B) { d0 = ZGATE_A; s0 = 3088; sl = 1536; }
    else if (n0 < ZK_B) { d0 = ZQ_B; s0 = 4624; sl = 1024; }
    else if (n0 < ZV_B) { d0 = ZK_B; s0 = 5648; sl = 1024; }
    else if (n0 < ZGATE_B) { d0 = ZV_B; s0 = 6672; sl = 1024; }
    else if (n0 < ZIQ) { d0 = ZGATE_B; s0 = 7696; sl = 1024; }
    else if (n0 < ZIK) { d0 = ZIQ; s0 = 8720; sl = 1024; }
    else if (n0 < ZIW) { d0 = ZIK; s0 = 9744; sl = 64; }
    else if (n0 < ZQ_C) { d0 = ZIW; s0 = 9808; sl = 16; }
    else if (n0 < ZK_C) { d0 = ZQ_C; s0 = 9824; sl = 768; }
    else if (n0 < ZV_C) { d0 = ZK_C; s0 = 10592; sl = 768; }
    else if (n0 < ZIF) { d0 = ZV_C; s0 = 11360; sl = 1536; }
    else if (n0 < ZO_C) { d0 = ZIF; s0 = 12896; sl = 12; }
    else if (n0 < ZGATE_C) { d0 = ZO_C; s0 = 12908; sl = 1536; }
    else { d0 = ZGATE_C; s0 = 14444; sl = 1536; }
    const int off = n0 - d0; int v = sl - off; v = v < 0 ? 0 : (v > 32 ? 32 : v);
    src0 = s0 + off; valid = v;
    cscale = (d0 == ZIQ) ? 0.0078125f : (d0 == ZIW) ? 2.0f : 1.0f;
}
__device__ __forceinline__ void transpose_item(const float* W, int K, int Nsrc, bf16* WT, int k0, int n0dst, int src0, int valid, LAS float* scr, int lane, const float* gk, const float cs = 1.0f) {
    const int j = lane & 31; const bool ok = j < valid;
    float vv[32];
    const float* wp = W + (size_t)(k0 + (lane >> 5)) * Nsrc + src0 + (ok ? j : 0);
#pragma unroll
    for (int i = 0; i < 32; ++i) vv[i] = wp[(size_t)(2 * i) * Nsrc];
#pragma unroll
    for (int i = 0; i < 32; ++i) { const int kk = 2 * i + (lane >> 5); const float gg = (gk ? gk[k0 + kk] : 1.0f) * cs; scr[kk * 33 + j] = ok ? vv[i] * gg : 0.f; }
    LDS_WAIT(); asm volatile("" ::: "memory");
    const int c = lane & 7;
#pragma unroll
    for (int jj = 0; jj < 4; ++jj) { const int n = (lane >> 3) + 8 * jj; const LAS float* s = scr + (8 * c) * 33 + n;
        u32x4 o; o.x = pk2(s[0 * 33], s[1 * 33]); o.y = pk2(s[2 * 33], s[3 * 33]); o.z = pk2(s[4 * 33], s[5 * 33]); o.w = pk2(s[6 * 33], s[7 * 33]);
        *(GAS u32x4*)(WT + (size_t)(n0dst + n) * K + k0 + 8 * c) = o; }
    LDS_WAIT(); asm volatile("" ::: "memory");
}
__device__ __forceinline__ void p0_prologue(const Frame& F, const float* w_in, const float* w_out, const float* w_ple_gate, const float* w_ple_proj, const float* pin, const int* pos, const float* g_in, const float* g_ple, const float* x) {
    LAS float* scr = (LAS float*)(F.lds + F.wave * 16384);
    constexpr int I_IN = (DM / 64) * (ZW / 32), I_SQ = (DM / 64) * (DM / 32), I_PL = (DPLE / 64) * (DM / 32), I_L = I_IN + 2 * I_SQ + I_PL;
    for (int it = F.gw; it < DEPTH * I_L; it += F.NGW) {
        const int L = it / I_L; int r = it - L * I_L;
        if (r < I_IN) { const int nb = r % (ZW / 32), kb = r / (ZW / 32); int s0, vd; float cs; zseg(nb * 32, s0, vd, cs);
            transpose_item(w_in + (size_t)L * DM * INW, DM, INW, (bf16*)(F.ws + WS_WIN) + (size_t)L * ZW * DM, kb * 64, nb * 32, s0, vd, scr, F.lane, g_in + (size_t)L * DM, cs); continue; }
        r -= I_IN;
        if (r < I_SQ) { const int nb = r % (DM / 32), kb = r / (DM / 32);
            transpose_item(w_out + (size_t)L * DM * DM, DM, DM, (bf16*)(F.ws + WS_WOUT) + (size_t)L * DM * DM, kb * 64, nb * 32, nb * 32, 32, scr, F.lane, nullptr); continue; }
        r -= I_SQ;
        if (r < I_SQ) { const int nb = r % (DM / 32), kb = r / (DM / 32);
            transpose_item(w_ple_gate + (size_t)L * DM * DM, DM, DM, (bf16*)(F.ws + WS_WGATE) + (size_t)L * DM * DM, kb * 64, nb * 32, nb * 32, 32, scr, F.lane, g_ple + (size_t)L * DM); continue; }
        r -= I_SQ;
        { const int nb = r % (DM / 32), kb = r / (DM / 32);
            transpose_item(w_ple_proj + (size_t)L * DPLE * DM, DPLE, DM, (bf16*)(F.ws + WS_WPLE) + (size_t)L * DM * DPLE, kb * 64, nb * 32, nb * 32, 32, scr, F.lane, nullptr); }
    }
    { bf16* hb = (bf16*)(F.ws + WS_U); float* rstd = (float*)(F.ws + WS_RSTD);
      for (int row = F.gw; row < SEQ; row += F.NGW) {
          const f32x4* xr = (const f32x4*)(x + (size_t)row * DM) + F.lane; f32x4 v[16]; float ss = 0.f;
#pragma unroll
          for (int j = 0; j < 16; ++j) { v[j] = xr[64 * j]; ss += (v[j][0] * v[j][0] + v[j][1] * v[j][1]) + (v[j][2] * v[j][2] + v[j][3] * v[j][3]); }
          ss = wave_sum(ss, F.lane); if (F.lane == 0) rstd[row] = 1.0f / sqrtf(ss * (1.0f / DM) + NORM_EPS);
          u32x2* o = (u32x2*)(hb + (size_t)row * DM) + F.lane;
#pragma unroll
          for (int j = 0; j < 16; ++j) { u32x2 w; w.x = pk2(v[j][0], v[j][1]); w.y = pk2(v[j][2], v[j][3]); o[64 * j] = w; } } }
    { const size_t n8 = (size_t)DEPTH * SEQ * DPLE / 8; bf16* pb = (bf16*)(F.ws + WS_PBF);
      for (size_t i = (size_t)blockIdx.x * NTHR + F.tid; i < n8; i += (size_t)F.G * NTHR) {
          const f32x4 a = *(const f32x4*)(pin + i * 8), b = *(const f32x4*)(pin + i * 8 + 4);
          u32x4 o; o.x = pk2(a[0], a[1]); o.y = pk2(a[2], a[3]); o.z = pk2(b[0], b[1]); o.w = pk2(b[2], b[3]);
          *(u32x4*)(pb + i * 8) = o; } }
    { float* cosA = (float*)(F.ws + WS_ROPE); float* sinA = cosA + (size_t)SEQ * 16; float* cosI = sinA + (size_t)SEQ * 16; float* sinI = cosI + (size_t)SEQ * 8;
      for (int i = blockIdx.x * NTHR + F.tid; i < SEQ * 24; i += F.G * NTHR) {
          const int t = i / 24, f = i % 24; const bool isA = f < 16; const int fi = isA ? f : f - 16; const double rot = isA ? 32.0 : 16.0;
          const float ex = -(float)(2 * fi) / (float)rot;
          const float inv = (float)exp((double)ex * 13.122363377404328);
          const float ang = (float)pos[t] * inv;
          const double a = (double)ang; const double n = rint(a * 0.15915494309189535);
          double rr = fma(-n, 6.283185307179586, a); rr = fma(-n, 2.4492935982947064e-16, rr);
          const float c = (float)cos(rr), s = (float)sin(rr);
          if (isA) { cosA[t * 16 + fi] = c; sinA[t * 16 + fi] = s; } else { cosI[t * 8 + fi] = c; sinI[t * 8 + fi] = s; } } }
}

__device__ __forceinline__ void reduce_rstd(const Frame& F) {
    const float* part = (const float*)(F.ws + WS_PART); float* rstd = (float*)(F.ws + WS_RSTD);
    for (int r4 = F.gw; r4 < SEQ / 4; r4 += F.NGW) { const int row = r4 * 4 + (F.lane >> 4); const f32x4 p = *(const f32x4*)(part + (size_t)row * 64 + (F.lane & 15) * 4);
        float s = (p[0] + p[1]) + (p[2] + p[3]); s += shx(s, 1, F.lane); s += shx(s, 2, F.lane); s += shx(s, 4, F.lane); s += shx(s, 8, F.lane);
        if ((F.lane & 15) == 0) rstd[row] = 1.0f / sqrtf(s * (1.0f / DM) + NORM_EPS); }
}
__device__ __forceinline__ void rmsnorm_to_bf16(const Frame& F, const float* src, const float* g, bf16* dst) {
    for (int row = F.gw; row < SEQ; row += F.NGW) {
        const f32x4* xr = (const f32x4*)(src + (size_t)row * DM) + F.lane; f32x4 v[16]; float ss = 0.f;
#pragma unroll
        for (int j = 0; j < 16; ++j) { v[j] = xr[64 * j]; ss += (v[j][0] * v[j][0] + v[j][1] * v[j][1]) + (v[j][2] * v[j][2] + v[j][3] * v[j][3]); }
        const float rs = 1.0f / sqrtf(wave_sum(ss, F.lane) * (1.0f / DM) + NORM_EPS);
        u32x2* o = (u32x2*)(dst + (size_t)row * DM) + F.lane;
#pragma unroll
        for (int j = 0; j < 16; ++j) { const f32x4 gv = ((const f32x4*)g)[F.lane + 64 * j]; u32x2 w; w.x = pk2(v[j][0] * rs * gv[0], v[j][1] * rs * gv[1]); w.y = pk2(v[j][2] * rs * gv[2], v[j][3] * rs * gv[3]); o[64 * j] = w; }
    }
}
__device__ __forceinline__ void rmsnorm_b2f(const Frame& F, const bf16* src, const float* g, float* dst) {
    for (int row = F.gw; row < SEQ; row += F.NGW) {
        const u32x4* xr = (const u32x4*)(src + (size_t)row * DM) + F.lane; float v[8][8]; float ss = 0.f;
#pragma unroll
        for (int j = 0; j < 8; ++j) { unpack8(xr[64 * j], v[j]);
#pragma unroll
            for (int q = 0; q < 8; ++q) ss += v[j][q] * v[j][q]; }
        const float rs = 1.0f / sqrtf(wave_sum(ss, F.lane) * (1.0f / DM) + NORM_EPS);
#pragma unroll
        for (int j = 0; j < 8; ++j) { const int c0 = (F.lane + 64 * j) * 8; const f32x4 g0 = *(const f32x4*)(g + c0), g1 = *(const f32x4*)(g + c0 + 4); f32x4 o0, o1;
#pragma unroll
            for (int q = 0; q < 4; ++q) { o0[q] = v[j][q] * rs * g0[q]; o1[q] = v[j][4 + q] * rs * g1[q]; }
            *(f32x4*)(dst + (size_t)row * DM + c0) = o0; *(f32x4*)(dst + (size_t)row * DM + c0 + 4) = o1; }
    }
}
__device__ __forceinline__ void rmsnorm_to_f32(const Frame& F, const float* src, const float* g, float* dst) {
    for (int row = F.gw; row < SEQ; row += F.NGW) {
        const f32x4* xr = (const f32x4*)(src + (size_t)row * DM) + F.lane; f32x4 v[16]; float ss = 0.f;
#pragma unroll
        for (int j = 0; j < 16; ++j) { v[j] = xr[64 * j]; ss += (v[j][0] * v[j][0] + v[j][1] * v[j][1]) + (v[j][2] * v[j][2] + v[j][3] * v[j][3]); }
        const float rs = 1.0f / sqrtf(wave_sum(ss, F.lane) * (1.0f / DM) + NORM_EPS);
        f32x4* o = (f32x4*)(dst + (size_t)row * DM) + F.lane;
#pragma unroll
        for (int j = 0; j < 16; ++j) { const f32x4 gv = ((const f32x4*)g)[F.lane + 64 * j]; f32x4 w; w[0] = v[j][0] * rs * gv[0]; w[1] = v[j][1] * rs * gv[1]; w[2] = v[j][2] * rs * gv[2]; w[3] = v[j][3] * rs * gv[3]; o[64 * j] = w; }
    }
}


__device__ __forceinline__ void p3_prep(const Frame& F, const float* wq, const float* wk, const float* b_ig, const float* b_fg, const float* wu, const float* bu) {
    const bf16* __restrict__ z = (const bf16*)(F.ws + WS_Z);
    const float* cosA = (const float*)(F.ws + WS_ROPE); const float* sinA = cosA + (size_t)SEQ * 16; const float* cosI = sinA + (size_t)SEQ * 16; const float* sinI = cosI + (size_t)SEQ * 8;
    const int gt = blockIdx.x * NTHR + F.tid, GT = F.G * NTHR;
#ifndef P3MASK
#define P3MASK 0
#endif
#define P3REP(k) for (int rep3_ = 0; rep3_ < (((P3MASK >> (k)) & 1) ? 2 : 1); ++rep3_)
    P3REP(1) { bf16* __restrict__ qk = (bf16*)(F.ws + WS_QA);
#pragma unroll 4
      for (int i = gt; i < 2 * 8 * SEQ; i += GT) { const int t = i & (SEQ - 1); bf16* p = qk + (size_t)i * 128;
          const u32x4 w0 = *(const u32x4*)p, w1 = *(const u32x4*)(p + 8), w2 = *(const u32x4*)(p + 16), w3 = *(const u32x4*)(p + 24);
          float x1[16], x2[16], o1[16], o2[16]; { float a[8]; unpack8(w0, a); for (int j = 0; j < 8; ++j) x1[j] = a[j]; unpack8(w1, a); for (int j = 0; j < 8; ++j) x1[8 + j] = a[j]; unpack8(w2, a); for (int j = 0; j < 8; ++j) x2[j] = a[j]; unpack8(w3, a); for (int j = 0; j < 8; ++j) x2[8 + j] = a[j]; }
          const float* cp = cosA + (size_t)t * 16; const float* sp = sinA + (size_t)t * 16;
#pragma unroll
          for (int j = 0; j < 16; ++j) { const float cc = cp[j], ss = sp[j]; o1[j] = x1[j] * cc - x2[j] * ss; o2[j] = x2[j] * cc + x1[j] * ss; }
          { float a[8]; for (int j = 0; j < 8; ++j) a[j] = o1[j]; *(u32x4*)p = pack8f(a); for (int j = 0; j < 8; ++j) a[j] = o1[8 + j]; *(u32x4*)(p + 8) = pack8f(a); for (int j = 0; j < 8; ++j) a[j] = o2[j]; *(u32x4*)(p + 16) = pack8f(a); for (int j = 0; j < 8; ++j) a[j] = o2[8 + j]; *(u32x4*)(p + 24) = pack8f(a); } } }
    P3REP(2) { bf16* __restrict__ iq = (bf16*)(F.ws + WS_IQ); bf16* __restrict__ ik = (bf16*)(F.ws + WS_IK); bf16* __restrict__ qt = (bf16*)(F.ws + WS_QT);
      for (int i = gt; i < SEQ * 8; i += GT) { const int t = i >> 3, c8 = i & 7;
          const float* cp = cosI + (size_t)t * 8; const float* sp = sinI + (size_t)t * 8;
          if (c8 == 1) { bf16* p = ik + (size_t)t * 64;
              float a[8], b[8], oa[8], ob[8]; unpack8(*(const u32x4*)p, a); unpack8(*(const u32x4*)(p + 8), b);
#pragma unroll
              for (int j = 0; j < 8; ++j) { const float cc = cp[j], ss = sp[j]; oa[j] = a[j] * cc - b[j] * ss; ob[j] = b[j] * cc + a[j] * ss; }
              *(u32x4*)p = pack8f(oa); *(u32x4*)(p + 8) = pack8f(ob);
          } else {
              float wv[16]; { const bf16* wp = z + (size_t)t * ZW + ZIW; float wa[8], wb[8]; unpack8(*(const u32x4*)wp, wa); unpack8(*(const u32x4*)(wp + 8), wb);
#pragma unroll
                for (int h = 0; h < 8; ++h) { wv[h] = wa[h]; wv[8 + h] = wb[h]; } }
              bf16* qo = qt + (size_t)t * 128;
              if (c8 == 0) { float sa[8], sb[8], cc[8], ss[8];
#pragma unroll
                  for (int j = 0; j < 8; ++j) { sa[j] = 0.f; sb[j] = 0.f; cc[j] = cp[j]; ss[j] = sp[j]; }
#pragma unroll
                  for (int h = 0; h < 16; ++h) { bf16* p = iq + ((size_t)t * 16 + h) * 64;
                      float a[8], b[8], oa[8], ob[8]; unpack8(*(const u32x4*)p, a); unpack8(*(const u32x4*)(p + 8), b);
#pragma unroll
                      for (int j = 0; j < 8; ++j) { oa[j] = a[j] * cc[j] - b[j] * ss[j]; ob[j] = b[j] * cc[j] + a[j] * ss[j]; }
                      const u32x4 pa = pack8f(oa), pb = pack8f(ob); *(u32x4*)p = pa; *(u32x4*)(p + 8) = pb; unpack8(pa, oa); unpack8(pb, ob);
#pragma unroll
                      for (int j = 0; j < 8; ++j) { sa[j] += wv[h] * oa[j]; sb[j] += wv[h] * ob[j]; } }
                  { const u32x4 hi = pack8f(sa); float r[8]; unpack8(hi, r);
#pragma unroll
                    for (int j = 0; j < 8; ++j) r[j] = sa[j] - r[j];
                    *(u32x4*)qo = hi; *(u32x4*)(qo + 64) = pack8f(r); }
                  { const u32x4 hi = pack8f(sb); float r[8]; unpack8(hi, r);
#pragma unroll
                    for (int j = 0; j < 8; ++j) r[j] = sb[j] - r[j];
                    *(u32x4*)(qo + 8) = hi; *(u32x4*)(qo + 72) = pack8f(r); }
              } else { float s8[8];
#pragma unroll
                  for (int j = 0; j < 8; ++j) s8[j] = 0.f;
#pragma unroll
                  for (int h = 0; h < 16; ++h) { float a[8]; unpack8(*(const u32x4*)(iq + ((size_t)t * 16 + h) * 64 + c8 * 8), a);
#pragma unroll
                      for (int j = 0; j < 8; ++j) s8[j] += wv[h] * a[j]; }
                  const u32x4 hi = pack8f(s8); float r[8]; unpack8(hi, r);
#pragma unroll
                  for (int j = 0; j < 8; ++j) r[j] = s8[j] - r[j];
                  *(u32x4*)(qo + c8 * 8) = hi; *(u32x4*)(qo + 64 + c8 * 8) = pack8f(r); } } } }
    P3REP(3) { bf16* __restrict__ cq = (bf16*)(F.ws + WS_CQ); bf16* __restrict__ ck = (bf16*)(F.ws + WS_CK);
      constexpr int PER = SEQ * 96;
#pragma unroll 4
      for (int i = gt; i < 2 * PER; i += GT) {
          const int which = i / PER, r = i - which * PER, c8 = r % 96, t = r / 96;
          const float* w = (which ? wk : wq) + c8 * 8; const int zc = (which ? ZK_C : ZQ_C) + c8 * 8; float acc[8];
#pragma unroll
          for (int j = 0; j < 8; ++j) acc[j] = 0.f;
#pragma unroll
          for (int tap = 0; tap < 4; ++tap) { const int ts = t - 3 + tap; if (ts >= 0) { float xv[8]; unpack8(*(const u32x4*)(z + (size_t)ts * ZW + zc), xv); const f32x4 w0 = *(const f32x4*)(w + tap * 768), w1 = *(const f32x4*)(w + tap * 768 + 4);
#pragma unroll
              for (int j = 0; j < 4; ++j) { acc[j] += xv[j] * w0[j]; acc[4 + j] += xv[4 + j] * w1[j]; } } }
          const float sc = which ? 1.0f : 0.08838834764831845f;
#pragma unroll
          for (int j = 0; j < 8; ++j) acc[j] = siluf_(acc[j]) * sc;
          *(u32x4*)((which ? ck : cq) + (size_t)t * 768 + c8 * 8) = pack8f(acc); } }
    P3REP(4) { float* mg = (float*)(F.ws + WS_MG);
      for (int u = F.gw; u < NCH * 6; u += F.NGW) { const int c = u / 6, h = u % 6, t = c * 64 + F.lane; const float bi = b_ig[h], bfg = b_fg[h];
          const float ci = bf2f(z[(size_t)t * ZW + ZIF + h]), cf = bf2f(z[(size_t)t * ZW + ZIF + 6 + h]);
          float v = log_sigmoidf(cf + bfg);
#pragma unroll
          for (int o = 1; o < 64; o <<= 1) { const float nb = shup(v, o, F.lane); if (F.lane >= o) v += nb; }
          mg[MG_B + (size_t)t * 8 + h] = v; mg[MG_I + (size_t)t * 8 + h] = ci + bi; } }
    P3REP(5) { float* bA = (float*)(F.ws + WS_BA); LAS float* al = (LAS float*)F.lds;
      for (int c = blockIdx.x; c < NCH; c += F.G) {
          __syncthreads();
          if (F.tid < 128) { const int s = F.tid >> 1, hf = F.tid & 1; float a[8]; unpack8(*(const u32x4*)(z + (size_t)(c * 64 + s) * ZW + ZLOW + hf * 8), a);
#pragma unroll
              for (int r = 0; r < 8; ++r) al[s * 16 + hf * 8 + r] = a[r]; }
          __syncthreads();
          for (int n = F.tid; n < 768; n += NTHR) { float wv[16];
#pragma unroll
              for (int r = 0; r < 16; ++r) wv[r] = wu[r * 768 + n];
              const float bb = bu[n]; float bs = 0.f; float* op = bA + (size_t)c * 64 * 768 + (n & ~3);
              const int ql = F.lane & 3;
              for (int s4 = 0; s4 < 64; s4 += 4) { float v[4];
#pragma unroll
                  for (int k = 0; k < 4; ++k) { const int s = s4 + k; const f32x4 a0 = *(const LAS f32x4*)(al + s * 16), a1 = *(const LAS f32x4*)(al + s * 16 + 4), a2 = *(const LAS f32x4*)(al + s * 16 + 8), a3 = *(const LAS f32x4*)(al + s * 16 + 12);
                      float x = bb;
#pragma unroll
                      for (int r = 0; r < 4; ++r) { x += a0[r] * wv[r]; x += a1[r] * wv[4 + r]; x += a2[r] * wv[8 + r]; x += a3[r] * wv[12 + r]; }
                      bs += (fminf(x, 0.f) - __logf(1.0f + __expf(-fabsf(x)))) * (1.0f / 16.0f); v[k] = bs; }
                  { const bool o1 = ql & 1, o2 = ql & 2;
                    const float x0 = o1 ? v[0] : v[1], x1 = o1 ? v[2] : v[3];
                    const float r0 = __int_as_float(__builtin_amdgcn_mov_dpp(__float_as_int(x0), 0xB1, 0xf, 0xf, false)), r1 = __int_as_float(__builtin_amdgcn_mov_dpp(__float_as_int(x1), 0xB1, 0xf, 0xf, false));
                    const float u0 = o1 ? r0 : v[0], u1 = o1 ? v[1] : r0, u2 = o1 ? r1 : v[2], u3 = o1 ? v[3] : r1;
                    const float y0 = o2 ? u0 : u2, y1 = o2 ? u1 : u3;
                    const float q0 = __int_as_float(__builtin_amdgcn_mov_dpp(__float_as_int(y0), 0x4E, 0xf, 0xf, false)), q1 = __int_as_float(__builtin_amdgcn_mov_dpp(__float_as_int(y1), 0x4E, 0xf, 0xf, false));
                    const f32x4 w = {o2 ? q0 : u0, o2 ? q1 : u1, o2 ? u2 : q0, o2 ? u3 : q1};
                    *(f32x4*)(op + (size_t)(s4 + ql) * 768) = w; } } } }
    }
}

__device__ __forceinline__ f32x16 mfma32(bf16x8 a, bf16x8 b, f32x16 c) { return __builtin_amdgcn_mfma_f32_32x32x16_bf16(a, b, c, 0, 0, 0); }
__device__ __forceinline__ f32x4 mfma16(bf16x8 a, bf16x8 b, f32x4 c) { return __builtin_amdgcn_mfma_f32_16x16x32_bf16(a, b, c, 0, 0, 0); }
__device__ __forceinline__ f32x16 zero16() { f32x16 z;
#pragma unroll
    for (int i = 0; i < 16; ++i) z[i] = 0.f;
    return z; }

__device__ __forceinline__ void p4_index_scores(const Frame& F) {
    const bf16* iq = (const bf16*)(F.ws + WS_IQ); const bf16* ik = (const bf16*)(F.ws + WS_IK); const bf16* zw = (const bf16*)(F.ws + WS_Z) + ZIW; _Float16* sc = (_Float16*)(F.ws + WS_SCORE);
    const int l15 = F.lane & 15, lq = F.lane >> 4;
    constexpr int NITEMS = 2112;
#define IDX_STAGE(j_, buf_) do { const int ln_ = hw_lane(); \
        _Pragma("unroll") for (int i_ = 0; i_ < 8; ++i_) { const int ci_ = i_ * 8 + F.wave, r_ = ci_ * 8 + (ln_ >> 3), c_ = (ln_ & 7) ^ ((r_ >> 1) & 7); \
            __builtin_amdgcn_global_load_lds((const unsigned*)(ik + (size_t)(512 * (j_) + r_) * 64 + c_ * 8), (LAS unsigned*)(F.lds + (buf_) * 65536 + ci_ * 1024), 16, 0, 0); } } while (0)
#define IDX_ADV(q_, d_, j_) do { if (++j_ > q_) { j_ = 0; if (++d_ == 4) { d_ = 0; ++q_; } } } while (0)
    const int i_beg = (int)(((long)blockIdx.x * NITEMS) / F.G), i_end = (int)(((long)(blockIdx.x + 1) * NITEMS) / F.G);
    int q4 = 0, d4 = 0, j = 0; { int r = i_beg; while (r >= 4 * (q4 + 1)) { r -= 4 * (q4 + 1); ++q4; } d4 = (r >= q4 + 1) + (r >= 2 * (q4 + 1)) + (r >= 3 * (q4 + 1)); j = r - d4 * (q4 + 1); }
    int par = 0; bool fresh = true;
    bf16x8 bq[16][2]; float w[16]; bf16x8 bt[4];
    if (i_beg < i_end) IDX_STAGE(j, 0);
    for (int bi = i_beg; bi < i_end; ++bi, par ^= 1) {
        const int g = 8 * (4 * q4 + d4) + F.wave, t0 = 16 * g, s0 = 512 * j;
        int s_end = s0 + 512; if (s_end > t0 + 16) s_end = t0 + 16;
        if (fresh) {
            const bf16* qp = iq + (size_t)(t0 + l15) * 1024 + 8 * lq;
#pragma unroll
            for (int h = 0; h < 16; ++h) { bq[h][0] = *(const bf16x8*)(qp + h * 64); bq[h][1] = *(const bf16x8*)(qp + h * 64 + 32); }
            { const bf16* wp = zw + (size_t)(t0 + l15) * ZW; float wa[8], wb[8]; unpack8(*(const u32x4*)wp, wa); unpack8(*(const u32x4*)(wp + 8), wb);
#pragma unroll
              for (int h = 0; h < 8; ++h) { w[h] = wa[h]; w[8 + h] = wb[h]; } }
            { const bf16* tp = (const bf16*)(F.ws + WS_QT) + (size_t)(t0 + l15) * 128 + 8 * lq; bt[0] = *(const bf16x8*)tp; bt[1] = *(const bf16x8*)(tp + 32); bt[2] = *(const bf16x8*)(tp + 64); bt[3] = *(const bf16x8*)(tp + 96); }
            VM_WAIT();
        } else asm volatile("s_waitcnt vmcnt(32)" ::: "memory");
        asm volatile("s_waitcnt lgkmcnt(0)" ::: "memory"); __builtin_amdgcn_s_barrier();
        int qn = q4, dn = d4, jn = j; IDX_ADV(qn, dn, jn);
        if (bi + 1 < i_end) IDX_STAGE(jn, par ^ 1);
        fresh = jn == 0;
        _Float16* orow = sc + (size_t)(t0 + l15) * SEQ + 4 * lq;
        const LAS unsigned char* kp0 = F.lds + par * 65536 + l15 * 128 + ((lq ^ (l15 >> 1)) << 4);
        const LAS unsigned char* kp1 = F.lds + par * 65536 + l15 * 128 + (((lq + 4) ^ (l15 >> 1)) << 4);
        for (int s = s0; s < s_end; s += 16) {
            const bf16x8 a0 = *(const LAS bf16x8*)kp0, a1 = *(const LAS bf16x8*)kp1; kp0 += 2048; kp1 += 2048;
            __builtin_amdgcn_s_setprio(1);
            f32x4 tot = mfma16(a0, bt[0], (f32x4){0.f, 0.f, 0.f, 0.f});
#pragma unroll
            for (int hh = 0; hh < 16; hh += 8) { f32x4 acc[8];
                __builtin_amdgcn_s_setprio(1);
#pragma unroll
                for (int h = 0; h < 8; ++h) acc[h] = mfma16(a0, bq[hh + h][0], (f32x4){0.f, 0.f, 0.f, 0.f});
                if (hh == 0) { tot = mfma16(a1, bt[1], tot); tot = mfma16(a0, bt[2], tot); }
#pragma unroll
                for (int h = 0; h < 8; ++h) acc[h] = mfma16(a1, bq[hh + h][1], acc[h]);
                if (hh == 0) tot = mfma16(a1, bt[3], tot);
                __builtin_amdgcn_s_setprio(0);
                __builtin_amdgcn_sched_barrier(0);
                asm volatile("s_nop 15");
#pragma unroll
                for (int h = 0; h < 8; ++h) {
#pragma unroll
                    for (int r = 0; r < 4; ++r) asm volatile("v_fma_f32 %0, %1, |%2|, %0" : "+v"(tot[r]) : "v"(w[hh + h]), "v"(acc[h][r])); } }
            { typedef _Float16 h16x4 __attribute__((ext_vector_type(4))); h16x4 hv; hv[0] = (_Float16)tot[0]; hv[1] = (_Float16)tot[1]; hv[2] = (_Float16)tot[2]; hv[3] = (_Float16)tot[3]; *(h16x4*)(orow + s) = hv; }
        }
        q4 = qn; d4 = dn; j = jn;
    }
#undef IDX_STAGE
#undef IDX_ADV
}

#define DST_STORE2(ptr_, acc_, g_) do { unsigned ax_ = pk2(acc_[4 * (g_)], acc_[4 * (g_) + 1]), ay_ = pk2(acc_[4 * (g_) + 2], acc_[4 * (g_) + 3]), bx_ = pk2(acc_[4 * (g_) + 4], acc_[4 * (g_) + 5]), by_ = pk2(acc_[4 * (g_) + 6], acc_[4 * (g_) + 7]); \
        const auto rx_ = __builtin_amdgcn_permlane32_swap(ax_, bx_, false, false); const auto ry_ = __builtin_amdgcn_permlane32_swap(ay_, by_, false, false); \
        *(u32x4*)((ptr_) + 8 * ((g_) + hi)) = (u32x4){(unsigned)rx_[0], (unsigned)ry_[0], (unsigned)rx_[1], (unsigned)ry_[1]}; } while (0)
__device__ __forceinline__ void p4_gla_local(const Frame& F) {
    const bf16* z = (const bf16*)(F.ws + WS_Z); const float* bA = (const float*)(F.ws + WS_BA); bf16* dS = (bf16*)(F.ws + WS_DS);
    LAS bf16* vT = (LAS bf16*)F.lds;
    LAS bf16* kT = vT + 128 * 72;
    const int r32 = F.lane & 31, hi = F.lane >> 5, s = F.tid >> 3, d8 = (F.tid & 7) * 8, e16 = (F.tid & 7) * 16;
    u32x4 kw, vw0, vw1; f32x4 b0, b1, e0, e1;
#define GLA_LOAD(u_) do { const int c_ = (u_) / 12, h_ = (u_) % 12, t0_ = c_ * 64; kw = *(const u32x4*)(z + (size_t)(t0_ + s) * ZW + ZK_A + h_ * 64 + d8); \
        const float* bp_ = bA + (size_t)(t0_ + s) * 768 + h_ * 64 + d8; const float* be_ = bA + (size_t)(t0_ + 63) * 768 + h_ * 64 + d8; \
        b0 = *(const f32x4*)bp_; b1 = *(const f32x4*)(bp_ + 4); e0 = *(const f32x4*)be_; e1 = *(const f32x4*)(be_ + 4); \
        const bf16* vp_ = z + (size_t)(t0_ + s) * ZW + ZV_A + h_ * 128 + e16; vw0 = *(const u32x4*)vp_; vw1 = *(const u32x4*)(vp_ + 8); } while (0)
    int u = blockIdx.x; if (u < NCH * 12) GLA_LOAD(u);
    for (; u < NCH * 12; u += F.G) {
        __syncthreads();
        { float kv[8]; unpack8(kw, kv);
#pragma unroll
          for (int j = 0; j < 4; ++j) { kT[TPOS(d8 + j, s, 3)] = f2bf(kv[j] * __expf(e0[j] - b0[j])); kT[TPOS(d8 + 4 + j, s, 3)] = f2bf(kv[4 + j] * __expf(e1[j] - b1[j])); }
          const unsigned ww[8] = {vw0.x, vw0.y, vw0.z, vw0.w, vw1.x, vw1.y, vw1.z, vw1.w};
#pragma unroll
          for (int j = 0; j < 8; ++j) { vT[TPOS(e16 + 2 * j, s, 4)] = (bf16)(ww[j] & 0xffffu); vT[TPOS(e16 + 2 * j + 1, s, 4)] = (bf16)(ww[j] >> 16); } }
        __syncthreads();
        if (u + F.G < NCH * 12) GLA_LOAD(u + F.G);
        const int et = F.wave >> 1, dt = F.wave & 1; f32x16 acc = zero16();
#pragma unroll
        for (int kk = 0; kk < 4; ++kk) { const bf16x8 a = *(const LAS bf16x8*)(kT + TRD(32 * dt + r32, 2 * kk + hi, 3)), b = *(const LAS bf16x8*)(vT + TRD(32 * et + r32, 2 * kk + hi, 4)); acc = mfma32(a, b, acc); }
        bf16* o = dS + ((size_t)u * 128 + 32 * et + r32) * 64 + 32 * dt;
        DST_STORE2(o, acc, 0); DST_STORE2(o, acc, 2);
    }
#undef GLA_LOAD
}

__device__ __forceinline__ void p4_mlstm_local(const Frame& F) {
    const bf16* z = (const bf16*)(F.ws + WS_Z); const bf16* ck = (const bf16*)(F.ws + WS_CK); float* mg = (float*)(F.ws + WS_MG); bf16* dC = (bf16*)(F.ws + WS_DC);
    LAS bf16* vT = (LAS bf16*)F.lds;
    LAS bf16* kT = vT + 256 * 72;
    LAS float* wsl = (LAS float*)(kT + 128 * 72);
    const int r32 = F.lane & 31, hi = F.lane >> 5, s = F.tid >> 3, d16 = (F.tid & 7) * 16, e32 = (F.tid & 7) * 32;
    u32x4 kw0, kw1, vw[4]; float gbs = 0.f, gig = 0.f;
#define ML_LOAD(u_) do { const int c_ = (u_) / 6, h_ = (u_) % 6, t0_ = c_ * 64; const bf16* kp_ = ck + (size_t)(t0_ + s) * 768 + h_ * 128 + d16; kw0 = *(const u32x4*)kp_; kw1 = *(const u32x4*)(kp_ + 8); \
        const bf16* vp_ = z + (size_t)(t0_ + s) * ZW + ZV_C + h_ * 256 + e32; _Pragma("unroll") for (int q_ = 0; q_ < 4; ++q_) vw[q_] = *(const u32x4*)(vp_ + 8 * q_); \
        if (F.wave == 0) { gbs = mg[MG_B + (size_t)(t0_ + F.lane) * 8 + h_]; gig = mg[MG_I + (size_t)(t0_ + F.lane) * 8 + h_]; } } while (0)
    const bool bal = F.G == 256, heavy = ((int)blockIdx.x & 3) == 3; const int nun = bal ? (heavy ? 3 : 7) : (NCH * 6 - (int)blockIdx.x + F.G - 1) / F.G;
#define ML_UNIT(k_) (bal ? ((k_) < 3 ? 256 * (k_) + (int)blockIdx.x : 768 + 192 * ((k_) - 3) + (int)blockIdx.x - ((int)blockIdx.x >> 2)) : (int)blockIdx.x + (k_) * F.G)
    int u = ML_UNIT(0); if (nun > 0) ML_LOAD(u);
    for (int ku = 0; ku < nun; ++ku, u = ML_UNIT(ku)) {
        __syncthreads();
        if (F.wave == 0) { const float be = __int_as_float(__builtin_amdgcn_readlane(__float_as_int(gbs), 63));
            const float a = be - gbs + gig; const float ml = wave_max(a, F.lane); wsl[F.lane] = __expf(a - ml); if (F.lane == 0) { mg[MG_ML + (size_t)u * 2] = be; mg[MG_ML + (size_t)u * 2 + 1] = ml; } }
        __syncthreads();
        { const float wsv = wsl[s]; float k0[8], k1[8]; unpack8(kw0, k0); unpack8(kw1, k1);
#pragma unroll
          for (int j = 0; j < 8; ++j) { kT[TPOS(d16 + j, s, 4)] = f2bf(k0[j] * wsv); kT[TPOS(d16 + 8 + j, s, 4)] = f2bf(k1[j] * wsv); }
#pragma unroll
          for (int q = 0; q < 4; ++q) { const unsigned ww[4] = {vw[q].x, vw[q].y, vw[q].z, vw[q].w};
#pragma unroll
              for (int j = 0; j < 4; ++j) { vT[TPOS(e32 + 8 * q + 2 * j, s, 5)] = (bf16)(ww[j] & 0xffffu); vT[TPOS(e32 + 8 * q + 2 * j + 1, s, 5)] = (bf16)(ww[j] >> 16); } } }
        __syncthreads();
        if (ku + 1 < nun) ML_LOAD(ML_UNIT(ku + 1));
        if (F.tid < 128) { float sum = 0.f; const LAS bf16* kr = kT + F.tid * 72;
#pragma unroll 8
            for (int ss = 0; ss < 64; ++ss) sum += bf2f(kr[ss]);
            mg[MG_DN + (size_t)u * 128 + F.tid] = sum; }
        const int et = F.wave; bf16x8 bv[4];
#pragma unroll
        for (int kk = 0; kk < 4; ++kk) bv[kk] = *(const LAS bf16x8*)(vT + TRD(32 * et + r32, 2 * kk + hi, 5));
        bf16* o = dC + ((size_t)u * 256 + 32 * et + r32) * 128;
#pragma unroll
        for (int dt = 0; dt < 4; ++dt) { f32x16 acc = zero16();
#pragma unroll
            for (int kk = 0; kk < 4; ++kk) { const bf16x8 a = *(const LAS bf16x8*)(kT + TRD(32 * dt + r32, 2 * kk + hi, 4)); acc = mfma32(a, bv[kk], acc); }
            DST_STORE2(o + 32 * dt, acc, 0); DST_STORE2(o + 32 * dt, acc, 2); }
    }
#undef ML_LOAD
#undef ML_UNIT
}

__device__ __forceinline__ void p5_scans(const Frame& F) {
    const float* bA = (const float*)(F.ws + WS_BA); const bf16* dS = (const bf16*)(F.ws + WS_DS); bf16* SP = (bf16*)(F.ws + WS_SP);
    float* mg = (float*)(F.ws + WS_MG); const bf16* dC = (const bf16*)(F.ws + WS_DC); bf16* CP = (bf16*)(F.ws + WS_CP);
    for (int grp = blockIdx.x + F.G * F.wave; grp < 579; grp += F.G * 8) {
        const int l = F.lane;
        if (grp < 192) {
            constexpr int SB = 4;
            const int i = grp * 64 + l, h = i >> 10, rem = i & 1023, e = rem >> 3, d8 = (rem & 7) * 8;
            float S[8];
#pragma unroll
            for (int q = 0; q < 8; ++q) S[q] = 0.f;
            u32x4 dlA[SB], dlB[SB]; f32x4 dcA[SB][2], dcB[SB][2];
#define G_LOAD(DL, DC, c0_) do { _Pragma("unroll") for (int k = 0; k < SB; ++k) { const int c = (c0_) + k; DL[k] = *(const u32x4*)(dS + ((size_t)(c * 12 + h) * 128 + e) * 64 + d8); \
                const float* cp_ = bA + (size_t)(c * 64 + 63) * 768 + h * 64 + d8; DC[k][0] = *(const f32x4*)cp_; DC[k][1] = *(const f32x4*)(cp_ + 4); } } while (0)
#define G_STEP(DL, DC, c0_) do { _Pragma("unroll") for (int k = 0; k < SB; ++k) { const int c = (c0_) + k; *(u32x4*)(SP + ((size_t)(c * 12 + h) * 128 + e) * 64 + d8) = pack8f(S); float dv_[8]; unpack8(DL[k], dv_); \
                _Pragma("unroll") for (int q = 0; q < 8; ++q) S[q] = __expf(DC[k][q >> 2][q & 3]) * S[q] + dv_[q]; } } while (0)
            G_LOAD(dlA, dcA, 0);
            for (int c0 = 0; c0 < NCH; c0 += 2 * SB) {
                G_LOAD(dlB, dcB, c0 + SB); G_STEP(dlA, dcA, c0);
                if (c0 + 2 * SB < NCH) G_LOAD(dlA, dcA, c0 + 2 * SB);
                G_STEP(dlB, dcB, c0 + SB); }
#undef G_LOAD
#undef G_STEP
        } else if (grp < 576) {
            constexpr int SB = 8;
            const int i = (grp - 192) * 64 + l, h = i >> 12, rem = i & 4095, e = rem >> 4, d8 = (rem & 15) * 8;
            float S[8]; float m = 0.f;
#pragma unroll
            for (int q = 0; q < 8; ++q) S[q] = 0.f;
            u32x4 dlA[SB], dlB[SB]; f32x2 mlA[SB], mlB[SB];
#define M_LOAD(DL, ML, c0_) do { _Pragma("unroll") for (int k = 0; k < SB; ++k) { const int c = (c0_) + k; ML[k] = *(const f32x2*)(mg + MG_ML + (size_t)(c * 6 + h) * 2); \
                DL[k] = *(const u32x4*)(dC + ((size_t)(c * 6 + h) * 256 + e) * 128 + d8); } } while (0)
#define M_STEP(DL, ML, c0_) do { _Pragma("unroll") for (int k = 0; k < SB; ++k) { const int c = (c0_) + k; \
                *(u32x4*)(CP + ((size_t)(c * 6 + h) * 256 + e) * 128 + d8) = pack8f(S); float dv_[8]; unpack8(DL[k], dv_); \
                const float a_state = ML[k][0] + m, m_new = fmaxf(a_state, ML[k][1]), f1 = __expf(a_state - m_new), f2 = __expf(ML[k][1] - m_new); \
                _Pragma("unroll") for (int q = 0; q < 8; ++q) S[q] = f1 * S[q] + f2 * dv_[q]; \
                m = m_new; } } while (0)
            M_LOAD(dlA, mlA, 0);
            for (int c0 = 0; c0 < NCH; c0 += 2 * SB) {
                M_LOAD(dlB, mlB, c0 + SB); M_STEP(dlA, mlA, c0);
                if (c0 + 2 * SB < NCH) M_LOAD(dlA, mlA, c0 + 2 * SB);
                M_STEP(dlB, mlB, c0 + SB); }
#undef M_LOAD
#undef M_STEP
        } else {
            constexpr int SB = 8;
            const int ii = (grp - 576) * 64 + l, h = ii >> 5, d4 = (ii & 31) * 4;
            f32x4 S = {0.f, 0.f, 0.f, 0.f}; float m = 0.f;
            for (int c0 = 0; c0 < NCH; c0 += SB) { f32x4 dl[SB]; f32x2 ml[SB];
#pragma unroll
                for (int k = 0; k < SB; ++k) { const int c = c0 + k; ml[k] = *(const f32x2*)(mg + MG_ML + (size_t)(c * 6 + h) * 2); dl[k] = *(const f32x4*)(mg + MG_DN + (size_t)(c * 6 + h) * 128 + d4); }
#pragma unroll
                for (int k = 0; k < SB; ++k) { const int c = c0 + k;
                    *(f32x4*)(mg + MG_NP + (size_t)(c * 6 + h) * 128 + d4) = S; if (d4 == 0) mg[MG_MP + (size_t)(c * 6 + h)] = m;
                    const float a_state = ml[k][0] + m, m_new = fmaxf(a_state, ml[k][1]), f1 = __expf(a_state - m_new), f2 = __expf(ml[k][1] - m_new);
#pragma unroll
                    for (int q = 0; q < 4; ++q) S[q] = f1 * S[q] + f2 * dl[k][q];
                    m = m_new; } }
        }
    }
}

__device__ __forceinline__ unsigned long long perm_word(unsigned long long x) {
    unsigned long long t;
    t = ((x >> 4) ^ x) & 0x00F000F000F000F0ull; x ^= t ^ (t << 4);
    t = ((x >> 8) ^ x) & 0x0000FF000000FF00ull; x ^= t ^ (t << 8);
    t = ((x >> 16) ^ x) & 0x00000000FFFF0000ull; x ^= t ^ (t << 16);
    return x;
}
__device__ __forceinline__ void p5_select(const Frame& F, unsigned* ctr) {
    const _Float16* sc = (const _Float16*)(F.ws + WS_SCORE); unsigned long long* mask = (unsigned long long*)(F.ws + WS_MASK);
    LAS unsigned char* wl = F.lds + F.wave * 12304;
    LAS unsigned* hist = (LAS unsigned*)wl;
    LAS unsigned* words = (LAS unsigned*)(wl + 8192);
    LAS float* cval = (LAS float*)(wl + 8192 + 2048);
    LAS int* ckey = (LAS int*)(wl + 8192 + 3072);
    const float PINF = __builtin_inff();
    constexpr int SEL_DYN0 = 12288;
    int t = F.gw; unsigned nq_ = 0u;
    for (;;) {
        int lane = F.lane; asm volatile("" : "+v"(lane));
        if (t >= SEL_DYN0 - F.NGW) { if (lane == 0) nq_ = __hip_atomic_fetch_add(ctr, 1u, __ATOMIC_RELAXED, __HIP_MEMORY_SCOPE_AGENT); }
#define SEL_NEXT() do { if (t < SEL_DYN0 - F.NGW) t += F.NGW; else t = SEL_DYN0 + __builtin_amdgcn_readfirstlane((int)nq_); } while (0)
        if (t >= SEQ) break;
        const unsigned long long lt_mask = (1ull << lane) - 1ull; const int lane8 = lane * 8;
        const int n = t + 1, nw = 4 * (t / 256 + 1), ng = (n + 63) >> 6;
        const _Float16* row = sc + (size_t)t * SEQ; unsigned long long* mrow = mask + (size_t)t * 256;
        if (n <= 256) {
            if (lane < nw) { const int k0 = lane * 64; const unsigned long long w = (t >= k0 + 63) ? ~0ull : (t < k0 ? 0ull : ((2ull << (t - k0)) - 1ull)); mrow[lane] = perm_word(w); }
            SEL_NEXT(); continue; }
        typedef _Float16 h16x8 __attribute__((ext_vector_type(8))); typedef _Float16 h16x2 __attribute__((ext_vector_type(2)));
        const int ng8 = (n + 511) >> 9, glast = ng8 - 1; const h16x8* row8 = (const h16x8*)row + lane;
        u32x4 vv[32];
#pragma unroll
        for (int g = 0; g < 32; ++g) vv[g] = *(const u32x4*)(row8 + (g < ng8 ? g : 0) * 64);
        int nvl = n - 512 * glast - lane8; nvl = nvl < 0 ? 0 : (nvl > 8 ? 8 : nvl); const unsigned vlast = (1u << nvl) - 1u;
#define SEL_FILL(G, FILLPAIR) do { unsigned* d_ = (unsigned*)&vv[G]; _Pragma("unroll") for (int q_ = 0; q_ < 4; ++q_) { \
            const unsigned keep_ = (((vlast >> (2 * q_)) & 1u) ? 0x0000ffffu : 0u) | (((vlast >> (2 * q_ + 1)) & 1u) ? 0xffff0000u : 0u); d_[q_] = (d_[q_] & keep_) | ((FILLPAIR) & ~keep_); } } while (0)
#pragma unroll
        for (int g = 0; g < 32; ++g) if (g == glast) { const unsigned f0 = (unsigned)__builtin_amdgcn_readfirstlane((int)vv[g].x) & 0xffffu; SEL_FILL(g, f0 | (f0 << 16)); }
        h16x2 pmin = {(_Float16)65504.f, (_Float16)65504.f}, pmax = {(_Float16)-65504.f, (_Float16)-65504.f};
#pragma unroll
        for (int g = 0; g < 32; ++g) if (g < ng8) {
#pragma unroll
            for (int q = 0; q < 4; ++q) { const h16x2 x = __builtin_bit_cast(h16x2, ((const unsigned*)&vv[g])[q]); pmin = __builtin_elementwise_min(pmin, x); pmax = __builtin_elementwise_max(pmax, x); } }
        float lmin = fminf((float)pmin[0], (float)pmin[1]), lmax = fmaxf((float)pmax[0], (float)pmax[1]);
        lmin = -wave_max(-lmin, lane); lmax = wave_max(lmax, lane);
        const float span = lmax - lmin, lo = lmin, scale = span > 0.f ? 2047.0f / span : 0.f, los = -lo * scale;
        { const unsigned fm = (unsigned)__builtin_bit_cast(unsigned short, (_Float16)lmin);
#pragma unroll
          for (int g = 0; g < 32; ++g) if (g == glast) SEL_FILL(g, fm | (fm << 16)); }
#undef SEL_FILL
#pragma unroll
        for (int k = 0; k < 8; ++k) *(LAS u32x4*)(hist + (k * 64 + lane) * 4) = (u32x4){0u, 0u, 0u, 0u};
#pragma unroll
        for (int k = 0; k < 2; ++k) *(LAS u32x4*)(words + (k * 64 + lane) * 4) = (u32x4){0u, 0u, 0u, 0u};
#define SEL_BIN(G, J) ({ const h16x2 x_ = __builtin_bit_cast(h16x2, ((const unsigned*)&vv[G])[(J) >> 1]); int b_ = (int)fmaf((float)x_[(J) & 1], scale, los); b_ = b_ < 0 ? 0 : (b_ > 2047 ? 2047 : b_); b_; })
#pragma unroll
        for (int g = 0; g < 32; ++g) asm volatile("" : "+v"(vv[g]));
#pragma unroll
        for (int g = 0; g < 32; ++g) if (g < ng8) {
#pragma unroll
            for (int j = 0; j < 8; ++j) { const int b = SEL_BIN(g, j); __hip_atomic_fetch_add(&hist[b], 1u, __ATOMIC_RELAXED, __HIP_MEMORY_SCOPE_WORKGROUP); } }
        unsigned mine = 0;
#pragma unroll
        for (int q = 0; q < 8; ++q) { const u32x4 x = *(const LAS u32x4*)(hist + lane * 32 + q * 4); mine += (x.x + x.y) + (x.z + x.w); }
        unsigned suf = mine;
#pragma unroll
        for (int o = 1; o < 64; o <<= 1) { const unsigned nb = shdn_u(suf, o, lane); if (lane + o < 64) suf += nb; }
        unsigned above = suf - mine; int Bl = -1; unsigned cal = 0;
        if (above < 256u && above + mine >= 256u) {
            for (int q = 31; q >= 0; --q) { const unsigned hq = hist[lane * 32 + q]; if (Bl < 0 && above + hq >= 256u) { Bl = lane * 32 + q; cal = above; } above += hq; } }
        const unsigned long long hitm = __ballot(Bl >= 0); const int src = hitm ? __builtin_ctzll(hitm) : 0;
        const int Bs = __builtin_amdgcn_readlane(Bl, src); const unsigned cnt_above = (unsigned)__builtin_amdgcn_readlane((int)cal, src);
#pragma unroll
        for (int g = 0; g < 32; ++g) asm volatile("" : "+v"(vv[g]));
        LAS unsigned char* wbytes = (LAS unsigned char*)words; LAS unsigned* mcnt = (LAS unsigned*)(ckey + 256);
        if (lane == 0) *mcnt = 0u;
#pragma unroll
        for (int g = 0; g < 32; ++g) if (g < ng8) { int b[8]; unsigned abits = 0u; bool anyc = false;
#pragma unroll
            for (int j = 7; j >= 0; --j) { b[j] = SEL_BIN(g, j); abits = __builtin_amdgcn_alignbit(abits, (unsigned)(Bs - b[j]), 31); anyc |= (b[j] == Bs); }
            const unsigned vm = (g == glast) ? vlast : 0xffu;
            wbytes[g * 64 + lane] = (unsigned char)(abits & vm);
            if (anyc) {
#pragma unroll
                for (int j = 0; j < 8; ++j) if (b[j] == Bs && ((vm >> j) & 1u)) { const unsigned pos = __hip_atomic_fetch_add(mcnt, 1u, __ATOMIC_RELAXED, __HIP_MEMORY_SCOPE_WORKGROUP);
                    if (pos < 256u) { const h16x2 x = __builtin_bit_cast(h16x2, ((const unsigned*)&vv[g])[j >> 1]); cval[pos] = (float)x[j & 1]; ckey[pos] = lane8 + (g * 512 + j); } } } }
#undef SEL_BIN
        const unsigned m = *mcnt;
        const unsigned need = 256u - cnt_above;
        if (m <= 256u) {
            for (unsigned c = lane; c < m; c += 64) { const float mv = cval[c]; const int mk = ckey[c]; unsigned rank = 0;
                for (unsigned j = 0; j < m; ++j) { const float ov = cval[j]; const int ok = ckey[j]; rank += (ov > mv || (ov == mv && ok < mk)) ? 1u : 0u; }
                if (rank < need) __hip_atomic_fetch_or(&words[2 * (mk >> 6) + ((mk >> 5) & 1)], 1u << (mk & 31), __ATOMIC_RELAXED, __HIP_MEMORY_SCOPE_WORKGROUP); }
        } else {
            for (int g = 0; g < ng; ++g) { const int key = g * 64 + lane; int b = -1; if (key < n) { b = (int)fmaf((float)row[key], scale, los); b = b < 0 ? 0 : (b > 2047 ? 2047 : b); }
                const unsigned long long bc = __ballot(b == Bs); if (lane == 0) { words[2 * g] |= (unsigned)bc; words[2 * g + 1] |= (unsigned)(bc >> 32); } }
        }
#pragma unroll
        for (int k = 0; k < 4; ++k) { const int w = lane + 64 * k; if (w < nw) { const unsigned long long x = (unsigned long long)words[2 * w] | ((unsigned long long)words[2 * w + 1] << 32); mrow[w] = perm_word(x); } }
        SEL_NEXT();
    }
#undef SEL_NEXT
}

__device__ __forceinline__ void p6_gla_out(const Frame& F, const float* gain) {
    const bf16* z = (const bf16*)(F.ws + WS_Z); const float* bA = (const float*)(F.ws + WS_BA); const bf16* SP = (const bf16*)(F.ws + WS_SP); bf16* y = (bf16*)(F.ws + WS_Y);
    LAS bf16* qd = (LAS bf16*)F.lds;
    LAS bf16* ki = qd + 64 * 72;
    LAS bf16* vT = ki + 64 * 72;
    LAS bf16* scl = vT + 128 * 72;
    LAS float* part = (LAS float*)(scl + 64 * 72);
    const int r32 = F.lane & 31, hi = F.lane >> 5, s = F.tid >> 3, d8 = (F.tid & 7) * 8, e16 = (F.tid & 7) * 16;
    u32x4 qw, kw, vw0, vw1; f32x4 b0, b1;
#define GO_LOAD(u_) do { const int c_ = (u_) / 12, h_ = (u_) % 12, t0_ = c_ * 64; const bf16* zr_ = z + (size_t)(t0_ + s) * ZW; qw = *(const u32x4*)(zr_ + ZQ_A + h_ * 64 + d8); kw = *(const u32x4*)(zr_ + ZK_A + h_ * 64 + d8); \
        const float* bp_ = bA + (size_t)(t0_ + s) * 768 + h_ * 64 + d8; b0 = *(const f32x4*)bp_; b1 = *(const f32x4*)(bp_ + 4); vw0 = *(const u32x4*)(zr_ + ZV_A + h_ * 128 + e16); vw1 = *(const u32x4*)(zr_ + ZV_A + h_ * 128 + e16 + 8); } while (0)
    int u = blockIdx.x; if (u < NCH * 12) GO_LOAD(u);
    for (; u < NCH * 12; u += F.G) {
        const int c = u / 12, h = u % 12, t0 = c * 64;
        __syncthreads();
        { float qv[8], kv[8], qo[8], ko[8]; unpack8(qw, qv); unpack8(kw, kv);
#pragma unroll
          for (int j = 0; j < 4; ++j) { const float ea = __expf(b0[j]), eb = __expf(b1[j]); qo[j] = qv[j] * 0.125f * ea; qo[4 + j] = qv[4 + j] * 0.125f * eb; ko[j] = kv[j] / ea; ko[4 + j] = kv[4 + j] / eb; }
          *(LAS u32x4*)(qd + s * 72 + d8) = pack8f(qo); *(LAS u32x4*)(ki + s * 72 + d8) = pack8f(ko);
          const unsigned ww[8] = {vw0.x, vw0.y, vw0.z, vw0.w, vw1.x, vw1.y, vw1.z, vw1.w};
#pragma unroll
          for (int j = 0; j < 8; ++j) { vT[TPOS(e16 + 2 * j, s, 4)] = (bf16)(ww[j] & 0xffffu); vT[TPOS(e16 + 2 * j + 1, s, 4)] = (bf16)(ww[j] >> 16); } }
        __syncthreads();
        if (u + F.G < NCH * 12) GO_LOAD(u + F.G);
        const int et = F.wave >> 1, tt = F.wave & 1, t = 32 * tt + r32;
        bf16x8 sa[4]; u32x4 gzv[2];
        { const bf16* sp = SP + ((size_t)u * 128 + 32 * et + r32) * 64 + 8 * hi;
#pragma unroll
          for (int kk = 0; kk < 4; ++kk) sa[kk] = *(const bf16x8*)(sp + 16 * kk);
#pragma unroll
          for (int gp = 0; gp < 2; ++gp) gzv[gp] = *(const u32x4*)(z + (size_t)(t0 + t) * ZW + ZGATE_A + h * 128 + 32 * et + 8 * (2 * gp + hi)); }
        if (F.wave < 4) { const int st = F.wave >> 1; f32x16 acc = zero16();
#pragma unroll
            for (int kk = 0; kk < 4; ++kk) { const bf16x8 a = *(const LAS bf16x8*)(ki + (32 * st + r32) * 72 + 16 * kk + 8 * hi), b = *(const LAS bf16x8*)(qd + (32 * tt + r32) * 72 + 16 * kk + 8 * hi); acc = mfma32(a, b, acc); }
#pragma unroll
            for (int g = 0; g < 4; ++g) { const int sb = 32 * st + 8 * g + 4 * hi; float m[4];
#pragma unroll
                for (int j = 0; j < 4; ++j) m[j] = (sb + j <= t) ? acc[4 * g + j] : 0.f;
                u32x2 w; w.x = pk2(m[0], m[1]); w.y = pk2(m[2], m[3]); *(LAS u32x2*)(scl + t * 72 + sb) = w; } }
        __syncthreads();
        f32x16 acc = zero16();
#pragma unroll
        for (int kk = 0; kk < 4; ++kk) { const bf16x8 b = *(const LAS bf16x8*)(qd + t * 72 + 16 * kk + 8 * hi); acc = mfma32(sa[kk], b, acc); }
#pragma unroll
        for (int kk = 0; kk < 4; ++kk) { const bf16x8 a = *(const LAS bf16x8*)(vT + TRD(32 * et + r32, 2 * kk + hi, 4)), b = *(const LAS bf16x8*)(scl + t * 72 + 16 * kk + 8 * hi); acc = mfma32(a, b, acc); }
        float ss = 0.f;
#pragma unroll
        for (int r = 0; r < 16; ++r) ss += acc[r] * acc[r];
        ss += shx(ss, 32, F.lane);
        if (hi == 0) part[t * 4 + et] = ss;
        __syncthreads();
        const f32x4 pp = *(const LAS f32x4*)(part + t * 4); const float rs = 1.0f / sqrtf(((pp[0] + pp[1]) + (pp[2] + pp[3])) * (1.0f / 128.0f) + NORM_EPS);
#pragma unroll
        for (int gp = 0; gp < 2; ++gp) {
            float x[8];
#pragma unroll
            for (int j = 0; j < 4; ++j) { const auto r_ = __builtin_amdgcn_permlane32_swap(__float_as_uint(acc[8 * gp + j]), __float_as_uint(acc[8 * gp + 4 + j]), false, false); x[j] = __uint_as_float(r_[0]); x[4 + j] = __uint_as_float(r_[1]); }
            const int e0 = 32 * et + 8 * (2 * gp + hi); const f32x4 g0 = *(const f32x4*)(gain + h * 128 + e0), g1 = *(const f32x4*)(gain + h * 128 + e0 + 4);
            float ga[8], o[8]; unpack8(gzv[gp], ga);
#pragma unroll
            for (int j = 0; j < 8; ++j) o[j] = x[j] * rs * (j < 4 ? g0[j & 3] : g1[j & 3]) * siluf_(ga[j]);
            *(u32x4*)(y + (size_t)(t0 + t) * DM + YA + h * 128 + e0) = pack8f(o); }
    }
#undef GO_LOAD
}

__device__ __forceinline__ void p6_mlstm_out(const Frame& F, const float* gain) {
    const bf16* z = (const bf16*)(F.ws + WS_Z); const bf16* cq = (const bf16*)(F.ws + WS_CQ); const bf16* ck = (const bf16*)(F.ws + WS_CK); const float* mg = (const float*)(F.ws + WS_MG);
    const bf16* CP = (const bf16*)(F.ws + WS_CP); bf16* y = (bf16*)(F.ws + WS_Y);
    LAS bf16* qs = (LAS bf16*)F.lds;
    LAS bf16* ks = qs + 64 * 136;
    LAS bf16* vT = ks + 64 * 136;
    LAS bf16* pw = vT + 256 * 72;
    LAS float* fl = (LAS float*)(pw + 64 * 72);
    LAS float* bc = fl;
    LAS float* ig = fl + 64;
    LAS float* mt = fl + 128;
    LAS float* wi = fl + 192;
    LAS float* qn = fl + 256;
    LAS float* rp = fl + 320;
    LAS float* np = fl + 448;
    LAS float* sp = fl + 576;
    const int r32 = F.lane & 31, hi = F.lane >> 5, s = F.tid >> 3, d16 = (F.tid & 7) * 16, e32 = (F.tid & 7) * 32;
    u32x4 qw0, qw1, kw0, kw1, vw[4]; float gb = 0.f, gi = 0.f, gn0 = 0.f, gn1 = 0.f, gmp = 0.f;
#define MO_LOAD(u_) do { const int c_ = (u_) / 6, h_ = (u_) % 6, t0_ = c_ * 64; const bf16* qp_ = cq + (size_t)(t0_ + s) * 768 + h_ * 128 + d16; const bf16* kp_ = ck + (size_t)(t0_ + s) * 768 + h_ * 128 + d16; \
        qw0 = *(const u32x4*)qp_; qw1 = *(const u32x4*)(qp_ + 8); kw0 = *(const u32x4*)kp_; kw1 = *(const u32x4*)(kp_ + 8); \
        const bf16* vp_ = z + (size_t)(t0_ + s) * ZW + ZV_C + h_ * 256 + e32; _Pragma("unroll") for (int q_ = 0; q_ < 4; ++q_) vw[q_] = *(const u32x4*)(vp_ + 8 * q_); \
        gmp = mg[MG_MP + (size_t)(u_)]; \
        if (F.wave == 0) { gb = mg[MG_B + (size_t)(t0_ + F.lane) * 8 + h_]; gi = mg[MG_I + (size_t)(t0_ + F.lane) * 8 + h_]; } \
        if (F.wave == 1) { gn0 = mg[MG_NP + (size_t)(u_) * 128 + F.lane]; gn1 = mg[MG_NP + (size_t)(u_) * 128 + 64 + F.lane]; } } while (0)
    int u = blockIdx.x; if (u < NCH * 6) MO_LOAD(u);
    for (; u < NCH * 6; u += F.G) {
        const int c = u / 6, h = u % 6, t0 = c * 64;
        __syncthreads();
        { *(LAS u32x4*)(qs + s * 136 + d16) = qw0; *(LAS u32x4*)(qs + s * 136 + d16 + 8) = qw1; *(LAS u32x4*)(ks + s * 136 + d16) = kw0; *(LAS u32x4*)(ks + s * 136 + d16 + 8) = kw1;
#pragma unroll
          for (int q = 0; q < 4; ++q) { const unsigned ww[4] = {vw[q].x, vw[q].y, vw[q].z, vw[q].w};
#pragma unroll
              for (int j = 0; j < 4; ++j) { vT[TPOS(e32 + 8 * q + 2 * j, s, 5)] = (bf16)(ww[j] & 0xffffu); vT[TPOS(e32 + 8 * q + 2 * j + 1, s, 5)] = (bf16)(ww[j] >> 16); } } }
        const float m_prev = gmp;
        if (F.wave == 0) { const float b = gb, ii = gi; float pm = ii - b;
#pragma unroll
            for (int o = 1; o < 64; o <<= 1) { const float nb = shup(pm, o, F.lane); if (F.lane >= o) pm = fmaxf(pm, nb); }
            const float m = b + fmaxf(m_prev, pm); bc[F.lane] = b; ig[F.lane] = ii; mt[F.lane] = m; wi[F.lane] = __expf(b + m_prev - m); }
        if (F.wave == 1) { np[F.lane] = gn0; np[64 + F.lane] = gn1; }
        __syncthreads();
        if (u + F.G < NCH * 6) MO_LOAD(u + F.G);
        const int et = F.wave; bf16x8 ca[8];
        { const bf16* cp = CP + ((size_t)u * 256 + 32 * et + r32) * 128 + 8 * hi;
#pragma unroll
          for (int kk = 0; kk < 8; ++kk) ca[kk] = *(const bf16x8*)(cp + 16 * kk); }
        if (F.wave >= 4) { const int tq = (F.tid - 256) >> 2, qq = (F.tid - 256) & 3; float s = 0.f;
#pragma unroll 8
            for (int d = 0; d < 32; ++d) s += bf2f(qs[tq * 136 + qq * 32 + d]) * np[qq * 32 + d];
            s += shx(s, 1, F.lane); s += shx(s, 2, F.lane); if (qq == 0) qn[tq] = s; }
        else { const int st = F.wave >> 1, tt = F.wave & 1, t = 32 * tt + r32; f32x16 acc = zero16();
#pragma unroll
            for (int kk = 0; kk < 8; ++kk) { const bf16x8 a = *(const LAS bf16x8*)(ks + (32 * st + r32) * 136 + 16 * kk + 8 * hi), b = *(const LAS bf16x8*)(qs + t * 136 + 16 * kk + 8 * hi); acc = mfma32(a, b, acc); }
            const float bt = bc[t], mtt = mt[t]; float rsum = 0.f;
#pragma unroll
            for (int g = 0; g < 4; ++g) { const int sb = 32 * st + 8 * g + 4 * hi; float m[4];
#pragma unroll
                for (int j = 0; j < 4; ++j) { const int s = sb + j; const float w = (s <= t) ? __expf(bt - bc[s] + ig[s] - mtt) : 0.f; m[j] = acc[4 * g + j] * w; rsum += m[j]; }
                u32x2 w2; w2.x = pk2(m[0], m[1]); w2.y = pk2(m[2], m[3]); *(LAS u32x2*)(pw + t * 72 + sb) = w2; }
            rsum += shx(rsum, 32, F.lane); if (hi == 0) rp[t * 2 + st] = rsum; }
        __syncthreads();
        f32x16 hv[2];
        { bf16x8 va[4];
#pragma unroll
          for (int kk = 0; kk < 4; ++kk) va[kk] = *(const LAS bf16x8*)(vT + TRD(32 * et + r32, 2 * kk + hi, 5));
#pragma unroll
          for (int tt = 0; tt < 2; ++tt) { const int t = 32 * tt + r32; f32x16 aI = zero16(), aA = zero16();
#pragma unroll
              for (int kk = 0; kk < 8; ++kk) { const bf16x8 b = *(const LAS bf16x8*)(qs + t * 136 + 16 * kk + 8 * hi); aI = mfma32(ca[kk], b, aI); }
#pragma unroll
              for (int kk = 0; kk < 4; ++kk) { const bf16x8 b = *(const LAS bf16x8*)(pw + t * 72 + 16 * kk + 8 * hi); aA = mfma32(va[kk], b, aA); }
              const float w = wi[t], den = w * qn[t] + rp[t * 2] + rp[t * 2 + 1], dn = 1.0f / fmaxf(fabsf(den), __expf(-mt[t])); float ss = 0.f;
#pragma unroll
              for (int r = 0; r < 16; ++r) { const float x = (w * aI[r] + aA[r]) * dn; hv[tt][r] = x; ss += x * x; }
              ss += shx(ss, 32, F.lane); if (hi == 0) sp[t * 8 + et] = ss; } }
        __syncthreads();
#pragma unroll
        for (int tt = 0; tt < 2; ++tt) { const int t = 32 * tt + r32; const f32x4 p0 = *(const LAS f32x4*)(sp + t * 8), p1 = *(const LAS f32x4*)(sp + t * 8 + 4);
            const float rs = 1.0f / sqrtf((((p0[0] + p0[1]) + (p0[2] + p0[3])) + ((p1[0] + p1[1]) + (p1[2] + p1[3]))) * (1.0f / 256.0f) + NORM_EPS);
            const bf16* zr = z + (size_t)(t0 + t) * ZW + h * 256;
#pragma unroll
            for (int gp = 0; gp < 2; ++gp) {
                float x[8];
#pragma unroll
                for (int j = 0; j < 4; ++j) { const auto r_ = __builtin_amdgcn_permlane32_swap(__float_as_uint(hv[tt][8 * gp + j]), __float_as_uint(hv[tt][8 * gp + 4 + j]), false, false); x[j] = __uint_as_float(r_[0]); x[4 + j] = __uint_as_float(r_[1]); }
                const int e0 = 32 * et + 8 * (2 * gp + hi); const f32x4 g0 = *(const f32x4*)(gain + h * 256 + e0), g1 = *(const f32x4*)(gain + h * 256 + e0 + 4);
                float oa[8], ga[8], o[8]; unpack8(*(const u32x4*)(zr + ZO_C + e0), oa); unpack8(*(const u32x4*)(zr + ZGATE_C + e0), ga);
#pragma unroll
                for (int j = 0; j < 8; ++j) o[j] = x[j] * rs * (j < 4 ? g0[j & 3] : g1[j & 3]) * sigmoidf_(oa[j]) * siluf_(ga[j]);
                *(u32x4*)(y + (size_t)(t0 + t) * DM + YC + h * 256 + e0) = pack8f(o); } }
    }
#undef MO_LOAD
}

namespace dsa {
constexpr int D = 128, NW = 8, QBLK = 32, KVBLK = 64, QB = NW * QBLK;
constexpr int SHM_V = KVBLK * D * 2, SHM_K = KVBLK * D * 2;
constexpr int LDS_BYTES = 2 * SHM_V + 2 * SHM_K + NW * 64 * 4;
constexpr float SCALE = 0.08838834764831845f;
constexpr float THR = 8.f;
constexpr bool WSKIP = false;
constexpr size_t VOFF = (WS_VA - WS_KA) / 2;
typedef short s16x4 __attribute__((ext_vector_type(4)));
template <class A, class Bt> struct same_t { static constexpr bool v = false; };
template <class A> struct same_t<A, A> { static constexpr bool v = true; };
#define KSWZ(row, colB) ((row) * 256 + ((colB) ^ (((row) & 7) << 4)))
#define SBAR() __builtin_amdgcn_sched_barrier(0)
__device__ __forceinline__ int v_st(int k, int c) { const int kk = (k & ~0xC) | ((k & 4) << 1) | ((k & 8) >> 1); return ((kk >> 3) * 4 + (c >> 5)) * 512 + ((kk & 7) * 32 + (c & 31)) * 2; }
__device__ __forceinline__ int v_rd_base(int lane) { return ((lane & 3) << 3) | (((lane >> 2) & 3) << 6) | (((lane >> 4) & 1) << 5) | (((lane >> 5) & 1) << 8); }
constexpr int v_rd_off(int d0, int ks, int half) { return d0 * 512 + ks * 4096 + half * 2048; }
__device__ __forceinline__ unsigned cvtpk(float lo, float hi) {
    unsigned r; asm volatile("v_cvt_pk_bf16_f32 %0, %1, %2" : "=v"(r) : "v"(lo), "v"(hi)); return r;
}
__device__ __forceinline__ bf16x8 pack8(f32x4 a, f32x4 b) {
    u32x4 w = {cvtpk(a[0], a[1]), cvtpk(a[2], a[3]), cvtpk(b[0], b[1]), cvtpk(b[2], b[3])};
    return *reinterpret_cast<bf16x8*>(&w);
}
template <class T> __device__ __forceinline__ bf16x8 load8(const T* p) {
    if constexpr (same_t<T, float>::v) { return pack8(*(const f32x4*)p, *(const f32x4*)(p + 4)); }
    else { return *reinterpret_cast<const bf16x8*>(p); }
}
__device__ __forceinline__ void mask_bits(f32x16& p0, f32x16& p1, unsigned w) {
#pragma unroll
    for (int r = 0; r < 16; ++r) {
        const unsigned m0 = (unsigned)__builtin_amdgcn_sbfe((int)w, r, 1), m1 = (unsigned)__builtin_amdgcn_sbfe((int)w, 16 + r, 1);
        p0[r] = __uint_as_float((__float_as_uint(p0[r]) & m0) | (0xff800000u & ~m0));
        p1[r] = __uint_as_float((__float_as_uint(p1[r]) & m1) | (0xff800000u & ~m1));
    }
}
__device__ __forceinline__ void partialSM(f32x16& p0, f32x16& p1, float& m_reg, float& mn, float& alpha) {
    float pmax = p0[0]; for (int r = 1; r < 16; ++r) pmax = fmaxf(pmax, p0[r]); for (int r = 0; r < 16; ++r) pmax = fmaxf(pmax, p1[r]);
    { auto rr = __builtin_amdgcn_permlane32_swap(__float_as_uint(pmax), __float_as_uint(pmax), false, false);
      pmax = fmaxf(__uint_as_float(rr[0]), __uint_as_float(rr[1])); }
    constexpr float C2 = 1.4426950408889634f * SCALE;
    if (__builtin_expect(__all((pmax - m_reg) * SCALE <= THR), 1)) { mn = m_reg; alpha = 1.f; }
    else { mn = fmaxf(m_reg, pmax); alpha = __builtin_amdgcn_exp2f((m_reg - mn) * C2); m_reg = mn; }
    const float mnL = -mn * C2;
    for (int r = 0; r < 16; ++r) p0[r] = fmaf(p0[r], C2, mnL); for (int r = 0; r < 16; ++r) p1[r] = fmaf(p1[r], C2, mnL);
    for (int r = 0; r < 16; ++r) p0[r] = __builtin_amdgcn_exp2f(p0[r]);
}
__device__ __forceinline__ void finishSM(f32x16& p0, f32x16& p1, float alpha, float& l_reg, bf16x8& pa0, bf16x8& pa1, bf16x8& pa2, bf16x8& pa3) {
    for (int r = 0; r < 16; ++r) p1[r] = __builtin_amdgcn_exp2f(p1[r]);
    float ps = 0; for (int r = 0; r < 16; ++r) ps += p0[r]; for (int r = 0; r < 16; ++r) ps += p1[r];
    { auto rr = __builtin_amdgcn_permlane32_swap(__float_as_uint(ps), __float_as_uint(ps), false, false);
      ps = __uint_as_float(rr[0]) + __uint_as_float(rr[1]); }
    l_reg = l_reg * alpha + ps;
#define PK4(P, B_, OUT) do { unsigned a0 = cvtpk(P[B_+0], P[B_+1]), a1 = cvtpk(P[B_+2], P[B_+3]);                          \
        unsigned b0 = cvtpk(P[B_+4], P[B_+5]), b1 = cvtpk(P[B_+6], P[B_+7]);                                             \
        auto r0 = __builtin_amdgcn_permlane32_swap(a0, b0, false, false); auto r1 = __builtin_amdgcn_permlane32_swap(a1, b1, false, false); \
        u32x4 w = {r0[0], r1[0], r0[1], r1[1]}; OUT = *reinterpret_cast<bf16x8*>(&w); } while (0)
    PK4(p0, 0, pa0); PK4(p0, 8, pa1); PK4(p1, 0, pa2); PK4(p1, 8, pa3);
#undef PK4
}
template <int KB, bool SK>
__device__ __forceinline__ void qkt(f32x16& p0, f32x16& p1, const char* K_lds, int r32, int hi, const bf16x8* qr, bool act) {
    if (SK && !act) { const float NEG = -__builtin_inff();
#pragma unroll
        for (int r = 0; r < 16; ++r) { p0[r] = NEG; p1[r] = NEG; } return; }
    p0 = f32x16{}; p1 = f32x16{};
    const char* kb[4];
#pragma unroll
    for (int dd = 0; dd < 4; ++dd) kb[dd] = K_lds + KB * SHM_K + KSWZ(r32, (dd * 16 + hi * 8) * 2);
#pragma unroll
    for (int d0 = 0; d0 < 8; ++d0) { const char* a = kb[d0 & 3] + (d0 >> 2) * 128;
        bf16x8 b0 = *reinterpret_cast<const bf16x8*>(a);
        bf16x8 b1 = *reinterpret_cast<const bf16x8*>(a + 32 * 256);
        p0 = __builtin_amdgcn_mfma_f32_32x32x16_bf16(b0, qr[d0], p0, 0, 0, 0);
        p1 = __builtin_amdgcn_mfma_f32_32x32x16_bf16(b1, qr[d0], p1, 0, 0, 0); }
}
template <int VB, bool SK>
__device__ __forceinline__ void pv_tile(f32x16* o, int vb0, bf16x8 pa0, bf16x8 pa1, bf16x8 pa2, bf16x8 pa3, bool act) {
    if (SK && !act) return;
#define TRRD(dst, off) asm volatile("ds_read_b64_tr_b16 %0, %1 offset:%2" : "=&v"(dst) : "v"(vb0), "i"(off) : "memory")
#define PV_D0(d0) do { s16x4 l0, l1, l2, l3, h0, h1, h2, h3; constexpr int b_ = VB * SHM_V + v_rd_off(d0, 0, 0);     \
        TRRD(l0, b_); TRRD(h0, b_ + 2048); TRRD(l1, b_ + 4096); TRRD(h1, b_ + 6144); TRRD(l2, b_ + 8192); TRRD(h2, b_ + 10240); TRRD(l3, b_ + 12288); TRRD(h3, b_ + 14336); \
        asm volatile("s_waitcnt lgkmcnt(0)" ::: "memory"); SBAR();                 \
        o[d0] = __builtin_amdgcn_mfma_f32_32x32x16_bf16(pa0, (bf16x8){l0[0], l0[1], l0[2], l0[3], h0[0], h0[1], h0[2], h0[3]}, o[d0], 0, 0, 0);   \
        o[d0] = __builtin_amdgcn_mfma_f32_32x32x16_bf16(pa1, (bf16x8){l1[0], l1[1], l1[2], l1[3], h1[0], h1[1], h1[2], h1[3]}, o[d0], 0, 0, 0);   \
        o[d0] = __builtin_amdgcn_mfma_f32_32x32x16_bf16(pa2, (bf16x8){l2[0], l2[1], l2[2], l2[3], h2[0], h2[1], h2[2], h2[3]}, o[d0], 0, 0, 0);   \
        o[d0] = __builtin_amdgcn_mfma_f32_32x32x16_bf16(pa3, (bf16x8){l3[0], l3[1], l3[2], l3[3], h3[0], h3[1], h3[2], h3[3]}, o[d0], 0, 0, 0); } while (0)
    PV_D0(0); PV_D0(1); PV_D0(2); PV_D0(3);
#undef PV_D0
#undef TRRD
}
template <class TIn, class TOut> struct BlockRef { const TIn* Q; const TIn* K; const unsigned long long* M; int P0; const unsigned short* G; unsigned short* Y; };
template <class TIn> struct Seam {
    bf16x8 qr[8];
    bf16x8 st_v0, st_v1, st_k0, st_k1; f32x4 sf0, sf1, sf2, sf3;
    f32x4 tq[16];
};
__device__ __forceinline__ int swa_jlo(int P0, int W) { const int lowk = P0 - W + 1; return lowk > 0 ? lowk / KVBLK : 0; }
#define ROW(p, k0, rr) ((p) + (size_t)((k0) + (rr)) * D + sc)
#define VMW() asm volatile("s_waitcnt vmcnt(0)" ::: "memory")
#define VMWN(n) asm volatile("s_waitcnt vmcnt(%0)" :: "i"(n) : "memory")
#define SLOAD_H(Kp, Vp, k0) do { S.st_v0 = load8<TIn>(ROW(Vp, k0, sr)); S.st_v1 = load8<TIn>(ROW(Vp, k0, 32 + sr));              \
                         S.st_k0 = load8<TIn>(ROW(Kp, k0, sr)); S.st_k1 = load8<TIn>(ROW(Kp, k0, 32 + sr)); } while (0)
#define SWRITE_HK(bf) do { *(bf16x8*)(K_lds + (bf) * SHM_K + kws) = S.st_k0; *(bf16x8*)(K_lds + (bf) * SHM_K + kws + 32 * 256) = S.st_k1; } while (0)
#define SWRITE_HV(bf) do { *(bf16x8*)(V_lds + (bf) * SHM_V + vst0) = S.st_v0; *(bf16x8*)(V_lds + (bf) * SHM_V + vst1) = S.st_v1; } while (0)
#define SWRITE_H(bf) do { SWRITE_HV(bf); SWRITE_HK(bf); } while (0)
#define SLOAD_F(p, k0) do { S.sf0 = *(const f32x4*)ROW(p, k0, sr); S.sf1 = *(const f32x4*)(ROW(p, k0, sr) + 4);                \
                            S.sf2 = *(const f32x4*)ROW(p, k0, 32 + sr); S.sf3 = *(const f32x4*)(ROW(p, k0, 32 + sr) + 4); } while (0)
#define SWRITE_KF(bf) do { *(bf16x8*)(K_lds + (bf) * SHM_K + kws) = pack8(S.sf0, S.sf1); *(bf16x8*)(K_lds + (bf) * SHM_K + kws + 32 * 256) = pack8(S.sf2, S.sf3); } while (0)
#define SWRITE_VF(bf) do { *(bf16x8*)(V_lds + (bf) * SHM_V + vst0) = pack8(S.sf0, S.sf1); *(bf16x8*)(V_lds + (bf) * SHM_V + vst1) = pack8(S.sf2, S.sf3); } while (0)
template <class TIn, class TOut>
__device__ __forceinline__ void causal_swa_prime(const BlockRef<TIn, TOut>& cur, int W, char* lds, Seam<TIn>& S) {
    constexpr bool F32 = same_t<TIn, float>::v;
    int tid_l = threadIdx.x; asm volatile("" : "+v"(tid_l));
    const int tid = tid_l, wid = __builtin_amdgcn_readfirstlane(tid >> 6), lane = tid & 63, r32 = lane & 31, hi = lane >> 5;
    const int sr = tid >> 4, sc = (tid & 15) * 8, kws = KSWZ(sr, sc * 2); char* K_lds = lds + 2 * SHM_V;
    const int kb0 = swa_jlo(cur.P0, W) * KVBLK;
    for (int d0 = 0; d0 < 8; ++d0) S.qr[d0] = load8<TIn>(cur.Q + (size_t)(wid * QBLK + r32) * D + d0 * 16 + hi * 8);
    if constexpr (F32) { SLOAD_F((const float*)cur.K, kb0); VMW(); SWRITE_KF(0); SBAR(); SLOAD_F((const float*)(cur.K + VOFF), kb0); }
    else { SLOAD_H(cur.K, (cur.K + VOFF), kb0); VMW(); SWRITE_HK(0); }
    __syncthreads();
}
template <class TIn, class TOut>
__device__ __forceinline__ void causal_swa_block(const BlockRef<TIn, TOut>& cur, const BlockRef<TIn, TOut>& nxt, int skv, int W, char* lds, Seam<TIn>& S) {
    constexpr bool F32 = same_t<TIn, float>::v;
    int tid_l = threadIdx.x; asm volatile("" : "+v"(tid_l));
    const int tid = tid_l, wid = __builtin_amdgcn_readfirstlane(tid >> 6), lane = tid & 63, r32 = lane & 31, hi = lane >> 5;
    const int j_lo = swa_jlo(cur.P0, W);
    int j_hi = (cur.P0 + QB - 1) / KVBLK + 1; if (j_hi > skv / KVBLK) j_hi = skv / KVBLK;
    const int NT = j_hi - j_lo;
    const int kbn = swa_jlo(nxt.P0, W) * KVBLK;
    const int qlo = cur.P0 + wid * QBLK, qm = qlo + r32 - 4 * hi;
    char* V_lds = lds; char* K_lds = lds + 2 * SHM_V;
    float* ws = (float*)(lds + 2 * SHM_V + 2 * SHM_K) + wid * 64; float* li_l = ws, * al_l = ws + 32;
    float m_reg = -1e30f, l_reg = 0; f32x16 o[4] = {};
    const int sr = tid >> 4, sc = (tid & 15) * 8, vst0 = v_st(sr, sc), vst1 = v_st(32 + sr, sc), kws = KSWZ(sr, sc * 2);
    const int vb0 = (int)(uintptr_t)V_lds + v_rd_base(lane);
    const TIn* Kh = cur.K; const TIn* Vh = (cur.K + VOFF);
#define RESC(a) do { if (__any((a) < 1.f)) { if (hi == 0) al_l[r32] = (a); asm volatile("s_waitcnt lgkmcnt(0)" ::: "memory");              \
                     for (int d_ = 0; d_ < 4; ++d_) for (int r = 0; r < 16; ++r) o[d_][r] *= al_l[crow(r, hi)]; } } while (0)
#define KBASE(t) ((j_lo + (t)) * KVBLK)
#define ACT(t) (KBASE(t) <= qlo + QBLK - 1 && KBASE(t) + KVBLK - 1 >= qlo - W + 1)
#define MASKT(P0_, P1_, MW_) mask_bits(P0_, P1_, MW_)
    constexpr int NQL = F32 ? 16 : 8;
    constexpr bool SK = WSKIP && !F32;
#define SEAM_K0() do { VMWN(NQL); if constexpr (F32) { SWRITE_KF(0); SBAR(); SLOAD_F((const float*)(nxt.K + VOFF), kbn); } else { SWRITE_HK(0); } SBAR(); } while (0)
    f32x16 pA0, pA1, pB0, pB1; float mnA, mnB, alA, alB; bf16x8 pa0, pa1, pa2, pa3;
    const unsigned* M32 = (const unsigned*)cur.M;
#define MOFF() ({ int l_ = lane; asm volatile("" : "+v"(l_)); (unsigned)(wid * QBLK + (l_ & 31)) * 512u + (unsigned)(l_ >> 5); })
    unsigned mw = M32[MOFF()];
    if constexpr (F32) { VMW(); SWRITE_VF(0); SBAR(); } else { SWRITE_HV(0); SBAR(); }
    if (NT > 1) { if constexpr (F32) SLOAD_F((const float*)Kh, KBASE(1)); else SLOAD_H(Kh, Vh, KBASE(1)); }
    SBAR(); qkt<0, SK>(pA0, pA1, K_lds, r32, hi, S.qr, ACT(0));
    if constexpr (F32) { if (NT > 1) { VMW(); SWRITE_KF(1); SBAR(); SLOAD_F((const float*)Vh, KBASE(1)); } }
    MASKT(pA0, pA1, mw); partialSM(pA0, pA1, m_reg, mnA, alA);
    if (NT > 1) { VMW(); if constexpr (F32) { SWRITE_VF(1); SBAR(); if (NT > 2) SLOAD_F((const float*)Kh, KBASE(2)); } else SWRITE_H(1); }
    __syncthreads();
#define HALF_STEP(PX0, PX1, mnX, alX, PY0, PY1, alY, t, KB, VB, SB) do {                                                      \
        mw = M32[MOFF() + 2u * (unsigned)(t)];                                                                                     \
        SBAR(); qkt<KB, SK>(PX0, PX1, K_lds, r32, hi, S.qr, ACT(t));                                             \
        finishSM(PY0, PY1, alY, l_reg, pa0, pa1, pa2, pa3); SBAR();                                                           \
        if ((t) + 1 < NT) { if constexpr (F32) { VMW(); SWRITE_KF(SB); SBAR(); SLOAD_F((const float*)Vh, KBASE((t) + 1)); }  \
                            else { SLOAD_H(Kh, Vh, KBASE((t) + 1)); } SBAR(); }                                               \
        pv_tile<VB, SK>(o, vb0, pa0, pa1, pa2, pa3, ACT((t) - 1)); MASKT(PX0, PX1, mw); partialSM(PX0, PX1, m_reg, mnX, alX);                                        \
        __syncthreads();                                                                                                      \
        if ((t) + 1 < NT) { VMW(); if constexpr (F32) { SWRITE_VF(SB); SBAR(); if ((t) + 2 < NT) SLOAD_F((const float*)Kh, KBASE((t) + 2)); } \
                            else { SWRITE_H(SB); } }                                                                          \
        RESC(alX); __syncthreads(); } while (0)
    for (int t = 1; t + 1 < NT; t += 2) {
        HALF_STEP(pB0, pB1, mnB, alB, pA0, pA1, alA, t, 1, 0, 0);
        HALF_STEP(pA0, pA1, mnA, alA, pB0, pB1, alB, t + 1, 0, 1, 1);
    }
    const bool even = (NT & 1) == 0;
    if (even) { mw = M32[MOFF() + 2u * (unsigned)(NT - 1)]; SBAR(); qkt<1, SK>(pB0, pB1, K_lds, r32, hi, S.qr, ACT(NT - 1)); SBAR(); }
#define QROW(e) (nxt.Q + (size_t)(wid * QBLK + r32) * D + ((e) >> 1) * 16 + hi * 8 + ((e) & 1) * 4)
    if constexpr (F32) { SLOAD_F((const float*)nxt.K, kbn); SBAR();
#pragma unroll
        for (int e = 0; e < 8; ++e) S.tq[e] = *(const f32x4*)QROW(e); }
    else { SLOAD_H(nxt.K, (nxt.K + VOFF), kbn); SBAR();
#pragma unroll
        for (int d0 = 0; d0 < 8; ++d0) S.qr[d0] = load8<TIn>(nxt.Q + (size_t)(wid * QBLK + r32) * D + d0 * 16 + hi * 8); }
    SBAR();
    finishSM(pA0, pA1, alA, l_reg, pa0, pa1, pa2, pa3); SBAR();
    if constexpr (F32) {
#pragma unroll
        for (int e = 8; e < 16; ++e) S.tq[e] = *(const f32x4*)QROW(e); SBAR(); }
#undef QROW
    pv_tile<0, SK>(o, vb0, pa0, pa1, pa2, pa3, ACT(even ? NT - 2 : NT - 1));
    if (even) { MASKT(pB0, pB1, mw); partialSM(pB0, pB1, m_reg, mnB, alB); __syncthreads(); RESC(alB);
        finishSM(pB0, pB1, alB, l_reg, pa0, pa1, pa2, pa3); SBAR(); pv_tile<1, SK>(o, vb0, pa0, pa1, pa2, pa3, ACT(NT - 1)); }
    SBAR(); SEAM_K0();
    if (hi == 0) li_l[r32] = l_reg; asm volatile("s_waitcnt lgkmcnt(0)" ::: "memory");
    float rli[16];
#pragma unroll
    for (int r = 0; r < 16; ++r) rli[r] = __builtin_amdgcn_rcpf(li_l[crow(r, hi)]);
    { unsigned short* ost = (unsigned short*)(lds + LDS_BYTES + wid * (16 * 136 * 2));
      const unsigned short* Gw = cur.G + (size_t)(wid * QBLK) * ZW; unsigned short* Yw = cur.Y + (size_t)(wid * QBLK) * DM;
#pragma unroll
      for (int ph = 0; ph < 2; ++ph) {
#pragma unroll
          for (int r = 8 * ph; r < 8 * ph + 8; ++r) { const int lrow = crow(r, hi) - 16 * ph;
#pragma unroll
              for (int d0 = 0; d0 < 4; ++d0) ost[lrow * 136 + d0 * 32 + r32] = f2bf(o[d0][r] * rli[r]); }
          asm volatile("s_waitcnt lgkmcnt(0)" ::: "memory");
#pragma unroll
          for (int i = 0; i < 4; ++i) { const int c = i * 64 + lane, lrow = c >> 4, d8 = (c & 15) * 8, row = 16 * ph + lrow; float ov[8], gv[8];
              unpack8(*(const u32x4*)(ost + lrow * 136 + d8), ov); unpack8(*(const u32x4*)(Gw + (size_t)row * ZW + d8), gv);
#pragma unroll
              for (int j = 0; j < 8; ++j) ov[j] *= siluf_(gv[j]);
              *(u32x4*)(Yw + (size_t)row * DM + d8) = pack8f(ov); }
          asm volatile("s_waitcnt lgkmcnt(0)" ::: "memory"); } }
    if constexpr (F32) {
#pragma unroll
        for (int d0 = 0; d0 < 8; ++d0) S.qr[d0] = pack8(S.tq[2 * d0], S.tq[2 * d0 + 1]); }
    __syncthreads();
#undef RESC
#undef KBASE
#undef ACT
#undef MASKT
#undef MOFF
#undef SEAM_K0
#undef HALF_STEP
}
#undef ROW
#undef VMW
#undef VMWN
#undef SLOAD_H
#undef SWRITE_HK
#undef SWRITE_HV
#undef SWRITE_H
#undef SLOAD_F
#undef SWRITE_KF
#undef SWRITE_VF

}

__device__ __forceinline__ void p6_dsa_attention(const Frame& F, char* lds_generic) {
    typedef dsa::BlockRef<unsigned short, unsigned short> Ref;
    const bf16* qA = (const bf16*)(F.ws + WS_QA); const bf16* kA = (const bf16*)(F.ws + WS_KA);
    const unsigned long long* mask = (const unsigned long long*)(F.ws + WS_MASK); const bf16* zz = (const bf16*)(F.ws + WS_Z); bf16* yy = (bf16*)(F.ws + WS_Y);
    constexpr int NQB = SEQ / dsa::QB, NITEM = 8 * (NQB / 2);
#define DSA_MKREF(R, item_, pass_) do { const int h_ = (item_) & 7, yy_ = (item_) >> 3, qb_ = (pass_) ? (NQB - 1 - yy_) : yy_, P0_ = qb_ * dsa::QB; \
        R.Q = qA + ((size_t)h_ * SEQ + P0_) * 128; R.K = kA + (size_t)h_ * SEQ * 128; R.M = mask + (size_t)P0_ * 256; R.P0 = P0_; R.G = zz + (size_t)P0_ * ZW + ZGATE_B + h_ * 128; R.Y = yy + (size_t)P0_ * DM + YB + h_ * 128; } while (0)
    int item = blockIdx.x; if (item >= NITEM) return;
    int pass = 0; Ref cur; DSA_MKREF(cur, item, 0);
    dsa::Seam<unsigned short> S;
    __syncthreads();
    dsa::causal_swa_prime<unsigned short, unsigned short>(cur, 1 << 30, lds_generic, S);
    for (;;) {
        const bool more_pass = pass == 0, more_item = item + F.G < NITEM, last = !more_pass && !more_item;
        int itn = item, pn = pass + 1; if (!more_pass) { pn = 0; itn = more_item ? item + F.G : item; }
        Ref nxt = cur; if (!last) DSA_MKREF(nxt, itn, pn);
        dsa::causal_swa_block<unsigned short, unsigned short>(cur, nxt, SEQ, 1 << 30, lds_generic, S);
        if (last) break;
        cur = nxt; item = itn; pass = pn;
    }
#undef DSA_MKREF
}

#ifdef DBG_CHECK
constexpr int DBG_T = 1024;
#if DBG_CHECK == 0
__device__ __forceinline__ void dbg_gla_seq(const Frame& F, float* ref) {
    const bf16* z = (const bf16*)(F.ws + WS_Z); const float* bA = (const float*)(F.ws + WS_BA);
    const int i4 = blockIdx.x * NTHR + F.tid; if (i4 >= 12 * 128 * 4) return;
    const int i = i4 >> 2, dq = (i4 & 3) * 16, h = i >> 7, e = i & 127; float S[16];
#pragma unroll
    for (int d = 0; d < 16; ++d) S[d] = 0.f;
    for (int t = 0; t < DBG_T; ++t) { const bf16* zr = z + (size_t)t * ZW; const float ve = bf2f(zr[ZV_A + h * 128 + e]); float o = 0.f;
#pragma unroll
        for (int d = 0; d < 16; ++d) { const float bt = bA[(size_t)t * 768 + h * 64 + dq + d], bp = (t & 63) ? bA[(size_t)(t - 1) * 768 + h * 64 + dq + d] : 0.f;
            S[d] = expf(bt - bp) * S[d] + bf2f(zr[ZK_A + h * 64 + dq + d]) * ve; o += bf2f(zr[ZQ_A + h * 64 + dq + d]) * 0.125f * S[d]; }
        o += shx(o, 1, F.lane); o += shx(o, 2, F.lane);
        if ((i4 & 3) == 0) ref[(size_t)t * 1536 + i] = o; }
}
#endif
#if DBG_CHECK == 1
__device__ __forceinline__ void dbg_mlstm_seq(const Frame& F, float* ref) {
    const bf16* z = (const bf16*)(F.ws + WS_Z); const bf16* cq = (const bf16*)(F.ws + WS_CQ); const bf16* ck = (const bf16*)(F.ws + WS_CK); const float* mg = (const float*)(F.ws + WS_MG);
    const int i = blockIdx.x * NTHR + F.tid; if (i >= 6 * 256) return;
    const int h = i >> 8, e = i & 255; float C[128]; float m = 0.f;
#pragma unroll
    for (int d = 0; d < 128; ++d) C[d] = 0.f;
    for (int t = 0; t < DBG_T; ++t) { const float bt = mg[MG_B + (size_t)t * 8 + h], bp = (t & 63) ? mg[MG_B + (size_t)(t - 1) * 8 + h] : 0.f, lf = bt - bp, ig = mg[MG_I + (size_t)t * 8 + h];
        const float mn = fmaxf(lf + m, ig), fa = expf(lf + m - mn), ia = expf(ig - mn); m = mn;
        const float ve = bf2f(z[(size_t)t * ZW + ZV_C + h * 256 + e]); float o = 0.f;
#pragma unroll
        for (int d = 0; d < 128; ++d) { C[d] = fa * C[d] + ia * bf2f(ck[(size_t)t * 768 + h * 128 + d]) * ve; o += bf2f(cq[(size_t)t * 768 + h * 128 + d]) * C[d]; }
        ref[(size_t)t * 1536 + i] = o;
#ifdef DBG_STATE
        if (t == 63) { const bf16* CP = (const bf16*)(F.ws + WS_CP); const float mp = mg[MG_MP + 6 + h]; float md = 0.f, mx = 0.f;
#pragma unroll
            for (int d = 0; d < 128; ++d) { const float a = bf2f(CP[((size_t)(6 + h) * 256 + e) * 128 + d]) * expf(mp - m), b = C[d]; md = fmaxf(md, fabsf(a - b)); mx = fmaxf(mx, fabsf(b)); }
            md = wave_max(md, F.lane); mx = wave_max(mx, F.lane);
            if (F.lane == 0) atomicMax((unsigned*)(F.ws + WS_CTL) + 2049, __float_as_uint(md / mx)); }
#endif
    }
}
#endif
__device__ __forceinline__ void dbg_compare(const Frame& F, const float* ref, const float* gainA, const float* gainC, int which, unsigned* res) {
    const bf16* z = (const bf16*)(F.ws + WS_Z); const bf16* y = (const bf16*)(F.ws + WS_Y);
    const int NH = which ? 6 : 12, HD = which ? 256 : 128;
    for (int u = F.gw; u < DBG_T * NH; u += F.NGW) { const int t = u / NH, h = u % NH; float ss = 0.f;
        for (int e = F.lane; e < HD; e += 64) { const float v = ref[(size_t)t * 1536 + h * HD + e]; ss += v * v; }
        ss = wave_sum(ss, F.lane); const float rs = 1.0f / sqrtf(ss / HD + NORM_EPS); float md = 0.f;
        for (int e = F.lane; e < HD; e += 64) { float v = ref[(size_t)t * 1536 + h * HD + e] * rs; float got;
            if (which) { v *= gainC[h * 256 + e] * sigmoidf_(bf2f(z[(size_t)t * ZW + ZO_C + h * 256 + e])) * siluf_(bf2f(z[(size_t)t * ZW + ZGATE_C + h * 256 + e])); got = bf2f(y[(size_t)t * DM + YC + h * 256 + e]); }
            else { v *= gainA[h * 128 + e] * siluf_(bf2f(z[(size_t)t * ZW + ZGATE_A + h * 128 + e])); got = bf2f(y[(size_t)t * DM + YA + h * 128 + e]); }
            md = fmaxf(md, fabsf(got - v)); }
        md = wave_max(md, F.lane); if (F.lane == 0) atomicMax(res, __float_as_uint(md)); }
}
#endif

struct Args { const void* in[18]; float* out; unsigned char* ws; };
#ifndef MIX_GLA
#define MIX_GLA 1
#endif
#ifndef MIX_MLSTM
#define MIX_MLSTM 1
#endif
#ifndef MIX_DSA
#define MIX_DSA 1
#endif

__global__ void __launch_bounds__(NTHR, 2) trunk_fwd(Args args) {
    extern __shared__ __attribute__((aligned(16))) unsigned char lds[];
    Frame F;
    F.lds = (LAS unsigned char*)lds; F.ws = args.ws;
    F.tid = threadIdx.x; F.lane = F.tid & 63; F.wave = __builtin_amdgcn_readfirstlane(F.tid >> 6);
    F.G = gridDim.x; { const int bx = blockIdx.x; F.vcu = (F.G % 8 == 0) ? (bx % 8) * (F.G / 8) + bx / 8 : bx; }
    F.gw = F.vcu * NWAVES + F.wave; F.NGW = F.G * NWAVES;
    volatile LAS unsigned* MISC = (volatile LAS unsigned*)(F.lds + MISC_OFF);
    for (int u = F.tid; u < (LDS_BYTES - RING_BYTES) / 4; u += NTHR) ((LAS unsigned*)(F.lds + RING_BYTES))[u] = 0u;
    __syncthreads();
    XcdBarrier bar = xcd_barrier_post((unsigned*)(F.ws + WS_CTL) + CW_BAR, MISC + 8);
#define GRID_BAR() do { size_t zb_ = 0; asm volatile("" : "+s"(zb_)); unsigned x_ = bar.x; asm volatile("" : "+s"(x_)); XcdBarrier b_; b_.bar = (unsigned*)(args.ws + zb_ + WS_CTL) + CW_BAR; b_.x = x_; b_.st = bar.st; xcd_barrier(b_); } while (0)
#define IN(k) ((const float*)args.in[k])
#define PHASE_BEGIN() do { size_t z_ = 0; asm volatile("" : "+s"(z_)); F.ws = args.ws + z_; unsigned lz_ = 0; asm volatile("" : "+s"(lz_)); F.lds = (LAS unsigned char*)lds + lz_; int t_ = threadIdx.x; asm volatile("" : "+v"(t_)); F.tid = t_; F.lane = t_ & 63; F.wave = __builtin_amdgcn_readfirstlane(t_ >> 6); \
        F.gw = F.vcu * NWAVES + F.wave; U = (bf16*)(F.ws + WS_U); Z = (bf16*)(F.ws + WS_Z); Y = (bf16*)(F.ws + WS_Y); PP = (bf16*)(F.ws + WS_PP); H = (float*)(F.ws + WS_H); } while (0)

    bf16 *U, *Z, *Y, *PP; float* H;

#ifndef DMASK
#define DMASK 0
#endif
#ifndef TPSHIFT
#define TPSHIFT 1.0f
#endif
#ifdef TPROBE
    unsigned long long tp_acc = 0, tp_t0 = 0; int tp_prev = -1;
#define TP_MARK(n) do { const unsigned long long t_ = __builtin_amdgcn_s_memrealtime(); if (tp_prev == TPROBE) tp_acc += t_ - tp_t0; tp_prev = (n); tp_t0 = t_; } while (0)
#else
#define TP_MARK(n) do { } while (0)
#endif
#define REP(n) for (int rep_ = 0; rep_ < (((DMASK >> (n)) & 1) ? 2 : 1); ++rep_)
#ifndef ONLY
#define PH(n) 1
#else
#define PH(n) ((n) == ONLY)
#endif
    TP_MARK(0); REP(0) { PHASE_BEGIN(); } REP(0) if (PH(0)) p0_prologue(F, IN(4), IN(13), IN(15), IN(16), IN(1), (const int*)args.in[2], IN(3), IN(14), IN(0));
    GRID_BAR();
    for (int L = 0; L < DEPTH; ++L) {

        TP_MARK(1); REP(1) { PHASE_BEGIN(); } REP(1) if (PH(1)) { if (L > 0) { reduce_rstd(F); GRID_BAR(); } }
        TP_MARK(2); REP(2) { PHASE_BEGIN(); } REP(2) if (PH(2)) { pg8::Gemm g{U, (const bf16*)(F.ws + WS_WIN) + (size_t)L * ZW * DM, SEQ, ZW, DM}; pg8::StaticOrder S; S.init(SEQ, ZW, F.G, (int)blockIdx.x);
          pg8::EpiBf16Row E{Z, ZW, (const float*)(F.ws + WS_RSTD), (bf16*)(F.ws + WS_QA), (bf16*)(F.ws + WS_IQ), (bf16*)(F.ws + WS_IK), ZQ_B, ZGATE_B, ZIQ, ZIK, SEQ};
          pg8::gemm_phase<pg8::EpiBf16Row, pg8::StaticOrder, true, true>(F.lds, g, S, E); }
        GRID_BAR();
        TP_MARK(3); REP(3) { PHASE_BEGIN(); } REP(3) if (PH(3)) p3_prep(F, IN(8) + (size_t)L * 4 * 768, IN(9) + (size_t)L * 4 * 768, IN(10) + L * 6, IN(11) + L * 6, IN(5) + (size_t)L * 16 * 768, IN(6) + (size_t)L * 768);
        GRID_BAR();
#if MIX_DSA
        TP_MARK(4); REP(4) { PHASE_BEGIN(); } REP(4) if (PH(4)) p4_index_scores(F);
#endif
#if MIX_GLA
        TP_MARK(5); REP(5) { PHASE_BEGIN(); } REP(5) if (PH(5)) p4_gla_local(F);
#endif
#if MIX_MLSTM
        TP_MARK(6); REP(6) { PHASE_BEGIN(); } REP(6) if (PH(6)) p4_mlstm_local(F);
#endif
        GRID_BAR();
#if MIX_GLA || MIX_MLSTM
        TP_MARK(7); REP(7) { PHASE_BEGIN(); } REP(7) if (PH(7)) p5_scans(F);
#endif
#if MIX_DSA
        TP_MARK(8); REP(8) { PHASE_BEGIN(); } REP(8) if (PH(8)) p5_select(F, (unsigned*)(F.ws + WS_CTL) + 8192 + 64 * L);
#endif
        GRID_BAR();
#if MIX_DSA
        TP_MARK(9); REP(9) { PHASE_BEGIN(); } REP(9) if (PH(9)) p6_dsa_attention(F, (char*)lds);
#else
        { unsigned zz_ = 0; asm volatile("" : "+v"(zz_));
        for (int i = blockIdx.x * NTHR + F.tid; i < SEQ * 128; i += F.G * NTHR) { const int t = i >> 7, c8 = i & 127; *(u32x4*)(Y + (size_t)t * DM + YB + c8 * 8) = (u32x4){zz_, zz_, zz_, zz_}; } }
#endif
#if MIX_GLA
        TP_MARK(10); REP(10) { PHASE_BEGIN(); } REP(10) if (PH(10)) p6_gla_out(F, IN(7) + (size_t)L * 1536);
#else
        { unsigned zz_ = 0; asm volatile("" : "+v"(zz_));
        for (int i = blockIdx.x * NTHR + F.tid; i < SEQ * 192; i += F.G * NTHR) { const int t = i / 192, c8 = i % 192; *(u32x4*)(Y + (size_t)t * DM + YA + c8 * 8) = (u32x4){zz_, zz_, zz_, zz_}; } }
#endif
#if MIX_MLSTM
        TP_MARK(11); REP(11) { PHASE_BEGIN(); } REP(11) if (PH(11)) p6_mlstm_out(F, IN(12) + (size_t)L * 1536);
#else
        { unsigned zz_ = 0; asm volatile("" : "+v"(zz_));
        for (int i = blockIdx.x * NTHR + F.tid; i < SEQ * 192; i += F.G * NTHR) { const int t = i / 192, c8 = i % 192; *(u32x4*)(Y + (size_t)t * DM + YC + c8 * 8) = (u32x4){zz_, zz_, zz_, zz_}; } }
#endif
        GRID_BAR();
#ifdef DBG_CHECK
        if (L == 0) { PHASE_BEGIN(); float* ref = (float*)(F.ws + WS_SCORE); unsigned* res = (unsigned*)(F.ws + WS_CTL) + 2048;
#if DBG_CHECK == 0
            dbg_gla_seq(F, ref);
#else
            dbg_mlstm_seq(F, ref);
#endif
            GRID_BAR();
            PHASE_BEGIN(); dbg_compare(F, (const float*)(F.ws + WS_SCORE), IN(7), IN(12), DBG_CHECK, (unsigned*)(F.ws + WS_CTL) + 2048);
            GRID_BAR(); }
#endif
        TP_MARK(12); REP(12) { PHASE_BEGIN(); } REP(12) if (PH(12)) { pg8::Gemm g{Y, (const bf16*)(F.ws + WS_WOUT) + (size_t)L * DM * DM, SEQ, DM, DM}; pg8::StaticOrder S; S.init(SEQ, DM, F.G, (int)blockIdx.x);
          pg8::EpiResB E{U, (bf16*)(F.ws + WS_HB2), (float*)(F.ws + WS_PART), DM};
          pg8::gemm_phase<pg8::EpiResB, pg8::StaticOrder, true, true>(F.lds, g, S, E); }
        GRID_BAR();
        TP_MARK(13); REP(13) { PHASE_BEGIN(); } REP(13) if (PH(13)) reduce_rstd(F);
        TP_MARK(14); REP(14) { PHASE_BEGIN(); } REP(14) if (PH(14)) { pg8::Gemm g{(const bf16*)(F.ws + WS_PBF) + (size_t)L * SEQ * DPLE, (const bf16*)(F.ws + WS_WPLE) + (size_t)L * DM * DPLE, SEQ, DM, DPLE}; pg8::StaticOrder S; S.init(SEQ, DM, F.G, (int)blockIdx.x);
          pg8::EpiBf16<0> E{PP, DM, nullptr, 0, 0, 1.f};
          pg8::gemm_phase<pg8::EpiBf16<0>, pg8::StaticOrder, true, true>(F.lds, g, S, E); }
        GRID_BAR();
        TP_MARK(15); REP(15) { PHASE_BEGIN(); } REP(15) if (PH(15)) { pg8::Gemm g{(const bf16*)(F.ws + WS_HB2), (const bf16*)(F.ws + WS_WGATE) + (size_t)L * DM * DM, SEQ, DM, DM}; pg8::StaticOrder S; S.init(SEQ, DM, F.G, (int)blockIdx.x);
          pg8::EpiGateB E{(const bf16*)(F.ws + WS_HB2), PP, (const float*)(F.ws + WS_RSTD), U, (float*)(F.ws + WS_PART), DM};
          pg8::gemm_phase<pg8::EpiGateB, pg8::StaticOrder, true, true>(F.lds, g, S, E); }
        GRID_BAR();
    }
    TP_MARK(16); REP(16) { PHASE_BEGIN(); } REP(16) if (PH(16)) rmsnorm_b2f(F, U, IN(17), args.out);
#ifdef TPROBE
    TP_MARK(99); GRID_BAR();
    if (blockIdx.x == 0 && threadIdx.x == 0) { const float us_ = 0.01f * (float)tp_acc * TPSHIFT; const float k_ = floorf(__logf(us_) * (1.0f / 0.0953102f)); args.out[0] = __expf((k_ + 0.5f) * 0.0953102f); }
#endif
#ifdef DBG_CHECK
#ifdef DBG_STATE
#define DBG_WORD 2049
#else
#define DBG_WORD 2048
#endif
    GRID_BAR();
    if (blockIdx.x == 0 && threadIdx.x == 0) args.out[0] = 10000.0f * __uint_as_float(__hip_atomic_load((unsigned*)(args.ws + WS_CTL) + DBG_WORD, __ATOMIC_RELAXED, __HIP_MEMORY_SCOPE_AGENT));
#endif
}

extern "C" void kernel_launch(void* const* d_in, const int* in_sizes, int n_in, void* d_out, int out_size, void* d_ws, size_t ws_size, hipStream_t stream) {
    static int grid = 0;
    if (grid == 0) {
        if (n_in != 18 || out_size != SEQ * DM || ws_size < WS_END) { fprintf(stderr, "kernel_launch: unexpected shapes (n_in %d, out %d, ws %zu < %zu)\n", n_in, out_size, ws_size, (size_t)WS_END); grid = -1; return; }
        int dev = 0, cus = 0, per_cu = 0;
        if (hipGetDevice(&dev) != hipSuccess || hipDeviceGetAttribute(&cus, hipDeviceAttributeMultiprocessorCount, dev) != hipSuccess) { grid = -1; return; }
        if (hipFuncSetAttribute((const void*)trunk_fwd, hipFuncAttributeMaxDynamicSharedMemorySize, LDS_BYTES) != hipSuccess) { fprintf(stderr, "kernel_launch: hipFuncSetAttribute failed\n"); grid = -1; return; }
        if (hipOccupancyMaxActiveBlocksPerMultiprocessor(&per_cu, (const void*)trunk_fwd, NTHR, LDS_BYTES) != hipSuccess || per_cu < 1) fprintf(stderr, "kernel_launch: occupancy query says %d\n", per_cu);
        (void)hipGetLastError();
        grid = cus;
    }
    if (grid < 0) return;
    if (hipMemsetAsync((char*)d_ws + WS_CTL, 0, CTL_ZERO_BYTES, stream) != hipSuccess) return;
    Args a{};
    for (int i = 0; i < 18; ++i) a.in[i] = d_in[i];
    a.out = (float*)d_out; a.ws = (unsigned char*)d_ws;
    hipLaunchKernelGGL(trunk_fwd, dim3(grid), dim3(NTHR), LDS_BYTES, stream, a);
}
```

```cpp
#include <hip/hip_runtime.h>
#include <cstdio>
#include <cstdint>
namespace pg8 {
#define PG8_LAS __attribute__((address_space(3)))
typedef unsigned short bf16_t;
typedef short bf16x8 __attribute__((ext_vector_type(8)));
typedef float f32x4 __attribute__((ext_vector_type(4)));
typedef unsigned u32x4 __attribute__((ext_vector_type(4)));
constexpr int BM = 256, BK = 64, HALF = 128, HTB = HALF * BK * 2  , STAGE_BYTES = 8 * HTB, NXCD = 8, WGM = 8;

__host__ __device__ __forceinline__ int lds_byte(int r, int c) { const int st = (r >> 4) * 2 + (c >> 5), rr = r & 15, cc = c & 31, ob = rr * 64 + cc * 2; return st * 1024 + (ob ^ (((ob >> 9) & 1) << 5)); }
__host__ __device__ __forceinline__ void stage_rc(int b, int& R, int& C) { const int st = b / 1024, sb = b % 1024, swz = sb ^ (((sb >> 9) & 1) << 5); R = (st >> 1) * 16 + swz / 64; C = (st & 1) * 32 + (swz % 64) / 2; }
__host__ __device__ __forceinline__ int perm32(int rho) { const int n = rho >> 4, i = rho & 15; return 8 * (i >> 2) + 4 * n + (i & 3); }

struct Unit { int pm, pn; };
struct Gemm { const bf16_t* A; const bf16_t* Bt; int M, N, K; };

struct StaticOrder {
    int nM, nN, nwg, G, c;
    __host__ __device__ void init(int M, int N, int G_, int c_) { nM = M / BM; nN = N / BM; nwg = nM * nN; G = G_; c = c_; }
    __host__ __device__ bool next(int i, Unit& u) const {
        const long L = (long)i * G + c; if (L >= nwg) return false;
        int wgid = (int)L; { const int q = nwg / NXCD, r = nwg % NXCD, xcd = wgid % NXCD, off = wgid / NXCD; wgid = (xcd < r ? xcd * (q + 1) : r * (q + 1) + (xcd - r) * q) + off; }
        const int nig = WGM * nN, gid = wgid / nig, fm = gid * WGM, gsz = (nM - fm) < WGM ? (nM - fm) : WGM;
        u.pm = fm + ((wgid % nig) % gsz); u.pn = (wgid % nig) / gsz; return true;
    }
    __device__ __forceinline__ void a_ready(const Unit&) const {}
    __device__ __forceinline__ void done(const Unit&) const {}
};

__device__ __forceinline__ unsigned cvt_pk_bf16(float lo, float hi) { unsigned r; asm volatile("v_cvt_pk_bf16_f32 %0, %1, %2" : "=v"(r) : "v"(lo), "v"(hi)); return r; }
typedef float f32x2 __attribute__((ext_vector_type(2)));
__device__ __forceinline__ f32x2 gelu_pk(f32x2 v) {
    const f32x2 av = __builtin_elementwise_abs(v), d = av * 0.2316418882f + 1.0f;
    f32x2 t; t.x = __builtin_amdgcn_rcpf(d.x); t.y = __builtin_amdgcn_rcpf(d.y);
    f32x2 q = t * 0.5307027145f + (-0.7265760135f); q = q * t + 0.7107068705f; q = q * t + (-0.142248368f); q = q * t + 0.127414796f; q = q * t;
    const f32x2 s = (v * v) * (-0.72134752044f);
    f32x2 e; e.x = __builtin_amdgcn_exp2f(s.x); e.y = __builtin_amdgcn_exp2f(s.y);
    const f32x2 m = v * (q * e), r = v - m;
    f32x2 o; o.x = v.x < 0.f ? m.x : r.x; o.y = v.y < 0.f ? m.y : r.y; return o;
}

template <int ACT  > struct EpiBf16 {
    static constexpr bool PERM = true, AFTER_DRAIN = false; static_assert(ACT == 0 || ACT == 1, "EpiBf16: ACT is 0 (none) or 1 (gelu_pk)");
    bf16_t* O; int ldc; const float* bias; int split_cols; size_t split_stride; float scale0;
    __device__ __forceinline__ void operator()(const f32x4 (&acc)[2][2][4][2], const Unit& u, int wr, int wc, int fr, int fq) const {
        const int row0 = u.pm * BM + wr * 64 + fr; int colt = u.pn * BM; bf16_t* base = O;
        float sc = 1.f; if (split_cols) { const int t = colt / split_cols; base += (size_t)t * split_stride; colt -= t * split_cols; if (t == 0) sc = scale0; }
        const int col0 = colt + wc * 32 + 8 * fq, bcol0 = u.pn * BM + wc * 32 + 8 * fq;
        f32x4 bv[2][2];
#pragma unroll
        for (int bj = 0; bj < 2; ++bj)
#pragma unroll
            for (int n = 0; n < 2; ++n) bv[bj][n] = bias ? *(const f32x4*)(bias + bcol0 + bj * HALF + 4 * n) : (f32x4){0.f, 0.f, 0.f, 0.f};
#pragma unroll
        for (int ai = 0; ai < 2; ++ai)
#pragma unroll
            for (int m = 0; m < 4; ++m) { bf16_t* rowp = base + (size_t)(row0 + ai * HALF + m * 16) * ldc + col0;
#pragma unroll
                for (int bj = 0; bj < 2; ++bj) { f32x4 v0 = acc[ai][bj][m][0] + bv[bj][0], v1 = acc[ai][bj][m][1] + bv[bj][1];
                    if (ACT == 1) { f32x2 a = gelu_pk((f32x2){v0[0], v0[1]}), b = gelu_pk((f32x2){v0[2], v0[3]}), c = gelu_pk((f32x2){v1[0], v1[1]}), d = gelu_pk((f32x2){v1[2], v1[3]});
                        v0 = (f32x4){a.x, a.y, b.x, b.y}; v1 = (f32x4){c.x, c.y, d.x, d.y}; }
                    v0 = v0 * sc; v1 = v1 * sc; u32x4 w; w.x = cvt_pk_bf16(v0[0], v0[1]); w.y = cvt_pk_bf16(v0[2], v0[3]); w.z = cvt_pk_bf16(v1[0], v1[1]); w.w = cvt_pk_bf16(v1[2], v1[3]);
                    *(u32x4*)(rowp + bj * HALF) = w; } }
    }
};

struct EpiResF32 {
    static constexpr bool PERM = false, AFTER_DRAIN = false;
    const float* base; float* out; int ldc;
    __device__ __forceinline__ void operator()(const f32x4 (&acc)[2][2][4][2], const Unit& u, int wr, int wc, int fr, int fq) const {
        const int row0 = u.pm * BM + wr * 64 + fr, col0 = u.pn * BM + wc * 32 + 4 * fq;
#pragma unroll
        for (int ai = 0; ai < 2; ++ai)
#pragma unroll
            for (int m = 0; m < 4; ++m) { const size_t off = (size_t)(row0 + ai * HALF + m * 16) * ldc + col0;
#pragma unroll
                for (int bj = 0; bj < 2; ++bj)
#pragma unroll
                    for (int n = 0; n < 2; ++n) { const f32x4 b = *(const f32x4*)(base + off + bj * HALF + n * 16); *(f32x4*)(out + off + bj * HALF + n * 16) = b + acc[ai][bj][m][n]; }
                asm volatile("" ::: "memory"); }
    }
};
struct EpiGate {
    static constexpr bool PERM = false, AFTER_DRAIN = false;
    float* h; const bf16_t* pp; int ldc;
    __device__ __forceinline__ void operator()(const f32x4 (&acc)[2][2][4][2], const Unit& u, int wr, int wc, int fr, int fq) const {
        typedef unsigned u32x2v __attribute__((ext_vector_type(2)));
        const int row0 = u.pm * BM + wr * 64 + fr, col0 = u.pn * BM + wc * 32 + 4 * fq;
#pragma unroll
        for (int ai = 0; ai < 2; ++ai)
#pragma unroll
            for (int m = 0; m < 4; ++m) { const size_t off = (size_t)(row0 + ai * HALF + m * 16) * ldc + col0;
#pragma unroll
                for (int bj = 0; bj < 2; ++bj)
#pragma unroll
                    for (int n = 0; n < 2; ++n) { const size_t o = off + bj * HALF + n * 16;
                        const f32x4 hv = *(const f32x4*)(h + o); const u32x2v pv = *(const u32x2v*)(pp + o); const f32x4 a = acc[ai][bj][m][n];
                        f32x4 p; p[0] = __uint_as_float(pv.x << 16); p[1] = __uint_as_float(pv.x & 0xffff0000u); p[2] = __uint_as_float(pv.y << 16); p[3] = __uint_as_float(pv.y & 0xffff0000u);
                        f32x4 r;
#pragma unroll
                        for (int j = 0; j < 4; ++j) { const float g = __builtin_amdgcn_rcpf(1.0f + __expf(-a[j])); r[j] = hv[j] + g * p[j]; }
                        *(f32x4*)(h + o) = r; }
                asm volatile("" ::: "memory"); }
    }
};

__device__ __forceinline__ float shx16(float v, int o, int lane) { return __int_as_float(__builtin_amdgcn_ds_bpermute((lane ^ o) << 2, __float_as_int(v))); }
struct EpiBf16Row {
    static constexpr bool PERM = true, AFTER_DRAIN = false;
    bf16_t* O; int ldc; const float* rs; bf16_t* hm; bf16_t* iq; bf16_t* ik; int c_hm0, c_hm1, c_iq0, c_ik0, seq;
    __device__ __forceinline__ void operator()(const f32x4 (&acc)[2][2][4][2], const Unit& u, int wr, int wc, int fr, int fq) const {
        const int row0 = u.pm * BM + wr * 64 + fr;
        bf16_t* bp[2]; size_t rstride[2]; bool live[2];
#pragma unroll
        for (int bj = 0; bj < 2; ++bj) { const int colb = u.pn * BM + bj * HALF; live[bj] = true;
            if (colb >= c_hm0 && colb < c_hm1) { const int rel = colb - c_hm0, which = rel >> 10, hh = (rel >> 7) & 7; bp[bj] = hm + ((size_t)(which * 8 + hh) * seq) * 128 + wc * 32 + 8 * fq; rstride[bj] = 128; }
            else if (colb >= c_iq0 && colb < c_ik0) { bp[bj] = iq + (colb - c_iq0) + wc * 32 + 8 * fq; rstride[bj] = 1024; }
            else if (colb == c_ik0) { bp[bj] = ik + wc * 32 + 8 * fq; rstride[bj] = 64; live[bj] = wc < 2; }
            else { bp[bj] = O + colb + wc * 32 + 8 * fq; rstride[bj] = (size_t)ldc; } }
#pragma unroll
        for (int ai = 0; ai < 2; ++ai)
#pragma unroll
            for (int m = 0; m < 4; ++m) { const int row = row0 + ai * HALF + m * 16; const float s = rs[row];
#pragma unroll
                for (int bj = 0; bj < 2; ++bj) { const f32x4 v0 = acc[ai][bj][m][0] * s, v1 = acc[ai][bj][m][1] * s;
                    u32x4 w; w.x = cvt_pk_bf16(v0[0], v0[1]); w.y = cvt_pk_bf16(v0[2], v0[3]); w.z = cvt_pk_bf16(v1[0], v1[1]); w.w = cvt_pk_bf16(v1[2], v1[3]);
                    if (live[bj]) *(u32x4*)(bp[bj] + (size_t)row * rstride[bj]) = w; } }
    }
};
struct EpiResF32N {
    static constexpr bool PERM = false, AFTER_DRAIN = false;
    const float* base; float* out; bf16_t* hb; float* part; int ldc;
    __device__ __forceinline__ void operator()(const f32x4 (&acc)[2][2][4][2], const Unit& u, int wr, int wc, int fr, int fq) const {
        typedef unsigned u32x2v __attribute__((ext_vector_type(2)));
        const int row0 = u.pm * BM + wr * 64 + fr, col0 = u.pn * BM + wc * 32 + 4 * fq, lane = fq * 16 + fr;
#pragma unroll
        for (int ai = 0; ai < 2; ++ai)
#pragma unroll
            for (int m = 0; m < 4; ++m) { const int row = row0 + ai * HALF + m * 16; const size_t off = (size_t)row * ldc + col0; float ss = 0.f;
#pragma unroll
                for (int bj = 0; bj < 2; ++bj)
#pragma unroll
                    for (int n = 0; n < 2; ++n) { const size_t o = off + bj * HALF + n * 16; const f32x4 r = *(const f32x4*)(base + o) + acc[ai][bj][m][n]; *(f32x4*)(out + o) = r;
                        u32x2v w; w.x = cvt_pk_bf16(r[0], r[1]); w.y = cvt_pk_bf16(r[2], r[3]); *(u32x2v*)(hb + o) = w; ss += (r[0] * r[0] + r[1] * r[1]) + (r[2] * r[2] + r[3] * r[3]); }
                ss += shx16(ss, 16, lane); ss += shx16(ss, 32, lane);
                if (fq == 0) part[(size_t)row * 64 + u.pn * 4 + wc] = ss;
                if (m & 1) asm volatile("" ::: "memory"); }
    }
};
struct EpiGateN {
    static constexpr bool PERM = false, AFTER_DRAIN = false;
    float* h; const bf16_t* pp; const float* rs; bf16_t* hb; float* part; int ldc;
    __device__ __forceinline__ void operator()(const f32x4 (&acc)[2][2][4][2], const Unit& u, int wr, int wc, int fr, int fq) const {
        typedef unsigned u32x2v __attribute__((ext_vector_type(2)));
        const int row0 = u.pm * BM + wr * 64 + fr, col0 = u.pn * BM + wc * 32 + 4 * fq, lane = fq * 16 + fr;
#pragma unroll
        for (int ai = 0; ai < 2; ++ai)
#pragma unroll
            for (int m = 0; m < 4; ++m) { const int row = row0 + ai * HALF + m * 16; const size_t off = (size_t)row * ldc + col0; const float s = rs[row]; float ss = 0.f;
#pragma unroll
                for (int bj = 0; bj < 2; ++bj)
#pragma unroll
                    for (int n = 0; n < 2; ++n) { const size_t o = off + bj * HALF + n * 16;
                        const f32x4 hv = *(const f32x4*)(h + o); const u32x2v pv = *(const u32x2v*)(pp + o); const f32x4 a = acc[ai][bj][m][n] * s;
                        f32x4 p; p[0] = __uint_as_float(pv.x << 16); p[1] = __uint_as_float(pv.x & 0xffff0000u); p[2] = __uint_as_float(pv.y << 16); p[3] = __uint_as_float(pv.y & 0xffff0000u);
                        f32x4 r;
#pragma unroll
                        for (int j = 0; j < 4; ++j) { const float g = __builtin_amdgcn_rcpf(1.0f + __expf(-a[j])); r[j] = hv[j] + g * p[j]; }
                        *(f32x4*)(h + o) = r; u32x2v w; w.x = cvt_pk_bf16(r[0], r[1]); w.y = cvt_pk_bf16(r[2], r[3]); *(u32x2v*)(hb + o) = w; ss += (r[0] * r[0] + r[1] * r[1]) + (r[2] * r[2] + r[3] * r[3]); }
                ss += shx16(ss, 16, lane); ss += shx16(ss, 32, lane);
                if (fq == 0) part[(size_t)row * 64 + u.pn * 4 + wc] = ss;
                if (m & 1) asm volatile("" ::: "memory"); }
    }
};

__device__ __forceinline__ void unpk8(const u32x4 w, float (&f)[8]) { f[0] = __uint_as_float(w.x << 16); f[1] = __uint_as_float(w.x & 0xffff0000u); f[2] = __uint_as_float(w.y << 16); f[3] = __uint_as_float(w.y & 0xffff0000u);
    f[4] = __uint_as_float(w.z << 16); f[5] = __uint_as_float(w.z & 0xffff0000u); f[6] = __uint_as_float(w.w << 16); f[7] = __uint_as_float(w.w & 0xffff0000u); }
struct EpiResB {
    static constexpr bool PERM = true, AFTER_DRAIN = false;
    const bf16_t* base; bf16_t* out; float* part; int ldc;
    __device__ __forceinline__ void operator()(const f32x4 (&acc)[2][2][4][2], const Unit& u, int wr, int wc, int fr, int fq) const {
        const int row0 = u.pm * BM + wr * 64 + fr, col0 = u.pn * BM + wc * 32 + 8 * fq, lane = fq * 16 + fr;
#pragma unroll
        for (int ai = 0; ai < 2; ++ai)
#pragma unroll
            for (int m = 0; m < 4; ++m) { const int row = row0 + ai * HALF + m * 16; const size_t off = (size_t)row * ldc + col0; float ss = 0.f;
#pragma unroll
                for (int bj = 0; bj < 2; ++bj) { const size_t o = off + bj * HALF; float b[8], r[8]; unpk8(*(const u32x4*)(base + o), b);
#pragma unroll
                    for (int j = 0; j < 4; ++j) { r[j] = b[j] + acc[ai][bj][m][0][j]; r[4 + j] = b[4 + j] + acc[ai][bj][m][1][j]; }
                    u32x4 w; w.x = cvt_pk_bf16(r[0], r[1]); w.y = cvt_pk_bf16(r[2], r[3]); w.z = cvt_pk_bf16(r[4], r[5]); w.w = cvt_pk_bf16(r[6], r[7]); *(u32x4*)(out + o) = w;
#pragma unroll
                    for (int j = 0; j < 8; ++j) ss += r[j] * r[j]; }
                ss += shx16(ss, 16, lane); ss += shx16(ss, 32, lane);
                if (fq == 0) part[(size_t)row * 64 + u.pn * 4 + wc] = ss;
                if (m & 1) asm volatile("" ::: "memory"); }
    }
};
struct EpiGateB {
    static constexpr bool PERM = true, AFTER_DRAIN = false;
    const bf16_t* hin; const bf16_t* pp; const float* rs; bf16_t* out; float* part; int ldc;
    __device__ __forceinline__ void operator()(const f32x4 (&acc)[2][2][4][2], const Unit& u, int wr, int wc, int fr, int fq) const {
        const int row0 = u.pm * BM + wr * 64 + fr, col0 = u.pn * BM + wc * 32 + 8 * fq, lane = fq * 16 + fr;
#pragma unroll
        for (int ai = 0; ai < 2; ++ai)
#pragma unroll
            for (int m = 0; m < 4; ++m) { const int row = row0 + ai * HALF + m * 16; const size_t off = (size_t)row * ldc + col0; const float s = rs[row]; float ss = 0.f;
#pragma unroll
                for (int bj = 0; bj < 2; ++bj) { const size_t o = off + bj * HALF; float hf[8], pf[8], r[8]; unpk8(*(const u32x4*)(hin + o), hf); unpk8(*(const u32x4*)(pp + o), pf);
#pragma unroll
                    for (int j = 0; j < 8; ++j) { const float a = (j < 4 ? acc[ai][bj][m][0][j & 3] : acc[ai][bj][m][1][j & 3]) * s; const float g = __builtin_amdgcn_rcpf(1.0f + __expf(-a)); r[j] = hf[j] + g * pf[j]; }
                    u32x4 w; w.x = cvt_pk_bf16(r[0], r[1]); w.y = cvt_pk_bf16(r[2], r[3]); w.z = cvt_pk_bf16(r[4], r[5]); w.w = cvt_pk_bf16(r[6], r[7]); *(u32x4*)(out + o) = w;
#pragma unroll
                    for (int j = 0; j < 8; ++j) ss += r[j] * r[j]; }
                ss += shx16(ss, 16, lane); ss += shx16(ss, 32, lane);
                if (fq == 0) part[(size_t)row * 64 + u.pn * 4 + wc] = ss;
                if (m & 1) asm volatile("" ::: "memory"); }
    }
};
template <class Epi, class Sched, bool ALIGN_EPI = false, bool SP2 = false>
__device__ __forceinline__ void gemm_phase(PG8_LAS unsigned char* lds, const Gemm g, const Sched& S, const Epi& E) {
    int tid_ = threadIdx.x; asm volatile("" : "+v"(tid_));
    const int tid = tid_, wid = __builtin_amdgcn_readfirstlane(tid >> 6), lane = tid & 63, wr = wid >> 2, wc = wid & 3, fr = lane & 15, fq = lane >> 4;
    const int K = g.K, nt = K / BK;
    unsigned voffA[2], voffB[2];
#pragma unroll
    for (int i = 0; i < 2; ++i) { int R, C; stage_rc(tid * 16 + i * 8192, R, C); const int Rb = Epi::PERM ? ((R & ~31) + perm32(R & 31)) : R;
        voffA[i] = (unsigned)(R * K + C) * 2u; voffB[i] = (unsigned)(Rb * K + C) * 2u; }
    const size_t kstep = (size_t)(BK * 2);
    const size_t hstep = (size_t)HALF * K * 2;
    const size_t tstep = 2 * hstep;
    const unsigned ldsw = (unsigned)wid * 1024u;
    const int aoff = lds_byte(wr * 64 + fr, fq * 8), boff = lds_byte(wc * 32 + fr, fq * 8);
#define PG8_SA(b, h) (((b) * 2 + (h)) * HTB)
#define PG8_SB(b, h) ((4 + (b) * 2 + (h)) * HTB)
#define PG8_STAGE(bufoff, gbase, voff) do { _Pragma("unroll") for (int _i = 0; _i < 2; ++_i) \
        __builtin_amdgcn_global_load_lds((const unsigned*)((const char*)(gbase) + (voff)[_i]), (PG8_LAS unsigned*)(lds + (bufoff) + ldsw + _i * 8192), 16, 0, 0); } while (0)
#define PG8_LDA(dst, b, h) do { _Pragma("unroll") for (int m = 0; m < 4; ++m) _Pragma("unroll") for (int k = 0; k < 2; ++k) dst[m][k] = *(const PG8_LAS bf16x8*)(lds + PG8_SA(b, h) + aoff + m * 2048 + k * 1024); } while (0)
#define PG8_LDB(dst, b, h) do { _Pragma("unroll") for (int n = 0; n < 2; ++n) _Pragma("unroll") for (int k = 0; k < 2; ++k) dst[n][k] = *(const PG8_LAS bf16x8*)(lds + PG8_SB(b, h) + boff + n * 2048 + k * 1024); } while (0)
#define PG8_MMA(ai, bj, At, Bt) do { __builtin_amdgcn_s_setprio(1); _Pragma("unroll") for (int m = 0; m < 4; ++m) _Pragma("unroll") for (int n = 0; n < 2; ++n) _Pragma("unroll") for (int k = 0; k < 2; ++k) \
        acc[ai][bj][m][n] = __builtin_amdgcn_mfma_f32_16x16x32_bf16(Bt[n][k], At[m][k], acc[ai][bj][m][n], 0, 0, 0); __builtin_amdgcn_s_setprio(0); } while (0)
#define PG8_WAIT_V(n) asm volatile("s_waitcnt vmcnt(" #n ")" ::: "memory")
#define PG8_WAIT_L(n) asm volatile("s_waitcnt lgkmcnt(" #n ")" ::: "memory")
#define PG8_BAR __builtin_amdgcn_s_barrier()
#define PG8_SCHED __builtin_amdgcn_sched_barrier(0)
    Unit cur, nxt; int ui = 0;
    if (!S.next(0, cur)) return;
    f32x4 acc[2][2][4][2];
#pragma unroll
    for (int a = 0; a < 2; ++a)
#pragma unroll
        for (int b = 0; b < 2; ++b)
#pragma unroll
            for (int m = 0; m < 4; ++m)
#pragma unroll
                for (int n = 0; n < 2; ++n) acc[a][b][m][n] = (f32x4){0.f, 0.f, 0.f, 0.f};
    bf16x8 At[4][2], B0[2][2], B1[2][2];
    const char* cA = (const char*)g.A + (size_t)cur.pm * tstep; const char* cB = (const char*)g.Bt + (size_t)cur.pn * tstep;
    S.a_ready(cur);
    if constexpr (SP2) {
        PG8_STAGE(PG8_SB(0, 0), cB, voffB); PG8_STAGE(PG8_SB(0, 1), cB + hstep, voffB); PG8_STAGE(PG8_SA(0, 0), cA, voffA); PG8_STAGE(PG8_SA(0, 1), cA + hstep, voffA);
        if (wr == 1) PG8_BAR;
        PG8_WAIT_V(2); PG8_BAR;
        PG8_STAGE(PG8_SB(1, 0), cB + kstep, voffB); PG8_STAGE(PG8_SA(1, 0), cA + kstep, voffA); PG8_STAGE(PG8_SB(1, 1), cB + hstep + kstep, voffB);
        PG8_WAIT_V(6); PG8_BAR;
    } else {
        PG8_STAGE(PG8_SB(0, 0), cB, voffB); PG8_STAGE(PG8_SA(0, 0), cA, voffA); PG8_STAGE(PG8_SB(0, 1), cB + hstep, voffB); PG8_STAGE(PG8_SA(0, 1), cA + hstep, voffA);
        if (wr == 1) PG8_BAR;
        PG8_WAIT_V(4); PG8_BAR;
        PG8_STAGE(PG8_SB(1, 0), cB + kstep, voffB); PG8_STAGE(PG8_SA(1, 0), cA + kstep, voffA); PG8_STAGE(PG8_SB(1, 1), cB + hstep + kstep, voffB);
        PG8_WAIT_V(6); PG8_BAR;
    }
    for (;;) {
        const bool has_next = S.next(ui + 1, nxt);
        const char* nA = has_next ? (const char*)g.A + (size_t)nxt.pm * tstep : cA; const char* nB = has_next ? (const char*)g.Bt + (size_t)nxt.pn * tstep : cB;
#pragma nounroll
        for (int t = 0; t < nt; t += 2) {
            const bool last = (t == nt - 2);
            const char* a1 = cA + (size_t)(t + 1) * kstep;
            const char* a2 = last ? nA : cA + (size_t)(t + 2) * kstep; const char* b2 = last ? nB : cB + (size_t)(t + 2) * kstep;
            const char* a3 = a2 + kstep; const char* b3 = b2 + kstep;
            if (last && has_next) S.a_ready(nxt);
            if constexpr (SP2) {
            PG8_LDB(B0, 0, 0); PG8_LDB(B1, 0, 1); PG8_SCHED; PG8_LDA(At, 0, 0); PG8_STAGE(PG8_SA(1, 1), a1 + hstep, voffA);
            PG8_WAIT_V(8); PG8_WAIT_L(0); PG8_BAR; PG8_MMA(0, 0, At, B0); PG8_MMA(0, 1, At, B1); PG8_BAR; PG8_SCHED;
            PG8_LDA(At, 0, 1); PG8_STAGE(PG8_SB(0, 0), b2, voffB); PG8_STAGE(PG8_SB(0, 1), b2 + hstep, voffB); PG8_STAGE(PG8_SA(0, 0), a2, voffA);
            PG8_WAIT_V(8); PG8_WAIT_L(0); PG8_BAR; PG8_MMA(1, 0, At, B0); PG8_MMA(1, 1, At, B1); PG8_BAR; PG8_SCHED;
            PG8_LDB(B0, 1, 0); PG8_LDB(B1, 1, 1); PG8_SCHED; PG8_LDA(At, 1, 0); PG8_STAGE(PG8_SA(0, 1), a2 + hstep, voffA);
            PG8_WAIT_V(8); PG8_WAIT_L(0); PG8_BAR; PG8_MMA(0, 0, At, B0); PG8_MMA(0, 1, At, B1); PG8_BAR; PG8_SCHED;
            PG8_LDA(At, 1, 1); PG8_STAGE(PG8_SB(1, 0), b3, voffB); PG8_STAGE(PG8_SB(1, 1), b3 + hstep, voffB); PG8_STAGE(PG8_SA(1, 0), a3, voffA);
            PG8_WAIT_V(8); PG8_WAIT_L(0); PG8_BAR; PG8_MMA(1, 0, At, B0); PG8_MMA(1, 1, At, B1); PG8_BAR; PG8_SCHED;
            } else {
            PG8_LDB(B0, 0, 0); PG8_SCHED; PG8_LDA(At, 0, 0); PG8_STAGE(PG8_SA(1, 1), a1 + hstep, voffA);
            PG8_WAIT_L(8); PG8_BAR; PG8_WAIT_L(0); PG8_MMA(0, 0, At, B0); PG8_BAR; PG8_SCHED;
            PG8_LDB(B1, 0, 1); PG8_STAGE(PG8_SB(0, 0), b2, voffB);
            PG8_BAR; PG8_WAIT_L(0); PG8_MMA(0, 1, At, B1); PG8_BAR;
            PG8_LDA(At, 0, 1); PG8_STAGE(PG8_SA(0, 0), a2, voffA);
            PG8_BAR; PG8_WAIT_L(0); PG8_MMA(1, 0, At, B0); PG8_BAR; PG8_SCHED;
            PG8_STAGE(PG8_SB(0, 1), b2 + hstep, voffB);
            PG8_WAIT_V(6); PG8_BAR; PG8_MMA(1, 1, At, B1); PG8_BAR;
            PG8_LDB(B0, 1, 0); PG8_SCHED; PG8_LDA(At, 1, 0); PG8_STAGE(PG8_SA(0, 1), a2 + hstep, voffA);
            PG8_WAIT_L(8); PG8_BAR; PG8_WAIT_L(0); PG8_MMA(0, 0, At, B0); PG8_BAR; PG8_SCHED;
            PG8_LDB(B1, 1, 1); PG8_STAGE(PG8_SB(1, 0), b3, voffB);
            PG8_BAR; PG8_WAIT_L(0); PG8_MMA(0, 1, At, B1); PG8_BAR;
            PG8_LDA(At, 1, 1); PG8_STAGE(PG8_SA(1, 0), a3, voffA);
            PG8_BAR; PG8_WAIT_L(0); PG8_MMA(1, 0, At, B0); PG8_BAR; PG8_SCHED;
            PG8_STAGE(PG8_SB(1, 1), b3 + hstep, voffB);
            PG8_WAIT_V(6); PG8_BAR; PG8_MMA(1, 1, At, B1); PG8_BAR;
            }
        }
        if constexpr (ALIGN_EPI) { if (wr == 0) PG8_BAR; }
        if constexpr (!Epi::AFTER_DRAIN) { E(acc, cur, wr, wc, fr, fq); S.done(cur); }
        if (!has_next) break;
#pragma unroll
        for (int a = 0; a < 2; ++a)
#pragma unroll
            for (int b = 0; b < 2; ++b)
#pragma unroll
                for (int m = 0; m < 4; ++m)
#pragma unroll
                    for (int n = 0; n < 2; ++n) acc[a][b][m][n] = (f32x4){0.f, 0.f, 0.f, 0.f};
        cur = nxt; cA = nA; cB = nB; ++ui;
        if constexpr (ALIGN_EPI) { if (wr == 1) PG8_BAR; }
    }
    PG8_WAIT_V(0);
    if constexpr (!ALIGN_EPI) { if (wr == 0) PG8_BAR; }
    PG8_BAR;
    if constexpr (Epi::AFTER_DRAIN) { E.fused(acc, cur, wr, wc, fr, fq, lds, wid, lane); S.done(cur); }
#undef PG8_SA
#undef PG8_SB
#undef PG8_STAGE
#undef PG8_LDA
#undef PG8_LDB
#undef PG8_MMA
#undef PG8_WAIT_V
#undef PG8_WAIT_L
#undef PG8_BAR
#undef PG8_SCHED
}
}

constexpr int SEQ = 16384, DM = 4096, DEPTH = 4, DPLE = 256;
constexpr int INW = 15980;
constexpr int ZW = 16384;
constexpr float NORM_EPS = 1e-6f;
constexpr int ZQ_A = 0, ZK_A = 768, ZV_A = 1536, ZLOW = 3072, ZGATE_A = 3200;
constexpr int ZQ_B = 4736, ZK_B = 5760, ZV_B = 6784, ZGATE_B = 7808, ZIQ = 8832, ZIK = 9856, ZIW = 9984;
constexpr int ZQ_C = 10112, ZK_C = 10880, ZV_C = 11648, ZIF = 13184, ZO_C = 13312, ZGATE_C = 14848;
constexpr int YA = 0, YB = 1536, YC = 2560;
constexpr int NCH = SEQ / 64;

constexpr size_t MiB = 1u << 20;
constexpr size_t WS_CTL = 0, CTL_ZERO_BYTES = 1 * MiB;
constexpr size_t WS_ROPE = 1 * MiB;
constexpr size_t WS_PBF = 4 * MiB;
constexpr size_t WS_WPLE = 36 * MiB;
constexpr size_t WS_WOUT = 44 * MiB;
constexpr size_t WS_WGATE = 172 * MiB;
constexpr size_t WS_WIN = 300 * MiB;
constexpr size_t WS_H = 812 * MiB;
constexpr size_t WS_QT = 812 * MiB;
constexpr size_t WS_U = 1068 * MiB;
constexpr size_t WS_Z = 1196 * MiB;
constexpr size_t WS_Y = 1708 * MiB;
constexpr size_t WS_PP = 1836 * MiB;
constexpr size_t WS_QA = 1964 * MiB, WS_KA = 1996 * MiB, WS_VA = 2028 * MiB;
constexpr size_t WS_IQ = 2060 * MiB;
constexpr size_t WS_IK = 2092 * MiB;
constexpr size_t WS_IW = 2094 * MiB;
constexpr size_t WS_MASK = 2096 * MiB;
constexpr size_t WS_BA = 2128 * MiB;
constexpr size_t WS_DS = 2176 * MiB;
constexpr size_t WS_SP = 2272 * MiB;
constexpr size_t WS_CQ = 2320 * MiB, WS_CK = 2344 * MiB;
constexpr size_t WS_MG = 2368 * MiB;
constexpr size_t WS_DC = 2372 * MiB;
constexpr size_t WS_CP = 2564 * MiB;
constexpr size_t WS_SCORE = 2660 * MiB;
constexpr size_t WS_HB2 = 3684 * MiB;
constexpr size_t WS_PART = 3812 * MiB;
constexpr size_t WS_RSTD = 3816 * MiB;
constexpr size_t WS_END = 3818 * MiB;
constexpr size_t MG_B = 0;
constexpr size_t MG_I = MG_B + (size_t)SEQ * 8;
constexpr size_t MG_ML = MG_I + (size_t)SEQ * 8;
constexpr size_t MG_MP = MG_ML + (size_t)NCH * 6 * 2;
constexpr size_t MG_DN = MG_MP + (size_t)NCH * 6;
constexpr size_t MG_NP = MG_DN + (size_t)NCH * 6 * 128;
static_assert((MG_NP + (size_t)NCH * 6 * 128) * 4 <= 4 * MiB, "mLSTM small arrays fit");

constexpr int CW_BAR = 4096;

constexpr int RING_BYTES = 131072;
constexpr int MISC_OFF = RING_BYTES + 320;
constexpr int LDS_BYTES = 147456;
constexpr int NWAVES = 8, NTHR = 512;

#define GAS __attribute__((address_space(1)))
#define LAS __attribute__((address_space(3)))
typedef unsigned short bf16;
typedef unsigned u32x4 __attribute__((ext_vector_type(4)));
typedef unsigned u32x2 __attribute__((ext_vector_type(2)));
typedef float f32x4 __attribute__((ext_vector_type(4)));
typedef float f32x2 __attribute__((ext_vector_type(2)));
typedef float f32x16 __attribute__((ext_vector_type(16)));
typedef short bf16x8 __attribute__((ext_vector_type(8)));
typedef short bf16x4 __attribute__((ext_vector_type(4)));
#define LDS_WAIT() asm volatile("s_waitcnt lgkmcnt(0)" ::: "memory")
#define VM_WAIT() asm volatile("s_waitcnt vmcnt(0)" ::: "memory")
#define TPOS(row_, s_, sh_) ((row_) * 72 + (((((s_) >> 3) ^ ((row_) >> (sh_))) & 7) << 3) + ((s_) & 7))
#define TRD(row_, chunk_, sh_) ((row_) * 72 + ((((chunk_) ^ ((row_) >> (sh_))) & 7) << 3))

__device__ __forceinline__ float bf2f(unsigned short b) { return __uint_as_float((unsigned)b << 16); }
__device__ __forceinline__ float bflo(unsigned w) { return __uint_as_float(w << 16); }
__device__ __forceinline__ float bfhi(unsigned w) { return __uint_as_float(w & 0xffff0000u); }
typedef __bf16 bf16x2_t __attribute__((ext_vector_type(2)));
__device__ __forceinline__ unsigned pk2(float lo, float hi) { const f32x2 v = {lo, hi}; const bf16x2_t b = __builtin_convertvector(v, bf16x2_t); return __builtin_bit_cast(unsigned, b); }
__device__ __forceinline__ unsigned short f2bf(float f) { return (unsigned short)(pk2(f, 0.f) & 0xffffu); }
__device__ __forceinline__ float shx(float v, int o, int lane) { return __int_as_float(__builtin_amdgcn_ds_bpermute((lane ^ o) << 2, __float_as_int(v))); }
__device__ __forceinline__ float shup(float v, int o, int lane) { return __int_as_float(__builtin_amdgcn_ds_bpermute(((lane - o) & 63) << 2, __float_as_int(v))); }
__device__ __forceinline__ unsigned shdn_u(unsigned v, int o, int lane) { return (unsigned)__builtin_amdgcn_ds_bpermute(((lane + o) & 63) << 2, (int)v); }
__device__ __forceinline__ float wave_sum(float v, int lane) {
#pragma unroll
    for (int o = 1; o < 64; o <<= 1) v += shx(v, o, lane);
    return v;
}
__device__ __forceinline__ float wave_max(float v, int lane) {
#pragma unroll
    for (int o = 1; o < 64; o <<= 1) v = fmaxf(v, shx(v, o, lane));
    return v;
}
__device__ __forceinline__ float log_sigmoidf(float x) { return fminf(x, 0.f) - log1pf(expf(-fabsf(x))); }
__device__ __forceinline__ float sigmoidf_(float x) { return __builtin_amdgcn_rcpf(1.0f + __expf(-x)); }
__device__ __forceinline__ float siluf_(float x) { return x * __builtin_amdgcn_rcpf(1.0f + __expf(-x)); }
__device__ __forceinline__ int crow(int r, int hi) { return (r & 3) + 8 * (r >> 2) + 4 * hi; }
__device__ __forceinline__ void unpack8(const u32x4 w, float (&f)[8]) { f[0] = bflo(w.x); f[1] = bfhi(w.x); f[2] = bflo(w.y); f[3] = bfhi(w.y); f[4] = bflo(w.z); f[5] = bfhi(w.z); f[6] = bflo(w.w); f[7] = bfhi(w.w); }
__device__ __forceinline__ u32x4 pack8f(const float (&f)[8]) { u32x4 o; o.x = pk2(f[0], f[1]); o.y = pk2(f[2], f[3]); o.z = pk2(f[4], f[5]); o.w = pk2(f[6], f[7]); return o; }
__device__ __forceinline__ int hw_lane() { int l; asm volatile("v_mbcnt_lo_u32_b32 %0, -1, 0\n\tv_mbcnt_hi_u32_b32 %0, -1, %0" : "=v"(l)); return l; }
#define XB_TMO      128
#define XB_XCNT(j)  (256  + 64 * (j))
#define XB_XSUB(j)  (1280 + 64 * (j))
#define XB_XGEN(j)  (2304 + 64 * (j))
#define XB_TOP      3328
#define XB_TOPGEN   3392
#define XCD_BAR_WORDS 3456
#define XB_SPIN_CAP (1u << 18)

__device__ __forceinline__ unsigned xb_ld(unsigned* p)              { return __hip_atomic_load(p, __ATOMIC_RELAXED, __HIP_MEMORY_SCOPE_AGENT); }
__device__ __forceinline__ unsigned xb_add(unsigned* p, unsigned v) { return __hip_atomic_fetch_add(p, v, __ATOMIC_RELAXED, __HIP_MEMORY_SCOPE_AGENT); }
__device__ __forceinline__ unsigned xb_xcc_id() { return (unsigned)__builtin_amdgcn_s_getreg((3 << 11) | 20) & 0xFu; }
#define XB_SPIN(cond, bar) do { unsigned _sp = 0; while (cond) { __builtin_amdgcn_s_sleep(1); \
    if ((++_sp & 255u) == 0u) { if (xb_ld(&(bar)[XB_TMO])) break; if (_sp > XB_SPIN_CAP) { atomicAdd(&(bar)[XB_TMO], 1u); break; } } } } while (0)

struct XcdBarrier {
    unsigned* bar; unsigned x;
    volatile LAS unsigned* st;
};

__device__ __forceinline__ XcdBarrier xcd_barrier_post(unsigned* bar, volatile LAS unsigned* st) {
    XcdBarrier b; b.bar = bar; b.x = xb_xcc_id(); b.st = st;
    if (threadIdx.x == 0) (void)xb_add(&bar[XB_XCNT(b.x)], 1u);
    return b;
}
__device__ __forceinline__ void xcd_barrier_complete(unsigned* bar, unsigned x, unsigned& nloc, unsigned& nx) {
    const unsigned G = gridDim.x * gridDim.y * gridDim.z;
    unsigned sum, cnt, mine, sp = 0u;
    for (;;) {
        sum = 0u; cnt = 0u; mine = 0u;
#pragma unroll
        for (unsigned j = 0; j < 16; ++j) { const unsigned c = xb_ld(&bar[XB_XCNT(j)]); sum += c; cnt += (c > 0u) ? 1u : 0u; mine = (j == x) ? c : mine; }
        if (sum == G) break;
        __builtin_amdgcn_s_sleep(1);
        if ((++sp & 255u) == 0u) { if (xb_ld(&bar[XB_TMO])) break; if (sp > XB_SPIN_CAP) { atomicAdd(&bar[XB_TMO], 1u); break; } }
    }
    nloc = mine > 0u ? mine : 1u; nx = cnt > 0u ? cnt : 1u;
}

__device__ __forceinline__ void xcd_barrier(const XcdBarrier& b) {
    asm volatile("s_waitcnt vmcnt(0)" ::: "memory");
    __syncthreads();
    if (threadIdx.x == 0) {
        unsigned* bar = b.bar;
        __builtin_amdgcn_s_waitcnt(0);
        unsigned nloc = b.st[0], nx = b.st[1];
        if (nloc == 0u) { xcd_barrier_complete(bar, b.x, nloc, nx); b.st[0] = nloc; b.st[1] = nx; }
        const unsigned old = xb_add(&bar[XB_XSUB(b.x)], 1u);
        const unsigned gen = old / nloc;
        if (old + 1u == (gen + 1u) * nloc) {
            __builtin_amdgcn_fence(__ATOMIC_RELEASE, "agent");
            asm volatile("s_waitcnt vmcnt(0)" ::: "memory");
            const unsigned og = xb_add(&bar[XB_TOP], 1u);
            const unsigned tg = og / nx;
            if (og + 1u == (tg + 1u) * nx) xb_add(&bar[XB_TOPGEN], 1u);
            else XB_SPIN(xb_ld(&bar[XB_TOPGEN]) == tg, bar);
            __builtin_amdgcn_fence(__ATOMIC_ACQUIRE, "agent");
            xb_add(&bar[XB_XGEN(b.x)], 1u);
            asm volatile("s_waitcnt vmcnt(0)" ::: "memory");
        } else {
            XB_SPIN(xb_ld(&bar[XB_XGEN(b.x)]) == gen, bar);
            __builtin_amdgcn_fence(__ATOMIC_ACQUIRE, "agent");
            asm volatile("s_waitcnt vmcnt(0)" ::: "memory");
        }
    }
    __syncthreads();
}

struct Frame {
    LAS unsigned char* lds;
    unsigned char* ws;
    int tid, lane, wave, G, vcu, gw, NGW;
};

__device__ __forceinline__ void zseg(int n0, int& src0, int& valid, float& cscale) {
    int d0, s0, sl;
    if (n0 < ZK_A) { d0 = ZQ_A; s0 = 0; sl = 768; }
    else if (n0 < ZV_A) { d0 = ZK_A; s0 = 768; sl = 768; }
    else if (n0 < ZLOW) { d0 = ZV_A; s0 = 1536; sl = 1536; }
    else if (n0 < ZGATE_A) { d0 = ZLOW; s0 = 3072; sl = 16; }
    else if (n0 < ZQ_B) { d0 = ZGATE_A; s0 = 3088; sl = 1536; }
    else if (n0 < ZK_B) { d0 = ZQ_B; s0 = 4624; sl = 1024; }
    else if (n0 < ZV_B) { d0 = ZK_B; s0 = 5648; sl = 1024; }
    else if (n0 < ZGATE_B) { d0 = ZV_B; s0 = 6672; sl = 1024; }
    else if (n0 < ZIQ) { d0 = ZGATE_B; s0 = 7696; sl = 1024; }
    else if (n0 < ZIK) { d0 = ZIQ; s0 = 8720; sl = 1024; }
    else if (n0 < ZIW) { d0 = ZIK; s0 = 9744; sl = 64; }
    else if (n0 < ZQ_C) { d0 = ZIW; s0 = 9808; sl = 16; }
    else if (n0 < ZK_C) { d0 = ZQ_C; s0 = 9824; sl = 768; }
    else if (n0 < ZV_C) { d0 = ZK_C; s0 = 10592; sl = 768; }
    else if (n0 < ZIF) { d0 = ZV_C; s0 = 11360; sl = 1536; }
    else if (n0 < ZO_C) { d0 = ZIF; s0 = 12896; sl = 12; }
    else if (n0 < ZGATE_C) { d0 = ZO_C; s0 = 12908; sl = 1536; }
    else { d0 = ZGATE_C; s0 = 14444; sl = 1536; }
    const int off = n0 - d0; int v = sl - off; v = v < 0 ? 0 : (v > 32 ? 32 : v);
    src0 = s0 + off; valid = v;
    cscale = (d0 == ZIQ) ? 0.0078125f : (d0 == ZIW) ? 2.0f : 1.0f;
}
__device__ __forceinline__ void transpose_item(const float* W, int K, int Nsrc, bf16* WT, int k0, int n0dst, int src0, int valid, LAS float* scr, int lane, const float* gk, const float cs = 1.0f) {
    const int j = lane & 31; const bool ok = j < valid;
    float vv[32];
    const float* wp = W + (size_t)(k0 + (lane >> 5)) * Nsrc + src0 + (ok ? j : 0);
#pragma unroll
    for (int i = 0; i < 32; ++i) vv[i] = wp[(size_t)(2 * i) * Nsrc];
#pragma unroll
    for (int i = 0; i < 32; ++i) { const int kk = 2 * i + (lane >> 5); const float gg = (gk ? gk[k0 + kk] : 1.0f) * cs; scr[kk * 33 + j] = ok ? vv[i] * gg : 0.f; }
    LDS_WAIT(); asm volatile("" ::: "memory");
    const int c = lane & 7;
#pragma unroll
    for (int jj = 0; jj < 4; ++jj) { const int n = (lane >> 3) + 8 * jj; const LAS float* s = scr + (8 * c) * 33 + n;
        u32x4 o; o.x = pk2(s[0 * 33], s[1 * 33]); o.y = pk2(s[2 * 33], s[3 * 33]); o.z = pk2(s[4 * 33], s[5 * 33]); o.w = pk2(s[6 * 33], s[7 * 33]);
        *(GAS u32x4*)(WT + (size_t)(n0dst + n) * K + k0 + 8 * c) = o; }
    LDS_WAIT(); asm volatile("" ::: "memory");
}
__device__ __forceinline__ void p0_prologue(const Frame& F, const float* w_in, const float* w_out, const float* w_ple_gate, const float* w_ple_proj, const float* pin, const int* pos, const float* g_in, const float* g_ple, const float* x) {
    LAS float* scr = (LAS float*)(F.lds + F.wave * 16384);
    constexpr int I_IN = (DM / 64) * (ZW / 32), I_SQ = (DM / 64) * (DM / 32), I_PL = (DPLE / 64) * (DM / 32), I_L = I_IN + 2 * I_SQ + I_PL;
    for (int it = F.gw; it < DEPTH * I_L; it += F.NGW) {
        const int L = it / I_L; int r = it - L * I_L;
        if (r < I_IN) { const int nb = r % (ZW / 32), kb = r / (ZW / 32); int s0, vd; float cs; zseg(nb * 32, s0, vd, cs);
            transpose_item(w_in + (size_t)L * DM * INW, DM, INW, (bf16*)(F.ws + WS_WIN) + (size_t)L * ZW * DM, kb * 64, nb * 32, s0, vd, scr, F.lane, g_in + (size_t)L * DM, cs); continue; }
        r -= I_IN;
        if (r < I_SQ) { const int nb = r % (DM / 32), kb = r / (DM / 32);
            transpose_item(w_out + (size_t)L * DM * DM, DM, DM, (bf16*)(F.ws + WS_WOUT) + (size_t)L * DM * DM, kb * 64, nb * 32, nb * 32, 32, scr, F.lane, nullptr); continue; }
        r -= I_SQ;
        if (r < I_SQ) { const int nb = r % (DM / 32), kb = r / (DM / 32);
            transpose_item(w_ple_gate + (size_t)L * DM * DM, DM, DM, (bf16*)(F.ws + WS_WGATE) + (size_t)L * DM * DM, kb * 64, nb * 32, nb * 32, 32, scr, F.lane, g_ple + (size_t)L * DM); continue; }
        r -= I_SQ;
        { const int nb = r % (DM / 32), kb = r / (DM / 32);
            transpose_item(w_ple_proj + (size_t)L * DPLE * DM, DPLE, DM, (bf16*)(F.ws + WS_WPLE) + (size_t)L * DM * DPLE, kb * 64, nb * 32, nb * 32, 32, scr, F.lane, nullptr); }
    }
    { bf16* hb = (bf16*)(F.ws + WS_U); float* rstd = (float*)(F.ws + WS_RSTD);
      for (int row = F.gw; row < SEQ; row += F.NGW) {
          const f32x4* xr = (const f32x4*)(x + (size_t)row * DM) + F.lane; f32x4 v[16]; float ss = 0.f;
#pragma unroll
          for (int j = 0; j < 16; ++j) { v[j] = xr[64 * j]; ss += (v[j][0] * v[j][0] + v[j][1] * v[j][1]) + (v[j][2] * v[j][2] + v[j][3] * v[j][3]); }
          ss = wave_sum(ss, F.lane); if (F.lane == 0) rstd[row] = 1.0f / sqrtf(ss * (1.0f / DM) + NORM_EPS);
          u32x2* o = (u32x2*)(hb + (size_t)row * DM) + F.lane;
#pragma unroll
          for (int j = 0; j < 16; ++j) { u32x2 w; w.x = pk2(v[j][0], v[j][1]); w.y = pk2(v[j][2], v[j][3]); o[64 * j] = w; } } }
    { const size_t n8 = (size_t)DEPTH * SEQ * DPLE / 8; bf16* pb = (bf16*)(F.ws + WS_PBF);
      for (size_t i = (size_t)blockIdx.x * NTHR + F.tid; i < n8; i += (size_t)F.G * NTHR) {
          const f32x4 a = *(const f32x4*)(pin + i * 8), b = *(const f32x4*)(pin + i * 8 + 4);
          u32x4 o; o.x = pk2(a[0], a[1]); o.y = pk2(a[2], a[3]); o.z = pk2(b[0], b[1]); o.w = pk2(b[2], b[3]);
          *(u32x4*)(pb + i * 8) = o; } }
    { float* cosA = (float*)(F.ws + WS_ROPE); float* sinA = cosA + (size_t)SEQ * 16; float* cosI = sinA + (size_t)SEQ * 16; float* sinI = cosI + (size_t)SEQ * 8;
      for (int i = blockIdx.x * NTHR + F.tid; i < SEQ * 24; i += F.G * NTHR) {
          const int t = i / 24, f = i % 24; const bool isA = f < 16; const int fi = isA ? f : f - 16; const double rot = isA ? 32.0 : 16.0;
          const float ex = -(float)(2 * fi) / (float)rot;
          const float inv = (float)exp((double)ex * 13.122363377404328);
          const float ang = (float)pos[t] * inv;
          const double a = (double)ang; const double n = rint(a * 0.15915494309189535);
          double rr = fma(-n, 6.283185307179586, a); rr = fma(-n, 2.4492935982947064e-16, rr);
          const float c = (float)cos(rr), s = (float)sin(rr);
          if (isA) { cosA[t * 16 + fi] = c; sinA[t * 16 + fi] = s; } else { cosI[t * 8 + fi] = c; sinI[t * 8 + fi] = s; } } }
}

__device__ __forceinline__ void reduce_rstd(const Frame& F) {
    const float* part = (const float*)(F.ws + WS_PART); float* rstd = (float*)(F.ws + WS_RSTD);
    for (int r4 = F.gw; r4 < SEQ / 4; r4 += F.NGW) { const int row = r4 * 4 + (F.lane >> 4); const f32x4 p = *(const f32x4*)(part + (size_t)row * 64 + (F.lane & 15) * 4);
        float s = (p[0] + p[1]) + (p[2] + p[3]); s += shx(s, 1, F.lane); s += shx(s, 2, F.lane); s += shx(s, 4, F.lane); s += shx(s, 8, F.lane);
        if ((F.lane & 15) == 0) rstd[row] = 1.0f / sqrtf(s * (1.0f / DM) + NORM_EPS); }
}
__device__ __forceinline__ void rmsnorm_to_bf16(const Frame& F, const float* src, const float* g, bf16* dst) {
    for (int row = F.gw; row < SEQ; row += F.NGW) {
        const f32x4* xr = (const f32x4*)(src + (size_t)row * DM) + F.lane; f32x4 v[16]; float ss = 0.f;
#pragma unroll
        for (int j = 0; j < 16; ++j) { v[j] = xr[64 * j]; ss += (v[j][0] * v[j][0] + v[j][1] * v[j][1]) + (v[j][2] * v[j][2] + v[j][3] * v[j][3]); }
        const float rs = 1.0f / sqrtf(wave_sum(ss, F.lane) * (1.0f / DM) + NORM_EPS);
        u32x2* o = (u32x2*)(dst + (size_t)row * DM) + F.lane;
#pragma unroll
        for (int j = 0; j < 16; ++j) { const f32x4 gv = ((const f32x4*)g)[F.lane + 64 * j]; u32x2 w; w.x = pk2(v[j][0] * rs * gv[0], v[j][1] * rs * gv[1]); w.y = pk2(v[j][2] * rs * gv[2], v[j][3] * rs * gv[3]); o[64 * j] = w; }
    }
}
__device__ __forceinline__ void rmsnorm_b2f(const Frame& F, const bf16* src, const float* g, float* dst) {
    for (int row = F.gw; row < SEQ; row += F.NGW) {
        const u32x4* xr = (const u32x4*)(src + (size_t)row * DM) + F.lane; float v[8][8]; float ss = 0.f;
#pragma unroll
        for (int j = 0; j < 8; ++j) { unpack8(xr[64 * j], v[j]);
#pragma unroll
            for (int q = 0; q < 8; ++q) ss += v[j][q] * v[j][q]; }
        const float rs = 1.0f / sqrtf(wave_sum(ss, F.lane) * (1.0f / DM) + NORM_EPS);
#pragma unroll
        for (int j = 0; j < 8; ++j) { const int c0 = (F.lane + 64 * j) * 8; const f32x4 g0 = *(const f32x4*)(g + c0), g1 = *(const f32x4*)(g + c0 + 4); f32x4 o0, o1;
#pragma unroll
            for (int q = 0; q < 4; ++q) { o0[q] = v[j][q] * rs * g0[q]; o1[q] = v[j][4 + q] * rs * g1[q]; }
            *(f32x4*)(dst + (size_t)row * DM + c0) = o0; *(f32x4*)(dst + (size_t)row * DM + c0 + 4) = o1; }
    }
}
__device__ __forceinline__ void rmsnorm_to_f32(const Frame& F, const float* src, const float* g, float* dst) {
    for (int row = F.gw; row < SEQ; row += F.NGW) {
        const f32x4* xr = (const f32x4*)(src + (size_t)row * DM) + F.lane; f32x4 v[16]; float ss = 0.f;
#pragma unroll
        for (int j = 0; j < 16; ++j) { v[j] = xr[64 * j]; ss += (v[j][0] * v[j][0] + v[j][1] * v[j][1]) + (v[j][2] * v[j][2] + v[j][3] * v[j][3]); }
        const float rs = 1.0f / sqrtf(wave_sum(ss, F.lane) * (1.0f / DM) + NORM_EPS);
        f32x4* o = (f32x4*)(dst + (size_t)row * DM) + F.lane;
#pragma unroll
        for (int j = 0; j < 16; ++j) { const f32x4 gv = ((const f32x4*)g)[F.lane + 64 * j]; f32x4 w; w[0] = v[j][0] * rs * gv[0]; w[1] = v[j][1] * rs * gv[1]; w[2] = v[j][2] * rs * gv[2]; w[3] = v[j][3] * rs * gv[3]; o[64 * j] = w; }
    }
}


__device__ __forceinline__ void p3_prep(const Frame& F, const float* wq, const float* wk, const float* b_ig, const float* b_fg, const float* wu, const float* bu) {
    const bf16* __restrict__ z = (const bf16*)(F.ws + WS_Z);
    const float* cosA = (const float*)(F.ws + WS_ROPE); const float* sinA = cosA + (size_t)SEQ * 16; const float* cosI = sinA + (size_t)SEQ * 16; const float* sinI = cosI + (size_t)SEQ * 8;
    const int gt = blockIdx.x * NTHR + F.tid, GT = F.G * NTHR;
#ifndef P3MASK
#define P3MASK 0
#endif
#define P3REP(k) for (int rep3_ = 0; rep3_ < (((P3MASK >> (k)) & 1) ? 2 : 1); ++rep3_)
    P3REP(1) { bf16* __restrict__ qk = (bf16*)(F.ws + WS_QA);
#pragma unroll 4
      for (int i = gt; i < 2 * 8 * SEQ; i += GT) { const int t = i & (SEQ - 1); bf16* p = qk + (size_t)i * 128;
          const u32x4 w0 = *(const u32x4*)p, w1 = *(const u32x4*)(p + 8), w2 = *(const u32x4*)(p + 16), w3 = *(const u32x4*)(p + 24);
          float x1[16], x2[16], o1[16], o2[16]; { float a[8]; unpack8(w0, a); for (int j = 0; j < 8; ++j) x1[j] = a[j]; unpack8(w1, a); for (int j = 0; j < 8; ++j) x1[8 + j] = a[j]; unpack8(w2, a); for (int j = 0; j < 8; ++j) x2[j] = a[j]; unpack8(w3, a); for (int j = 0; j < 8; ++j) x2[8 + j] = a[j]; }
          const float* cp = cosA + (size_t)t * 16; const float* sp = sinA + (size_t)t * 16;
#pragma unroll
          for (int j = 0; j < 16; ++j) { const float cc = cp[j], ss = sp[j]; o1[j] = x1[j] * cc - x2[j] * ss; o2[j] = x2[j] * cc + x1[j] * ss; }
          { float a[8]; for (int j = 0; j < 8; ++j) a[j] = o1[j]; *(u32x4*)p = pack8f(a); for (int j = 0; j < 8; ++j) a[j] = o1[8 + j]; *(u32x4*)(p + 8) = pack8f(a); for (int j = 0; j < 8; ++j) a[j] = o2[j]; *(u32x4*)(p + 16) = pack8f(a); for (int j = 0; j < 8; ++j) a[j] = o2[8 + j]; *(u32x4*)(p + 24) = pack8f(a); } } }
    P3REP(2) { bf16* __restrict__ iq = (bf16*)(F.ws + WS_IQ); bf16* __restrict__ ik = (bf16*)(F.ws + WS_IK); bf16* __restrict__ qt = (bf16*)(F.ws + WS_QT);
      for (int i = gt; i < SEQ * 8; i += GT) { const int t = i >> 3, c8 = i & 7;
          const float* cp = cosI + (size_t)t * 8; const float* sp = sinI + (size_t)t * 8;
          if (c8 == 1) { bf16* p = ik + (size_t)t * 64;
              float a[8], b[8], oa[8], ob[8]; unpack8(*(const u32x4*)p, a); unpack8(*(const u32x4*)(p + 8), b);
#pragma unroll
              for (int j = 0; j < 8; ++j) { const float cc = cp[j], ss = sp[j]; oa[j] = a[j] * cc - b[j] * ss; ob[j] = b[j] * cc + a[j] * ss; }
              *(u32x4*)p = pack8f(oa); *(u32x4*)(p + 8) = pack8f(ob);
          } else {
              float wv[16]; { const bf16* wp = z + (size_t)t * ZW + ZIW; float wa[8], wb[8]; unpack8(*(const u32x4*)wp, wa); unpack8(*(const u32x4*)(wp + 8), wb);
#pragma unroll
                for (int h = 0; h < 8; ++h) { wv[h] = wa[h]; wv[8 + h] = wb[h]; } }
              bf16* qo = qt + (size_t)t * 128;
              if (c8 == 0) { float sa[8], sb[8], cc[8], ss[8];
#pragma unroll
                  for (int j = 0; j < 8; ++j) { sa[j] = 0.f; sb[j] = 0.f; cc[j] = cp[j]; ss[j] = sp[j]; }
#pragma unroll
                  for (int h = 0; h < 16; ++h) { bf16* p = iq + ((size_t)t * 16 + h) * 64;
                      float a[8], b[8], oa[8], ob[8]; unpack8(*(const u32x4*)p, a); unpack8(*(const u32x4*)(p + 8), b);
#pragma unroll
                      for (int j = 0; j < 8; ++j) { oa[j] = a[j] * cc[j] - b[j] * ss[j]; ob[j] = b[j] * cc[j] + a[j] * ss[j]; }
                      const u32x4 pa = pack8f(oa), pb = pack8f(ob); *(u32x4*)p = pa; *(u32x4*)(p + 8) = pb; unpack8(pa, oa); unpack8(pb, ob);
#pragma unroll
                      for (int j = 0; j < 8; ++j) { sa[j] += wv[h] * oa[j]; sb[j] += wv[h] * ob[j]; } }
                  { const u32x4 hi = pack8f(sa); float r[8]; unpack8(hi, r);
#pragma unroll
                    for (int j = 0; j < 8; ++j) r[j] = sa[j] - r[j];
                    *(u32x4*)qo = hi; *(u32x4*)(qo + 64) = pack8f(r); }
                  { const u32x4 hi = pack8f(sb); float r[8]; unpack8(hi, r);
#pragma unroll
                    for (int j = 0; j < 8; ++j) r[j] = sb[j] - r[j];
                    *(u32x4*)(qo + 8) = hi; *(u32x4*)(qo + 72) = pack8f(r); }
              } else { float s8[8];
#pragma unroll
                  for (int j = 0; j < 8; ++j) s8[j] = 0.f;
#pragma unroll
                  for (int h = 0; h < 16; ++h) { float a[8]; unpack8(*(const u32x4*)(iq + ((size_t)t * 16 + h) * 64 + c8 * 8), a);
#pragma unroll
                      for (int j = 0; j < 8; ++j) s8[j] += wv[h] * a[j]; }
                  const u32x4 hi = pack8f(s8); float r[8]; unpack8(hi, r);
#pragma unroll
                  for (int j = 0; j < 8; ++j) r[j] = s8[j] - r[j];
                  *(u32x4*)(qo + c8 * 8) = hi; *(u32x4*)(qo + 64 + c8 * 8) = pack8f(r); } } } }
    P3REP(3) { bf16* __restrict__ cq = (bf16*)(F.ws + WS_CQ); bf16* __restrict__ ck = (bf16*)(F.ws + WS_CK);
      constexpr int PER = SEQ * 96;
#pragma unroll 4
      for (int i = gt; i < 2 * PER; i += GT) {
          const int which = i / PER, r = i - which * PER, c8 = r % 96, t = r / 96;
          const float* w = (which ? wk : wq) + c8 * 8; const int zc = (which ? ZK_C : ZQ_C) + c8 * 8; float acc[8];
#pragma unroll
          for (int j = 0; j < 8; ++j) acc[j] = 0.f;
#pragma unroll
          for (int tap = 0; tap < 4; ++tap) { const int ts = t - 3 + tap; if (ts >= 0) { float xv[8]; unpack8(*(const u32x4*)(z + (size_t)ts * ZW + zc), xv); const f32x4 w0 = *(const f32x4*)(w + tap * 768), w1 = *(const f32x4*)(w + tap * 768 + 4);
#pragma unroll
              for (int j = 0; j < 4; ++j) { acc[j] += xv[j] * w0[j]; acc[4 + j] += xv[4 + j] * w1[j]; } } }
          const float sc = which ? 1.0f : 0.08838834764831845f;
#pragma unroll
          for (int j = 0; j < 8; ++j) acc[j] = siluf_(acc[j]) * sc;
          *(u32x4*)((which ? ck : cq) + (size_t)t * 768 + c8 * 8) = pack8f(acc); } }
    P3REP(4) { float* mg = (float*)(F.ws + WS_MG);
      for (int u = F.gw; u < NCH * 6; u += F.NGW) { const int c = u / 6, h = u % 6, t = c * 64 + F.lane; const float bi = b_ig[h], bfg = b_fg[h];
          const float ci = bf2f(z[(size_t)t * ZW + ZIF + h]), cf = bf2f(z[(size_t)t * ZW + ZIF + 6 + h]);
          float v = log_sigmoidf(cf + bfg);
#pragma unroll
          for (int o = 1; o < 64; o <<= 1) { const float nb = shup(v, o, F.lane); if (F.lane >= o) v += nb; }
          mg[MG_B + (size_t)t * 8 + h] = v; mg[MG_I + (size_t)t * 8 + h] = ci + bi; } }
    P3REP(5) { float* bA = (float*)(F.ws + WS_BA); LAS float* al = (LAS float*)F.lds;
      for (int c = blockIdx.x; c < NCH; c += F.G) {
          __syncthreads();
          if (F.tid < 128) { const int s = F.tid >> 1, hf = F.tid & 1; float a[8]; unpack8(*(const u32x4*)(z + (size_t)(c * 64 + s) * ZW + ZLOW + hf * 8), a);
#pragma unroll
              for (int r = 0; r < 8; ++r) al[s * 16 + hf * 8 + r] = a[r]; }
          __syncthreads();
          for (int n = F.tid; n < 768; n += NTHR) { float wv[16];
#pragma unroll
              for (int r = 0; r < 16; ++r) wv[r] = wu[r * 768 + n];
              const float bb = bu[n]; float bs = 0.f; float* op = bA + (size_t)c * 64 * 768 + (n & ~3);
              const int ql = F.lane & 3;
              for (int s4 = 0; s4 < 64; s4 += 4) { float v[4];
#pragma unroll
                  for (int k = 0; k < 4; ++k) { const int s = s4 + k; const f32x4 a0 = *(const LAS f32x4*)(al + s * 16), a1 = *(const LAS f32x4*)(al + s * 16 + 4), a2 = *(const LAS f32x4*)(al + s * 16 + 8), a3 = *(const LAS f32x4*)(al + s * 16 + 12);
                      float x = bb;
#pragma unroll
                      for (int r = 0; r < 4; ++r) { x += a0[r] * wv[r]; x += a1[r] * wv[4 + r]; x += a2[r] * wv[8 + r]; x += a3[r] * wv[12 + r]; }
                      bs += (fminf(x, 0.f) - __logf(1.0f + __expf(-fabsf(x)))) * (1.0f / 16.0f); v[k] = bs; }
                  { const bool o1 = ql & 1, o2 = ql & 2;
                    const float x0 = o1 ? v[0] : v[1], x1 = o1 ? v[2] : v[3];
                    const float r0 = __int_as_float(__builtin_amdgcn_mov_dpp(__float_as_int(x0), 0xB1, 0xf, 0xf, false)), r1 = __int_as_float(__builtin_amdgcn_mov_dpp(__float_as_int(x1), 0xB1, 0xf, 0xf, false));
                    const float u0 = o1 ? r0 : v[0], u1 = o1 ? v[1] : r0, u2 = o1 ? r1 : v[2], u3 = o1 ? v[3] : r1;
                    const float y0 = o2 ? u0 : u2, y1 = o2 ? u1 : u3;
                    const float q0 = __int_as_float(__builtin_amdgcn_mov_dpp(__float_as_int(y0), 0x4E, 0xf, 0xf, false)), q1 = __int_as_float(__builtin_amdgcn_mov_dpp(__float_as_int(y1), 0x4E, 0xf, 0xf, false));
                    const f32x4 w = {o2 ? q0 : u0, o2 ? q1 : u1, o2 ? u2 : q0, o2 ? u3 : q1};
                    *(f32x4*)(op + (size_t)(s4 + ql) * 768) = w; } } } }
    }
}

__device__ __forceinline__ f32x16 mfma32(bf16x8 a, bf16x8 b, f32x16 c) { return __builtin_amdgcn_mfma_f32_32x32x16_bf16(a, b, c, 0, 0, 0); }
__device__ __forceinline__ f32x4 mfma16(bf16x8 a, bf16x8 b, f32x4 c) { return __builtin_amdgcn_mfma_f32_16x16x32_bf16(a, b, c, 0, 0, 0); }
__device__ __forceinline__ f32x16 zero16() { f32x16 z;
#pragma unroll
    for (int i = 0; i < 16; ++i) z[i] = 0.f;
    return z; }

__device__ __forceinline__ void p4_index_scores(const Frame& F) {
    const bf16* iq = (const bf16*)(F.ws + WS_IQ); const bf16* ik = (const bf16*)(F.ws + WS_IK); const bf16* zw = (const bf16*)(F.ws + WS_Z) + ZIW; _Float16* sc = (_Float16*)(F.ws + WS_SCORE);
    const int l15 = F.lane & 15, lq = F.lane >> 4;
    constexpr int NITEMS = 2112;
#define IDX_STAGE(j_, buf_) do { const int ln_ = hw_lane(); \
        _Pragma("unroll") for (int i_ = 0; i_ < 8; ++i_) { const int ci_ = i_ * 8 + F.wave, r_ = ci_ * 8 + (ln_ >> 3), c_ = (ln_ & 7) ^ ((r_ >> 1) & 7); \
            __builtin_amdgcn_global_load_lds((const unsigned*)(ik + (size_t)(512 * (j_) + r_) * 64 + c_ * 8), (LAS unsigned*)(F.lds + (buf_) * 65536 + ci_ * 1024), 16, 0, 0); } } while (0)
#define IDX_ADV(q_, d_, j_) do { if (++j_ > q_) { j_ = 0; if (++d_ == 4) { d_ = 0; ++q_; } } } while (0)
    const int i_beg = (int)(((long)blockIdx.x * NITEMS) / F.G), i_end = (int)(((long)(blockIdx.x + 1) * NITEMS) / F.G);
    int q4 = 0, d4 = 0, j = 0; { int r = i_beg; while (r >= 4 * (q4 + 1)) { r -= 4 * (q4 + 1); ++q4; } d4 = (r >= q4 + 1) + (r >= 2 * (q4 + 1)) + (r >= 3 * (q4 + 1)); j = r - d4 * (q4 + 1); }
    int par = 0; bool fresh = true;
    bf16x8 bq[16][2]; float w[16]; bf16x8 bt[4];
    if (i_beg < i_end) IDX_STAGE(j, 0);
    for (int bi = i_beg; bi < i_end; ++bi, par ^= 1) {
        const int g = 8 * (4 * q4 + d4) + F.wave, t0 = 16 * g, s0 = 512 * j;
        int s_end = s0 + 512; if (s_end > t0 + 16) s_end = t0 + 16;
        if (fresh) {
            const bf16* qp = iq + (size_t)(t0 + l15) * 1024 + 8 * lq;
#pragma unroll
            for (int h = 0; h < 16; ++h) { bq[h][0] = *(const bf16x8*)(qp + h * 64); bq[h][1] = *(const bf16x8*)(qp + h * 64 + 32); }
            { const bf16* wp = zw + (size_t)(t0 + l15) * ZW; float wa[8], wb[8]; unpack8(*(const u32x4*)wp, wa); unpack8(*(const u32x4*)(wp + 8), wb);
#pragma unroll
              for (int h = 0; h < 8; ++h) { w[h] = wa[h]; w[8 + h] = wb[h]; } }
            { const bf16* tp = (const bf16*)(F.ws + WS_QT) + (size_t)(t0 + l15) * 128 + 8 * lq; bt[0] = *(const bf16x8*)tp; bt[1] = *(const bf16x8*)(tp + 32); bt[2] = *(const bf16x8*)(tp + 64); bt[3] = *(const bf16x8*)(tp + 96); }
            VM_WAIT();
        } else asm volatile("s_waitcnt vmcnt(32)" ::: "memory");
        asm volatile("s_waitcnt lgkmcnt(0)" ::: "memory"); __builtin_amdgcn_s_barrier();
        int qn = q4, dn = d4, jn = j; IDX_ADV(qn, dn, jn);
        if (bi + 1 < i_end) IDX_STAGE(jn, par ^ 1);
        fresh = jn == 0;
        _Float16* orow = sc + (size_t)(t0 + l15) * SEQ + 4 * lq;
        const LAS unsigned char* kp0 = F.lds + par * 65536 + l15 * 128 + ((lq ^ (l15 >> 1)) << 4);
        const LAS unsigned char* kp1 = F.lds + par * 65536 + l15 * 128 + (((lq + 4) ^ (l15 >> 1)) << 4);
        for (int s = s0; s < s_end; s += 16) {
            const bf16x8 a0 = *(const LAS bf16x8*)kp0, a1 = *(const LAS bf16x8*)kp1; kp0 += 2048; kp1 += 2048;
            __builtin_amdgcn_s_setprio(1);
            f32x4 tot = mfma16(a0, bt[0], (f32x4){0.f, 0.f, 0.f, 0.f});
#pragma unroll
            for (int hh = 0; hh < 16; hh += 8) { f32x4 acc[8];
                __builtin_amdgcn_s_setprio(1);
#pragma unroll
                for (int h = 0; h < 8; ++h) acc[h] = mfma16(a0, bq[hh + h][0], (f32x4){0.f, 0.f, 0.f, 0.f});
                if (hh == 0) { tot = mfma16(a1, bt[1], tot); tot = mfma16(a0, bt[2], tot); }
#pragma unroll
                for (int h = 0; h < 8; ++h) acc[h] = mfma16(a1, bq[hh + h][1], acc[h]);
                if (hh == 0) tot = mfma16(a1, bt[3], tot);
                __builtin_amdgcn_s_setprio(0);
                __builtin_amdgcn_sched_barrier(0);
                asm volatile("s_nop 15");
#pragma unroll
                for (int h = 0; h < 8; ++h) {
#pragma unroll
                    for (int r = 0; r < 4; ++r) asm volatile("v_fma_f32 %0, %1, |%2|, %0" : "+v"(tot[r]) : "v"(w[hh + h]), "v"(acc[h][r])); } }
            { typedef _Float16 h16x4 __attribute__((ext_vector_type(4))); h16x4 hv; hv[0] = (_Float16)tot[0]; hv[1] = (_Float16)tot[1]; hv[2] = (_Float16)tot[2]; hv[3] = (_Float16)tot[3]; *(h16x4*)(orow + s) = hv; }
        }
        q4 = qn; d4 = dn; j = jn;
    }
#undef IDX_STAGE
#undef IDX_ADV
}

#define DST_STORE2(ptr_, acc_, g_) do { unsigned ax_ = pk2(acc_[4 * (g_)], acc_[4 * (g_) + 1]), ay_ = pk2(acc_[4 * (g_) + 2], acc_[4 * (g_) + 3]), bx_ = pk2(acc_[4 * (g_) + 4], acc_[4 * (g_) + 5]), by_ = pk2(acc_[4 * (g_) + 6], acc_[4 * (g_) + 7]); \
        const auto rx_ = __builtin_amdgcn_permlane32_swap(ax_, bx_, false, false); const auto ry_ = __builtin_amdgcn_permlane32_swap(ay_, by_, false, false); \
        *(u32x4*)((ptr_) + 8 * ((g_) + hi)) = (u32x4){(unsigned)rx_[0], (unsigned)ry_[0], (unsigned)rx_[1], (unsigned)ry_[1]}; } while (0)
__device__ __forceinline__ void p4_gla_local(const Frame& F) {
    const bf16* z = (const bf16*)(F.ws + WS_Z); const float* bA = (const float*)(F.ws + WS_BA); bf16* dS = (bf16*)(F.ws + WS_DS);
    LAS bf16* vT = (LAS bf16*)F.lds;
    LAS bf16* kT = vT + 128 * 72;
    const int r32 = F.lane & 31, hi = F.lane >> 5, s = F.tid >> 3, d8 = (F.tid & 7) * 8, e16 = (F.tid & 7) * 16;
    u32x4 kw, vw0, vw1; f32x4 b0, b1, e0, e1;
#define GLA_LOAD(u_) do { const int c_ = (u_) / 12, h_ = (u_) % 12, t0_ = c_ * 64; kw = *(const u32x4*)(z + (size_t)(t0_ + s) * ZW + ZK_A + h_ * 64 + d8); \
        const float* bp_ = bA + (size_t)(t0_ + s) * 768 + h_ * 64 + d8; const float* be_ = bA + (size_t)(t0_ + 63) * 768 + h_ * 64 + d8; \
        b0 = *(const f32x4*)bp_; b1 = *(const f32x4*)(bp_ + 4); e0 = *(const f32x4*)be_; e1 = *(const f32x4*)(be_ + 4); \
        const bf16* vp_ = z + (size_t)(t0_ + s) * ZW + ZV_A + h_ * 128 + e16; vw0 = *(const u32x4*)vp_; vw1 = *(const u32x4*)(vp_ + 8); } while (0)
    int u = blockIdx.x; if (u < NCH * 12) GLA_LOAD(u);
    for (; u < NCH * 12; u += F.G) {
        __syncthreads();
        { float kv[8]; unpack8(kw, kv);
#pragma unroll
          for (int j = 0; j < 4; ++j) { kT[TPOS(d8 + j, s, 3)] = f2bf(kv[j] * __expf(e0[j] - b0[j])); kT[TPOS(d8 + 4 + j, s, 3)] = f2bf(kv[4 + j] * __expf(e1[j] - b1[j])); }
          const unsigned ww[8] = {vw0.x, vw0.y, vw0.z, vw0.w, vw1.x, vw1.y, vw1.z, vw1.w};
#pragma unroll
          for (int j = 0; j < 8; ++j) { vT[TPOS(e16 + 2 * j, s, 4)] = (bf16)(ww[j] & 0xffffu); vT[TPOS(e16 + 2 * j + 1, s, 4)] = (bf16)(ww[j] >> 16); } }
        __syncthreads();
        if (u + F.G < NCH * 12) GLA_LOAD(u + F.G);
        const int et = F.wave >> 1, dt = F.wave & 1; f32x16 acc = zero16();
#pragma unroll
        for (int kk = 0; kk < 4; ++kk) { const bf16x8 a = *(const LAS bf16x8*)(kT + TRD(32 * dt + r32, 2 * kk + hi, 3)), b = *(const LAS bf16x8*)(vT + TRD(32 * et + r32, 2 * kk + hi, 4)); acc = mfma32(a, b, acc); }
        bf16* o = dS + ((size_t)u * 128 + 32 * et + r32) * 64 + 32 * dt;
        DST_STORE2(o, acc, 0); DST_STORE2(o, acc, 2);
    }
#undef GLA_LOAD
}

__device__ __forceinline__ void p4_mlstm_local(const Frame& F) {
    const bf16* z = (const bf16*)(F.ws + WS_Z); const bf16* ck = (const bf16*)(F.ws + WS_CK); float* mg = (float*)(F.ws + WS_MG); bf16* dC = (bf16*)(F.ws + WS_DC);
    LAS bf16* vT = (LAS bf16*)F.lds;
    LAS bf16* kT = vT + 256 * 72;
    LAS float* wsl = (LAS float*)(kT + 128 * 72);
    const int r32 = F.lane & 31, hi = F.lane >> 5, s = F.tid >> 3, d16 = (F.tid & 7) * 16, e32 = (F.tid & 7) * 32;
    u32x4 kw0, kw1, vw[4]; float gbs = 0.f, gig = 0.f;
#define ML_LOAD(u_) do { const int c_ = (u_) / 6, h_ = (u_) % 6, t0_ = c_ * 64; const bf16* kp_ = ck + (size_t)(t0_ + s) * 768 + h_ * 128 + d16; kw0 = *(const u32x4*)kp_; kw1 = *(const u32x4*)(kp_ + 8); \
        const bf16* vp_ = z + (size_t)(t0_ + s) * ZW + ZV_C + h_ * 256 + e32; _Pragma("unroll") for (int q_ = 0; q_ < 4; ++q_) vw[q_] = *(const u32x4*)(vp_ + 8 * q_); \
        if (F.wave == 0) { gbs = mg[MG_B + (size_t)(t0_ + F.lane) * 8 + h_]; gig = mg[MG_I + (size_t)(t0_ + F.lane) * 8 + h_]; } } while (0)
    const bool bal = F.G == 256, heavy = ((int)blockIdx.x & 3) == 3; const int nun = bal ? (heavy ? 3 : 7) : (NCH * 6 - (int)blockIdx.x + F.G - 1) / F.G;
#define ML_UNIT(k_) (bal ? ((k_) < 3 ? 256 * (k_) + (int)blockIdx.x : 768 + 192 * ((k_) - 3) + (int)blockIdx.x - ((int)blockIdx.x >> 2)) : (int)blockIdx.x + (k_) * F.G)
    int u = ML_UNIT(0); if (nun > 0) ML_LOAD(u);
    for (int ku = 0; ku < nun; ++ku, u = ML_UNIT(ku)) {
        __syncthreads();
        if (F.wave == 0) { const float be = __int_as_float(__builtin_amdgcn_readlane(__float_as_int(gbs), 63));
            const float a = be - gbs + gig; const float ml = wave_max(a, F.lane); wsl[F.lane] = __expf(a - ml); if (F.lane == 0) { mg[MG_ML + (size_t)u * 2] = be; mg[MG_ML + (size_t)u * 2 + 1] = ml; } }
        __syncthreads();
        { const float wsv = wsl[s]; float k0[8], k1[8]; unpack8(kw0, k0); unpack8(kw1, k1);
#pragma unroll
          for (int j = 0; j < 8; ++j) { kT[TPOS(d16 + j, s, 4)] = f2bf(k0[j] * wsv); kT[TPOS(d16 + 8 + j, s, 4)] = f2bf(k1[j] * wsv); }
#pragma unroll
          for (int q = 0; q < 4; ++q) { const unsigned ww[4] = {vw[q].x, vw[q].y, vw[q].z, vw[q].w};
#pragma unroll
              for (int j = 0; j < 4; ++j) { vT[TPOS(e32 + 8 * q + 2 * j, s, 5)] = (bf16)(ww[j] & 0xffffu); vT[TPOS(e32 + 8 * q + 2 * j + 1, s, 5)] = (bf16)(ww[j] >> 16); } } }
        __syncthreads();
        if (ku + 1 < nun) ML_LOAD(ML_UNIT(ku + 1));
        if (F.tid < 128) { float sum = 0.f; const LAS bf16* kr = kT + F.tid * 72;
#pragma unroll 8
            for (int ss = 0; ss < 64; ++ss) sum += bf2f(kr[ss]);
            mg[MG_DN + (size_t)u * 128 + F.tid] = sum; }
        const int et = F.wave; bf16x8 bv[4];
#pragma unroll
        for (int kk = 0; kk < 4; ++kk) bv[kk] = *(const LAS bf16x8*)(vT + TRD(32 * et + r32, 2 * kk + hi, 5));
        bf16* o = dC + ((size_t)u * 256 + 32 * et + r32) * 128;
#pragma unroll
        for (int dt = 0; dt < 4; ++dt) { f32x16 acc = zero16();
#pragma unroll
            for (int kk = 0; kk < 4; ++kk) { const bf16x8 a = *(const LAS bf16x8*)(kT + TRD(32 * dt + r32, 2 * kk + hi, 4)); acc = mfma32(a, bv[kk], acc); }
            DST_STORE2(o + 32 * dt, acc, 0); DST_STORE2(o + 32 * dt, acc, 2); }
    }
#undef ML_LOAD
#undef ML_UNIT
}

__device__ __forceinline__ void p5_scans(const Frame& F) {
    const float* bA = (const float*)(F.ws + WS_BA); const bf16* dS = (const bf16*)(F.ws + WS_DS); bf16* SP = (bf16*)(F.ws + WS_SP);
    float* mg = (float*)(F.ws + WS_MG); const bf16* dC = (const bf16*)(F.ws + WS_DC); bf16* CP = (bf16*)(F.ws + WS_CP);
    for (int grp = blockIdx.x + F.G * F.wave; grp < 579; grp += F.G * 8) {
        const int l = F.lane;
        if (grp < 192) {
            constexpr int SB = 4;
            const int i = grp * 64 + l, h = i >> 10, rem = i & 1023, e = rem >> 3, d8 = (rem & 7) * 8;
            float S[8];
#pragma unroll
            for (int q = 0; q < 8; ++q) S[q] = 0.f;
            u32x4 dlA[SB], dlB[SB]; f32x4 dcA[SB][2], dcB[SB][2];
#define G_LOAD(DL, DC, c0_) do { _Pragma("unroll") for (int k = 0; k < SB; ++k) { const int c = (c0_) + k; DL[k] = *(const u32x4*)(dS + ((size_t)(c * 12 + h) * 128 + e) * 64 + d8); \
                const float* cp_ = bA + (size_t)(c * 64 + 63) * 768 + h * 64 + d8; DC[k][0] = *(const f32x4*)cp_; DC[k][1] = *(const f32x4*)(cp_ + 4); } } while (0)
#define G_STEP(DL, DC, c0_) do { _Pragma("unroll") for (int k = 0; k < SB; ++k) { const int c = (c0_) + k; *(u32x4*)(SP + ((size_t)(c * 12 + h) * 128 + e) * 64 + d8) = pack8f(S); float dv_[8]; unpack8(DL[k], dv_); \
                _Pragma("unroll") for (int q = 0; q < 8; ++q) S[q] = __expf(DC[k][q >> 2][q & 3]) * S[q] + dv_[q]; } } while (0)
            G_LOAD(dlA, dcA, 0);
            for (int c0 = 0; c0 < NCH; c0 += 2 * SB) {
                G_LOAD(dlB, dcB, c0 + SB); G_STEP(dlA, dcA, c0);
                if (c0 + 2 * SB < NCH) G_LOAD(dlA, dcA, c0 + 2 * SB);
                G_STEP(dlB, dcB, c0 + SB); }
#undef G_LOAD
#undef G_STEP
        } else if (grp < 576) {
            constexpr int SB = 8;
            const int i = (grp - 192) * 64 + l, h = i >> 12, rem = i & 4095, e = rem >> 4, d8 = (rem & 15) * 8;
            float S[8]; float m = 0.f;
#pragma unroll
            for (int q = 0; q < 8; ++q) S[q] = 0.f;
            u32x4 dlA[SB], dlB[SB]; f32x2 mlA[SB], mlB[SB];
#define M_LOAD(DL, ML, c0_) do { _Pragma("unroll") for (int k = 0; k < SB; ++k) { const int c = (c0_) + k; ML[k] = *(const f32x2*)(mg + MG_ML + (size_t)(c * 6 + h) * 2); \
                DL[k] = *(const u32x4*)(dC + ((size_t)(c * 6 + h) * 256 + e) * 128 + d8); } } while (0)
#define M_STEP(DL, ML, c0_) do { _Pragma("unroll") for (int k = 0; k < SB; ++k) { const int c = (c0_) + k; \
                *(u32x4*)(CP + ((size_t)(c * 6 + h) * 256 + e) * 128 + d8) = pack8f(S); float dv_[8]; unpack8(DL[k], dv_); \
                const float a_state = ML[k][0] + m, m_new = fmaxf(a_state, ML[k][1]), f1 = __expf(a_state - m_new), f2 = __expf(ML[k][1] - m_new); \
                _Pragma("unroll") for (int q = 0; q < 8; ++q) S[q] = f1 * S[q] + f2 * dv_[q]; \
                m = m_new; } } while (0)
            M_LOAD(dlA, mlA, 0);
            for (int c0 = 0; c0 < NCH; c0 += 2 * SB) {
                M_LOAD(dlB, mlB, c0 + SB); M_STEP(dlA, mlA, c0);
                if (c0 + 2 * SB < NCH) M_LOAD(dlA, mlA, c0 + 2 * SB);
                M_STEP(dlB, mlB, c0 + SB); }
#undef M_LOAD
#undef M_STEP
        } else {
            constexpr int SB = 8;
            const int ii = (grp - 576) * 64 + l, h = ii >> 5, d4 = (ii & 31) * 4;
            f32x4 S = {0.f, 0.f, 0.f, 0.f}; float m = 0.f;
            for (int c0 = 0; c0 < NCH; c0 += SB) { f32x4 dl[SB]; f32x2 ml[SB];
#pragma unroll
                for (int k = 0; k < SB; ++k) { const int c = c0 + k; ml[k] = *(const f32x2*)(mg + MG_ML + (size_t)(c * 6 + h) * 2); dl[k] = *(const f32x4*)(mg + MG_DN + (size_t)(c * 6 + h) * 128 + d4); }
#pragma unroll
                for (int k = 0; k < SB; ++k) { const int c = c0 + k;
                    *(f32x4*)(mg + MG_NP + (size_t)(c * 6 + h) * 128 + d4) = S; if (d4 == 0) mg[MG_MP + (size_t)(c * 6 + h)] = m;
                    const float a_state = ml[k][0] + m, m_new = fmaxf(a_state, ml[k][1]), f1 = __expf(a_state - m_new), f2 = __expf(ml[k][1] - m_new);
#pragma unroll
                    for (int q = 0; q < 4; ++q) S[q] = f1 * S[q] + f2 * dl[k][q];
                    m = m_new; } }
        }
    }
}

__device__ __forceinline__ unsigned long long perm_word(unsigned long long x) {
    unsigned long long t;
    t = ((x >> 4) ^ x) & 0x00F000F000F000F0ull; x ^= t ^ (t << 4);
    t = ((x >> 8) ^ x) & 0x0000FF000000FF00ull; x ^= t ^ (t << 8);
    t = ((x >> 16) ^ x) & 0x00000000FFFF0000ull; x ^= t ^ (t << 16);
    return x;
}
__device__ __forceinline__ void p5_select(const Frame& F, unsigned* ctr) {
    const _Float16* sc = (const _Float16*)(F.ws + WS_SCORE); unsigned long long* mask = (unsigned long long*)(F.ws + WS_MASK);
    LAS unsigned char* wl = F.lds + F.wave * 12304;
    LAS unsigned* hist = (LAS unsigned*)wl;
    LAS unsigned* words = (LAS unsigned*)(wl + 8192);
    LAS float* cval = (LAS float*)(wl + 8192 + 2048);
    LAS int* ckey = (LAS int*)(wl + 8192 + 3072);
    const float PINF = __builtin_inff();
    constexpr int SEL_DYN0 = 12288;
    int t = F.gw; unsigned nq_ = 0u;
    for (;;) {
        int lane = F.lane; asm volatile("" : "+v"(lane));
        if (t >= SEL_DYN0 - F.NGW) { if (lane == 0) nq_ = __hip_atomic_fetch_add(ctr, 1u, __ATOMIC_RELAXED, __HIP_MEMORY_SCOPE_AGENT); }
#define SEL_NEXT() do { if (t < SEL_DYN0 - F.NGW) t += F.NGW; else t = SEL_DYN0 + __builtin_amdgcn_readfirstlane((int)nq_); } while (0)
        if (t >= SEQ) break;
        const unsigned long long lt_mask = (1ull << lane) - 1ull; const int lane8 = lane * 8;
        const int n = t + 1, nw = 4 * (t / 256 + 1), ng = (n + 63) >> 6;
        const _Float16* row = sc + (size_t)t * SEQ; unsigned long long* mrow = mask + (size_t)t * 256;
        if (n <= 256) {
            if (lane < nw) { const int k0 = lane * 64; const unsigned long long w = (t >= k0 + 63) ? ~0ull : (t < k0 ? 0ull : ((2ull << (t - k0)) - 1ull)); mrow[lane] = perm_word(w); }
            SEL_NEXT(); continue; }
        typedef _Float16 h16x8 __attribute__((ext_vector_type(8))); typedef _Float16 h16x2 __attribute__((ext_vector_type(2)));
        const int ng8 = (n + 511) >> 9, glast = ng8 - 1; const h16x8* row8 = (const h16x8*)row + lane;
        u32x4 vv[32];
#pragma unroll
        for (int g = 0; g < 32; ++g) vv[g] = *(const u32x4*)(row8 + (g < ng8 ? g : 0) * 64);
        int nvl = n - 512 * glast - lane8; nvl = nvl < 0 ? 0 : (nvl > 8 ? 8 : nvl); const unsigned vlast = (1u << nvl) - 1u;
#define SEL_FILL(G, FILLPAIR) do { unsigned* d_ = (unsigned*)&vv[G]; _Pragma("unroll") for (int q_ = 0; q_ < 4; ++q_) { \
            const unsigned keep_ = (((vlast >> (2 * q_)) & 1u) ? 0x0000ffffu : 0u) | (((vlast >> (2 * q_ + 1)) & 1u) ? 0xffff0000u : 0u); d_[q_] = (d_[q_] & keep_) | ((FILLPAIR) & ~keep_); } } while (0)
#pragma unroll
        for (int g = 0; g < 32; ++g) if (g == glast) { const unsigned f0 = (unsigned)__builtin_amdgcn_readfirstlane((int)vv[g].x) & 0xffffu; SEL_FILL(g, f0 | (f0 << 16)); }
        h16x2 pmin = {(_Float16)65504.f, (_Float16)65504.f}, pmax = {(_Float16)-65504.f, (_Float16)-65504.f};
#pragma unroll
        for (int g = 0; g < 32; ++g) if (g < ng8) {
#pragma unroll
            for (int q = 0; q < 4; ++q) { const h16x2 x = __builtin_bit_cast(h16x2, ((const unsigned*)&vv[g])[q]); pmin = __builtin_elementwise_min(pmin, x); pmax = __builtin_elementwise_max(pmax, x); } }
        float lmin = fminf((float)pmin[0], (float)pmin[1]), lmax = fmaxf((float)pmax[0], (float)pmax[1]);
        lmin = -wave_max(-lmin, lane); lmax = wave_max(lmax, lane);
        const float span = lmax - lmin, lo = lmin, scale = span > 0.f ? 2047.0f / span : 0.f, los = -lo * scale;
        { const unsigned fm = (unsigned)__builtin_bit_cast(unsigned short, (_Float16)lmin);
#pragma unroll
          for (int g = 0; g < 32; ++g) if (g == glast) SEL_FILL(g, fm | (fm << 16)); }
#undef SEL_FILL
#pragma unroll
        for (int k = 0; k < 8; ++k) *(LAS u32x4*)(hist + (k * 64 + lane) * 4) = (u32x4){0u, 0u, 0u, 0u};
#pragma unroll
        for (int k = 0; k < 2; ++k) *(LAS u32x4*)(words + (k * 64 + lane) * 4) = (u32x4){0u, 0u, 0u, 0u};
#define SEL_BIN(G, J) ({ const h16x2 x_ = __builtin_bit_cast(h16x2, ((const unsigned*)&vv[G])[(J) >> 1]); int b_ = (int)fmaf((float)x_[(J) & 1], scale, los); b_ = b_ < 0 ? 0 : (b_ > 2047 ? 2047 : b_); b_; })
#pragma unroll
        for (int g = 0; g < 32; ++g) asm volatile("" : "+v"(vv[g]));
#pragma unroll
        for (int g = 0; g < 32; ++g) if (g < ng8) {
#pragma unroll
            for (int j = 0; j < 8; ++j) { const int b = SEL_BIN(g, j); __hip_atomic_fetch_add(&hist[b], 1u, __ATOMIC_RELAXED, __HIP_MEMORY_SCOPE_WORKGROUP); } }
        unsigned mine = 0;
#pragma unroll
        for (int q = 0; q < 8; ++q) { const u32x4 x = *(const LAS u32x4*)(hist + lane * 32 + q * 4); mine += (x.x + x.y) + (x.z + x.w); }
        unsigned suf = mine;
#pragma unroll
        for (int o = 1; o < 64; o <<= 1) { const unsigned nb = shdn_u(suf, o, lane); if (lane + o < 64) suf += nb; }
        const unsigned above = suf - mine; int Bs = -1; unsigned cnt_above = 0;
        { const unsigned long long segm = __ballot(above < 256u && above + mine >= 256u);
          if (segm) { const int sl = __builtin_ctzll(segm); const unsigned ab0 = (unsigned)__builtin_amdgcn_readlane((int)above, sl); const int l31 = lane & 31;
              const unsigned hq = hist[sl * 32 + l31]; unsigned sfx = hq;
#pragma unroll
              for (int o = 1; o < 32; o <<= 1) { const unsigned nb = shdn_u(sfx, o, lane); if (l31 + o < 32) sfx += nb; }
              const unsigned abv = ab0 + sfx - hq;
              const unsigned long long hm = __ballot(lane < 32 && abv < 256u && abv + hq >= 256u);
              if (hm) { const int hl = __builtin_ctzll(hm); Bs = sl * 32 + hl; cnt_above = (unsigned)__builtin_amdgcn_readlane((int)abv, hl); } } }
#pragma unroll
        for (int g = 0; g < 32; ++g) asm volatile("" : "+v"(vv[g]));
        LAS unsigned char* wbytes = (LAS unsigned char*)words; LAS unsigned* mcnt = (LAS unsigned*)(ckey + 256);
        if (lane == 0) *mcnt = 0u;
#pragma unroll
        for (int g = 0; g < 32; ++g) if (g < ng8) { int b[8]; unsigned abits = 0u; bool anyc = false;
#pragma unroll
            for (int j = 7; j >= 0; --j) { b[j] = SEL_BIN(g, j); abits = __builtin_amdgcn_alignbit(abits, (unsigned)(Bs - b[j]), 31); anyc |= (b[j] == Bs); }
            const unsigned vm = (g == glast) ? vlast : 0xffu;
            wbytes[g * 64 + lane] = (unsigned char)(abits & vm);
            if (anyc) {
#pragma unroll
                for (int j = 0; j < 8; ++j) if (b[j] == Bs && ((vm >> j) & 1u)) { const unsigned pos = __hip_atomic_fetch_add(mcnt, 1u, __ATOMIC_RELAXED, __HIP_MEMORY_SCOPE_WORKGROUP);
                    if (pos < 256u) { const h16x2 x = __builtin_bit_cast(h16x2, ((const unsigned*)&vv[g])[j >> 1]); cval[pos] = (float)x[j & 1]; ckey[pos] = lane8 + (g * 512 + j); } } } }
#undef SEL_BIN
        const unsigned m = *mcnt;
        const unsigned need = 256u - cnt_above;
        if (m <= 256u) {
            for (unsigned c = lane; c < m; c += 64) { const float mv = cval[c]; const int mk = ckey[c]; unsigned rank = 0;
                for (unsigned j = 0; j < m; ++j) { const float ov = cval[j]; const int ok = ckey[j]; rank += (ov > mv || (ov == mv && ok < mk)) ? 1u : 0u; }
                if (rank < need) __hip_atomic_fetch_or(&words[2 * (mk >> 6) + ((mk >> 5) & 1)], 1u << (mk & 31), __ATOMIC_RELAXED, __HIP_MEMORY_SCOPE_WORKGROUP); }
        } else {
            for (int g = 0; g < ng; ++g) { const int key = g * 64 + lane; int b = -1; if (key < n) { b = (int)fmaf((float)row[key], scale, los); b = b < 0 ? 0 : (b > 2047 ? 2047 : b); }
                const unsigned long long bc = __ballot(b == Bs); if (lane == 0) { words[2 * g] |= (unsigned)bc; words[2 * g + 1] |= (unsigned)(bc >> 32); } }
        }
#pragma unroll
        for (int k = 0; k < 4; ++k) { const int w = lane + 64 * k; if (w < nw) { const unsigned long long x = (unsigned long long)words[2 * w] | ((unsigned long long)words[2 * w + 1] << 32); mrow[w] = perm_word(x); } }
        SEL_NEXT();
    }
#undef SEL_NEXT
}

__device__ __forceinline__ void p6_gla_out(const Frame& F, const float* gain) {
    const bf16* z = (const bf16*)(F.ws + WS_Z); const float* bA = (const float*)(F.ws + WS_BA); const bf16* SP = (const bf16*)(F.ws + WS_SP); bf16* y = (bf16*)(F.ws + WS_Y);
    LAS bf16* qd = (LAS bf16*)F.lds;
    LAS bf16* ki = qd + 64 * 72;
    LAS bf16* vT = ki + 64 * 72;
    LAS bf16* scl = vT + 128 * 72;
    LAS float* part = (LAS float*)(scl + 64 * 72);
    const int r32 = F.lane & 31, hi = F.lane >> 5, s = F.tid >> 3, d8 = (F.tid & 7) * 8, e16 = (F.tid & 7) * 16;
    u32x4 qw, kw, vw0, vw1; f32x4 b0, b1;
#define GO_LOAD(u_) do { const int c_ = (u_) / 12, h_ = (u_) % 12, t0_ = c_ * 64; const bf16* zr_ = z + (size_t)(t0_ + s) * ZW; qw = *(const u32x4*)(zr_ + ZQ_A + h_ * 64 + d8); kw = *(const u32x4*)(zr_ + ZK_A + h_ * 64 + d8); \
        const float* bp_ = bA + (size_t)(t0_ + s) * 768 + h_ * 64 + d8; b0 = *(const f32x4*)bp_; b1 = *(const f32x4*)(bp_ + 4); vw0 = *(const u32x4*)(zr_ + ZV_A + h_ * 128 + e16); vw1 = *(const u32x4*)(zr_ + ZV_A + h_ * 128 + e16 + 8); } while (0)
    int u = blockIdx.x; if (u < NCH * 12) GO_LOAD(u);
    for (; u < NCH * 12; u += F.G) {
        const int c = u / 12, h = u % 12, t0 = c * 64;
        __syncthreads();
        { float qv[8], kv[8], qo[8], ko[8]; unpack8(qw, qv); unpack8(kw, kv);
#pragma unroll
          for (int j = 0; j < 4; ++j) { const float ea = __expf(b0[j]), eb = __expf(b1[j]); qo[j] = qv[j] * 0.125f * ea; qo[4 + j] = qv[4 + j] * 0.125f * eb; ko[j] = kv[j] / ea; ko[4 + j] = kv[4 + j] / eb; }
          *(LAS u32x4*)(qd + s * 72 + d8) = pack8f(qo); *(LAS u32x4*)(ki + s * 72 + d8) = pack8f(ko);
          const unsigned ww[8] = {vw0.x, vw0.y, vw0.z, vw0.w, vw1.x, vw1.y, vw1.z, vw1.w};
#pragma unroll
          for (int j = 0; j < 8; ++j) { vT[TPOS(e16 + 2 * j, s, 4)] = (bf16)(ww[j] & 0xffffu); vT[TPOS(e16 + 2 * j + 1, s, 4)] = (bf16)(ww[j] >> 16); } }
        __syncthreads();
        if (u + F.G < NCH * 12) GO_LOAD(u + F.G);
        const int et = F.wave >> 1, tt = F.wave & 1, t = 32 * tt + r32;
        bf16x8 sa[4]; u32x4 gzv[2];
        { const bf16* sp = SP + ((size_t)u * 128 + 32 * et + r32) * 64 + 8 * hi;
#pragma unroll
          for (int kk = 0; kk < 4; ++kk) sa[kk] = *(const bf16x8*)(sp + 16 * kk);
#pragma unroll
          for (int gp = 0; gp < 2; ++gp) gzv[gp] = *(const u32x4*)(z + (size_t)(t0 + t) * ZW + ZGATE_A + h * 128 + 32 * et + 8 * (2 * gp + hi)); }
        if (F.wave < 4) { const int st = F.wave >> 1; f32x16 acc = zero16();
#pragma unroll
            for (int kk = 0; kk < 4; ++kk) { const bf16x8 a = *(const LAS bf16x8*)(ki + (32 * st + r32) * 72 + 16 * kk + 8 * hi), b = *(const LAS bf16x8*)(qd + (32 * tt + r32) * 72 + 16 * kk + 8 * hi); acc = mfma32(a, b, acc); }
#pragma unroll
            for (int g = 0; g < 4; ++g) { const int sb = 32 * st + 8 * g + 4 * hi; float m[4];
#pragma unroll
                for (int j = 0; j < 4; ++j) m[j] = (sb + j <= t) ? acc[4 * g + j] : 0.f;
                u32x2 w; w.x = pk2(m[0], m[1]); w.y = pk2(m[2], m[3]); *(LAS u32x2*)(scl + t * 72 + sb) = w; } }
        __syncthreads();
        f32x16 acc = zero16();
#pragma unroll
        for (int kk = 0; kk < 4; ++kk) { const bf16x8 b = *(const LAS bf16x8*)(qd + t * 72 + 16 * kk + 8 * hi); acc = mfma32(sa[kk], b, acc); }
#pragma unroll
        for (int kk = 0; kk < 4; ++kk) { const bf16x8 a = *(const LAS bf16x8*)(vT + TRD(32 * et + r32, 2 * kk + hi, 4)), b = *(const LAS bf16x8*)(scl + t * 72 + 16 * kk + 8 * hi); acc = mfma32(a, b, acc); }
        float ss = 0.f;
#pragma unroll
        for (int r = 0; r < 16; ++r) ss += acc[r] * acc[r];
        ss += shx(ss, 32, F.lane);
        if (hi == 0) part[t * 4 + et] = ss;
        __syncthreads();
        const f32x4 pp = *(const LAS f32x4*)(part + t * 4); const float rs = 1.0f / sqrtf(((pp[0] + pp[1]) + (pp[2] + pp[3])) * (1.0f / 128.0f) + NORM_EPS);
#pragma unroll
        for (int gp = 0; gp < 2; ++gp) {
            float x[8];
#pragma unroll
            for (int j = 0; j < 4; ++j) { const auto r_ = __builtin_amdgcn_permlane32_swap(__float_as_uint(acc[8 * gp + j]), __float_as_uint(acc[8 * gp + 4 + j]), false, false); x[j] = __uint_as_float(r_[0]); x[4 + j] = __uint_as_float(r_[1]); }
            const int e0 = 32 * et + 8 * (2 * gp + hi); const f32x4 g0 = *(const f32x4*)(gain + h * 128 + e0), g1 = *(const f32x4*)(gain + h * 128 + e0 + 4);
            float ga[8], o[8]; unpack8(gzv[gp], ga);
#pragma unroll
            for (int j = 0; j < 8; ++j) o[j] = x[j] * rs * (j < 4 ? g0[j & 3] : g1[j & 3]) * siluf_(ga[j]);
            *(u32x4*)(y + (size_t)(t0 + t) * DM + YA + h * 128 + e0) = pack8f(o); }
    }
#undef GO_LOAD
}

__device__ __forceinline__ void p6_mlstm_out(const Frame& F, const float* gain) {
    const bf16* z = (const bf16*)(F.ws + WS_Z); const bf16* cq = (const bf16*)(F.ws + WS_CQ); const bf16* ck = (const bf16*)(F.ws + WS_CK); const float* mg = (const float*)(F.ws + WS_MG);
    const bf16* CP = (const bf16*)(F.ws + WS_CP); bf16* y = (bf16*)(F.ws + WS_Y);
    LAS bf16* qs = (LAS bf16*)F.lds;
    LAS bf16* ks = qs + 64 * 136;
    LAS bf16* vT = ks + 64 * 136;
    LAS bf16* pw = vT + 256 * 72;
    LAS float* fl = (LAS float*)(pw + 64 * 72);
    LAS float* bc = fl;
    LAS float* ig = fl + 64;
    LAS float* mt = fl + 128;
    LAS float* wi = fl + 192;
    LAS float* qn = fl + 256;
    LAS float* rp = fl + 320;
    LAS float* np = fl + 448;
    LAS float* sp = fl + 576;
    const int r32 = F.lane & 31, hi = F.lane >> 5, s = F.tid >> 3, d16 = (F.tid & 7) * 16, e32 = (F.tid & 7) * 32;
    u32x4 qw0, qw1, kw0, kw1, vw[4]; float gb = 0.f, gi = 0.f, gn0 = 0.f, gn1 = 0.f, gmp = 0.f;
#define MO_LOAD(u_) do { const int c_ = (u_) / 6, h_ = (u_) % 6, t0_ = c_ * 64; const bf16* qp_ = cq + (size_t)(t0_ + s) * 768 + h_ * 128 + d16; const bf16* kp_ = ck + (size_t)(t0_ + s) * 768 + h_ * 128 + d16; \
        qw0 = *(const u32x4*)qp_; qw1 = *(const u32x4*)(qp_ + 8); kw0 = *(const u32x4*)kp_; kw1 = *(const u32x4*)(kp_ + 8); \
        const bf16* vp_ = z + (size_t)(t0_ + s) * ZW + ZV_C + h_ * 256 + e32; _Pragma("unroll") for (int q_ = 0; q_ < 4; ++q_) vw[q_] = *(const u32x4*)(vp_ + 8 * q_); \
        gmp = mg[MG_MP + (size_t)(u_)]; \
        if (F.wave == 0) { gb = mg[MG_B + (size_t)(t0_ + F.lane) * 8 + h_]; gi = mg[MG_I + (size_t)(t0_ + F.lane) * 8 + h_]; } \
        if (F.wave == 1) { gn0 = mg[MG_NP + (size_t)(u_) * 128 + F.lane]; gn1 = mg[MG_NP + (size_t)(u_) * 128 + 64 + F.lane]; } } while (0)
    int u = blockIdx.x; if (u < NCH * 6) MO_LOAD(u);
    for (; u < NCH * 6; u += F.G) {
        const int c = u / 6, h = u % 6, t0 = c * 64;
        __syncthreads();
        { *(LAS u32x4*)(qs + s * 136 + d16) = qw0; *(LAS u32x4*)(qs + s * 136 + d16 + 8) = qw1; *(LAS u32x4*)(ks + s * 136 + d16) = kw0; *(LAS u32x4*)(ks + s * 136 + d16 + 8) = kw1;
#pragma unroll
          for (int q = 0; q < 4; ++q) { const unsigned ww[4] = {vw[q].x, vw[q].y, vw[q].z, vw[q].w};
#pragma unroll
              for (int j = 0; j < 4; ++j) { vT[TPOS(e32 + 8 * q + 2 * j, s, 5)] = (bf16)(ww[j] & 0xffffu); vT[TPOS(e32 + 8 * q + 2 * j + 1, s, 5)] = (bf16)(ww[j] >> 16); } } }
        const float m_prev = gmp;
        if (F.wave == 0) { const float b = gb, ii = gi; float pm = ii - b;
#pragma unroll
            for (int o = 1; o < 64; o <<= 1) { const float nb = shup(pm, o, F.lane); if (F.lane >= o) pm = fmaxf(pm, nb); }
            const float m = b + fmaxf(m_prev, pm); bc[F.lane] = b; ig[F.lane] = ii; mt[F.lane] = m; wi[F.lane] = __expf(b + m_prev - m); }
        if (F.wave == 1) { np[F.lane] = gn0; np[64 + F.lane] = gn1; }
        __syncthreads();
        if (u + F.G < NCH * 6) MO_LOAD(u + F.G);
        const int et = F.wave; bf16x8 ca[8];
        { const bf16* cp = CP + ((size_t)u * 256 + 32 * et + r32) * 128 + 8 * hi;
#pragma unroll
          for (int kk = 0; kk < 8; ++kk) ca[kk] = *(const bf16x8*)(cp + 16 * kk); }
        if (F.wave >= 4) { const int tq = (F.tid - 256) >> 2, qq = (F.tid - 256) & 3; float s = 0.f;
#pragma unroll 8
            for (int d = 0; d < 32; ++d) s += bf2f(qs[tq * 136 + qq * 32 + d]) * np[qq * 32 + d];
            s += shx(s, 1, F.lane); s += shx(s, 2, F.lane); if (qq == 0) qn[tq] = s; }
        else { const int st = F.wave >> 1, tt = F.wave & 1, t = 32 * tt + r32; f32x16 acc = zero16();
#pragma unroll
            for (int kk = 0; kk < 8; ++kk) { const bf16x8 a = *(const LAS bf16x8*)(ks + (32 * st + r32) * 136 + 16 * kk + 8 * hi), b = *(const LAS bf16x8*)(qs + t * 136 + 16 * kk + 8 * hi); acc = mfma32(a, b, acc); }
            const float bt = bc[t], mtt = mt[t]; float rsum = 0.f;
#pragma unroll
            for (int g = 0; g < 4; ++g) { const int sb = 32 * st + 8 * g + 4 * hi; float m[4];
#pragma unroll
                for (int j = 0; j < 4; ++j) { const int s = sb + j; const float w = (s <= t) ? __expf(bt - bc[s] + ig[s] - mtt) : 0.f; m[j] = acc[4 * g + j] * w; rsum += m[j]; }
                u32x2 w2; w2.x = pk2(m[0], m[1]); w2.y = pk2(m[2], m[3]); *(LAS u32x2*)(pw + t * 72 + sb) = w2; }
            rsum += shx(rsum, 32, F.lane); if (hi == 0) rp[t * 2 + st] = rsum; }
        __syncthreads();
        f32x16 hv[2];
        { bf16x8 va[4];
#pragma unroll
          for (int kk = 0; kk < 4; ++kk) va[kk] = *(const LAS bf16x8*)(vT + TRD(32 * et + r32, 2 * kk + hi, 5));
#pragma unroll
          for (int tt = 0; tt < 2; ++tt) { const int t = 32 * tt + r32; f32x16 aI = zero16(), aA = zero16();
#pragma unroll
              for (int kk = 0; kk < 8; ++kk) { const bf16x8 b = *(const LAS bf16x8*)(qs + t * 136 + 16 * kk + 8 * hi); aI = mfma32(ca[kk], b, aI); }
#pragma unroll
              for (int kk = 0; kk < 4; ++kk) { const bf16x8 b = *(const LAS bf16x8*)(pw + t * 72 + 16 * kk + 8 * hi); aA = mfma32(va[kk], b, aA); }
              const float w = wi[t], den = w * qn[t] + rp[t * 2] + rp[t * 2 + 1], dn = 1.0f / fmaxf(fabsf(den), __expf(-mt[t])); float ss = 0.f;
#pragma unroll
              for (int r = 0; r < 16; ++r) { const float x = (w * aI[r] + aA[r]) * dn; hv[tt][r] = x; ss += x * x; }
              ss += shx(ss, 32, F.lane); if (hi == 0) sp[t * 8 + et] = ss; } }
        __syncthreads();
#pragma unroll
        for (int tt = 0; tt < 2; ++tt) { const int t = 32 * tt + r32; const f32x4 p0 = *(const LAS f32x4*)(sp + t * 8), p1 = *(const LAS f32x4*)(sp + t * 8 + 4);
            const float rs = 1.0f / sqrtf((((p0[0] + p0[1]) + (p0[2] + p0[3])) + ((p1[0] + p1[1]) + (p1[2] + p1[3]))) * (1.0f / 256.0f) + NORM_EPS);
            const bf16* zr = z + (size_t)(t0 + t) * ZW + h * 256;
#pragma unroll
            for (int gp = 0; gp < 2; ++gp) {
                float x[8];
#pragma unroll
                for (int j = 0; j < 4; ++j) { const auto r_ = __builtin_amdgcn_permlane32_swap(__float_as_uint(hv[tt][8 * gp + j]), __float_as_uint(hv[tt][8 * gp + 4 + j]), false, false); x[j] = __uint_as_float(r_[0]); x[4 + j] = __uint_as_float(r_[1]); }
                const int e0 = 32 * et + 8 * (2 * gp + hi); const f32x4 g0 = *(const f32x4*)(gain + h * 256 + e0), g1 = *(const f32x4*)(gain + h * 256 + e0 + 4);
                float oa[8], ga[8], o[8]; unpack8(*(const u32x4*)(zr + ZO_C + e0), oa); unpack8(*(const u32x4*)(zr + ZGATE_C + e0), ga);
#pragma unroll
                for (int j = 0; j < 8; ++j) o[j] = x[j] * rs * (j < 4 ? g0[j & 3] : g1[j & 3]) * sigmoidf_(oa[j]) * siluf_(ga[j]);
                *(u32x4*)(y + (size_t)(t0 + t) * DM + YC + h * 256 + e0) = pack8f(o); } }
    }
#undef MO_LOAD
}

namespace dsa {
constexpr int D = 128, NW = 8, QBLK = 32, KVBLK = 64, QB = NW * QBLK;
constexpr int SHM_V = KVBLK * D * 2, SHM_K = KVBLK * D * 2;
constexpr int LDS_BYTES = 2 * SHM_V + 2 * SHM_K + NW * 64 * 4;
constexpr float SCALE = 0.08838834764831845f;
constexpr float THR = 8.f;
constexpr bool WSKIP = false;
constexpr size_t VOFF = (WS_VA - WS_KA) / 2;
typedef short s16x4 __attribute__((ext_vector_type(4)));
template <class A, class Bt> struct same_t { static constexpr bool v = false; };
template <class A> struct same_t<A, A> { static constexpr bool v = true; };
#define KSWZ(row, colB) ((row) * 256 + ((colB) ^ (((row) & 7) << 4)))
#define SBAR() __builtin_amdgcn_sched_barrier(0)
__device__ __forceinline__ int v_st(int k, int c) { const int kk = (k & ~0xC) | ((k & 4) << 1) | ((k & 8) >> 1); return ((kk >> 3) * 4 + (c >> 5)) * 512 + ((kk & 7) * 32 + (c & 31)) * 2; }
__device__ __forceinline__ int v_rd_base(int lane) { return ((lane & 3) << 3) | (((lane >> 2) & 3) << 6) | (((lane >> 4) & 1) << 5) | (((lane >> 5) & 1) << 8); }
constexpr int v_rd_off(int d0, int ks, int half) { return d0 * 512 + ks * 4096 + half * 2048; }
__device__ __forceinline__ unsigned cvtpk(float lo, float hi) {
    unsigned r; asm volatile("v_cvt_pk_bf16_f32 %0, %1, %2" : "=v"(r) : "v"(lo), "v"(hi)); return r;
}
__device__ __forceinline__ bf16x8 pack8(f32x4 a, f32x4 b) {
    u32x4 w = {cvtpk(a[0], a[1]), cvtpk(a[2], a[3]), cvtpk(b[0], b[1]), cvtpk(b[2], b[3])};
    return *reinterpret_cast<bf16x8*>(&w);
}
template <class T> __device__ __forceinline__ bf16x8 load8(const T* p) {
    if constexpr (same_t<T, float>::v) { return pack8(*(const f32x4*)p, *(const f32x4*)(p + 4)); }
    else { return *reinterpret_cast<const bf16x8*>(p); }
}
__device__ __forceinline__ void mask_bits(f32x16& p0, f32x16& p1, unsigned w) {
#pragma unroll
    for (int r = 0; r < 16; ++r) {
        const unsigned m0 = (unsigned)__builtin_amdgcn_sbfe((int)w, r, 1), m1 = (unsigned)__builtin_amdgcn_sbfe((int)w, 16 + r, 1);
        p0[r] = __uint_as_float((__float_as_uint(p0[r]) & m0) | (0xff800000u & ~m0));
        p1[r] = __uint_as_float((__float_as_uint(p1[r]) & m1) | (0xff800000u & ~m1));
    }
}
__device__ __forceinline__ void partialSM(f32x16& p0, f32x16& p1, float& m_reg, float& mn, float& alpha) {
    float pmax = p0[0]; for (int r = 1; r < 16; ++r) pmax = fmaxf(pmax, p0[r]); for (int r = 0; r < 16; ++r) pmax = fmaxf(pmax, p1[r]);
    { auto rr = __builtin_amdgcn_permlane32_swap(__float_as_uint(pmax), __float_as_uint(pmax), false, false);
      pmax = fmaxf(__uint_as_float(rr[0]), __uint_as_float(rr[1])); }
    constexpr float C2 = 1.4426950408889634f * SCALE;
    if (__builtin_expect(__all((pmax - m_reg) * SCALE <= THR), 1)) { mn = m_reg; alpha = 1.f; }
    else { mn = fmaxf(m_reg, pmax); alpha = __builtin_amdgcn_exp2f((m_reg - mn) * C2); m_reg = mn; }
    const float mnL = -mn * C2;
    for (int r = 0; r < 16; ++r) p0[r] = fmaf(p0[r], C2, mnL); for (int r = 0; r < 16; ++r) p1[r] = fmaf(p1[r], C2, mnL);
    for (int r = 0; r < 16; ++r) p0[r] = __builtin_amdgcn_exp2f(p0[r]);
}
__device__ __forceinline__ void finishSM(f32x16& p0, f32x16& p1, float alpha, float& l_reg, bf16x8& pa0, bf16x8& pa1, bf16x8& pa2, bf16x8& pa3) {
    for (int r = 0; r < 16; ++r) p1[r] = __builtin_amdgcn_exp2f(p1[r]);
    float ps = 0; for (int r = 0; r < 16; ++r) ps += p0[r]; for (int r = 0; r < 16; ++r) ps += p1[r];
    { auto rr = __builtin_amdgcn_permlane32_swap(__float_as_uint(ps), __float_as_uint(ps), false, false);
      ps = __uint_as_float(rr[0]) + __uint_as_float(rr[1]); }
    l_reg = l_reg * alpha + ps;
#define PK4(P, B_, OUT) do { unsigned a0 = cvtpk(P[B_+0], P[B_+1]), a1 = cvtpk(P[B_+2], P[B_+3]);                          \
        unsigned b0 = cvtpk(P[B_+4], P[B_+5]), b1 = cvtpk(P[B_+6], P[B_+7]);                                             \
        auto r0 = __builtin_amdgcn_permlane32_swap(a0, b0, false, false); auto r1 = __builtin_amdgcn_permlane32_swap(a1, b1, false, false); \
        u32x4 w = {r0[0], r1[0], r0[1], r1[1]}; OUT = *reinterpret_cast<bf16x8*>(&w); } while (0)
    PK4(p0, 0, pa0); PK4(p0, 8, pa1); PK4(p1, 0, pa2); PK4(p1, 8, pa3);
#undef PK4
}
template <int KB, bool SK>
__device__ __forceinline__ void qkt(f32x16& p0, f32x16& p1, const char* K_lds, int r32, int hi, const bf16x8* qr, bool act) {
    if (SK && !act) { const float NEG = -__builtin_inff();
#pragma unroll
        for (int r = 0; r < 16; ++r) { p0[r] = NEG; p1[r] = NEG; } return; }
    p0 = f32x16{}; p1 = f32x16{};
    const char* kb[4];
#pragma unroll
    for (int dd = 0; dd < 4; ++dd) kb[dd] = K_lds + KB * SHM_K + KSWZ(r32, (dd * 16 + hi * 8) * 2);
#pragma unroll
    for (int d0 = 0; d0 < 8; ++d0) { const char* a = kb[d0 & 3] + (d0 >> 2) * 128;
        bf16x8 b0 = *reinterpret_cast<const bf16x8*>(a);
        bf16x8 b1 = *reinterpret_cast<const bf16x8*>(a + 32 * 256);
        p0 = __builtin_amdgcn_mfma_f32_32x32x16_bf16(b0, qr[d0], p0, 0, 0, 0);
        p1 = __builtin_amdgcn_mfma_f32_32x32x16_bf16(b1, qr[d0], p1, 0, 0, 0); }
}
template <int VB, bool SK>
__device__ __forceinline__ void pv_tile(f32x16* o, int vb0, bf16x8 pa0, bf16x8 pa1, bf16x8 pa2, bf16x8 pa3, bool act) {
    if (SK && !act) return;
#define TRRD(dst, off) asm volatile("ds_read_b64_tr_b16 %0, %1 offset:%2" : "=&v"(dst) : "v"(vb0), "i"(off) : "memory")
#define PV_D0(d0) do { s16x4 l0, l1, l2, l3, h0, h1, h2, h3; constexpr int b_ = VB * SHM_V + v_rd_off(d0, 0, 0);     \
        TRRD(l0, b_); TRRD(h0, b_ + 2048); TRRD(l1, b_ + 4096); TRRD(h1, b_ + 6144); TRRD(l2, b_ + 8192); TRRD(h2, b_ + 10240); TRRD(l3, b_ + 12288); TRRD(h3, b_ + 14336); \
        asm volatile("s_waitcnt lgkmcnt(0)" ::: "memory"); SBAR();                 \
        o[d0] = __builtin_amdgcn_mfma_f32_32x32x16_bf16(pa0, (bf16x8){l0[0], l0[1], l0[2], l0[3], h0[0], h0[1], h0[2], h0[3]}, o[d0], 0, 0, 0);   \
        o[d0] = __builtin_amdgcn_mfma_f32_32x32x16_bf16(pa1, (bf16x8){l1[0], l1[1], l1[2], l1[3], h1[0], h1[1], h1[2], h1[3]}, o[d0], 0, 0, 0);   \
        o[d0] = __builtin_amdgcn_mfma_f32_32x32x16_bf16(pa2, (bf16x8){l2[0], l2[1], l2[2], l2[3], h2[0], h2[1], h2[2], h2[3]}, o[d0], 0, 0, 0);   \
        o[d0] = __builtin_amdgcn_mfma_f32_32x32x16_bf16(pa3, (bf16x8){l3[0], l3[1], l3[2], l3[3], h3[0], h3[1], h3[2], h3[3]}, o[d0], 0, 0, 0); } while (0)
    PV_D0(0); PV_D0(1); PV_D0(2); PV_D0(3);
#undef PV_D0
#undef TRRD
}
template <class TIn, class TOut> struct BlockRef { const TIn* Q; const TIn* K; const unsigned long long* M; int P0; const unsigned short* G; unsigned short* Y; };
template <class TIn> struct Seam {
    bf16x8 qr[8];
    bf16x8 st_v0, st_v1, st_k0, st_k1; f32x4 sf0, sf1, sf2, sf3;
    f32x4 tq[16];
};
__device__ __forceinline__ int swa_jlo(int P0, int W) { const int lowk = P0 - W + 1; return lowk > 0 ? lowk / KVBLK : 0; }
#define ROW(p, k0, rr) ((p) + (size_t)((k0) + (rr)) * D + sc)
#define VMW() asm volatile("s_waitcnt vmcnt(0)" ::: "memory")
#define VMWN(n) asm volatile("s_waitcnt vmcnt(%0)" :: "i"(n) : "memory")
#define SLOAD_H(Kp, Vp, k0) do { S.st_v0 = load8<TIn>(ROW(Vp, k0, sr)); S.st_v1 = load8<TIn>(ROW(Vp, k0, 32 + sr));              \
                         S.st_k0 = load8<TIn>(ROW(Kp, k0, sr)); S.st_k1 = load8<TIn>(ROW(Kp, k0, 32 + sr)); } while (0)
#define SWRITE_HK(bf) do { *(bf16x8*)(K_lds + (bf) * SHM_K + kws) = S.st_k0; *(bf16x8*)(K_lds + (bf) * SHM_K + kws + 32 * 256) = S.st_k1; } while (0)
#define SWRITE_HV(bf) do { *(bf16x8*)(V_lds + (bf) * SHM_V + vst0) = S.st_v0; *(bf16x8*)(V_lds + (bf) * SHM_V + vst1) = S.st_v1; } while (0)
#define SWRITE_H(bf) do { SWRITE_HV(bf); SWRITE_HK(bf); } while (0)
#define SLOAD_F(p, k0) do { S.sf0 = *(const f32x4*)ROW(p, k0, sr); S.sf1 = *(const f32x4*)(ROW(p, k0, sr) + 4);                \
                            S.sf2 = *(const f32x4*)ROW(p, k0, 32 + sr); S.sf3 = *(const f32x4*)(ROW(p, k0, 32 + sr) + 4); } while (0)
#define SWRITE_KF(bf) do { *(bf16x8*)(K_lds + (bf) * SHM_K + kws) = pack8(S.sf0, S.sf1); *(bf16x8*)(K_lds + (bf) * SHM_K + kws + 32 * 256) = pack8(S.sf2, S.sf3); } while (0)
#define SWRITE_VF(bf) do { *(bf16x8*)(V_lds + (bf) * SHM_V + vst0) = pack8(S.sf0, S.sf1); *(bf16x8*)(V_lds + (bf) * SHM_V + vst1) = pack8(S.sf2, S.sf3); } while (0)
template <class TIn, class TOut>
__device__ __forceinline__ void causal_swa_prime(const BlockRef<TIn, TOut>& cur, int W, char* lds, Seam<TIn>& S) {
    constexpr bool F32 = same_t<TIn, float>::v;
    int tid_l = threadIdx.x; asm volatile("" : "+v"(tid_l));
    const int tid = tid_l, wid = __builtin_amdgcn_readfirstlane(tid >> 6), lane = tid & 63, r32 = lane & 31, hi = lane >> 5;
    const int sr = tid >> 4, sc = (tid & 15) * 8, kws = KSWZ(sr, sc * 2); char* K_lds = lds + 2 * SHM_V;
    const int kb0 = swa_jlo(cur.P0, W) * KVBLK;
    for (int d0 = 0; d0 < 8; ++d0) S.qr[d0] = load8<TIn>(cur.Q + (size_t)(wid * QBLK + r32) * D + d0 * 16 + hi * 8);
    if constexpr (F32) { SLOAD_F((const float*)cur.K, kb0); VMW(); SWRITE_KF(0); SBAR(); SLOAD_F((const float*)(cur.K + VOFF), kb0); }
    else { SLOAD_H(cur.K, (cur.K + VOFF), kb0); VMW(); SWRITE_HK(0); }
    __syncthreads();
}
template <class TIn, class TOut>
__device__ __forceinline__ void causal_swa_block(const BlockRef<TIn, TOut>& cur, const BlockRef<TIn, TOut>& nxt, int skv, int W, char* lds, Seam<TIn>& S) {
    constexpr bool F32 = same_t<TIn, float>::v;
    int tid_l = threadIdx.x; asm volatile("" : "+v"(tid_l));
    const int tid = tid_l, wid = __builtin_amdgcn_readfirstlane(tid >> 6), lane = tid & 63, r32 = lane & 31, hi = lane >> 5;
    const int j_lo = swa_jlo(cur.P0, W);
    int j_hi = (cur.P0 + QB - 1) / KVBLK + 1; if (j_hi > skv / KVBLK) j_hi = skv / KVBLK;
    const int NT = j_hi - j_lo;
    const int kbn = swa_jlo(nxt.P0, W) * KVBLK;
    const int qlo = cur.P0 + wid * QBLK, qm = qlo + r32 - 4 * hi;
    char* V_lds = lds; char* K_lds = lds + 2 * SHM_V;
    float* ws = (float*)(lds + 2 * SHM_V + 2 * SHM_K) + wid * 64; float* li_l = ws, * al_l = ws + 32;
    float m_reg = -1e30f, l_reg = 0; f32x16 o[4] = {};
    const int sr = tid >> 4, sc = (tid & 15) * 8, vst0 = v_st(sr, sc), vst1 = v_st(32 + sr, sc), kws = KSWZ(sr, sc * 2);
    const int vb0 = (int)(uintptr_t)V_lds + v_rd_base(lane);
    const TIn* Kh = cur.K; const TIn* Vh = (cur.K + VOFF);
#define RESC(a) do { if (__any((a) < 1.f)) { if (hi == 0) al_l[r32] = (a); asm volatile("s_waitcnt lgkmcnt(0)" ::: "memory");              \
                     for (int d_ = 0; d_ < 4; ++d_) for (int r = 0; r < 16; ++r) o[d_][r] *= al_l[crow(r, hi)]; } } while (0)
#define KBASE(t) ((j_lo + (t)) * KVBLK)
#define ACT(t) (KBASE(t) <= qlo + QBLK - 1 && KBASE(t) + KVBLK - 1 >= qlo - W + 1)
#define MASKT(P0_, P1_, MW_) mask_bits(P0_, P1_, MW_)
    constexpr int NQL = F32 ? 16 : 8;
    constexpr bool SK = WSKIP && !F32;
#define SEAM_K0() do { VMWN(NQL); if constexpr (F32) { SWRITE_KF(0); SBAR(); SLOAD_F((const float*)(nxt.K + VOFF), kbn); } else { SWRITE_HK(0); } SBAR(); } while (0)
    f32x16 pA0, pA1, pB0, pB1; float mnA, mnB, alA, alB; bf16x8 pa0, pa1, pa2, pa3;
    const unsigned* M32 = (const unsigned*)cur.M;
#define MOFF() ({ int l_ = lane; asm volatile("" : "+v"(l_)); (unsigned)(wid * QBLK + (l_ & 31)) * 512u + (unsigned)(l_ >> 5); })
    unsigned mw = M32[MOFF()];
    if constexpr (F32) { VMW(); SWRITE_VF(0); SBAR(); } else { SWRITE_HV(0); SBAR(); }
    if (NT > 1) { if constexpr (F32) SLOAD_F((const float*)Kh, KBASE(1)); else SLOAD_H(Kh, Vh, KBASE(1)); }
    SBAR(); qkt<0, SK>(pA0, pA1, K_lds, r32, hi, S.qr, ACT(0));
    if constexpr (F32) { if (NT > 1) { VMW(); SWRITE_KF(1); SBAR(); SLOAD_F((const float*)Vh, KBASE(1)); } }
    MASKT(pA0, pA1, mw); partialSM(pA0, pA1, m_reg, mnA, alA);
    if (NT > 1) { VMW(); if constexpr (F32) { SWRITE_VF(1); SBAR(); if (NT > 2) SLOAD_F((const float*)Kh, KBASE(2)); } else SWRITE_H(1); }
    __syncthreads();
#define HALF_STEP(PX0, PX1, mnX, alX, PY0, PY1, alY, t, KB, VB, SB) do {                                                      \
        mw = M32[MOFF() + 2u * (unsigned)(t)];                                                                                     \
        SBAR(); qkt<KB, SK>(PX0, PX1, K_lds, r32, hi, S.qr, ACT(t));                                             \
        finishSM(PY0, PY1, alY, l_reg, pa0, pa1, pa2, pa3); SBAR();                                                           \
        if ((t) + 1 < NT) { if constexpr (F32) { VMW(); SWRITE_KF(SB); SBAR(); SLOAD_F((const float*)Vh, KBASE((t) + 1)); }  \
                            else { SLOAD_H(Kh, Vh, KBASE((t) + 1)); } SBAR(); }                                               \
        pv_tile<VB, SK>(o, vb0, pa0, pa1, pa2, pa3, ACT((t) - 1)); MASKT(PX0, PX1, mw); partialSM(PX0, PX1, m_reg, mnX, alX);                                        \
        __syncthreads();                                                                                                      \
        if ((t) + 1 < NT) { VMW(); if constexpr (F32) { SWRITE_VF(SB); SBAR(); if ((t) + 2 < NT) SLOAD_F((const float*)Kh, KBASE((t) + 2)); } \
                            else { SWRITE_H(SB); } }                                                                          \
        RESC(alX); __syncthreads(); } while (0)
    for (int t = 1; t + 1 < NT; t += 2) {
        HALF_STEP(pB0, pB1, mnB, alB, pA0, pA1, alA, t, 1, 0, 0);
        HALF_STEP(pA0, pA1, mnA, alA, pB0, pB1, alB, t + 1, 0, 1, 1);
    }
    const bool even = (NT & 1) == 0;
    if (even) { mw = M32[MOFF() + 2u * (unsigned)(NT - 1)]; SBAR(); qkt<1, SK>(pB0, pB1, K_lds, r32, hi, S.qr, ACT(NT - 1)); SBAR(); }
#define QROW(e) (nxt.Q + (size_t)(wid * QBLK + r32) * D + ((e) >> 1) * 16 + hi * 8 + ((e) & 1) * 4)
    if constexpr (F32) { SLOAD_F((const float*)nxt.K, kbn); SBAR();
#pragma unroll
        for (int e = 0; e < 8; ++e) S.tq[e] = *(const f32x4*)QROW(e); }
    else { SLOAD_H(nxt.K, (nxt.K + VOFF), kbn); SBAR();
#pragma unroll
        for (int d0 = 0; d0 < 8; ++d0) S.qr[d0] = load8<TIn>(nxt.Q + (size_t)(wid * QBLK + r32) * D + d0 * 16 + hi * 8); }
    SBAR();
    finishSM(pA0, pA1, alA, l_reg, pa0, pa1, pa2, pa3); SBAR();
    if constexpr (F32) {
#pragma unroll
        for (int e = 8; e < 16; ++e) S.tq[e] = *(const f32x4*)QROW(e); SBAR(); }
#undef QROW
    pv_tile<0, SK>(o, vb0, pa0, pa1, pa2, pa3, ACT(even ? NT - 2 : NT - 1));
    if (even) { MASKT(pB0, pB1, mw); partialSM(pB0, pB1, m_reg, mnB, alB); __syncthreads(); RESC(alB);
        finishSM(pB0, pB1, alB, l_reg, pa0, pa1, pa2, pa3); SBAR(); pv_tile<1, SK>(o, vb0, pa0, pa1, pa2, pa3, ACT(NT - 1)); }
    SBAR(); SEAM_K0();
    if (hi == 0) li_l[r32] = l_reg; asm volatile("s_waitcnt lgkmcnt(0)" ::: "memory");
    float rli[16];
#pragma unroll
    for (int r = 0; r < 16; ++r) rli[r] = __builtin_amdgcn_rcpf(li_l[crow(r, hi)]);
    { unsigned short* ost = (unsigned short*)(lds + LDS_BYTES + wid * (16 * 136 * 2));
      const unsigned short* Gw = cur.G + (size_t)(wid * QBLK) * ZW; unsigned short* Yw = cur.Y + (size_t)(wid * QBLK) * DM;
#pragma unroll
      for (int ph = 0; ph < 2; ++ph) {
#pragma unroll
          for (int r = 8 * ph; r < 8 * ph + 8; ++r) { const int lrow = crow(r, hi) - 16 * ph;
#pragma unroll
              for (int d0 = 0; d0 < 4; ++d0) ost[lrow * 136 + d0 * 32 + r32] = f2bf(o[d0][r] * rli[r]); }
          asm volatile("s_waitcnt lgkmcnt(0)" ::: "memory");
#pragma unroll
          for (int i = 0; i < 4; ++i) { const int c = i * 64 + lane, lrow = c >> 4, d8 = (c & 15) * 8, row = 16 * ph + lrow; float ov[8], gv[8];
              unpack8(*(const u32x4*)(ost + lrow * 136 + d8), ov); unpack8(*(const u32x4*)(Gw + (size_t)row * ZW + d8), gv);
#pragma unroll
              for (int j = 0; j < 8; ++j) ov[j] *= siluf_(gv[j]);
              *(u32x4*)(Yw + (size_t)row * DM + d8) = pack8f(ov); }
          asm volatile("s_waitcnt lgkmcnt(0)" ::: "memory"); } }
    if constexpr (F32) {
#pragma unroll
        for (int d0 = 0; d0 < 8; ++d0) S.qr[d0] = pack8(S.tq[2 * d0], S.tq[2 * d0 + 1]); }
    __syncthreads();
#undef RESC
#undef KBASE
#undef ACT
#undef MASKT
#undef MOFF
#undef SEAM_K0
#undef HALF_STEP
}
#undef ROW
#undef VMW
#undef VMWN
#undef SLOAD_H
#undef SWRITE_HK
#undef SWRITE_HV
#undef SWRITE_H
#undef SLOAD_F
#undef SWRITE_KF
#undef SWRITE_VF

}

__device__ __forceinline__ void p6_dsa_attention(const Frame& F, char* lds_generic) {
    typedef dsa::BlockRef<unsigned short, unsigned short> Ref;
    const bf16* qA = (const bf16*)(F.ws + WS_QA); const bf16* kA = (const bf16*)(F.ws + WS_KA);
    const unsigned long long* mask = (const unsigned long long*)(F.ws + WS_MASK); const bf16* zz = (const bf16*)(F.ws + WS_Z); bf16* yy = (bf16*)(F.ws + WS_Y);
    constexpr int NQB = SEQ / dsa::QB, NITEM = 8 * (NQB / 2);
#define DSA_MKREF(R, item_, pass_) do { const int h_ = (item_) & 7, yy_ = (item_) >> 3, qb_ = (pass_) ? (NQB - 1 - yy_) : yy_, P0_ = qb_ * dsa::QB; \
        R.Q = qA + ((size_t)h_ * SEQ + P0_) * 128; R.K = kA + (size_t)h_ * SEQ * 128; R.M = mask + (size_t)P0_ * 256; R.P0 = P0_; R.G = zz + (size_t)P0_ * ZW + ZGATE_B + h_ * 128; R.Y = yy + (size_t)P0_ * DM + YB + h_ * 128; } while (0)
    int item = blockIdx.x; if (item >= NITEM) return;
    int pass = 0; Ref cur; DSA_MKREF(cur, item, 0);
    dsa::Seam<unsigned short> S;
    __syncthreads();
    dsa::causal_swa_prime<unsigned short, unsigned short>(cur, 1 << 30, lds_generic, S);
    for (;;) {
        const bool more_pass = pass == 0, more_item = item + F.G < NITEM, last = !more_pass && !more_item;
        int itn = item, pn = pass + 1; if (!more_pass) { pn = 0; itn = more_item ? item + F.G : item; }
        Ref nxt = cur; if (!last) DSA_MKREF(nxt, itn, pn);
        dsa::causal_swa_block<unsigned short, unsigned short>(cur, nxt, SEQ, 1 << 30, lds_generic, S);
        if (last) break;
        cur = nxt; item = itn; pass = pn;
    }
#undef DSA_MKREF
}

#ifdef DBG_CHECK
constexpr int DBG_T = 1024;
#if DBG_CHECK == 0
__device__ __forceinline__ void dbg_gla_seq(const Frame& F, float* ref) {
    const bf16* z = (const bf16*)(F.ws + WS_Z); const float* bA = (const float*)(F.ws + WS_BA);
    const int i4 = blockIdx.x * NTHR + F.tid; if (i4 >= 12 * 128 * 4) return;
    const int i = i4 >> 2, dq = (i4 & 3) * 16, h = i >> 7, e = i & 127; float S[16];
#pragma unroll
    for (int d = 0; d < 16; ++d) S[d] = 0.f;
    for (int t = 0; t < DBG_T; ++t) { const bf16* zr = z + (size_t)t * ZW; const float ve = bf2f(zr[ZV_A + h * 128 + e]); float o = 0.f;
#pragma unroll
        for (int d = 0; d < 16; ++d) { const float bt = bA[(size_t)t * 768 + h * 64 + dq + d], bp = (t & 63) ? bA[(size_t)(t - 1) * 768 + h * 64 + dq + d] : 0.f;
            S[d] = expf(bt - bp) * S[d] + bf2f(zr[ZK_A + h * 64 + dq + d]) * ve; o += bf2f(zr[ZQ_A + h * 64 + dq + d]) * 0.125f * S[d]; }
        o += shx(o, 1, F.lane); o += shx(o, 2, F.lane);
        if ((i4 & 3) == 0) ref[(size_t)t * 1536 + i] = o; }
}
#endif
#if DBG_CHECK == 1
__device__ __forceinline__ void dbg_mlstm_seq(const Frame& F, float* ref) {
    const bf16* z = (const bf16*)(F.ws + WS_Z); const bf16* cq = (const bf16*)(F.ws + WS_CQ); const bf16* ck = (const bf16*)(F.ws + WS_CK); const float* mg = (const float*)(F.ws + WS_MG);
    const int i = blockIdx.x * NTHR + F.tid; if (i >= 6 * 256) return;
    const int h = i >> 8, e = i & 255; float C[128]; float m = 0.f;
#pragma unroll
    for (int d = 0; d < 128; ++d) C[d] = 0.f;
    for (int t = 0; t < DBG_T; ++t) { const float bt = mg[MG_B + (size_t)t * 8 + h], bp = (t & 63) ? mg[MG_B + (size_t)(t - 1) * 8 + h] : 0.f, lf = bt - bp, ig = mg[MG_I + (size_t)t * 8 + h];
        const float mn = fmaxf(lf + m, ig), fa = expf(lf + m - mn), ia = expf(ig - mn); m = mn;
        const float ve = bf2f(z[(size_t)t * ZW + ZV_C + h * 256 + e]); float o = 0.f;
#pragma unroll
        for (int d = 0; d < 128; ++d) { C[d] = fa * C[d] + ia * bf2f(ck[(size_t)t * 768 + h * 128 + d]) * ve; o += bf2f(cq[(size_t)t * 768 + h * 128 + d]) * C[d]; }
        ref[(size_t)t * 1536 + i] = o;
#ifdef DBG_STATE
        if (t == 63) { const bf16* CP = (const bf16*)(F.ws + WS_CP); const float mp = mg[MG_MP + 6 + h]; float md = 0.f, mx = 0.f;
#pragma unroll
            for (int d = 0; d < 128; ++d) { const float a = bf2f(CP[((size_t)(6 + h) * 256 + e) * 128 + d]) * expf(mp - m), b = C[d]; md = fmaxf(md, fabsf(a - b)); mx = fmaxf(mx, fabsf(b)); }
            md = wave_max(md, F.lane); mx = wave_max(mx, F.lane);
            if (F.lane == 0) atomicMax((unsigned*)(F.ws + WS_CTL) + 2049, __float_as_uint(md / mx)); }
#endif
    }
}
#endif
__device__ __forceinline__ void dbg_compare(const Frame& F, const float* ref, const float* gainA, const float* gainC, int which, unsigned* res) {
    const bf16* z = (const bf16*)(F.ws + WS_Z); const bf16* y = (const bf16*)(F.ws + WS_Y);
    const int NH = which ? 6 : 12, HD = which ? 256 : 128;
    for (int u = F.gw; u < DBG_T * NH; u += F.NGW) { const int t = u / NH, h = u % NH; float ss = 0.f;
        for (int e = F.lane; e < HD; e += 64) { const float v = ref[(size_t)t * 1536 + h * HD + e]; ss += v * v; }
        ss = wave_sum(ss, F.lane); const float rs = 1.0f / sqrtf(ss / HD + NORM_EPS); float md = 0.f;
        for (int e = F.lane; e < HD; e += 64) { float v = ref[(size_t)t * 1536 + h * HD + e] * rs; float got;
            if (which) { v *= gainC[h * 256 + e] * sigmoidf_(bf2f(z[(size_t)t * ZW + ZO_C + h * 256 + e])) * siluf_(bf2f(z[(size_t)t * ZW + ZGATE_C + h * 256 + e])); got = bf2f(y[(size_t)t * DM + YC + h * 256 + e]); }
            else { v *= gainA[h * 128 + e] * siluf_(bf2f(z[(size_t)t * ZW + ZGATE_A + h * 128 + e])); got = bf2f(y[(size_t)t * DM + YA + h * 128 + e]); }
            md = fmaxf(md, fabsf(got - v)); }
        md = wave_max(md, F.lane); if (F.lane == 0) atomicMax(res, __float_as_uint(md)); }
}
#endif

struct Args { const void* in[18]; float* out; unsigned char* ws; };
#ifndef MIX_GLA
#define MIX_GLA 1
#endif
#ifndef MIX_MLSTM
#define MIX_MLSTM 1
#endif
#ifndef MIX_DSA
#define MIX_DSA 1
#endif

__global__ void __launch_bounds__(NTHR, 2) trunk_fwd(Args args) {
    extern __shared__ __attribute__((aligned(16))) unsigned char lds[];
    Frame F;
    F.lds = (LAS unsigned char*)lds; F.ws = args.ws;
    F.tid = threadIdx.x; F.lane = F.tid & 63; F.wave = __builtin_amdgcn_readfirstlane(F.tid >> 6);
    F.G = gridDim.x; { const int bx = blockIdx.x; F.vcu = (F.G % 8 == 0) ? (bx % 8) * (F.G / 8) + bx / 8 : bx; }
    F.gw = F.vcu * NWAVES + F.wave; F.NGW = F.G * NWAVES;
    volatile LAS unsigned* MISC = (volatile LAS unsigned*)(F.lds + MISC_OFF);
    for (int u = F.tid; u < (LDS_BYTES - RING_BYTES) / 4; u += NTHR) ((LAS unsigned*)(F.lds + RING_BYTES))[u] = 0u;
    __syncthreads();
    XcdBarrier bar = xcd_barrier_post((unsigned*)(F.ws + WS_CTL) + CW_BAR, MISC + 8);
#define GRID_BAR() do { size_t zb_ = 0; asm volatile("" : "+s"(zb_)); unsigned x_ = bar.x; asm volatile("" : "+s"(x_)); XcdBarrier b_; b_.bar = (unsigned*)(args.ws + zb_ + WS_CTL) + CW_BAR; b_.x = x_; b_.st = bar.st; xcd_barrier(b_); } while (0)
#define IN(k) ((const float*)args.in[k])
#define PHASE_BEGIN() do { size_t z_ = 0; asm volatile("" : "+s"(z_)); F.ws = args.ws + z_; unsigned lz_ = 0; asm volatile("" : "+s"(lz_)); F.lds = (LAS unsigned char*)lds + lz_; int t_ = threadIdx.x; asm volatile("" : "+v"(t_)); F.tid = t_; F.lane = t_ & 63; F.wave = __builtin_amdgcn_readfirstlane(t_ >> 6); \
        F.gw = F.vcu * NWAVES + F.wave; U = (bf16*)(F.ws + WS_U); Z = (bf16*)(F.ws + WS_Z); Y = (bf16*)(F.ws + WS_Y); PP = (bf16*)(F.ws + WS_PP); H = (float*)(F.ws + WS_H); } while (0)

    bf16 *U, *Z, *Y, *PP; float* H;

#ifndef DMASK
#define DMASK 0
#endif
#ifndef TPSHIFT
#define TPSHIFT 1.0f
#endif
#ifdef TPROBE
    unsigned long long tp_acc = 0, tp_t0 = 0; int tp_prev = -1;
#define TP_MARK(n) do { const unsigned long long t_ = __builtin_amdgcn_s_memrealtime(); if (tp_prev == TPROBE) tp_acc += t_ - tp_t0; tp_prev = (n); tp_t0 = t_; } while (0)
#else
#define TP_MARK(n) do { } while (0)
#endif
#define REP(n) for (int rep_ = 0; rep_ < (((DMASK >> (n)) & 1) ? 2 : 1); ++rep_)
#ifndef ONLY
#define PH(n) 1
#else
#define PH(n) ((n) == ONLY)
#endif
    TP_MARK(0); REP(0) { PHASE_BEGIN(); } REP(0) if (PH(0)) p0_prologue(F, IN(4), IN(13), IN(15), IN(16), IN(1), (const int*)args.in[2], IN(3), IN(14), IN(0));
    GRID_BAR();
    for (int L = 0; L < DEPTH; ++L) {

        TP_MARK(1); REP(1) { PHASE_BEGIN(); } REP(1) if (PH(1)) { if (L > 0) { reduce_rstd(F); GRID_BAR(); } }
        TP_MARK(2); REP(2) { PHASE_BEGIN(); } REP(2) if (PH(2)) { pg8::Gemm g{U, (const bf16*)(F.ws + WS_WIN) + (size_t)L * ZW * DM, SEQ, ZW, DM}; pg8::StaticOrder S; S.init(SEQ, ZW, F.G, (int)blockIdx.x);
          pg8::EpiBf16Row E{Z, ZW, (const float*)(F.ws + WS_RSTD), (bf16*)(F.ws + WS_QA), (bf16*)(F.ws + WS_IQ), (bf16*)(F.ws + WS_IK), ZQ_B, ZGATE_B, ZIQ, ZIK, SEQ};
          pg8::gemm_phase<pg8::EpiBf16Row, pg8::StaticOrder, true, true>(F.lds, g, S, E); }
        GRID_BAR();
        TP_MARK(3); REP(3) { PHASE_BEGIN(); } REP(3) if (PH(3)) p3_prep(F, IN(8) + (size_t)L * 4 * 768, IN(9) + (size_t)L * 4 * 768, IN(10) + L * 6, IN(11) + L * 6, IN(5) + (size_t)L * 16 * 768, IN(6) + (size_t)L * 768);
        GRID_BAR();
#if MIX_DSA
        TP_MARK(4); REP(4) { PHASE_BEGIN(); } REP(4) if (PH(4)) p4_index_scores(F);
#endif
#if MIX_GLA
        TP_MARK(5); REP(5) { PHASE_BEGIN(); } REP(5) if (PH(5)) p4_gla_local(F);
#endif
#if MIX_MLSTM
        TP_MARK(6); REP(6) { PHASE_BEGIN(); } REP(6) if (PH(6)) p4_mlstm_local(F);
#endif
        GRID_BAR();
#if MIX_GLA || MIX_MLSTM
        TP_MARK(7); REP(7) { PHASE_BEGIN(); } REP(7) if (PH(7)) p5_scans(F);
#endif
#if MIX_DSA
        TP_MARK(8); REP(8) { PHASE_BEGIN(); } REP(8) if (PH(8)) p5_select(F, (unsigned*)(F.ws + WS_CTL) + 8192 + 64 * L);
#endif
        GRID_BAR();
#if MIX_DSA
        TP_MARK(9); REP(9) { PHASE_BEGIN(); } REP(9) if (PH(9)) p6_dsa_attention(F, (char*)lds);
#else
        { unsigned zz_ = 0; asm volatile("" : "+v"(zz_));
        for (int i = blockIdx.x * NTHR + F.tid; i < SEQ * 128; i += F.G * NTHR) { const int t = i >> 7, c8 = i & 127; *(u32x4*)(Y + (size_t)t * DM + YB + c8 * 8) = (u32x4){zz_, zz_, zz_, zz_}; } }
#endif
#if MIX_GLA
        TP_MARK(10); REP(10) { PHASE_BEGIN(); } REP(10) if (PH(10)) p6_gla_out(F, IN(7) + (size_t)L * 1536);
#else
        { unsigned zz_ = 0; asm volatile("" : "+v"(zz_));
        for (int i = blockIdx.x * NTHR + F.tid; i < SEQ * 192; i += F.G * NTHR) { const int t = i / 192, c8 = i % 192; *(u32x4*)(Y + (size_t)t * DM + YA + c8 * 8) = (u32x4){zz_, zz_, zz_, zz_}; } }
#endif
#if MIX_MLSTM
        TP_MARK(11); REP(11) { PHASE_BEGIN(); } REP(11) if (PH(11)) p6_mlstm_out(F, IN(12) + (size_t)L * 1536);
#else
        { unsigned zz_ = 0; asm volatile("" : "+v"(zz_));
        for (int i = blockIdx.x * NTHR + F.tid; i < SEQ * 192; i += F.G * NTHR) { const int t = i / 192, c8 = i % 192; *(u32x4*)(Y + (size_t)t * DM + YC + c8 * 8) = (u32x4){zz_, zz_, zz_, zz_}; } }
#endif
        GRID_BAR();
#ifdef DBG_CHECK
        if (L == 0) { PHASE_BEGIN(); float* ref = (float*)(F.ws + WS_SCORE); unsigned* res = (unsigned*)(F.ws + WS_CTL) + 2048;
#if DBG_CHECK == 0
            dbg_gla_seq(F, ref);
#else
            dbg_mlstm_seq(F, ref);
#endif
            GRID_BAR();
            PHASE_BEGIN(); dbg_compare(F, (const float*)(F.ws + WS_SCORE), IN(7), IN(12), DBG_CHECK, (unsigned*)(F.ws + WS_CTL) + 2048);
            GRID_BAR(); }
#endif
        TP_MARK(12); REP(12) { PHASE_BEGIN(); } REP(12) if (PH(12)) { pg8::Gemm g{Y, (const bf16*)(F.ws + WS_WOUT) + (size_t)L * DM * DM, SEQ, DM, DM}; pg8::StaticOrder S; S.init(SEQ, DM, F.G, (int)blockIdx.x);
          pg8::EpiResB E{U, (bf16*)(F.ws + WS_HB2), (float*)(F.ws + WS_PART), DM};
          pg8::gemm_phase<pg8::EpiResB, pg8::StaticOrder, true, true>(F.lds, g, S, E); }
        GRID_BAR();
        TP_MARK(13); REP(13) { PHASE_BEGIN(); } REP(13) if (PH(13)) reduce_rstd(F);
        TP_MARK(14); REP(14) { PHASE_BEGIN(); } REP(14) if (PH(14)) { pg8::Gemm g{(const bf16*)(F.ws + WS_PBF) + (size_t)L * SEQ * DPLE, (const bf16*)(F.ws + WS_WPLE) + (size_t)L * DM * DPLE, SEQ, DM, DPLE}; pg8::StaticOrder S; S.init(SEQ, DM, F.G, (int)blockIdx.x);
          pg8::EpiBf16<0> E{PP, DM, nullptr, 0, 0, 1.f};
          pg8::gemm_phase<pg8::EpiBf16<0>, pg8::StaticOrder, true, true>(F.lds, g, S, E); }
        GRID_BAR();
        TP_MARK(15); REP(15) { PHASE_BEGIN(); } REP(15) if (PH(15)) { pg8::Gemm g{(const bf16*)(F.ws + WS_HB2), (const bf16*)(F.ws + WS_WGATE) + (size_t)L * DM * DM, SEQ, DM, DM}; pg8::StaticOrder S; S.init(SEQ, DM, F.G, (int)blockIdx.x);
          pg8::EpiGateB E{(const bf16*)(F.ws + WS_HB2), PP, (const float*)(F.ws + WS_RSTD), U, (float*)(F.ws + WS_PART), DM};
          pg8::gemm_phase<pg8::EpiGateB, pg8::StaticOrder, true, true>(F.lds, g, S, E); }
        GRID_BAR();
    }
    TP_MARK(16); REP(16) { PHASE_BEGIN(); } REP(16) if (PH(16)) rmsnorm_b2f(F, U, IN(17), args.out);
#ifdef TPROBE
    TP_MARK(99); GRID_BAR();
    if (blockIdx.x == 0 && threadIdx.x == 0) { const float us_ = 0.01f * (float)tp_acc * TPSHIFT; const float k_ = floorf(__logf(us_) * (1.0f / 0.0953102f)); args.out[0] = __expf((k_ + 0.5f) * 0.0953102f); }
#endif
#ifdef DBG_CHECK
#ifdef DBG_STATE
#define DBG_WORD 2049
#else
#define DBG_WORD 2048
#endif
    GRID_BAR();
    if (blockIdx.x == 0 && threadIdx.x == 0) args.out[0] = 10000.0f * __uint_as_float(__hip_atomic_load((unsigned*)(args.ws + WS_CTL) + DBG_WORD, __ATOMIC_RELAXED, __HIP_MEMORY_SCOPE_AGENT));
#endif
}

extern "C" void kernel_launch(void* const* d_in, const int* in_sizes, int n_in, void* d_out, int out_size, void* d_ws, size_t ws_size, hipStream_t stream) {
    static int grid = 0;
    if (grid == 0) {
        if (n_in != 18 || out_size != SEQ * DM || ws_size < WS_END) { fprintf(stderr, "kernel_launch: unexpected shapes (n_in %d, out %d, ws %zu < %zu)\n", n_in, out_size, ws_size, (size_t)WS_END); grid = -1; return; }
        int dev = 0, cus = 0, per_cu = 0;
        if (hipGetDevice(&dev) != hipSuccess || hipDeviceGetAttribute(&cus, hipDeviceAttributeMultiprocessorCount, dev) != hipSuccess) { grid = -1; return; }
        if (hipFuncSetAttribute((const void*)trunk_fwd, hipFuncAttributeMaxDynamicSharedMemorySize, LDS_BYTES) != hipSuccess) { fprintf(stderr, "kernel_launch: hipFuncSetAttribute failed\n"); grid = -1; return; }
        if (hipOccupancyMaxActiveBlocksPerMultiprocessor(&per_cu, (const void*)trunk_fwd, NTHR, LDS_BYTES) != hipSuccess || per_cu < 1) fprintf(stderr, "kernel_launch: occupancy query says %d\n", per_cu);
        (void)hipGetLastError();
        grid = cus;
    }
    if (grid < 0) return;
    if (hipMemsetAsync((char*)d_ws + WS_CTL, 0, CTL_ZERO_BYTES, stream) != hipSuccess) return;
    Args a{};
    for (int i = 0; i < 18; ++i) a.in[i] = d_in[i];
    a.out = (float*)d_out; a.ws = (unsigned char*)d_ws;
    hipLaunchKernelGGL(trunk_fwd, dim3(grid), dim3(NTHR), LDS_BYTES, stream, a);
}
```
